# Optimizing an MI355X kernel written in HIP

```python
import jax, jax.numpy as jnp
from jax import lax
import numpy as np

D_MODEL = 1024
BATCH = 8
SEQ = 4096
DEPTH = 1

MEM_LEN = 256
MLA_HEADS = 8
MLA_NOPE = 64
MLA_ROPE = 32
MLA_V = 64
MLA_Q_RANK = 256
MLA_KV_RANK = 128
FOX_HEADS = 8
FOX_HEAD_DIM = 64
MIX_WIDTH = MLA_HEADS * MLA_V + FOX_HEADS * FOX_HEAD_DIM
IN_COLS = MLA_Q_RANK + MLA_KV_RANK + MLA_ROPE + 3 * FOX_HEADS * FOX_HEAD_DIM + FOX_HEADS
X_HEADS = 4
X_HEAD_DIM = D_MODEL // X_HEADS
N_EXPERTS = 32
TOP_K = 4
D_EXPERT = D_MODEL
SWIGLU_LIMIT = 7.0
SWIGLU_ALPHA = 1.702
ROPE_THETA = 10000.0
Q_BLOCK = 128
EPS = 1e-6

kernel_name = "hymba_mla_fox_memxattn_moe"


def rmsnorm(x, g):
    xf = x.astype(jnp.float32)
    y = xf * lax.rsqrt(jnp.mean(xf * xf, axis=-1, keepdims=True) + EPS)
    return (y * g.astype(jnp.float32)).astype(x.dtype)


def rope(x, pos):
    half = x.shape[-1] // 2
    inv = ROPE_THETA ** (-jnp.arange(half, dtype=jnp.float32) / half)
    ang = pos.astype(jnp.float32)[:, None] * inv[None, :]
    cos = jnp.cos(ang).astype(x.dtype)
    sin = jnp.sin(ang).astype(x.dtype)
    x1, x2 = x[..., :half], x[..., half:]
    return jnp.concatenate([x1 * cos - x2 * sin, x2 * cos + x1 * sin], axis=-1)


def causal_block_attention(q, k, v, scale, log_decay=None):
    B, H, S, Dk = q.shape
    nb = S // Q_BLOCK
    q_blocks = q.reshape(B, H, nb, Q_BLOCK, Dk).transpose(2, 0, 1, 3, 4)
    key_pos = jnp.arange(S)
    if log_decay is None:
        xs = (jnp.arange(nb), q_blocks)
    else:
        c_blocks = log_decay.reshape(B, H, nb, Q_BLOCK).transpose(2, 0, 1, 3)
        xs = (jnp.arange(nb), q_blocks, c_blocks)

    def one_block(args):
        i, qi = args[0], args[1]
        s = jnp.einsum('bhqd,bhkd->bhqk', qi, k, preferred_element_type=jnp.float32) * scale
        if log_decay is not None:
            s = s + args[2][..., :, None] - log_decay.astype(jnp.float32)[:, :, None, :]
        q_pos = i * Q_BLOCK + jnp.arange(Q_BLOCK)
        mask = key_pos[None, :] <= q_pos[:, None]
        s = jnp.where(mask, s, jnp.finfo(jnp.float32).min)
        p = jax.nn.softmax(s, axis=-1)
        return jnp.einsum('bhqk,bhkd->bhqd', p.astype(v.dtype), v)

    out = lax.map(one_block, xs)
    return out.transpose(1, 2, 0, 3, 4).reshape(B, H, S, v.shape[-1])


def hybrid_mixer(hn, w_in, q_norm, w_q_up, kv_norm, w_kv_up, b_forget, g_out_mla, g_out_fox, w_o):
    B, S, _ = hn.shape
    proj = hn @ w_in
    fw = FOX_HEADS * FOX_HEAD_DIM
    cuts = list(np.cumsum([MLA_Q_RANK, MLA_KV_RANK, MLA_ROPE, fw, fw, fw]))
    q_lat, kv_lat, k_pe, fq, fk, fv, f_logit = jnp.split(proj, cuts, axis=-1)
    pos = jnp.arange(S)

    q = (rmsnorm(q_lat, q_norm) @ w_q_up).reshape(B, S, MLA_HEADS, MLA_NOPE + MLA_ROPE).transpose(0, 2, 1, 3)
    q_mla = jnp.concatenate([q[..., :MLA_NOPE], rope(q[..., MLA_NOPE:], pos)], axis=-1)
    kv = (rmsnorm(kv_lat, kv_norm) @ w_kv_up).reshape(B, S, MLA_HEADS, MLA_NOPE + MLA_V).transpose(0, 2, 1, 3)
    k_rope = rope(k_pe[:, None, :, :], pos)
    k_mla = jnp.concatenate([kv[..., :MLA_NOPE], jnp.broadcast_to(k_rope, (B, MLA_HEADS, S, MLA_ROPE))], axis=-1)
    v_mla = kv[..., MLA_NOPE:]
    o_mla = causal_block_attention(q_mla, k_mla, v_mla, (MLA_NOPE + MLA_ROPE) ** -0.5)

    heads = lambda t: t.reshape(B, S, FOX_HEADS, FOX_HEAD_DIM).transpose(0, 2, 1, 3)
    log_f = jax.nn.log_sigmoid(f_logit.astype(jnp.float32) + b_forget.astype(jnp.float32))
    c = jnp.cumsum(log_f, axis=1).transpose(0, 2, 1)
    o_fox = causal_block_attention(heads(fq), heads(fk), heads(fv), FOX_HEAD_DIM ** -0.5, c)

    o_mla = o_mla.transpose(0, 2, 1, 3).reshape(B, S, MLA_HEADS * MLA_V)
    o_fox = o_fox.transpose(0, 2, 1, 3).reshape(B, S, fw)
    o = jnp.concatenate([rmsnorm(o_mla, g_out_mla), rmsnorm(o_fox, g_out_fox)], axis=-1)
    return o @ w_o


def memory_cross_attention(hn, mem, mem_norm, w_xq, w_mem_kv, w_xo):
    B, S, _ = hn.shape
    M = mem.shape[1]
    mn = rmsnorm(mem, mem_norm)
    q = (hn @ w_xq).reshape(B, S, X_HEADS, X_HEAD_DIM)
    kv = (mn @ w_mem_kv).reshape(B, M, 2, X_HEADS, X_HEAD_DIM)
    k, v = kv[:, :, 0], kv[:, :, 1]
    s = jnp.einsum('bshd,bmhd->bhsm', q, k, preferred_element_type=jnp.float32) * X_HEAD_DIM ** -0.5
    p = jax.nn.softmax(s, axis=-1)
    o = jnp.einsum('bhsm,bmhd->bshd', p.astype(v.dtype), v).reshape(B, S, D_MODEL)
    return o @ w_xo


def moe_ffn(hn, w_router, b_router, w_gate_up, b_gate_up, w_down, b_down):
    B, S, D = hn.shape
    T = B * S
    xt = hn.reshape(T, D)
    logits = (xt @ w_router).astype(jnp.float32) + b_router.astype(jnp.float32)
    top_vals, top_idx = lax.top_k(logits, TOP_K)
    gates = jax.nn.softmax(top_vals, axis=-1)
    flat_e = top_idx.reshape(-1)
    order = jnp.argsort(flat_e)
    e_sorted = flat_e[order]
    tok = order // TOP_K
    group_sizes = jnp.bincount(flat_e, length=N_EXPERTS).astype(jnp.int32)
    xs = xt[tok]
    h = lax.ragged_dot(xs, w_gate_up, group_sizes) + b_gate_up[e_sorted]
    glu = jnp.minimum(h[:, ::2], SWIGLU_LIMIT)
    lin = jnp.clip(h[:, 1::2], -SWIGLU_LIMIT, SWIGLU_LIMIT)
    act = glu * jax.nn.sigmoid(SWIGLU_ALPHA * glu) * (lin + 1.0)
    y = lax.ragged_dot(act, w_down, group_sizes) + b_down[e_sorted]
    y = y * gates.reshape(-1)[order].astype(y.dtype)[:, None]
    out = jax.ops.segment_sum(y, tok, num_segments=T)
    return out.reshape(B, S, D)


def setup_inputs(seed: int = 0) -> dict:
    key = jax.random.key(seed)
    ks = jax.random.split(key, 32)
    f32 = jnp.float32
    L = DEPTH
    nrm = lambda k, shape, fan_in: jax.random.normal(k, shape, f32) * (fan_in ** -0.5)
    gain = lambda k, shape: 1.0 + 0.02 * jax.random.normal(k, shape, f32)
    small = lambda k, shape: 0.01 * jax.random.normal(k, shape, f32)
    return {
        "x": jax.random.normal(ks[0], (BATCH, SEQ, D_MODEL), f32),
        "mem": jax.random.normal(ks[1], (BATCH, MEM_LEN, D_MODEL), f32),
        "ln_mix": gain(ks[2], (L, D_MODEL)),
        "w_in": nrm(ks[3], (L, D_MODEL, IN_COLS), D_MODEL),
        "q_norm": gain(ks[4], (L, MLA_Q_RANK)),
        "w_q_up": nrm(ks[5], (L, MLA_Q_RANK, MLA_HEADS * (MLA_NOPE + MLA_ROPE)), MLA_Q_RANK),
        "kv_norm": gain(ks[6], (L, MLA_KV_RANK)),
        "w_kv_up": nrm(ks[7], (L, MLA_KV_RANK, MLA_HEADS * (MLA_NOPE + MLA_V)), MLA_KV_RANK),
        "b_forget": jax.random.uniform(ks[8], (L, FOX_HEADS), f32, minval=1.0, maxval=4.0),
        "g_out_mla": gain(ks[9], (L, MLA_HEADS * MLA_V)),
        "g_out_fox": gain(ks[10], (L, FOX_HEADS * FOX_HEAD_DIM)),
        "w_o": nrm(ks[11], (L, MIX_WIDTH, D_MODEL), MIX_WIDTH),
        "ln_cross": gain(ks[12], (L, D_MODEL)),
        "mem_norm": gain(ks[13], (L, D_MODEL)),
        "w_xq": nrm(ks[14], (L, D_MODEL, D_MODEL), D_MODEL),
        "w_mem_kv": nrm(ks[15], (L, D_MODEL, 2 * D_MODEL), D_MODEL),
        "w_xo": nrm(ks[16], (L, D_MODEL, D_MODEL), D_MODEL),
        "ln_ffn": gain(ks[17], (L, D_MODEL)),
        "w_router": nrm(ks[18], (L, D_MODEL, N_EXPERTS), D_MODEL),
        "b_router": small(ks[19], (L, N_EXPERTS)),
        "w_gate_up": nrm(ks[20], (L, N_EXPERTS, D_MODEL, 2 * D_EXPERT), D_MODEL),
        "b_gate_up": small(ks[21], (L, N_EXPERTS, 2 * D_EXPERT)),
        "w_down": nrm(ks[22], (L, N_EXPERTS, D_EXPERT, D_MODEL), D_EXPERT),
        "b_down": small(ks[23], (L, N_EXPERTS, D_MODEL)),
        "ln_final": gain(ks[24], (D_MODEL,)),
    }


def reference(x, mem, ln_mix, w_in, q_norm, w_q_up, kv_norm, w_kv_up, b_forget, g_out_mla, g_out_fox, w_o,
              ln_cross, mem_norm, w_xq, w_mem_kv, w_xo, ln_ffn, w_router, b_router, w_gate_up, b_gate_up,
              w_down, b_down, ln_final):
    h = x
    for l in range(DEPTH):
        h = h + hybrid_mixer(rmsnorm(h, ln_mix[l]), w_in[l], q_norm[l], w_q_up[l], kv_norm[l], w_kv_up[l],
                             b_forget[l], g_out_mla[l], g_out_fox[l], w_o[l])
        h = h + memory_cross_attention(rmsnorm(h, ln_cross[l]), mem, mem_norm[l], w_xq[l], w_mem_kv[l], w_xo[l])
        h = h + moe_ffn(rmsnorm(h, ln_ffn[l]), w_router[l], b_router[l], w_gate_up[l], b_gate_up[l],
                        w_down[l], b_down[l])
    return rmsnorm(h, ln_final)
```

```cpp
#include <hip/hip_runtime.h>
#include <cstdio>
#include <cstdint>

constexpr int DM = 1024, BATCH = 8, SEQ = 4096, T = BATCH * SEQ, MEMLEN = 256, TM = BATCH * MEMLEN;
constexpr int NPROJ = 2048;
constexpr int C_QLAT = 0, C_KVLAT = 256, C_KPE = 384, C_FQ = 416, C_FK = 928, C_FV = 1440, C_FL = 1952, IN_COLS = 1960;
constexpr int NEXP = 32, TOPK = 4, DEXP = 1024;
constexpr float EPS = 1e-6f, LOG2E = 1.4426950408889634f;
constexpr float C2M = 0.10206207261596577f * LOG2E;
constexpr float C2F = 0.125f * LOG2E;
constexpr float C2X = 0.0625f * LOG2E;

typedef unsigned short bf16;
__device__ __forceinline__ float bf2f(bf16 v) { return __uint_as_float(((unsigned)v) << 16); }
__device__ __forceinline__ bf16 f2bf(float f) { unsigned u = __float_as_uint(f); return (bf16)((u + 0x7fffu + ((u >> 16) & 1u)) >> 16); }

constexpr size_t MiB = 1u << 20;
constexpr size_t WS_CTL = 0;
constexpr size_t WS_ROPE = 1 * MiB;
constexpr size_t WS_CUM = 2 * MiB;
constexpr size_t WS_KAUG = 3 * MiB;
constexpr size_t WS_SSQQ = 7 * MiB;
constexpr size_t WS_SSQKV = 7 * MiB + 512 * 1024;
constexpr size_t WS_SSO = 8 * MiB;
constexpr size_t WS_SSQ1 = 994 * MiB;
constexpr size_t WS_TOPI = 10 * MiB + 512 * 1024;
constexpr size_t WS_GATE = 11 * MiB;
constexpr size_t WS_SLOT = 11 * MiB + 512 * 1024;
constexpr size_t WS_LIST = 12 * MiB;
constexpr size_t WS_WIN = 16 * MiB;
constexpr size_t WS_WQ = 20 * MiB;
constexpr size_t WS_WKV = 20 * MiB + 512 * 1024;
constexpr size_t WS_WO = 21 * MiB;
constexpr size_t WS_WXQ = 23 * MiB;
constexpr size_t WS_WMKV = 25 * MiB;
constexpr size_t WS_WXO = 29 * MiB;
constexpr size_t WS_WGU = 32 * MiB;
constexpr size_t WS_WD = 160 * MiB;
constexpr size_t WS_XN = 224 * MiB;
constexpr size_t WS_PROJ = 288 * MiB;
constexpr size_t WS_QM = 416 * MiB;
constexpr size_t WS_KVM = 464 * MiB;
constexpr size_t WS_O = 528 * MiB;
constexpr size_t WS_XQ = 592 * MiB;
constexpr size_t WS_XO = 656 * MiB;
constexpr size_t WS_MEMN = 720 * MiB;
constexpr size_t WS_KVMEM = 724 * MiB;
constexpr size_t WS_ACT = 736 * MiB;
constexpr size_t WS_SC = 736 * MiB;
constexpr size_t WS_Y = 288 * MiB;
constexpr size_t WS_END = 1000 * MiB;
constexpr int CW_CNT = 64;

#include <hip/hip_cooperative_groups.h>
#include <type_traits>
namespace cg = cooperative_groups;
#define LAS __attribute__((address_space(3)))
#define GAS __attribute__((address_space(1)))
typedef short bf16x8 __attribute__((ext_vector_type(8)));
typedef short s16x4 __attribute__((ext_vector_type(4)));
typedef float f32x4 __attribute__((ext_vector_type(4)));
typedef float f32x2 __attribute__((ext_vector_type(2)));
typedef float f32x16 __attribute__((ext_vector_type(16)));
typedef unsigned u32x4 __attribute__((ext_vector_type(4)));
typedef unsigned u32x2 __attribute__((ext_vector_type(2)));
typedef __bf16 bf16x2_t __attribute__((ext_vector_type(2)));
__device__ __forceinline__ unsigned cvtpk(float lo, float hi) { f32x2 v = {lo, hi}; bf16x2_t b = __builtin_convertvector(v, bf16x2_t); return __builtin_bit_cast(unsigned, b); }
__device__ __forceinline__ int lane_id() { int l; asm volatile("v_mbcnt_lo_u32_b32 %0, -1, 0\n\tv_mbcnt_hi_u32_b32 %0, -1, %0" : "=v"(l)); return l; }
__device__ __forceinline__ float wave_sum(float v) {
#pragma unroll
    for (int o = 1; o < 64; o <<= 1) v += __shfl_xor(v, o);
    return v;
}

constexpr float XQ8_SCALE = 32.f;
constexpr float WXQ8_SCALE = 256.f, WXO8_SCALE = 32.f, H8_SCALE = 4.f, XO8_SCALE = 64.f;
namespace pg8 {
constexpr int BM = 256, BK = 64, HALF = 128, HTB = HALF * BK * 2  , STAGE_BYTES = 8 * HTB, NXCD = 8, WGM = 8;
__host__ __device__ __forceinline__ int lds_byte(int r, int c) { const int st = (r >> 4) * 2 + (c >> 5), rr = r & 15, cc = c & 31, ob = rr * 64 + cc * 2; return st * 1024 + (ob ^ (((ob >> 9) & 1) << 5)); }
__host__ __device__ __forceinline__ void stage_rc(int b, int& R, int& C) { const int st = b / 1024, sb = b % 1024, swz = sb ^ (((sb >> 9) & 1) << 5); R = (st >> 1) * 16 + swz / 64; C = (st & 1) * 32 + (swz % 64) / 2; }
__host__ __device__ __forceinline__ int perm32(int rho) { const int n = rho >> 4, i = rho & 15; return 8 * (i >> 2) + 4 * n + (i & 3); }

struct Unit { int row0, col0, rows, pn, e; const char* a; const char* b; const int* list; };

typedef int i32x8 __attribute__((ext_vector_type(8)));
typedef int i32x4 __attribute__((ext_vector_type(4)));
template <class Epi, class Sched, bool GATHER, bool F8 = false>
__device__ __forceinline__ void gemm_phase(LAS unsigned char* lds, LAS unsigned* tabs, const int K, const int lda, const Sched& S, const Epi& E, const int wave) {
    int tid_ = (wave << 6) | lane_id(); asm volatile("" : "+v"(tid_));
    const int tid = tid_, wid = __builtin_amdgcn_readfirstlane(tid >> 6), lane = tid & 63, wr = wid >> 2, wc = wid & 3, fr = lane & 15, fq = lane >> 4;
    const int nt = K / (F8 ? 128 : BK);
    const int rowA = F8 ? lda : 2 * lda, rowB = F8 ? K : 2 * K;
    unsigned vB[2], vA[2], vcu[2][2];
#pragma unroll
    for (int i = 0; i < 2; ++i) { int R, C; stage_rc(tid * 16 + i * 8192, R, C); const int Rb = Epi::PERM ? ((R & ~31) + perm32(R & 31)) : R;
        vB[i] = (unsigned)(Rb * rowB + 2 * C); vA[i] = (unsigned)(R * rowA + 2 * C);
#pragma unroll
        for (int h = 0; h < 2; ++h) vcu[h][i] = 0u; }
    const size_t hstepA = (size_t)HALF * rowA;
    const size_t kstep = (size_t)(BK * 2);
    const size_t hstepB = (size_t)HALF * rowB;
    const unsigned ldsw = (unsigned)wid * 1024u;
    const unsigned lds_u32 = (unsigned)__builtin_amdgcn_readfirstlane((int)(unsigned)(size_t)lds);
    const int aoff = lds_byte(wr * 64 + fr, F8 ? fq * 16 : fq * 8); int boff = lds_byte(wc * 32 + fr, F8 ? fq * 16 : fq * 8) + 4 * HTB;
    asm volatile("" : "+v"(boff));
#define PG8_SA(b, h) (((b) * 2 + (h)) * HTB)
#define PG8_SB(b, h) ((4 + (b) * 2 + (h)) * HTB)
#define PG8_STAGE(bufoff, gbase, voff) do { const unsigned long long _gb = (unsigned long long)(gbase); \
        const unsigned _glo = __builtin_amdgcn_readfirstlane((unsigned)_gb), _ghi = __builtin_amdgcn_readfirstlane((unsigned)(_gb >> 32)); const unsigned long long _sb = ((unsigned long long)_ghi << 32) | _glo; \
        _Pragma("unroll") for (int _i = 0; _i < 2; ++_i) { unsigned _keep; const unsigned _dst = lds_u32 + (unsigned)(bufoff) + ldsw + _i * 8192u; \
        asm volatile("s_mov_b32 %0, m0\n\ts_mov_b32 m0, %3\n\ts_nop 0\n\tglobal_load_lds_dwordx4 %1, %2\n\ts_mov_b32 m0, %0" : "=&s"(_keep) : "v"((voff)[_i]), "s"(_sb), "s"(_dst) : "memory"); } } while (0)
#define PG8_STAGE_A(bufoff, gbase, h, vsel) do { if constexpr (GATHER) { PG8_STAGE(bufoff, gbase, (vsel)[h]); } else { PG8_STAGE(bufoff, (gbase) + (h) * hstepA, vA); } } while (0)
#define PG8_RD8(dst, off) do { const i32x4 _l = *(const LAS i32x4*)(lds + (off)), _h = *(const LAS i32x4*)(lds + (off) + 16); dst = __builtin_shufflevector(_l, _h, 0, 1, 2, 3, 4, 5, 6, 7); } while (0)
#define PG8_LDA(dst, dst8, b, h) do { if constexpr (F8) { _Pragma("unroll") for (int m = 0; m < 4; ++m) PG8_RD8(dst8[m], PG8_SA(b, h) + aoff + m * 2048); } \
        else { _Pragma("unroll") for (int m = 0; m < 4; ++m) _Pragma("unroll") for (int k = 0; k < 2; ++k) dst[m][k] = *(const LAS bf16x8*)(lds + PG8_SA(b, h) + aoff + m * 2048 + k * 1024); } } while (0)
#define PG8_LDB(dst, dst8, b, h) do { if constexpr (F8) { _Pragma("unroll") for (int n = 0; n < 2; ++n) PG8_RD8(dst8[n], ((b) * 2 + (h)) * HTB + boff + n * 2048); } \
        else { _Pragma("unroll") for (int n = 0; n < 2; ++n) _Pragma("unroll") for (int k = 0; k < 2; ++k) dst[n][k] = *(const LAS bf16x8*)(lds + ((b) * 2 + (h)) * HTB + boff + n * 2048 + k * 1024); } } while (0)
#define PG8_MMA(ai, bj, At, At8, Bt, Bt8) do { __builtin_amdgcn_s_setprio(1); _Pragma("unroll") for (int m = 0; m < 4; ++m) _Pragma("unroll") for (int n = 0; n < 2; ++n) { \
        if constexpr (F8) acc[ai][bj][m][n] = __builtin_amdgcn_mfma_scale_f32_16x16x128_f8f6f4(Bt8[n], At8[m], acc[ai][bj][m][n], 0, 0, 0, 0x7F7F7F7F, 0, 0x7F7F7F7F); \
        else { _Pragma("unroll") for (int k = 0; k < 2; ++k) acc[ai][bj][m][n] = __builtin_amdgcn_mfma_f32_16x16x32_bf16(Bt[n][k], At[m][k], acc[ai][bj][m][n], 0, 0, 0); } } \
        __builtin_amdgcn_s_setprio(0); } while (0)
#define PG8_WAIT_V(n) asm volatile("s_waitcnt vmcnt(" #n ")" ::: "memory")
#define PG8_WAIT_L(n) asm volatile("s_waitcnt lgkmcnt(" #n ")" ::: "memory")
#define PG8_BAR __builtin_amdgcn_s_barrier()
#define PG8_SCHED __builtin_amdgcn_sched_barrier(0)
#define PG8_TABDMA(u, slot) __builtin_amdgcn_global_load_lds((const unsigned*)((u).list + lane_id() * 4), (LAS unsigned*)(tabs + (slot) * 256), 16, 0, 0)
#define PG8_TABOFF(dst, slot) do { const int _tid = (wid << 6) | lane_id(); _Pragma("unroll") for (int _i = 0; _i < 2; ++_i) { int _R, _C; stage_rc(_tid * 16 + _i * 8192, _R, _C); \
        _Pragma("unroll") for (int _h = 0; _h < 2; ++_h) { unsigned _t = tabs[(slot) * 256 + _h * HALF + _R] >> 2; _t = _t < (unsigned)(T - 1) ? _t : (unsigned)(T - 1); \
        dst[_h][_i] = _t * (unsigned)rowA + 2u * (unsigned)_C; } } } while (0)
    __builtin_amdgcn_s_waitcnt(0x0F70);
    Unit cur, nxt; int ui = 0;
    if (!S.next(0, cur)) return;
    if constexpr (GATHER) { PG8_TABDMA(cur, 0); PG8_WAIT_V(0); PG8_BAR; PG8_TABOFF(vcu, 0); PG8_WAIT_L(0); }
    f32x4 acc[2][2][4][2];
    bf16x8 At[4][2], B0[2][2], B1[2][2]; i32x8 At8[4], B08[2], B18[2];
    const char* cA = cur.a; const char* cB = cur.b;
    PG8_STAGE(PG8_SB(0, 0), cB, vB); PG8_STAGE(PG8_SB(0, 1), cB + hstepB, vB); PG8_STAGE_A(PG8_SA(0, 0), cA, 0, vcu); PG8_STAGE_A(PG8_SA(0, 1), cA, 1, vcu);
    if (wr == 1) PG8_BAR;
    PG8_WAIT_V(2); PG8_BAR;
    PG8_STAGE(PG8_SB(1, 0), cB + kstep, vB); PG8_STAGE_A(PG8_SA(1, 0), cA + kstep, 0, vcu); PG8_STAGE(PG8_SB(1, 1), cB + hstepB + kstep, vB);
    PG8_WAIT_V(6); PG8_BAR;
    asm volatile("" ::: "memory");
#pragma unroll
    for (int a = 0; a < 2; ++a)
#pragma unroll
        for (int b = 0; b < 2; ++b)
#pragma unroll
            for (int m = 0; m < 4; ++m)
#pragma unroll
                for (int n = 0; n < 2; ++n) acc[a][b][m][n] = (f32x4){0.f, 0.f, 0.f, 0.f};
    for (;;) {
        const bool has_next = S.next(ui + 1, nxt);
        if constexpr (GATHER) { if (has_next) PG8_TABDMA(nxt, (ui + 1) & 1); }
        const char* nA = has_next ? nxt.a : cA; const char* nB = has_next ? nxt.b : cB;
#pragma nounroll
        for (int t = 0; t < nt; t += 2) {
            const bool last = (t == nt - 2);
            if constexpr (Epi::MID) { if (t == nt / 2) { const int l2_ = lane_id(); E.mid(acc, cur, wr, l2_ & 15); } }
            unsigned v2[2][2];
#pragma unroll
            for (int h = 0; h < 2; ++h)
#pragma unroll
                for (int i = 0; i < 2; ++i) v2[h][i] = vcu[h][i];
            if constexpr (GATHER) { if (last && has_next) { PG8_TABOFF(v2, (ui + 1) & 1); PG8_WAIT_L(0); } }
            const char* a1 = cA + (size_t)(t + 1) * kstep;
            const char* a2 = last ? nA : cA + (size_t)(t + 2) * kstep; const char* b2 = last ? nB : cB + (size_t)(t + 2) * kstep;
            const char* a3 = a2 + kstep; const char* b3 = b2 + kstep;
            PG8_LDB(B0, B08, 0, 0); PG8_LDB(B1, B18, 0, 1); PG8_SCHED; PG8_LDA(At, At8, 0, 0); PG8_STAGE_A(PG8_SA(1, 1), a1, 1, vcu);
            PG8_WAIT_V(8); PG8_WAIT_L(0); PG8_BAR; PG8_MMA(0, 0, At, At8, B0, B08); PG8_MMA(0, 1, At, At8, B1, B18); PG8_BAR; PG8_SCHED;
            PG8_LDA(At, At8, 0, 1); PG8_STAGE(PG8_SB(0, 0), b2, vB); PG8_STAGE(PG8_SB(0, 1), b2 + hstepB, vB); PG8_STAGE_A(PG8_SA(0, 0), a2, 0, v2);
            PG8_WAIT_V(8); PG8_WAIT_L(0); PG8_BAR; PG8_MMA(1, 0, At, At8, B0, B08); PG8_MMA(1, 1, At, At8, B1, B18); PG8_BAR; PG8_SCHED;
            PG8_LDB(B0, B08, 1, 0); PG8_LDB(B1, B18, 1, 1); PG8_SCHED; PG8_LDA(At, At8, 1, 0); PG8_STAGE_A(PG8_SA(0, 1), a2, 1, v2);
            PG8_WAIT_V(8); PG8_WAIT_L(0); PG8_BAR; PG8_MMA(0, 0, At, At8, B0, B08); PG8_MMA(0, 1, At, At8, B1, B18); PG8_BAR; PG8_SCHED;
            PG8_LDA(At, At8, 1, 1); PG8_STAGE(PG8_SB(1, 0), b3, vB); PG8_STAGE(PG8_SB(1, 1), b3 + hstepB, vB); PG8_STAGE_A(PG8_SA(1, 0), a3, 0, v2);
            PG8_WAIT_V(8); PG8_WAIT_L(0); PG8_BAR; PG8_MMA(1, 0, At, At8, B0, B08); PG8_MMA(1, 1, At, At8, B1, B18); PG8_BAR; PG8_SCHED;
        }
        if (wr == 0) PG8_BAR;
        { const int l2_ = lane_id(); E(acc, cur, wr, wc, l2_ & 15, l2_ >> 4); }
        if (!has_next) break;
#pragma unroll
        for (int a = 0; a < 2; ++a)
#pragma unroll
            for (int b = 0; b < 2; ++b)
#pragma unroll
                for (int m = 0; m < 4; ++m)
#pragma unroll
                    for (int n = 0; n < 2; ++n) acc[a][b][m][n] = (f32x4){0.f, 0.f, 0.f, 0.f};
        cur = nxt; cA = nA; cB = nB; ++ui;
        if constexpr (GATHER) { PG8_TABOFF(vcu, ui & 1); PG8_WAIT_L(0); }
        if (wr == 1) PG8_BAR;
    }
    PG8_WAIT_V(0);
    PG8_BAR;
#undef PG8_SA
#undef PG8_SB
#undef PG8_STAGE
#undef PG8_STAGE_A
#undef PG8_RD8
#undef PG8_LDA
#undef PG8_LDB
#undef PG8_MMA
#undef PG8_TABDMA
#undef PG8_TABOFF
}
struct TileOrder {
    int nM, nN, nwg, G, c;
    __device__ __forceinline__ void init(int nM_, int nN_, int G_, int c_) { nM = nM_; nN = nN_; nwg = nM * nN; G = G_; c = c_; }
    __device__ __forceinline__ bool tile(int i, int& pm, int& pn) const {
        const int L = i * G + c; if (L >= nwg) return false;
        int wgid = L; { const int q = nwg / NXCD, r = nwg % NXCD, xcd = wgid % NXCD, off = wgid / NXCD; wgid = (xcd < r ? xcd * (q + 1) : r * (q + 1) + (xcd - r) * q) + off; }
        const int nig = WGM * nN, gid = wgid / nig, fm = gid * WGM, gsz = (nM - fm) < WGM ? (nM - fm) : WGM;
        pm = fm + ((wgid % nig) % gsz); pn = (wgid % nig) / gsz; return true;
    }
};
struct DenseSched {
    TileOrder o; const char* A; const char* Bt; int lda, K;
    __device__ __forceinline__ void init(const bf16* A_, int lda_, const bf16* Bt_, int M, int N, int K_, int G, int c) { o.init(M / BM, N / BM, G, c); A = (const char*)A_; Bt = (const char*)Bt_; lda = lda_; K = K_; }
    __device__ __forceinline__ bool next(int i, Unit& u) const { int pm, pn; if (!o.tile(i, pm, pn)) return false; u.row0 = pm * BM; u.col0 = pn * BM; u.rows = BM; u.pn = pn; u.e = 0;
        u.a = A + (size_t)pm * BM * lda * 2; u.b = Bt + (size_t)pn * BM * K * 2; u.list = nullptr; return true; }
};
}

__device__ __forceinline__ float sum4sq(const f32x4& v) { return (v[0] * v[0] + v[1] * v[1]) + (v[2] * v[2] + v[3] * v[3]); }
__device__ __forceinline__ void st_bf4(bf16* p, const f32x4& v) { u32x2 w; w.x = cvtpk(v[0], v[1]); w.y = cvtpk(v[2], v[3]); *(u32x2*)p = w; }
__device__ __forceinline__ int cofs8(int fq) { return 4 * fq + (fq & 1) * 12; }
__device__ __forceinline__ void st_bf8(bf16* p, const f32x4& v0, const f32x4& v1) {
    const unsigned a0 = cvtpk(v0[0], v0[1]), a1 = cvtpk(v0[2], v0[3]), b0 = cvtpk(v1[0], v1[1]), b1 = cvtpk(v1[2], v1[3]);
    const auto r0 = __builtin_amdgcn_permlane16_swap(a0, b0, false, false), r1 = __builtin_amdgcn_permlane16_swap(a1, b1, false, false);
    *(u32x4*)p = (u32x4){r0[0], r1[0], r0[1], r1[1]}; }
struct EpiProj {
    static constexpr bool PERM = false, MID = false;
    bf16* PROJ; float* ssqq; float* ssqkv; const float* rope; float* LF; const float* bfor;
    __device__ __forceinline__ void operator()(f32x4 (&acc)[2][2][4][2], const pg8::Unit& u, int wr, int wc, int fr, int fq) const {
        asm volatile("" : "+v"(fr), "+v"(fq));
        const bool rp1 = (u.pn == 1) && (wc == 0);
        f32x4 ca[8], cb[8];
        if (rp1) {
#pragma unroll
            for (int g = 0; g < 8; ++g) { const int pos = (u.row0 + (g >> 2) * 128 + wr * 64 + (g & 3) * 16 + fr) & (SEQ - 1); const float* q = rope + 2 * (pos * 16 + fq * 4); ca[g] = *(const f32x4*)q; cb[g] = *(const f32x4*)(q + 4); } }
#pragma unroll
        for (int ai = 0; ai < 2; ++ai)
#pragma unroll
            for (int m = 0; m < 4; ++m) {
                const int row = u.row0 + ai * 128 + wr * 64 + m * 16 + fr;
                if (u.pn == 0) { float s = (sum4sq(acc[ai][0][m][0]) + sum4sq(acc[ai][0][m][1])) + (sum4sq(acc[ai][1][m][0]) + sum4sq(acc[ai][1][m][1]));
                    s += __shfl_xor(s, 16); s += __shfl_xor(s, 32); if (fq == 0) ssqq[(size_t)row * 4 + wc] = s; }
                if (u.pn == 1) { float s = sum4sq(acc[ai][0][m][0]) + sum4sq(acc[ai][0][m][1]);
                    s += __shfl_xor(s, 16); s += __shfl_xor(s, 32); if (fq == 0) ssqkv[(size_t)row * 4 + wc] = s;
                    if (wc == 0) { const f32x4 x1 = acc[ai][1][m][0], x2 = acc[ai][1][m][1]; f32x4 y1, y2; const f32x4 c0 = ca[ai * 4 + m], c1 = cb[ai * 4 + m];
#pragma unroll
                        for (int e = 0; e < 4; ++e) { const float cx = e < 2 ? c0[2 * e] : c1[2 * e - 4], sx = e < 2 ? c0[2 * e + 1] : c1[2 * e - 3]; y1[e] = x1[e] * cx - x2[e] * sx; y2[e] = x2[e] * cx + x1[e] * sx; }
                        acc[ai][1][m][0] = y1; acc[ai][1][m][1] = y2; } }
                if (u.pn == 7 && wc == 1 && fq < 2) { const f32x4 z4 = acc[ai][1][m][0]; f32x4 lf;
#pragma unroll
                    for (int e = 0; e < 4; ++e) { const float z = z4[e] + bfor[fq * 4 + e]; lf[e] = fminf(z, 0.f) - 0.6931471805599453f * __builtin_amdgcn_logf(1.f + __builtin_amdgcn_exp2f(-LOG2E * fabsf(z))); }
                    *(f32x4*)(LF + (size_t)row * 8 + fq * 4) = lf; }
                bf16* rp = PROJ + (size_t)row * NPROJ + u.col0 + wc * 32 + cofs8(fq);
#pragma unroll
                for (int bj = 0; bj < 2; ++bj) st_bf8(rp + bj * 128, acc[ai][bj][m][0], acc[ai][bj][m][1]);
                asm volatile("" ::: "memory");
            }
    }
};
template <int NS, bool ROPE> struct EpiScale {
    static constexpr bool PERM = false, MID = false;
    bf16* C; int ldc; const float* ss; float inv_n; const float* rope; float osc = 1.f;
    __device__ __forceinline__ void operator()(f32x4 (&acc)[2][2][4][2], const pg8::Unit& u, int wr, int wc, int fr, int fq) const {
        asm volatile("" : "+v"(fr), "+v"(fq));
        const int rbase = u.row0 + wr * 64 + fr;
        f32x4 q[8], ca[8], cb[8]; int bjr = -1;
        if constexpr (ROPE) { const int g0 = (u.col0 >> 5) + wc; bjr = (g0 % 3 == 2) ? 0 : (((g0 + 4) % 3 == 2) ? 1 : -1);
            if (bjr >= 0) {
#pragma unroll
                for (int g = 0; g < 8; ++g) { const int pos = (rbase + (g >> 2) * 128 + (g & 3) * 16) & (SEQ - 1); const float* qq = rope + 2 * (pos * 16 + fq * 4); ca[g] = *(const f32x4*)qq; cb[g] = *(const f32x4*)(qq + 4); } } }
        float q1[8];
        if constexpr (NS == 16) {
#pragma unroll
            for (int g = 0; g < 8; ++g) q[g] = *(const f32x4*)(ss + (size_t)(rbase + (g >> 2) * 128 + (g & 3) * 16) * NS + 4 * fq); }
        if constexpr (NS == 4) {
#pragma unroll
            for (int g = 0; g < 8; ++g) q1[g] = ss[(size_t)(rbase + (g >> 2) * 128 + (g & 3) * 16) * 4 + fq]; }
#pragma unroll
        for (int g = 0; g < 8; ++g) { const int ai = g >> 2, m = g & 3;
                const int row = rbase + ai * 128 + m * 16; float sc = 1.f;
                if constexpr (NS > 0) { float t = NS == 16 ? (q[g][0] + q[g][1]) + (q[g][2] + q[g][3]) : q1[g];
                    t += __shfl_xor(t, 16); t += __shfl_xor(t, 32);
                    sc = rsqrtf(t * inv_n + EPS) * osc; }
                bf16* rp = C + (size_t)row * ldc + u.col0 + wc * 32 + cofs8(fq);
#pragma unroll
                for (int bj = 0; bj < 2; ++bj) {
                    f32x4 v0 = acc[ai][bj][m][0] * sc, v1 = acc[ai][bj][m][1] * sc;
                    if constexpr (ROPE) { if (bj == bjr) { f32x4 y1, y2; const f32x4 c0 = ca[g], c1 = cb[g];
#pragma unroll
                        for (int e = 0; e < 4; ++e) { const float cx = e < 2 ? c0[2 * e] : c1[2 * e - 4], sx = e < 2 ? c0[2 * e + 1] : c1[2 * e - 3]; y1[e] = v0[e] * cx - v1[e] * sx; y2[e] = v1[e] * cx + v0[e] * sx; }
                        v0 = y1; v1 = y2; } }
                    st_bf8(rp + bj * 128, v0, v1);
                }
                asm volatile("" ::: "memory");
            }
    }
};

__device__ __forceinline__ u32x2 pack8_f8(const f32x4& v0, const f32x4& v1, float sc) {
    f32x4 a0, a1;
#pragma unroll
    for (int e = 0; e < 4; ++e) { const auto r = __builtin_amdgcn_permlane16_swap(__float_as_uint(v0[e]), __float_as_uint(v1[e]), false, false); a0[e] = __uint_as_float(r[0]) * sc; a1[e] = __uint_as_float(r[1]) * sc; }
    int w0 = 0, w1 = 0; w0 = __builtin_amdgcn_cvt_pk_fp8_f32(a0[0], a0[1], w0, false); w0 = __builtin_amdgcn_cvt_pk_fp8_f32(a0[2], a0[3], w0, true);
    w1 = __builtin_amdgcn_cvt_pk_fp8_f32(a1[0], a1[1], w1, false); w1 = __builtin_amdgcn_cvt_pk_fp8_f32(a1[2], a1[3], w1, true); return (u32x2){(unsigned)w0, (unsigned)w1}; }
struct EpiMemKV {
    static constexpr bool PERM = false, MID = false;   static constexpr int NST = 16;
    bf16* C; unsigned char* k8;
    __device__ __forceinline__ void operator()(f32x4 (&acc)[2][2][4][2], const pg8::Unit& u, int wr, int wc, int fr, int fq) const {
        asm volatile("" : "+v"(fr), "+v"(fq));
        const int rbase = u.row0 + wr * 64 + fr;
#pragma unroll
        for (int g = 0; g < 8; ++g) { const int ai = g >> 2, m = g & 3; const int row = rbase + ai * 128 + m * 16; const int cc = u.col0 + wc * 32 + cofs8(fq);
#pragma unroll
            for (int bj = 0; bj < 2; ++bj) {
                if (u.pn < 4) *(u32x2*)(k8 + (size_t)row * 1024 + cc + bj * 128) = pack8_f8(acc[ai][bj][m][0], acc[ai][bj][m][1], 1.f);
                else st_bf8(C + (size_t)row * 2048 + cc + bj * 128, acc[ai][bj][m][0], acc[ai][bj][m][1]); }
            asm volatile("" ::: "memory"); }
    }
};
struct EpiXQ8 {
    static constexpr bool PERM = false, MID = false;   static constexpr int NST = 16;
    unsigned char* C8; const float* ss; float osc;
    __device__ __forceinline__ void operator()(f32x4 (&acc)[2][2][4][2], const pg8::Unit& u, int wr, int wc, int fr, int fq) const {
        asm volatile("" : "+v"(fr), "+v"(fq));
        const int rbase = u.row0 + wr * 64 + fr; f32x4 q[8];
#pragma unroll
        for (int g = 0; g < 8; ++g) q[g] = *(const f32x4*)(ss + (size_t)(rbase + (g >> 2) * 128 + (g & 3) * 16) * 16 + 4 * fq);
#pragma unroll
        for (int g = 0; g < 8; ++g) { const int ai = g >> 2, m = g & 3; const int row = rbase + ai * 128 + m * 16;
            float t = (q[g][0] + q[g][1]) + (q[g][2] + q[g][3]); t += __shfl_xor(t, 16); t += __shfl_xor(t, 32);
            const float sc = rsqrtf(t * (1.f / 1024.f) + EPS) * osc;
#pragma unroll
            for (int bj = 0; bj < 2; ++bj) *(u32x2*)(C8 + (size_t)row * DM + u.col0 + wc * 32 + cofs8(fq) + bj * 128) = pack8_f8(acc[ai][bj][m][0], acc[ai][bj][m][1], sc);
            asm volatile("" ::: "memory"); }
    }
};

struct EpiWo {
    static constexpr bool PERM = false, MID = true;
    const float* sso; const float* x; float* out; bf16* hb; float* ssq1; unsigned char* h8;
    __device__ __forceinline__ void mid(f32x4 (&acc)[2][2][4][2], const pg8::Unit& u, int wr, int fr) const {
        asm volatile("" : "+v"(fr));
        int fq = lane_id() >> 4; asm volatile("" : "+v"(fq));
        const int rbase = u.row0 + wr * 64 + fr; f32x4 p[8];
#pragma unroll
        for (int g = 0; g < 8; ++g) p[g] = *((const f32x4*)(sso + (size_t)(rbase + (g >> 2) * 128 + (g & 3) * 16) * 16) + fq);
#pragma unroll
        for (int g = 0; g < 8; ++g) { const int ai = g >> 2, m = g & 3;
            float t = (p[g][0] + p[g][1]) + (p[g][2] + p[g][3]); t += __shfl_xor(t, 16); const float o = __shfl_xor(t, 32);
            const float sm = fq < 2 ? t : o, sf = fq < 2 ? o : t;
            const float ratio = rsqrtf(sm * (1.f / 512.f) + EPS) / rsqrtf(sf * (1.f / 512.f) + EPS);
#pragma unroll
            for (int bj = 0; bj < 2; ++bj)
#pragma unroll
                for (int n = 0; n < 2; ++n) acc[ai][bj][m][n] *= ratio;
            asm volatile("" ::: "memory"); }
    }
    __device__ __forceinline__ void operator()(f32x4 (&acc)[2][2][4][2], const pg8::Unit& u, int wr, int wc, int fr, int fq) const {
        asm volatile("" : "+v"(fr), "+v"(fq));
        const int rbase = u.row0 + wr * 64 + fr; const int cb = u.col0 + wc * 32 + fq * 4;
        f32x4 xc[2][2], xn[2][2], sf4[8]; float ssg[8]; unsigned w8p[2][2];
#pragma unroll
        for (int g = 0; g < 8; ++g) sf4[g] = *((const f32x4*)(sso + (size_t)(rbase + (g >> 2) * 128 + (g & 3) * 16) * 16) + 2 + (fq & 1));
#pragma unroll
        for (int bj = 0; bj < 2; ++bj)
#pragma unroll
            for (int n = 0; n < 2; ++n) xc[bj][n] = *(const f32x4*)(x + (size_t)rbase * DM + cb + bj * 128 + n * 16);
#pragma unroll
        for (int g = 0; g < 8; ++g) { const int ai = g >> 2, m = g & 3; const int row = rbase + ai * 128 + m * 16;
            if (g + 1 < 8) { const int rn = rbase + ((g + 1) >> 2) * 128 + ((g + 1) & 3) * 16;
#pragma unroll
                for (int bj = 0; bj < 2; ++bj)
#pragma unroll
                    for (int n = 0; n < 2; ++n) xn[bj][n] = *(const f32x4*)(x + (size_t)rn * DM + cb + bj * 128 + n * 16); }
            float tf = (sf4[g][0] + sf4[g][1]) + (sf4[g][2] + sf4[g][3]); tf += __shfl_xor(tf, 16);
            const float rf = rsqrtf(tf * (1.f / 512.f) + EPS);
            const size_t off = (size_t)row * DM + u.col0 + wc * 32 + cofs8(fq); float ss = 0.f;
#pragma unroll
            for (int bj = 0; bj < 2; ++bj) { const f32x4 h0 = xc[bj][0] + acc[ai][bj][m][0] * rf, h1 = xc[bj][1] + acc[ai][bj][m][1] * rf; ss += sum4sq(h0) + sum4sq(h1);
                f32x4 a0, a1;
#pragma unroll
                for (int e = 0; e < 4; ++e) { const auto r = __builtin_amdgcn_permlane16_swap(__float_as_uint(h0[e]), __float_as_uint(h1[e]), false, false); a0[e] = __uint_as_float(r[0]); a1[e] = __uint_as_float(r[1]); }
                *(u32x4*)(hb + off + bj * 128) = (u32x4){cvtpk(a0[0], a0[1]), cvtpk(a0[2], a0[3]), cvtpk(a1[0], a1[1]), cvtpk(a1[2], a1[3])};
                int w0 = 0, w1 = 0; w0 = __builtin_amdgcn_cvt_pk_fp8_f32(a0[0] * H8_SCALE, a0[1] * H8_SCALE, w0, false); w0 = __builtin_amdgcn_cvt_pk_fp8_f32(a0[2] * H8_SCALE, a0[3] * H8_SCALE, w0, true);
                w1 = __builtin_amdgcn_cvt_pk_fp8_f32(a1[0] * H8_SCALE, a1[1] * H8_SCALE, w1, false); w1 = __builtin_amdgcn_cvt_pk_fp8_f32(a1[2] * H8_SCALE, a1[3] * H8_SCALE, w1, true);
                if ((g & 1) == 0) { w8p[bj][0] = (unsigned)w0; w8p[bj][1] = (unsigned)w1; }
                else {
                    const auto r0 = __builtin_amdgcn_permlane32_swap(w8p[bj][0], (unsigned)w0, false, false), r1 = __builtin_amdgcn_permlane32_swap(w8p[bj][1], (unsigned)w1, false, false);
                    const int rw = row - ((fq < 2) ? 16 : 0);
                    *(u32x4*)(h8 + (size_t)rw * DM + u.col0 + wc * 32 + (fq & 1) * 16 + bj * 128) = (u32x4){r0[0], r1[0], r0[1], r1[1]}; } }
            ss += __shfl_xor(ss, 16); ss += __shfl_xor(ss, 32); ssg[g] = ss;
            asm volatile("" ::: "memory");
#pragma unroll
            for (int bj = 0; bj < 2; ++bj)
#pragma unroll
                for (int n = 0; n < 2; ++n) xc[bj][n] = xn[bj][n]; }
        { const float s0 = fq == 0 ? ssg[0] : fq == 1 ? ssg[1] : fq == 2 ? ssg[2] : ssg[3], s1 = fq == 0 ? ssg[4] : fq == 1 ? ssg[5] : fq == 2 ? ssg[6] : ssg[7];
          float* sp = ssq1 + (size_t)(rbase + fq * 16) * 16 + u.pn * 4 + wc; sp[0] = s0; sp[128 * 16] = s1; }
    }
};
struct EpiAddOut {
    static constexpr bool PERM = false, MID = false;
    bf16* hb; float osc;
    __device__ __forceinline__ void operator()(f32x4 (&acc)[2][2][4][2], const pg8::Unit& u, int wr, int wc, int fr, int fq) const {
        asm volatile("" : "+v"(fr), "+v"(fq));
        const int rbase = u.row0 + wr * 64 + fr; const int cb = u.col0 + wc * 32 + cofs8(fq);
        u32x4 xc[2], xn[2];
#pragma unroll
        for (int bj = 0; bj < 2; ++bj) xc[bj] = *(const u32x4*)(hb + (size_t)rbase * DM + cb + bj * 128);
#pragma unroll
        for (int g = 0; g < 8; ++g) { const int ai = g >> 2, m = g & 3; const int row = rbase + ai * 128 + m * 16;
            if (g + 1 < 8) { const int rn = rbase + ((g + 1) >> 2) * 128 + ((g + 1) & 3) * 16;
#pragma unroll
                for (int bj = 0; bj < 2; ++bj) xn[bj] = *(const u32x4*)(hb + (size_t)rn * DM + cb + bj * 128); }
#pragma unroll
            for (int bj = 0; bj < 2; ++bj) { const u32x4 w = xc[bj]; f32x4 a0, a1;
#pragma unroll
                for (int e = 0; e < 4; ++e) { const auto r = __builtin_amdgcn_permlane16_swap(__float_as_uint(acc[ai][bj][m][0][e]), __float_as_uint(acc[ai][bj][m][1][e]), false, false); a0[e] = __uint_as_float(r[0]) * osc; a1[e] = __uint_as_float(r[1]) * osc; }
                const f32x4 h0 = (f32x4){__uint_as_float(w.x << 16), __uint_as_float(w.x & 0xffff0000u), __uint_as_float(w.y << 16), __uint_as_float(w.y & 0xffff0000u)} + a0;
                const f32x4 h1 = (f32x4){__uint_as_float(w.z << 16), __uint_as_float(w.z & 0xffff0000u), __uint_as_float(w.w << 16), __uint_as_float(w.w & 0xffff0000u)} + a1;
                *(u32x4*)(hb + (size_t)row * DM + cb + bj * 128) = (u32x4){cvtpk(h0[0], h0[1]), cvtpk(h0[2], h0[3]), cvtpk(h1[0], h1[1]), cvtpk(h1[2], h1[3])}; }
            asm volatile("" ::: "memory");
#pragma unroll
            for (int bj = 0; bj < 2; ++bj) xc[bj] = xn[bj]; }
    }
};

namespace att {
__device__ __forceinline__ int crow(int r, int hi) { return (r & 3) + 8 * (r >> 2) + 4 * hi; }
struct Src { const bf16* q; int ldq; const bf16* k1; int ldk1; const bf16* k2; int ldk2; const bf16* v; int ldv; bf16* o; int ldo; float* sso; int nt; int q0; const float* kn; const float* cum; };
typedef short v4i16_t __attribute__((ext_vector_type(4)));
__device__ __forceinline__ s16x4 vtr(const LAS unsigned char* p) { return __builtin_bit_cast(s16x4, __builtin_amdgcn_ds_read_tr16_b64_v4i16((LAS v4i16_t*)p)); }
__device__ __forceinline__ float rowmax32(const f32x16& p0, const f32x16& p1) {
    float a = fmaxf(fmaxf(p0[0], p0[1]), p1[0]), b = fmaxf(fmaxf(p0[2], p0[3]), p1[1]); a = fmaxf(fmaxf(a, p1[2]), p1[3]);
#pragma unroll
    for (int r = 4; r < 16; r += 4) { a = fmaxf(fmaxf(a, p0[r]), p0[r + 1]); b = fmaxf(fmaxf(b, p0[r + 2]), p0[r + 3]); a = fmaxf(fmaxf(a, p1[r]), p1[r + 1]); b = fmaxf(fmaxf(b, p1[r + 2]), p1[r + 3]); }
    const float m = fmaxf(a, b);
    auto rr = __builtin_amdgcn_permlane32_swap(__float_as_uint(m), __float_as_uint(m), false, false);
    return fmaxf(__uint_as_float(rr[0]), __uint_as_float(rr[1]));
}
template <int I, int N, class F> __device__ __forceinline__ void cfor(F&& f) { if constexpr (I < N) { f(std::integral_constant<int, I>{}); cfor<I + 1, N>(f); } }
template <int D0, int NKS, bool AUG> __device__ __forceinline__ void kread(bf16x8& f0, bf16x8& f1, unsigned base, unsigned abase) {
    if constexpr (AUG && D0 == NKS - 1) { asm volatile("ds_read_b128 %0, %1 offset:8192" : "=v"(f0) : "v"(abase)); asm volatile("ds_read_b128 %0, %1 offset:8704" : "=v"(f1) : "v"(abase)); }
    else { asm volatile("ds_read_b128 %0, %1 offset:%2" : "=v"(f0) : "v"(base), "n"(D0 * 2048)); asm volatile("ds_read_b128 %0, %1 offset:%2" : "=v"(f1) : "v"(base), "n"(D0 * 2048 + 512)); }
}
template <int NKS, int NC1, int NCH, int ND0, bool CAUSAL, bool AUG, bool REV, bool WSSO, bool EARLY = false, bool ASMK = true>
__device__ __forceinline__ void unit(const Src& s, LAS unsigned char* lds, const int wave) {
    int tid_ = (wave << 6) | lane_id(); asm volatile("" : "+v"(tid_));
    const int tid = tid_, lane = tid & 63, r32 = lane & 31, hi = lane >> 5, wid = __builtin_amdgcn_readfirstlane(tid >> 6);
    constexpr int KSL = NCH * 1024, VSL = ND0 * 4096, KPW = (NCH + 7) / 8, VPW = ND0 / 2;
    constexpr int VOFF = 2 * KSL, WSF = VOFF + 2 * VSL;
    constexpr float THR = 8.f;
    LAS float* wsf = (LAS float*)(lds + WSF) + wid * 64;
    bf16x8 qr[NKS];
    { const bf16* qw = s.q + (size_t)(wid * 32 + r32) * s.ldq + hi * 8;
#pragma unroll
      for (int d0 = 0; d0 < NKS; ++d0) { if (AUG && d0 == NKS - 1) { const short one = hi ? (short)0 : (short)0x3F80; qr[d0] = (bf16x8){one, one, one, 0, 0, 0, 0, 0}; } else qr[d0] = *(const bf16x8*)(qw + d0 * 16); } }
    LAS float* shf = (LAS float*)(lds + WSF + 2048);
    float thr = 0.f;
    if constexpr (EARLY) {
        float q2 = 0.f;
#pragma unroll
        for (int d0 = 0; d0 < NKS - 1; ++d0)
#pragma unroll
            for (int j = 0; j < 8; ++j) { const float f = __uint_as_float(((unsigned)(unsigned short)qr[d0][j]) << 16); q2 += f * f; }
        { auto rr = __builtin_amdgcn_permlane32_swap(__float_as_uint(q2), __float_as_uint(q2), false, false); q2 = __uint_as_float(rr[0]) + __uint_as_float(rr[1]); }
#pragma unroll
        for (int o_ = 1; o_ < 32; o_ <<= 1) q2 = fmaxf(q2, __shfl_xor(q2, o_));
        if (lane == 0) shf[wid] = q2;
        float kn = s.kn[lane];
#pragma unroll
        for (int o_ = 1; o_ < 64; o_ <<= 1) { const float up = __shfl_up(kn, o_); if (lane >= o_) kn = fmaxf(kn, up); }
        thr = kn;
    }
    u32x4 kreg[2][KPW], vreg[2][VPW];
#define ATT_LOAD(t, S_) do { \
    _Pragma("unroll") for (int i_ = 0; i_ < KPW; ++i_) { const int c_ = (wid + 8 * i_ < NCH) ? wid + 8 * i_ : wid; const size_t row_ = (size_t)(t) * 64 + lane;     \
        const bf16* g_ = (c_ < NC1) ? s.k1 + row_ * s.ldk1 + c_ * 8 : s.k2 + row_ * s.ldk2 + (c_ - NC1) * 8; kreg[S_][i_] = *(const u32x4*)g_; } \
    _Pragma("unroll") for (int i_ = 0; i_ < VPW; ++i_) { const int p_ = wid + 8 * i_; const int dh_ = p_ >> 2, rg_ = p_ & 3; \
        vreg[S_][i_] = *(const u32x4*)(s.v + ((size_t)(t) * 64 + 16 * rg_ + (lane >> 2)) * s.ldv + dh_ * 32 + (lane & 3) * 8); } } while (0)
#define ATT_WRITE(slot, S_) do { \
    _Pragma("unroll") for (int i_ = 0; i_ < KPW; ++i_) { const int c_ = (wid + 8 * i_ < NCH) ? wid + 8 * i_ : wid; *(LAS u32x4*)(lds + (slot) * KSL + c_ * 1024 + lane * 16) = kreg[S_][i_]; } \
    _Pragma("unroll") for (int i_ = 0; i_ < VPW; ++i_) { const int p_ = wid + 8 * i_; *(LAS u32x4*)(lds + VOFF + (slot) * VSL + p_ * 1024 + lane * 16) = vreg[S_][i_]; } } while (0)
    const int nt = s.nt;
    ATT_LOAD(REV ? nt - 1 : 0, 0); ATT_LOAD(REV ? nt - 2 : 1, 1); ATT_WRITE(0, 0);
    __syncthreads();
    if constexpr (EARLY) { float qm = shf[0];
#pragma unroll
        for (int w = 1; w < 8; ++w) qm = fmaxf(qm, shf[w]);
        thr = sqrtf(qm) * thr * 1.001f - s.cum[64 * lane + 63] * LOG2E; }
    float m = 0.f, l = 0.f; f32x16 o[ND0]; bool have = false;
    f32x16 negm = f32x16{};
#pragma unroll
    for (int d = 0; d < ND0; ++d) o[d] = f32x16{};
    const int qmin = s.q0 + wid * 32;
    auto body = [&](auto parc, const int i) -> bool { constexpr int PAR = decltype(parc)::value;
        const int t = REV ? nt - 1 - i : i; constexpr int cur = PAR;
        if constexpr (EARLY) { if (i > 0) { float mmin = shf[8 + (PAR ^ 1) * 8];
#pragma unroll
            for (int w = 1; w < 8; ++w) mmin = fminf(mmin, shf[8 + (PAR ^ 1) * 8 + w]);
            const float bound = __uint_as_float(__builtin_amdgcn_readlane(__float_as_uint(thr), t));
            if (bound - mmin < -40.f) return false; } }
        { const int t2 = REV ? (t >= 2 ? t - 2 : 0) : (t + 2 < nt ? t + 2 : nt - 1); ATT_LOAD(t2, PAR); }
        const bool skip = CAUSAL && (64 * t > qmin + 31);
        if (!skip) {
            const LAS unsigned char* kb = lds + cur * KSL + r32 * 16;
            f32x16 p0 = negm, p1 = negm;
            if constexpr (!ASMK) {
                const LAS unsigned char* kq = kb + hi * 1024; bf16x8 ka[8], kc[8];
#pragma unroll
                for (int d = 0; d < 4; ++d) { ka[2 * d] = *(const LAS bf16x8*)(kq + d * 2048); ka[2 * d + 1] = *(const LAS bf16x8*)(kq + d * 2048 + 512); }
#pragma unroll
                for (int g0 = 0; g0 < NKS; g0 += 4) {
                    if (g0 + 4 < NKS) {
#pragma unroll
                        for (int d = 0; d < 4; ++d) { kc[2 * d] = *(const LAS bf16x8*)(kq + (g0 + 4 + d) * 2048); kc[2 * d + 1] = *(const LAS bf16x8*)(kq + (g0 + 4 + d) * 2048 + 512); } }
                    __builtin_amdgcn_sched_group_barrier(0x100, 8, 0);
#pragma unroll
                    for (int d = 0; d < 4; ++d) { p0 = __builtin_amdgcn_mfma_f32_32x32x16_bf16(ka[2 * d], qr[g0 + d], p0, 0, 0, 0); p1 = __builtin_amdgcn_mfma_f32_32x32x16_bf16(ka[2 * d + 1], qr[g0 + d], p1, 0, 0, 0); }
                    __builtin_amdgcn_sched_group_barrier(0x008, 8, 0);
#pragma unroll
                    for (int z = 0; z < 8; ++z) ka[z] = kc[z];
                }
            } else {
            constexpr int KB = (NKS % 3 == 0 || NKS == 5) ? 3 : 4, NB = (NKS + KB - 1) / KB;
            const unsigned kbase = (unsigned)(size_t)(kb + hi * 1024), abase = (unsigned)(size_t)kb;
            bf16x8 kfa[2 * KB], kfb[2 * KB];
#pragma unroll
            for (int z_ = 0; z_ < 2 * KB; ++z_) { kfa[z_] = bf16x8{}; kfb[z_] = bf16x8{}; }
            cfor<0, KB>([&](auto ic) { constexpr int D = decltype(ic)::value; if constexpr (D < NKS) kread<D, NKS, AUG>(kfa[2 * D], kfa[2 * D + 1], kbase, abase); });
            cfor<0, NB>([&](auto bc) { constexpr int B = decltype(bc)::value;
                if constexpr (B % 2 == 0) { if constexpr (KB == 3) asm volatile("s_waitcnt lgkmcnt(0)" : "+v"(kfa[0]), "+v"(kfa[1]), "+v"(kfa[2]), "+v"(kfa[3]), "+v"(kfa[4]), "+v"(kfa[5]) :: "memory");
                                            else asm volatile("s_waitcnt lgkmcnt(0)" : "+v"(kfa[0]), "+v"(kfa[1]), "+v"(kfa[2]), "+v"(kfa[3]), "+v"(kfa[4]), "+v"(kfa[5]), "+v"(kfa[6]), "+v"(kfa[7]) :: "memory"); }
                else { if constexpr (KB == 3) asm volatile("s_waitcnt lgkmcnt(0)" : "+v"(kfb[0]), "+v"(kfb[1]), "+v"(kfb[2]), "+v"(kfb[3]), "+v"(kfb[4]), "+v"(kfb[5]) :: "memory");
                       else asm volatile("s_waitcnt lgkmcnt(0)" : "+v"(kfb[0]), "+v"(kfb[1]), "+v"(kfb[2]), "+v"(kfb[3]), "+v"(kfb[4]), "+v"(kfb[5]), "+v"(kfb[6]), "+v"(kfb[7]) :: "memory"); }
                __builtin_amdgcn_sched_barrier(0);
                if constexpr (B % 2 == 0) {
                    cfor<0, KB>([&](auto ic) { constexpr int D = (B + 1) * KB + decltype(ic)::value; if constexpr (D < NKS) kread<D, NKS, AUG>(kfb[2 * decltype(ic)::value], kfb[2 * decltype(ic)::value + 1], kbase, abase); });
                    __builtin_amdgcn_sched_barrier(0);
                    cfor<0, KB>([&](auto ic) { constexpr int D = B * KB + decltype(ic)::value; if constexpr (D < NKS) { p0 = __builtin_amdgcn_mfma_f32_32x32x16_bf16(kfa[2 * decltype(ic)::value], qr[D], p0, 0, 0, 0); p1 = __builtin_amdgcn_mfma_f32_32x32x16_bf16(kfa[2 * decltype(ic)::value + 1], qr[D], p1, 0, 0, 0); } });
                } else {
                    cfor<0, KB>([&](auto ic) { constexpr int D = (B + 1) * KB + decltype(ic)::value; if constexpr (D < NKS) kread<D, NKS, AUG>(kfa[2 * decltype(ic)::value], kfa[2 * decltype(ic)::value + 1], kbase, abase); });
                    __builtin_amdgcn_sched_barrier(0);
                    cfor<0, KB>([&](auto ic) { constexpr int D = B * KB + decltype(ic)::value; if constexpr (D < NKS) { p0 = __builtin_amdgcn_mfma_f32_32x32x16_bf16(kfb[2 * decltype(ic)::value], qr[D], p0, 0, 0, 0); p1 = __builtin_amdgcn_mfma_f32_32x32x16_bf16(kfb[2 * decltype(ic)::value + 1], qr[D], p1, 0, 0, 0); } });
                }
            });
            }
            const LAS unsigned char* vb = lds + VOFF + cur * VSL + ((lane >> 4) & 1) * 32 + (lane & 3) * 8 + (4 * hi + ((lane & 15) >> 2)) * 64;
            s16x4 vlo[2][4], vhi[2][4];
#pragma unroll
            for (int d = 0; d < 2; ++d)
#pragma unroll
                for (int ks = 0; ks < 4; ++ks) { vlo[d][ks] = vtr(vb + d * 4096 + ks * 1024); vhi[d][ks] = vtr(vb + d * 4096 + ks * 1024 + 512); }
            __builtin_amdgcn_sched_group_barrier(0x100, 16, 0);
            if (CAUSAL && (64 * t + 63 > qmin)) { const int q = qmin + r32, kv0 = 64 * t + 4 * hi;
#pragma unroll
                for (int r = 0; r < 16; ++r) { const int kv = kv0 + (r & 3) + 8 * (r >> 2); if (kv > q) p0[r] = -INFINITY; if (kv + 32 > q) p1[r] = -INFINITY; } }
            const float rmd = rowmax32(p0, p1);
            if (!have || __any(rmd > THR)) {
                const float dd = have ? fmaxf(rmd, 0.f) : rmd, alpha = have ? __builtin_amdgcn_exp2f(-dd) : 1.f; l *= alpha; m += dd;
#pragma unroll
                for (int r = 0; r < 16; ++r) { p0[r] -= dd; p1[r] -= dd; negm[r] = -m; }
                if (have) {
                    if (hi == 0) wsf[r32] = alpha;
                    asm volatile("s_waitcnt lgkmcnt(0)" ::: "memory");
#pragma unroll
                    for (int r = 0; r < 16; ++r) { const float a = wsf[crow(r, hi)];
#pragma unroll
                        for (int d = 0; d < ND0; ++d) o[d][r] *= a; } }
                have = true;
            }
            float sacc = 0.f;
#pragma unroll
            for (int r = 0; r < 16; ++r) { p0[r] = __builtin_amdgcn_exp2f(p0[r]); p1[r] = __builtin_amdgcn_exp2f(p1[r]); }
            { float sb_ = 0.f;
#pragma unroll
              for (int r = 0; r < 16; ++r) { sacc += p0[r]; asm("" : "+v"(sacc)); sb_ += p1[r]; asm("" : "+v"(sb_)); }
              sacc += sb_; }
            l += sacc;
            u32x4 pw[4];
#pragma unroll
            for (int j = 0; j < 4; ++j) { pw[0][j] = cvtpk(p0[2 * j], p0[2 * j + 1]); pw[1][j] = cvtpk(p0[8 + 2 * j], p0[8 + 2 * j + 1]); pw[2][j] = cvtpk(p1[2 * j], p1[2 * j + 1]); pw[3][j] = cvtpk(p1[8 + 2 * j], p1[8 + 2 * j + 1]); }
#pragma unroll
            for (int d = 0; d < 2; ++d)
#pragma unroll
                for (int ks = 0; ks < 4; ++ks) { const bf16x8 vf = (bf16x8){vlo[d][ks][0], vlo[d][ks][1], vlo[d][ks][2], vlo[d][ks][3], vhi[d][ks][0], vhi[d][ks][1], vhi[d][ks][2], vhi[d][ks][3]};
                    o[d] = __builtin_amdgcn_mfma_f32_32x32x16_bf16(__builtin_bit_cast(bf16x8, pw[ks]), vf, o[d], 0, 0, 0); }
            if constexpr (ND0 > 2) {
#pragma unroll
                for (int d = 2; d < ND0; d += 2) { s16x4 wlo[2][4], whi[2][4];
#pragma unroll
                    for (int e = 0; e < 2; ++e)
#pragma unroll
                        for (int ks = 0; ks < 4; ++ks) { wlo[e][ks] = vtr(vb + (d + e) * 4096 + ks * 1024); whi[e][ks] = vtr(vb + (d + e) * 4096 + ks * 1024 + 512); }
#pragma unroll
                    for (int e = 0; e < 2; ++e)
#pragma unroll
                        for (int ks = 0; ks < 4; ++ks) { const bf16x8 vf = (bf16x8){wlo[e][ks][0], wlo[e][ks][1], wlo[e][ks][2], wlo[e][ks][3], whi[e][ks][0], whi[e][ks][1], whi[e][ks][2], whi[e][ks][3]};
                            o[d + e] = __builtin_amdgcn_mfma_f32_32x32x16_bf16(__builtin_bit_cast(bf16x8, pw[ks]), vf, o[d + e], 0, 0, 0); }
                    __builtin_amdgcn_sched_group_barrier(0x100, 16, 1); __builtin_amdgcn_sched_group_barrier(0x008, 8, 1); } }
        }
        ATT_WRITE(cur ^ 1, PAR ^ 1);
        if constexpr (EARLY) { float mw = have ? m : -1e30f;
#pragma unroll
            for (int o_ = 1; o_ < 32; o_ <<= 1) mw = fminf(mw, __shfl_xor(mw, o_));
            if (lane == 0) shf[8 + PAR * 8 + wid] = mw; }
        __syncthreads();
        return true;
    };
    for (int i = 0; i < nt; i += 2) { if (!body(std::integral_constant<int, 0>{}, i)) break; if (!body(std::integral_constant<int, 1>{}, i + 1)) break; }
    { auto rr = __builtin_amdgcn_permlane32_swap(__float_as_uint(l), __float_as_uint(l), false, false); l = __uint_as_float(rr[0]) + __uint_as_float(rr[1]); }
    if (hi == 0) wsf[32 + r32] = 1.f / l;
    asm volatile("s_waitcnt lgkmcnt(0)" ::: "memory");
    LAS bf16* stg = (LAS bf16*)(lds + wid * (ND0 * 2048));
#pragma unroll
    for (int r = 0; r < 16; ++r) { const float rl = wsf[32 + crow(r, hi)]; const int orow = crow(r, hi);
#pragma unroll
        for (int d = 0; d < ND0; ++d) stg[orow * (ND0 * 32) + d * 32 + r32] = f2bf(o[d][r] * rl); }
    asm volatile("s_waitcnt lgkmcnt(0)" ::: "memory");
    constexpr int CPR = ND0 * 4, RPI = 64 / CPR;
    bf16* ow = s.o + (size_t)(wid * 32) * s.ldo;
#pragma unroll
    for (int it = 0; it < 32 / RPI; ++it) { const int row = it * RPI + lane / CPR, ch = lane % CPR; const u32x4 v = *(const LAS u32x4*)(stg + row * (ND0 * 32) + ch * 8);
        *(u32x4*)(ow + (size_t)row * s.ldo + ch * 8) = v;
        if (WSSO) { float ss = 0.f;
#pragma unroll
            for (int j = 0; j < 4; ++j) { const float a = __uint_as_float(v[j] << 16), b = __uint_as_float(v[j] & 0xffff0000u); ss += a * a + b * b; }
#pragma unroll
            for (int sh = 1; sh < CPR; sh <<= 1) ss += __shfl_xor(ss, sh);
            if (ch == 0) s.sso[(size_t)(wid * 32 + row) * 16] = ss; } }
    __syncthreads();
#undef ATT_LOAD
#undef ATT_WRITE
}
__device__ __forceinline__ void xunit(const Src& s, LAS unsigned char* lds, const int wave) {
    int tid_ = (wave << 6) | lane_id(); asm volatile("" : "+v"(tid_));
    const int tid = tid_, lane = tid & 63, r32 = lane & 31, hi = lane >> 5, wid = __builtin_amdgcn_readfirstlane(tid >> 6);
    constexpr int KSL = 16384, VSL = 16384, VOFF = 2 * KSL, STG = VOFF + 2 * VSL;
    LAS float* wsf = (LAS float*)(lds + 131072) + wid * 64;
    f32x16 p[4][2];
#pragma unroll
    for (int t = 0; t < 4; ++t) { p[t][0] = f32x16{}; p[t][1] = f32x16{}; }
    typedef int xi4 __attribute__((ext_vector_type(4))); typedef int xi8 __attribute__((ext_vector_type(8)));
    u32x4 sreg[2][2];
#define X_LOAD(J) do { if constexpr ((J) < 4) { _Pragma("unroll") for (int i_ = 0; i_ < 2; ++i_) sreg[(J) & 1][i_] = *(const u32x4*)((const unsigned char*)s.k1 + (size_t)((J) * 64 + lane) * s.ldk1 + (wid + 8 * i_) * 16); } \
        else if constexpr ((J) < 12) { _Pragma("unroll") for (int i_ = 0; i_ < 2; ++i_) { const int p_ = wid + 8 * i_, dh_ = p_ >> 2, rg_ = p_ & 3; \
            sreg[(J) & 1][i_] = *(const u32x4*)(s.v + (size_t)(((J) & 3) * 64 + 16 * rg_ + (lane >> 2)) * s.ldv + (((J) - 4) >> 2) * 128 + dh_ * 32 + (lane & 3) * 8); } } } while (0)
#define X_WRITE(J) do { if constexpr ((J) < 12) { _Pragma("unroll") for (int i_ = 0; i_ < 2; ++i_) *(LAS u32x4*)(lds + ((J) < 4 ? 0 : VOFF) + ((J) & 1) * KSL + (wid + 8 * i_) * 1024 + lane * 16) = sreg[(J) & 1][i_]; } } while (0)
    X_LOAD(0); X_LOAD(1);
    xi8 q8[4];
    { const unsigned char* qw8 = (const unsigned char*)s.q + (size_t)(wid * 32 + r32) * s.ldq + hi * 32;
#pragma unroll
      for (int s_ = 0; s_ < 4; ++s_) { const xi4 lo_ = *(const xi4*)(qw8 + 64 * s_), hi_ = *(const xi4*)(qw8 + 64 * s_ + 16); q8[s_] = __builtin_shufflevector(lo_, hi_, 0, 1, 2, 3, 4, 5, 6, 7); } }
    X_WRITE(0);
    __syncthreads();
    cfor<0, 4>([&](auto ic) { constexpr int I = decltype(ic)::value;
        X_LOAD(I + 2);
        const LAS unsigned char* kq = lds + (I & 1) * KSL + r32 * 16 + hi * 2048; xi8 kf[8];
#pragma unroll
        for (int s_ = 0; s_ < 4; ++s_)
#pragma unroll
            for (int kb = 0; kb < 2; ++kb) { const xi4 lo_ = *(const LAS xi4*)(kq + s_ * 4096 + kb * 512), hi_ = *(const LAS xi4*)(kq + s_ * 4096 + 1024 + kb * 512); kf[2 * s_ + kb] = __builtin_shufflevector(lo_, hi_, 0, 1, 2, 3, 4, 5, 6, 7); }
#pragma unroll
        for (int s_ = 0; s_ < 4; ++s_) { p[I][0] = __builtin_amdgcn_mfma_scale_f32_32x32x64_f8f6f4(kf[2 * s_], q8[s_], p[I][0], 0, 0, 0, 0x7F7F7F7F, 0, 0x7F7F7F7F);
                                       p[I][1] = __builtin_amdgcn_mfma_scale_f32_32x32x64_f8f6f4(kf[2 * s_ + 1], q8[s_], p[I][1], 0, 0, 0, 0x7F7F7F7F, 0, 0x7F7F7F7F); }
        X_WRITE(I + 1);
        __syncthreads();
    });
    float m = rowmax32(p[0][0], p[0][1]);
#pragma unroll
    for (int t = 1; t < 4; ++t) m = fmaxf(m, rowmax32(p[t][0], p[t][1]));
    float l = 0.f; u32x4 pw[4][4];
#pragma unroll
    for (int t = 0; t < 4; ++t) { float sacc = 0.f;
#pragma unroll
        for (int r = 0; r < 16; ++r) { p[t][0][r] = __builtin_amdgcn_exp2f((p[t][0][r] - m) * (1.f / XQ8_SCALE)); p[t][1][r] = __builtin_amdgcn_exp2f((p[t][1][r] - m) * (1.f / XQ8_SCALE)); sacc += p[t][0][r] + p[t][1][r]; }
        l += sacc;
#pragma unroll
        for (int j = 0; j < 4; ++j) { pw[t][0][j] = cvtpk(p[t][0][2 * j], p[t][0][2 * j + 1]); pw[t][1][j] = cvtpk(p[t][0][8 + 2 * j], p[t][0][8 + 2 * j + 1]); pw[t][2][j] = cvtpk(p[t][1][2 * j], p[t][1][2 * j + 1]); pw[t][3][j] = cvtpk(p[t][1][8 + 2 * j], p[t][1][8 + 2 * j + 1]); } }
    { auto rr = __builtin_amdgcn_permlane32_swap(__float_as_uint(l), __float_as_uint(l), false, false); l = __uint_as_float(rr[0]) + __uint_as_float(rr[1]); }
    if (hi == 0) wsf[32 + r32] = 1.f / l;
    asm volatile("s_waitcnt lgkmcnt(0)" ::: "memory");
    f32x16 o[4];
    cfor<0, 8>([&](auto ic) { constexpr int I = decltype(ic)::value, TT = I & 3, DVH = I >> 2;
        X_LOAD(I + 6);
        if constexpr (TT == 0) {
#pragma unroll
            for (int d = 0; d < 4; ++d) o[d] = f32x16{}; }
        const LAS unsigned char* vb = lds + VOFF + (I & 1) * VSL + ((lane >> 4) & 1) * 32 + (lane & 3) * 8 + (4 * hi + ((lane & 15) >> 2)) * 64;
#pragma unroll
        for (int d = 0; d < 4; d += 2) { s16x4 vlo[2][4], vhi[2][4];
#pragma unroll
            for (int e = 0; e < 2; ++e)
#pragma unroll
                for (int ks = 0; ks < 4; ++ks) { vlo[e][ks] = vtr(vb + (d + e) * 4096 + ks * 1024); vhi[e][ks] = vtr(vb + (d + e) * 4096 + ks * 1024 + 512); }
#pragma unroll
            for (int e = 0; e < 2; ++e)
#pragma unroll
                for (int ks = 0; ks < 4; ++ks) { const bf16x8 vf = (bf16x8){vlo[e][ks][0], vlo[e][ks][1], vlo[e][ks][2], vlo[e][ks][3], vhi[e][ks][0], vhi[e][ks][1], vhi[e][ks][2], vhi[e][ks][3]};
                    o[d + e] = __builtin_amdgcn_mfma_f32_32x32x16_bf16(__builtin_bit_cast(bf16x8, pw[TT][ks]), vf, o[d + e], 0, 0, 0); } }
        X_WRITE(I + 5);
        if constexpr (TT == 3) {
            LAS bf16* stg = (LAS bf16*)(lds + STG + wid * 8192);
#pragma unroll
            for (int r = 0; r < 16; ++r) { const float rl = wsf[32 + crow(r, hi)]; const int orow = crow(r, hi);
#pragma unroll
                for (int d = 0; d < 4; ++d) stg[orow * 128 + d * 32 + r32] = f2bf(o[d][r] * rl); }
            asm volatile("s_waitcnt lgkmcnt(0)" ::: "memory");
            unsigned char* ow = (unsigned char*)s.o + (size_t)(wid * 32) * s.ldo + DVH * 128;
#pragma unroll
            for (int it = 0; it < 4; ++it) { const int row = it * 8 + (lane >> 3), ch = lane & 7; const u32x4 v0 = *(const LAS u32x4*)(stg + row * 128 + ch * 16), v1 = *(const LAS u32x4*)(stg + row * 128 + ch * 16 + 8); u32x4 f;
#pragma unroll
                for (int j = 0; j < 4; ++j) { const unsigned q_ = j < 2 ? v0[2 * j] : v1[2 * j - 4], r_ = j < 2 ? v0[2 * j + 1] : v1[2 * j - 3]; int w = 0;
                    w = __builtin_amdgcn_cvt_pk_fp8_f32(__uint_as_float(q_ << 16) * XO8_SCALE, __uint_as_float(q_ & 0xffff0000u) * XO8_SCALE, w, false);
                    w = __builtin_amdgcn_cvt_pk_fp8_f32(__uint_as_float(r_ << 16) * XO8_SCALE, __uint_as_float(r_ & 0xffff0000u) * XO8_SCALE, w, true); f[j] = (unsigned)w; }
                *(u32x4*)(ow + (size_t)row * s.ldo + ch * 16) = f; }
            asm volatile("s_waitcnt lgkmcnt(0)" ::: "memory"); }
        __syncthreads();
    });
#undef X_LOAD
#undef X_WRITE
}
}

#define XB_TMO      128
#define XB_XCNT(j)  (256  + 64 * (j))
#define XB_XSUB(j)  (1280 + 64 * (j))
#define XB_XGEN(j)  (2304 + 64 * (j))
#define XB_TOP      3328
#define XB_TOPGEN   3392
#define XCD_BAR_WORDS 3456
#define XB_SPIN_CAP (1u << 18)
__device__ __forceinline__ unsigned xb_ld(unsigned* p)              { return __hip_atomic_load(p, __ATOMIC_RELAXED, __HIP_MEMORY_SCOPE_AGENT); }
__device__ __forceinline__ unsigned xb_add(unsigned* p, unsigned v) { return __hip_atomic_fetch_add(p, v, __ATOMIC_RELAXED, __HIP_MEMORY_SCOPE_AGENT); }
__device__ __forceinline__ unsigned xb_xcc_id() { return (unsigned)__builtin_amdgcn_s_getreg((3 << 11) | 20) & 0xFu; }
#define XB_SPIN(cond, bar) do { unsigned _sp = 0; while (cond) { __builtin_amdgcn_s_sleep(1); \
    if ((++_sp & 255u) == 0u) { if (xb_ld(&(bar)[XB_TMO])) break; if (_sp > XB_SPIN_CAP) { atomicAdd(&(bar)[XB_TMO], 1u); break; } } } } while (0)
struct XcdBarrier { unsigned* bar; unsigned x; volatile LAS unsigned* st; bool wave0; };
__device__ __forceinline__ XcdBarrier xcd_barrier_post(unsigned* bar, volatile LAS unsigned* st, int wave) {
    XcdBarrier b; b.bar = bar; b.x = xb_xcc_id(); b.st = st; b.wave0 = (wave == 0);
    if (b.wave0 && lane_id() == 0) (void)xb_add(&bar[XB_XCNT(b.x)], 1u);
    return b;
}
__device__ __forceinline__ void xcd_barrier_complete(unsigned* bar, unsigned x, unsigned& nloc, unsigned& nx) {
    const unsigned G = gridDim.x * gridDim.y * gridDim.z;
    unsigned sum, cnt, mine, sp = 0u;
    for (;;) {
        sum = 0u; cnt = 0u; mine = 0u;
#pragma unroll
        for (unsigned j = 0; j < 16; ++j) { const unsigned c = xb_ld(&bar[XB_XCNT(j)]); sum += c; cnt += (c > 0u) ? 1u : 0u; mine = (j == x) ? c : mine; }
        if (sum == G) break;
        __builtin_amdgcn_s_sleep(1);
        if ((++sp & 255u) == 0u) { if (xb_ld(&bar[XB_TMO])) break; if (sp > XB_SPIN_CAP) { atomicAdd(&bar[XB_TMO], 1u); break; } }
    }
    nloc = mine > 0u ? mine : 1u; nx = cnt > 0u ? cnt : 1u;
}
__device__ __forceinline__ void xcd_barrier(const XcdBarrier& b) {
    asm volatile("s_waitcnt vmcnt(0)" ::: "memory");
    __syncthreads();
    if (b.wave0 && lane_id() == 0) {
        unsigned* bar = b.bar;
        __builtin_amdgcn_s_waitcnt(0);
        unsigned nloc = b.st[0], nx = b.st[1];
        if (nloc == 0u) { xcd_barrier_complete(bar, b.x, nloc, nx); b.st[0] = nloc; b.st[1] = nx; }
        const unsigned old = xb_add(&bar[XB_XSUB(b.x)], 1u);
        const unsigned gen = old / nloc;
        if (old + 1u == (gen + 1u) * nloc) {
            __builtin_amdgcn_fence(__ATOMIC_RELEASE, "agent");
            asm volatile("s_waitcnt vmcnt(0)" ::: "memory");
            const unsigned og = xb_add(&bar[XB_TOP], 1u);
            const unsigned tg = og / nx;
            if (og + 1u == (tg + 1u) * nx) xb_add(&bar[XB_TOPGEN], 1u);
            else XB_SPIN(xb_ld(&bar[XB_TOPGEN]) == tg, bar);
            __builtin_amdgcn_fence(__ATOMIC_ACQUIRE, "agent");
            xb_add(&bar[XB_XGEN(b.x)], 1u);
            asm volatile("s_waitcnt vmcnt(0)" ::: "memory");
        } else {
            XB_SPIN(xb_ld(&bar[XB_XGEN(b.x)]) == gen, bar);
            __builtin_amdgcn_fence(__ATOMIC_ACQUIRE, "agent");
            asm volatile("s_waitcnt vmcnt(0)" ::: "memory");
        }
    }
    __syncthreads();
}

constexpr int NWAVES = 8;
constexpr int RING_BYTES = 131072, TABS_OFF = RING_BYTES, MISC_OFF = TABS_OFF + 2048, LDS_BYTES = 147456;
constexpr int CW_FOXQ = 256;
constexpr int CW_BAR = 4096;
constexpr int N_PHASES = 11;
constexpr float W8_SCALE = 32.f, ACT8_SCALE = 4.f, Y8_SCALE = 16.f;
#ifndef PROBE_REP
#define PROBE_REP -1
#endif
#define REPS(k) for (int rep_ = 0; rep_ < ((PROBE_REP) == (k) ? 2 : 1); ++rep_)
struct MegaArgs {
    const float* in[25]; float* out; unsigned char* ws; int ph_lo, ph_hi; int coop; int pad;
};
struct Frame {
    LAS unsigned char* lds; volatile LAS unsigned* MISC; LAS unsigned* tabs;
    int wave, vcu, G;
};
struct P0Item { const float* W; bf16* WT; const float* kscale; const float* kscale2; int K, N, NT, c_lo, c_hi, item; float cscale; bool f8; };
__device__ __forceinline__ void p0_load(const P0Item& d, f32x4 (&v)[8], int lane) {
    const int nblk = d.NT / 32, kb = d.item / nblk, nb = d.item % nblk, k0 = 64 * kb, n0 = 32 * nb; const int r8 = lane >> 3, c4 = lane & 7, nn = n0 + 4 * c4;
#pragma unroll
    for (int i = 0; i < 8; ++i) { const int kk = i * 8 + r8; v[i] = (f32x4){0.f, 0.f, 0.f, 0.f}; if (nn < d.N) v[i] = __builtin_nontemporal_load((const f32x4*)(d.W + (size_t)(k0 + kk) * d.N + nn)); }
}
__device__ __forceinline__ void p0_finish(const P0Item& d, const f32x4 (&v)[8], LAS float* scr, int lane) {
    const int nblk = d.NT / 32, kb = d.item / nblk, nb = d.item % nblk, k0 = 64 * kb, n0 = 32 * nb; const int r8 = lane >> 3, c4 = lane & 7, nn = n0 + 4 * c4;
    const float cs = (nn >= d.c_lo && nn < d.c_hi) ? d.cscale : 1.f;
#pragma unroll
    for (int i = 0; i < 8; ++i) { const int kk = i * 8 + r8; float ks = cs; if (d.kscale) ks *= (d.kscale2 && k0 >= 512) ? d.kscale2[k0 + kk - 512] : d.kscale[k0 + kk];
        LAS float* p = scr + kk * 33 + 4 * c4; p[0] = v[i][0] * ks; p[1] = v[i][1] * ks; p[2] = v[i][2] * ks; p[3] = v[i][3] * ks; }
    asm volatile("s_waitcnt lgkmcnt(0)" ::: "memory");
    const int c = lane & 7;
#pragma unroll
    for (int j = 0; j < 4; ++j) { const int n = (lane >> 3) + 8 * j; const LAS float* s = scr + (8 * c) * 33 + n;
        if (d.f8) { int w0 = 0, w1 = 0; w0 = __builtin_amdgcn_cvt_pk_fp8_f32(s[0 * 33], s[1 * 33], w0, false); w0 = __builtin_amdgcn_cvt_pk_fp8_f32(s[2 * 33], s[3 * 33], w0, true);
            w1 = __builtin_amdgcn_cvt_pk_fp8_f32(s[4 * 33], s[5 * 33], w1, false); w1 = __builtin_amdgcn_cvt_pk_fp8_f32(s[6 * 33], s[7 * 33], w1, true);
            *(u32x2*)((unsigned char*)d.WT + (size_t)(n0 + n) * d.K + k0 + 8 * c) = (u32x2){(unsigned)w0, (unsigned)w1}; }
        else { u32x4 o; o.x = cvtpk(s[0 * 33], s[1 * 33]); o.y = cvtpk(s[2 * 33], s[3 * 33]); o.z = cvtpk(s[4 * 33], s[5 * 33]); o.w = cvtpk(s[6 * 33], s[7 * 33]);
            *(u32x4*)(d.WT + (size_t)(n0 + n) * d.K + k0 + 8 * c) = o; } }
    asm volatile("s_waitcnt lgkmcnt(0)" ::: "memory");
}
__device__ __forceinline__ void rms_row_to_bf16(const float* xrow, const float* g, bf16* orow, int lane) {
    const f32x4* xr = (const f32x4*)xrow + lane; const f32x4* gr = (const f32x4*)g + lane;
    f32x4 v[4]; float s = 0.f;
#pragma unroll
    for (int j = 0; j < 4; ++j) { v[j] = xr[64 * j]; s += sum4sq(v[j]); }
    const float r = rsqrtf(wave_sum(s) * (1.f / DM) + EPS);
#pragma unroll
    for (int j = 0; j < 4; ++j) { const f32x4 o = v[j] * r * gr[64 * j]; st_bf4(orow + 4 * lane + 256 * j, o); }
}
constexpr size_t WS_WRG = 31 * MiB;
constexpr size_t WS_KN = 1 * MiB + 512 * 1024;
constexpr size_t WS_XF8 = 416 * MiB;
constexpr size_t WS_H1F8 = 880 * MiB;
constexpr size_t WS_XOF8 = 912 * MiB;
constexpr size_t WS_KM8 = 944 * MiB;
constexpr size_t WS_GSORT = 868 * MiB;
constexpr size_t WS_LF = 996 * MiB;

__device__ __forceinline__ P0Item p0_decode(const MegaArgs& a, int it) {
    unsigned char* ws = a.ws;
    constexpr int I_IN = 16 * 64, I_Q = 4 * 24, I_KV = 2 * 32, I_SQ = 16 * 32, I_MKV = 16 * 64, I_GU = 16 * 64, I_D = 16 * 32;
    P0Item d; d.kscale = nullptr; d.kscale2 = nullptr; d.cscale = 1.f; d.c_lo = 0; d.c_hi = 0; d.f8 = false; int r = it;
    if (r < NEXP * I_GU) { const int e = r / I_GU; d.W = a.in[20] + (size_t)e * DM * 2048; d.K = DM; d.N = 2048; d.NT = 2048; d.WT = (bf16*)(ws + WS_WGU + (size_t)e * 2048 * DM); d.f8 = true; d.cscale = W8_SCALE; d.c_hi = 2048; d.item = r % I_GU; return d; } r -= NEXP * I_GU;
    if (r < NEXP * I_D) { const int e = r / I_D; d.W = a.in[22] + (size_t)e * DEXP * DM; d.K = DEXP; d.N = DM; d.NT = DM; d.WT = (bf16*)(ws + WS_WD + (size_t)e * DM * DEXP); d.f8 = true; d.cscale = W8_SCALE; d.c_hi = DM; d.item = r % I_D; return d; } r -= NEXP * I_D;
    if (r < I_IN) { d.W = a.in[3]; d.K = DM; d.N = IN_COLS; d.NT = NPROJ; d.WT = (bf16*)(ws + WS_WIN); d.cscale = C2F; d.c_lo = C_FQ; d.c_hi = C_FK; d.item = r; return d; } r -= I_IN;
    if (r < I_Q) { d.W = a.in[5]; d.K = 256; d.N = 768; d.NT = 768; d.WT = (bf16*)(ws + WS_WQ); d.kscale = a.in[4]; d.cscale = C2M; d.c_lo = 0; d.c_hi = 768; d.item = r; return d; } r -= I_Q;
    if (r < I_KV) { d.W = a.in[7]; d.K = 128; d.N = 1024; d.NT = 1024; d.WT = (bf16*)(ws + WS_WKV); d.kscale = a.in[6]; d.item = r; return d; } r -= I_KV;
    if (r < I_SQ) { d.W = a.in[11]; d.K = DM; d.N = DM; d.NT = DM; d.WT = (bf16*)(ws + WS_WO); d.kscale = a.in[9]; d.kscale2 = a.in[10]; d.item = r; return d; } r -= I_SQ;
    if (r < I_SQ) { d.W = a.in[14]; d.K = DM; d.N = DM; d.NT = DM; d.WT = (bf16*)(ws + WS_WXQ); d.kscale = a.in[12]; d.cscale = C2X * WXQ8_SCALE; d.c_lo = 0; d.c_hi = DM; d.f8 = true; d.item = r; return d; } r -= I_SQ;
    if (r < I_SQ) { d.W = a.in[16]; d.K = DM; d.N = DM; d.NT = DM; d.WT = (bf16*)(ws + WS_WXO); d.cscale = WXO8_SCALE; d.c_lo = 0; d.c_hi = DM; d.f8 = true; d.item = r; return d; } r -= I_SQ;
    d.W = a.in[15]; d.K = DM; d.N = 2048; d.NT = 2048; d.WT = (bf16*)(ws + WS_WMKV); d.item = r; return d;
}
constexpr int P0_NITEMS = 16 * 64 + 4 * 24 + 2 * 32 + 3 * 16 * 32 + 16 * 64 + NEXP * 16 * 64 + NEXP * 16 * 32;
__device__ __forceinline__ void rms_rows2_to_bf16(const float* x0, const float* x1, const float* g, bf16* o0, bf16* o1, int lane) {
    const f32x4* xa = (const f32x4*)x0 + lane; const f32x4* xb = (const f32x4*)x1 + lane; const f32x4* gr = (const f32x4*)g + lane;
    f32x4 va[4], vb[4]; float sa = 0.f, sb = 0.f;
#pragma unroll
    for (int j = 0; j < 4; ++j) { va[j] = __builtin_nontemporal_load(xa + 64 * j); vb[j] = __builtin_nontemporal_load(xb + 64 * j); }
#pragma unroll
    for (int j = 0; j < 4; ++j) { sa += sum4sq(va[j]); sb += sum4sq(vb[j]); }
    const float ra = rsqrtf(wave_sum(sa) * (1.f / DM) + EPS), rb = rsqrtf(wave_sum(sb) * (1.f / DM) + EPS);
#pragma unroll
    for (int j = 0; j < 4; ++j) { const f32x4 gg = gr[64 * j]; st_bf4(o0 + 4 * lane + 256 * j, va[j] * ra * gg); st_bf4(o1 + 4 * lane + 256 * j, vb[j] * rb * gg); }
}
__device__ __forceinline__ void p0_prologue(const Frame& F, const MegaArgs& a) {
    LAS float* scr = (LAS float*)(F.lds + F.wave * 16384);
    int lane = lane_id(); asm volatile("" : "+v"(lane)); const int gw = F.vcu * NWAVES + F.wave, NGW = F.G * NWAVES;
    unsigned char* ws = a.ws;
    { f32x4 va[8], vb[8]; int it = gw;
      if (it < P0_NITEMS) { P0Item da = p0_decode(a, it); p0_load(da, va, lane);
        for (;;) {
            const int itb = it + NGW; P0Item db; const bool hb = itb < P0_NITEMS; if (hb) { db = p0_decode(a, itb); p0_load(db, vb, lane); }
            p0_finish(da, va, scr, lane);
            if (!hb) break;
            const int ita = itb + NGW; const bool ha = ita < P0_NITEMS; if (ha) { da = p0_decode(a, ita); p0_load(da, va, lane); }
            p0_finish(db, vb, scr, lane);
            if (!ha) break;
            it = ita;
        } } }
    for (int m = 2 * gw; m < T; m += 2 * NGW) rms_rows2_to_bf16(a.in[0] + (size_t)m * DM, a.in[0] + (size_t)(m + 1) * DM, a.in[2], (bf16*)(ws + WS_XN) + (size_t)m * DM, (bf16*)(ws + WS_XN) + (size_t)(m + 1) * DM, lane);
    for (int m = 2 * gw; m < TM; m += 2 * NGW) rms_rows2_to_bf16(a.in[1] + (size_t)m * DM, a.in[1] + (size_t)(m + 1) * DM, a.in[13], (bf16*)(ws + WS_MEMN) + (size_t)m * DM, (bf16*)(ws + WS_MEMN) + (size_t)(m + 1) * DM, lane);
    { float* tab = (float*)(ws + WS_ROPE); for (int i = gw * 64 + lane; i < 4096 * 16; i += NGW * 64) { const int pos = i >> 4, j = i & 15; const float inv = powf(10000.f, -(float)j / 16.f); const float ang = (float)pos * inv; tab[2 * i] = cosf(ang); tab[2 * i + 1] = sinf(ang); } }
    { bf16* wh = (bf16*)(ws + WS_WRG); bf16* wl = wh + DM * NEXP;
      for (int i = gw * 64 + lane; i < DM * NEXP; i += NGW * 64) { const float w = a.in[18][i] * a.in[17][i >> 5]; const bf16 h = f2bf(w); const int o_ = (i & 31) * DM + (i >> 5); wh[o_] = h; wl[o_] = f2bf(w - bf2f(h)); } }
}
__device__ __forceinline__ void p2_scan_item(const float* LF, float* cum, bf16* kaug, int item, int lane) {
    const int b = item >> 3, ck = item & 7; const float* base = LF + (size_t)b * SEQ * 8;
    float carry[8];
#pragma unroll
    for (int h = 0; h < 8; ++h) carry[h] = 0.f;
    for (int p = lane; p < ck * 512; p += 64) { const f32x4 x0 = *(const f32x4*)(base + (size_t)p * 8), x1 = *(const f32x4*)(base + (size_t)p * 8 + 4);
#pragma unroll
        for (int e = 0; e < 4; ++e) { carry[e] += x0[e]; carry[4 + e] += x1[e]; } }
#pragma unroll
    for (int h = 0; h < 8; ++h) carry[h] = wave_sum(carry[h]);
    const int s0 = ck * 512 + lane * 8;
    float v[8][8];
#pragma unroll
    for (int i = 0; i < 8; ++i) { const f32x4 x0 = *(const f32x4*)(base + (size_t)(s0 + i) * 8), x1 = *(const f32x4*)(base + (size_t)(s0 + i) * 8 + 4);
#pragma unroll
        for (int e = 0; e < 4; ++e) { v[i][e] = x0[e]; v[i][4 + e] = x1[e]; } }
#pragma unroll
    for (int h = 0; h < 8; ++h) {
#pragma unroll
        for (int i = 1; i < 8; ++i) v[i][h] += v[i - 1][h];
        float tot = v[7][h], inc = tot;
#pragma unroll
        for (int o = 1; o < 64; o <<= 1) { const float up = __shfl_up(inc, o); if (lane >= o) inc += up; }
        const float off = carry[h] + (inc - tot);
#pragma unroll
        for (int i = 0; i < 8; ++i) v[i][h] += off;
    }
#pragma unroll
    for (int h = 0; h < 8; ++h) {
        float* cr = cum + (size_t)(b * 8 + h) * SEQ + s0; *(f32x4*)cr = (f32x4){v[0][h], v[1][h], v[2][h], v[3][h]}; *(f32x4*)(cr + 4) = (f32x4){v[4][h], v[5][h], v[6][h], v[7][h]};
        bf16* kr = kaug + ((size_t)(b * 8 + h) * SEQ + s0) * 8;
#pragma unroll
        for (int i = 0; i < 8; ++i) { const float x = -v[i][h] * LOG2E; const unsigned hi = cvtpk(x, 0.f) & 0xffffu; const float r1 = x - __uint_as_float(hi << 16); const unsigned mid = cvtpk(r1, 0.f) & 0xffffu;
            const float r2 = r1 - __uint_as_float(mid << 16); const unsigned lo = cvtpk(r2, 0.f) & 0xffffu; *(u32x4*)(kr + i * 8) = (u32x4){hi | (mid << 16), lo, 0u, 0u}; }
    }
}

struct EpiGateUp {
    static constexpr bool PERM = true, MID = false;
    const float* bias; unsigned char* ACT8;
    __device__ __forceinline__ void act(const f32x4 (&a4)[2][2], const f32x4 (&bv)[2][2], unsigned (&w)[2]) const {
        const f32x4 sv = (f32x4){1.f / W8_SCALE, ACT8_SCALE / W8_SCALE, 1.f / W8_SCALE, ACT8_SCALE / W8_SCALE};
#pragma unroll
        for (int bj = 0; bj < 2; ++bj) { const f32x4 v0 = a4[bj][0] * sv + bv[bj][0], v1 = a4[bj][1] * sv + bv[bj][1];
            const f32x4 G = (f32x4){fminf(v0[0], 7.f), fminf(v0[2], 7.f), fminf(v1[0], 7.f), fminf(v1[2], 7.f)};
            const f32x4 L = (f32x4){__builtin_amdgcn_fmed3f(v0[1], -6.f * ACT8_SCALE, 8.f * ACT8_SCALE), __builtin_amdgcn_fmed3f(v0[3], -6.f * ACT8_SCALE, 8.f * ACT8_SCALE),
                                    __builtin_amdgcn_fmed3f(v1[1], -6.f * ACT8_SCALE, 8.f * ACT8_SCALE), __builtin_amdgcn_fmed3f(v1[3], -6.f * ACT8_SCALE, 8.f * ACT8_SCALE)};
            const f32x4 tt = G * (-1.702f * LOG2E);
            const f32x4 dd = (f32x4){__builtin_amdgcn_exp2f(tt[0]), __builtin_amdgcn_exp2f(tt[1]), __builtin_amdgcn_exp2f(tt[2]), __builtin_amdgcn_exp2f(tt[3])} + 1.f;
            const f32x4 rr = (f32x4){__builtin_amdgcn_rcpf(dd[0]), __builtin_amdgcn_rcpf(dd[1]), __builtin_amdgcn_rcpf(dd[2]), __builtin_amdgcn_rcpf(dd[3])};
            const f32x4 a = (G * rr) * L;
            int x = 0; x = __builtin_amdgcn_cvt_pk_fp8_f32(a[0], a[1], x, false); x = __builtin_amdgcn_cvt_pk_fp8_f32(a[2], a[3], x, true); w[bj] = (unsigned)x; }
    }
    __device__ __forceinline__ void operator()(f32x4 (&acc)[2][2][4][2], const pg8::Unit& u, int wr, int wc, int fr, int fq) const {
        asm volatile("" : "+v"(fr), "+v"(fq));
        const int c0 = u.col0 + wc * 32 + fq * 8; const float* bp = bias + (size_t)u.e * 2048 + c0;
        const f32x4 bm = (f32x4){1.f, ACT8_SCALE, 1.f, ACT8_SCALE}, ba = (f32x4){0.f, ACT8_SCALE, 0.f, ACT8_SCALE};
        f32x4 bv[2][2];
#pragma unroll
        for (int bj = 0; bj < 2; ++bj) { bv[bj][0] = *(const f32x4*)(bp + bj * 128) * bm + ba; bv[bj][1] = *(const f32x4*)(bp + bj * 128 + 4) * bm + ba; }
#pragma unroll
        for (int ai = 0; ai < 2; ++ai)
#pragma unroll
            for (int mp = 0; mp < 2; ++mp) {
                asm volatile("" : "+v"(acc[ai][0][2 * mp][0]), "+v"(acc[ai][0][2 * mp][1]), "+v"(acc[ai][1][2 * mp][0]), "+v"(acc[ai][1][2 * mp][1]));
                unsigned d[2][2];
#pragma unroll
                for (int q = 0; q < 2; ++q) { const int m = 2 * mp + q; unsigned w[2]; const f32x4 a4[2][2] = {{acc[ai][0][m][0], acc[ai][0][m][1]}, {acc[ai][1][m][0], acc[ai][1][m][1]}}; act(a4, bv, w);
                    const auto r = __builtin_amdgcn_permlane16_swap(w[0], w[1], false, false); d[q][0] = r[0]; d[q][1] = r[1]; }
                const auto r0 = __builtin_amdgcn_permlane32_swap(d[0][0], d[1][0], false, false), r1 = __builtin_amdgcn_permlane32_swap(d[0][1], d[1][1], false, false);
                int f2 = fr, q2 = fq; asm volatile("" : "+v"(f2), "+v"(q2));
                const int rl = ai * 128 + wr * 64 + (2 * mp + (q2 >> 1)) * 16 + f2; const unsigned rowi = rl < u.rows ? (unsigned)(u.row0 + rl) : (unsigned)(T * 4 + rl);
                *(u32x4*)(ACT8 + (rowi * (unsigned)DEXP + (unsigned)((u.col0 >> 1) + wc * 16 + (q2 & 1) * 64))) = (u32x4){r0[0], r1[0], r0[1], r1[1]};
                asm volatile("" ::: "memory"); }
    }
};
struct EpiDown {
    static constexpr bool PERM = true, MID = false;
    const float* bias; const float* gsort; const int* list0; unsigned char* Y8;
    __device__ __forceinline__ void operator()(f32x4 (&acc)[2][2][4][2], const pg8::Unit& u, int wr, int wc, int fr, int fq) const {
        asm volatile("" : "+v"(fr), "+v"(fq));
        const int c0 = u.col0 + wc * 32 + fq * 8; const float* bp = bias + (size_t)u.e * DM + c0;
        const float* gp = gsort + (u.list - list0) + wr * 64 + fq * 16 + fr;
        const float g0 = gp[0] * Y8_SCALE, g1 = gp[128] * Y8_SCALE;
        f32x4 bv[2][2];
#pragma unroll
        for (int bj = 0; bj < 2; ++bj) { bv[bj][0] = *(const f32x4*)(bp + bj * 128); bv[bj][1] = *(const f32x4*)(bp + bj * 128 + 4); }
#pragma unroll
        for (int g = 0; g < 8; ++g) { const int ai = g >> 2, m = g & 3;
                int f2 = fr, q2 = fq; asm volatile("" : "+v"(f2), "+v"(q2));
                const float gg = __int_as_float(__builtin_amdgcn_ds_bpermute(4 * (m * 16 + f2), __float_as_int(ai ? g1 : g0)));
                const int rl = ai * 128 + wr * 64 + m * 16 + f2; const unsigned rowi = rl < u.rows ? (unsigned)(u.row0 + rl) : (unsigned)(T * 4 + rl);
                unsigned w[2][2];
#pragma unroll
                for (int bj = 0; bj < 2; ++bj) { const f32x4 v0 = (acc[ai][bj][m][0] * (1.f / (W8_SCALE * ACT8_SCALE)) + bv[bj][0]) * gg, v1 = (acc[ai][bj][m][1] * (1.f / (W8_SCALE * ACT8_SCALE)) + bv[bj][1]) * gg;
                    int w0 = 0, w1 = 0; w0 = __builtin_amdgcn_cvt_pk_fp8_f32(v0[0], v0[1], w0, false); w0 = __builtin_amdgcn_cvt_pk_fp8_f32(v0[2], v0[3], w0, true);
                    w1 = __builtin_amdgcn_cvt_pk_fp8_f32(v1[0], v1[1], w1, false); w1 = __builtin_amdgcn_cvt_pk_fp8_f32(v1[2], v1[3], w1, true); w[bj][0] = (unsigned)w0; w[bj][1] = (unsigned)w1; }
                const auto r0 = __builtin_amdgcn_permlane16_swap(w[0][0], w[1][0], false, false), r1 = __builtin_amdgcn_permlane16_swap(w[0][1], w[1][1], false, false);
                *(u32x4*)(Y8 + (rowi * (unsigned)DM + (unsigned)(u.col0 + wc * 32 + ((q2 & 1) ? 128 + 8 * (q2 - 1) : 8 * q2)))) = (u32x4){r0[0], r1[0], r0[1], r1[1]};
                asm volatile("" ::: "memory");
            }
    }
};
struct MoeSched {
    pg8::TileOrder o; const volatile LAS int* tpre; const volatile LAS int* roff;
    const char* A; size_t a_row_bytes; const char* Wt; size_t w_exp_bytes; int brow; const int* list; bool gather;
    __device__ __forceinline__ void tables(const volatile LAS int* tp, const volatile LAS int* ro) { tpre = tp; roff = ro; }
    __device__ __forceinline__ bool next(int i, pg8::Unit& u) const { int pm, pn; if (!o.tile(i, pm, pn)) return false;
        int l = lane_id(); const int j = l < 32 ? l : 32; const int tv = tpre[j], rv = roff[j];
        const unsigned long long mk = __ballot(l >= 1 && l < NEXP && tv <= pm); const int e = __builtin_popcountll(mk);
        const int tp = __builtin_amdgcn_readlane(tv, e), r0 = __builtin_amdgcn_readlane(rv, e), r1 = __builtin_amdgcn_readlane(rv, e + 1);
        const int mt = pm - tp, cnt = r1 - r0; u.row0 = r0 + mt * 256; u.rows = (cnt - mt * 256) < 256 ? (cnt - mt * 256) : 256; u.col0 = pn * 256; u.pn = pn; u.e = e;
        u.a = gather ? A : A + (size_t)u.row0 * a_row_bytes; u.b = Wt + (size_t)e * w_exp_bytes + (size_t)pn * 256 * brow; u.list = list + (size_t)e * T + mt * 256; return true; }
};
__device__ __forceinline__ int moe_tables(const Frame& F, const int* cnt) {
    volatile LAS int* tp = (volatile LAS int*)(F.MISC + 64); volatile LAS int* ro = (volatile LAS int*)(F.MISC + 128);
    __syncthreads();
    if (F.wave == 0 && lane_id() == 0) { int t = 0, r = 0; for (int e = 0; e < NEXP; ++e) { const int c = __hip_atomic_load(cnt + e, __ATOMIC_RELAXED, __HIP_MEMORY_SCOPE_AGENT); tp[e] = t; ro[e] = r; t += (c + 255) >> 8; r += c; } tp[NEXP] = t; ro[NEXP] = r; }
    __syncthreads();
    return __builtin_amdgcn_readfirstlane(tp[NEXP]);
}
__device__ __forceinline__ void p7_route(const Frame& F, const MegaArgs& a, const size_t dummy) {
    unsigned char* ws = a.ws; const float* wrg = (const float*)(ws + WS_WRG); const bf16* h2 = (const bf16*)(ws + WS_XN); const float* gln = a.in[17]; const float* br = a.in[19];
    unsigned char* XF8 = ws + WS_XF8 + dummy; int* cnt = (int*)(ws + WS_CTL) + CW_CNT + (dummy ? 64 : 0);   const size_t d2 = dummy ? (WS_QM - WS_TOPI) : 0; int* topi = (int*)(ws + WS_TOPI + d2); float* gate = (float*)(ws + WS_GATE + d2); int* slot = (int*)(ws + WS_SLOT + d2); int* list = (int*)(ws + WS_LIST + d2); float* gsort = (float*)(ws + WS_GSORT + (dummy ? 8 * MiB : 0));
    LAS float* W = (LAS float*)F.lds; int tid = (F.wave << 6) | lane_id(); asm volatile("" : "+v"(tid)); const int lane = tid & 63;
    volatile LAS int* lcnt = (volatile LAS int*)(F.MISC + 16); volatile LAS int* lbase = (volatile LAS int*)(F.MISC + 192); LAS int* rec = (LAS int*)(F.MISC + 256);
    { const bf16* wh = (const bf16*)wrg; LAS unsigned char* Wb = F.lds;
      for (int idx = tid; idx < 8192; idx += NWAVES * 64) { const int pc = idx >> 12, R = (idx >> 5) & 127, c = idx & 31, kq_ = R >> 5, e = R & 31;
          *(LAS u32x4*)(Wb + pc * 65536 + R * 512 + ((c ^ (R & 15)) << 4)) = *(const u32x4*)(wh + (size_t)pc * DM * NEXP + e * DM + 32 * c + 8 * kq_); } }
    if (tid < NEXP) lcnt[tid] = 0;
    __syncthreads();
    const int TPB = T / F.G, t0 = F.vcu * TPB, TPW = TPB / NWAVES;
    const int li = lane & 15, kq = lane >> 4, tw0 = t0 + F.wave * TPW;
    float rs;
    f32x4 d0 = (f32x4){0.f, 0.f, 0.f, 0.f}, d1 = (f32x4){0.f, 0.f, 0.f, 0.f};
    { const bf16* xrow = h2 + (size_t)(tw0 + li) * DM + 8 * kq; const LAS unsigned char* w0 = F.lds + (kq * 32 + li) * 512;
      float ssq = 0.f;
#pragma unroll
      for (int c = 0; c < 4; ++c) { u32x4 xr[8];
#pragma unroll
          for (int u = 0; u < 8; ++u) xr[u] = *(const u32x4*)(xrow + 32 * (8 * c + u));
#pragma unroll
          for (int u = 0; u < 8; ++u) { const int sw = ((8 * c + u) ^ li) << 4; const bf16x8 av = __builtin_bit_cast(bf16x8, xr[u]);
              const bf16x8 bh0 = *(const LAS bf16x8*)(w0 + sw), bl0 = *(const LAS bf16x8*)(w0 + 65536 + sw), bh1 = *(const LAS bf16x8*)(w0 + 8192 + sw), bl1 = *(const LAS bf16x8*)(w0 + 65536 + 8192 + sw);
              d0 = __builtin_amdgcn_mfma_f32_16x16x32_bf16(av, bh0, d0, 0, 0, 0); d1 = __builtin_amdgcn_mfma_f32_16x16x32_bf16(av, bh1, d1, 0, 0, 0);
              d0 = __builtin_amdgcn_mfma_f32_16x16x32_bf16(av, bl0, d0, 0, 0, 0); d1 = __builtin_amdgcn_mfma_f32_16x16x32_bf16(av, bl1, d1, 0, 0, 0);
#pragma unroll
              for (int j = 0; j < 4; ++j) { const float xl = __uint_as_float(xr[u][j] << 16), xh = __uint_as_float(xr[u][j] & 0xffff0000u); ssq += xl * xl + xh * xh; } } }
      ssq += __shfl_xor(ssq, 16); ssq += __shfl_xor(ssq, 32); rs = rsqrtf(ssq * (1.f / DM) + EPS); }
    { const float b0 = br[li], b1 = br[li + 16];
#pragma unroll
      for (int r = 0; r < 4; ++r) { const float rt = __shfl(rs, 4 * kq + r); float c0 = d0[r] * rt + b0, c1 = d1[r] * rt + b1;
        float tv[4]; int ti[4];
#pragma unroll
        for (int k = 0; k < 4; ++k) { float bv = c0; int bi = li; if (c1 > c0) { bv = c1; bi = li + 16; }
#pragma unroll
            for (int o = 1; o < 16; o <<= 1) { const float ov = __shfl_xor(bv, o); const int oi = __shfl_xor(bi, o); if (ov > bv || (ov == bv && oi < bi)) { bv = ov; bi = oi; } }
            tv[k] = bv; ti[k] = bi; if (bi == li) c0 = -INFINITY; if (bi == li + 16) c1 = -INFINITY; }
        const float e1 = __expf(tv[1] - tv[0]), e2 = __expf(tv[2] - tv[0]), e3 = __expf(tv[3] - tv[0]); const float inv = 1.f / (1.f + e1 + e2 + e3);
        const float gs[4] = {inv, e1 * inv, e2 * inv, e3 * inv};
        const int tok = F.wave * TPW + 4 * kq + r;
#pragma unroll
        for (int k = 0; k < 4; ++k) if ((ti[k] & 15) == li) { const int ex = ti[k]; const int ls = __hip_atomic_fetch_add((LAS int*)(lcnt + ex), 1, __ATOMIC_RELAXED, __HIP_MEMORY_SCOPE_WORKGROUP); LAS int* rr = rec + (tok * 4 + k) * 3; rr[0] = ex; rr[1] = __float_as_int(gs[k]); rr[2] = ls; } } }
    { f32x4 gv[4];
#pragma unroll
      for (int j = 0; j < 4; ++j) gv[j] = *(const f32x4*)(gln + 16 * lane + 4 * j);
#pragma unroll
      for (int tb = 0; tb < 16; tb += 8) { u32x4 xw[8][2];
#pragma unroll
          for (int tt = 0; tt < 8; ++tt)
#pragma unroll
              for (int j = 0; j < 2; ++j) xw[tt][j] = *(const u32x4*)(h2 + (size_t)(tw0 + tb + tt) * DM + 16 * lane + 8 * j);
#pragma unroll
          for (int tt = 0; tt < 8; ++tt) { const float rt = __shfl(rs, tb + tt); u32x4 f;
#pragma unroll
              for (int j = 0; j < 4; ++j) { const unsigned a0 = xw[tt][j >> 1][(j & 1) * 2], a1 = xw[tt][j >> 1][(j & 1) * 2 + 1];
                  const f32x4 y = (f32x4){__uint_as_float(a0 << 16), __uint_as_float(a0 & 0xffff0000u), __uint_as_float(a1 << 16), __uint_as_float(a1 & 0xffff0000u)} * rt * gv[j];
                  int w = 0; w = __builtin_amdgcn_cvt_pk_fp8_f32(y[0], y[1], w, false); w = __builtin_amdgcn_cvt_pk_fp8_f32(y[2], y[3], w, true); f[j] = (unsigned)w; }
              *(u32x4*)(XF8 + (size_t)(tw0 + tb + tt) * DM + 16 * lane) = f; } } }
    __syncthreads();
    if (tid < NEXP) lbase[tid] = atomicAdd(cnt + tid, (int)lcnt[tid]);
    __syncthreads();
    for (int idx = tid; idx < TPB * 4; idx += NWAVES * 64) { const LAS int* r = rec + idx * 3; const int e = r[0], sl = lbase[e] + r[2]; const int gi = t0 * 4 + idx;
        topi[gi] = e; gate[gi] = __int_as_float(r[1]); slot[gi] = sl; list[(size_t)e * T + sl] = gi; gsort[(size_t)e * T + sl] = __int_as_float(r[1]); }
}
__device__ __forceinline__ void p10_combine(const Frame& F, const MegaArgs& a, float* dst) {
    unsigned char* ws = a.ws; const unsigned char* Y8 = ws + WS_Y; const bf16* h2 = (const bf16*)(ws + WS_XN); const int* topi = (const int*)(ws + WS_TOPI); const int* slot = (const int*)(ws + WS_SLOT); const float* g = a.in[24];
    const volatile LAS int* ro = (const volatile LAS int*)(F.MISC + 128); int lane = lane_id(); asm volatile("" : "+v"(lane));
    const int t0 = F.vcu * NWAVES + F.wave, ts = F.G * NWAVES;
    f32x4 gv[4];
#pragma unroll
    for (int j = 0; j < 4; ++j) gv[j] = *(const f32x4*)(g + 16 * lane + 4 * j);
    constexpr int NB = 3;
    u32x4 yn[NB][4], hn[NB][2]; int en[NB], sn[NB];
#define P10_IDX(bt) do { _Pragma("unroll") for (int q_ = 0; q_ < NB; ++q_) { const int tt_ = (bt) + q_ * ts; en[q_] = 0; sn[q_] = 0; if (tt_ < T && lane < 4) { en[q_] = topi[tt_ * 4 + lane]; sn[q_] = slot[tt_ * 4 + lane]; } } } while (0)
#define P10_LOAD(bt) do { _Pragma("unroll") for (int q_ = 0; q_ < NB; ++q_) { const int tt_ = (bt) + q_ * ts; if (tt_ < T) { \
        const int pl_ = (lane < 4 ? ro[en[q_]] : 0) + sn[q_]; \
        _Pragma("unroll") for (int k = 0; k < 4; ++k) { const size_t pos = (size_t)__builtin_amdgcn_readlane(pl_, k); yn[q_][k] = *(const u32x4*)(Y8 + pos * DM + 16 * lane); } \
        _Pragma("unroll") for (int j = 0; j < 2; ++j) hn[q_][j] = *(const u32x4*)(h2 + (size_t)tt_ * DM + 16 * lane + 8 * j); } } } while (0)
    P10_IDX(t0); P10_LOAD(t0); P10_IDX(t0 + NB * ts);
    for (int tb = t0; tb < T; tb += NB * ts) {
        u32x4 y[NB][4], hw[NB][2];
#pragma unroll
        for (int q = 0; q < NB; ++q) {
#pragma unroll
            for (int k = 0; k < 4; ++k) y[q][k] = yn[q][k];
#pragma unroll
            for (int j = 0; j < 2; ++j) hw[q][j] = hn[q][j]; }
        if (tb + NB * ts < T) { P10_LOAD(tb + NB * ts); P10_IDX(tb + 2 * NB * ts); }
#pragma unroll
        for (int q = 0; q < NB; ++q) { const int t = tb + q * ts; if (t < T) {
            f32x4 v[4];
#pragma unroll
            for (int j = 0; j < 4; ++j) { f32x4 ys = (f32x4){0.f, 0.f, 0.f, 0.f};
#pragma unroll
                for (int k = 0; k < 4; ++k) { const f32x2 lo = __builtin_amdgcn_cvt_pk_f32_fp8((int)y[q][k][j], false), hi = __builtin_amdgcn_cvt_pk_f32_fp8((int)y[q][k][j], true); ys[0] += lo.x; ys[1] += lo.y; ys[2] += hi.x; ys[3] += hi.y; }
                const unsigned w0 = hw[q][j >> 1][(j & 1) * 2], w1 = hw[q][j >> 1][(j & 1) * 2 + 1];
                v[j] = (f32x4){__uint_as_float(w0 << 16), __uint_as_float(w0 & 0xffff0000u), __uint_as_float(w1 << 16), __uint_as_float(w1 & 0xffff0000u)} + ys * (1.f / Y8_SCALE); }
            float sq = 0.f;
#pragma unroll
            for (int j = 0; j < 4; ++j) sq += sum4sq(v[j]);
            const float r = rsqrtf(wave_sum(sq) * (1.f / DM) + EPS);
#pragma unroll
            for (int j = 0; j < 4; ++j) *(f32x4*)(dst + (size_t)t * DM + 16 * lane + 4 * j) = v[j] * r * gv[j]; } }
    }
#undef P10_LOAD
#undef P10_IDX
}
__global__ void __launch_bounds__(NWAVES * 64, 2) mega_fwd(MegaArgs args) {
    extern __shared__ __attribute__((aligned(16))) unsigned char lds_raw[];
    Frame F;
    F.lds = (LAS unsigned char*)lds_raw; F.MISC = (volatile LAS unsigned*)(F.lds + MISC_OFF); F.tabs = (LAS unsigned*)(F.lds + TABS_OFF);
    F.wave = __builtin_amdgcn_readfirstlane((int)threadIdx.x >> 6);
    F.G = gridDim.x; { const int bx = blockIdx.x; F.vcu = (F.G % 8 == 0) ? (bx % 8) * (F.G / 8) + bx / 8 : bx; }
    unsigned char* ws = args.ws;
    unsigned* ctl = (unsigned*)(ws + WS_CTL);
    for (int u = (F.wave << 6) | lane_id(); u < (LDS_BYTES - MISC_OFF) / 4; u += NWAVES * 64) ((LAS unsigned*)(F.lds + MISC_OFF))[u] = 0u;
    __syncthreads();
    XcdBarrier bar; bar.bar = ctl + CW_BAR; bar.x = 0; bar.st = nullptr; bar.wave0 = false;
    if (args.coop) bar = xcd_barrier_post(ctl + CW_BAR, F.MISC + 8, F.wave);
    const int lo = args.ph_lo, hi = args.ph_hi;
#define IN(k) (lo <= (k) && (k) < hi)
#define SEAM(k) do { if (args.coop && IN(k) && IN((k) + 1)) { xcd_barrier(bar); if ((PROBE_REP) == 100) xcd_barrier(bar); } } while (0)
    bf16 *WinT = (bf16*)(ws + WS_WIN), *WqT = (bf16*)(ws + WS_WQ), *WkvT = (bf16*)(ws + WS_WKV), *WmkvT = (bf16*)(ws + WS_WMKV);
    bf16 *XN = (bf16*)(ws + WS_XN), *PROJ = (bf16*)(ws + WS_PROJ), *QM = (bf16*)(ws + WS_QM), *KVM = (bf16*)(ws + WS_KVM), *MEMN = (bf16*)(ws + WS_MEMN), *KVMEM = (bf16*)(ws + WS_KVMEM);
    float *rope = (float*)(ws + WS_ROPE), *ssqq = (float*)(ws + WS_SSQQ), *ssqkv = (float*)(ws + WS_SSQKV), *LF = (float*)(ws + WS_LF);

    if (IN(0)) { REPS(0) p0_prologue(F, args); }
    if (args.coop == 2) cg::this_grid().sync();
    SEAM(0);
    if (IN(1)) REPS(1) {
        pg8::DenseSched S; S.init(XN, DM, WinT, T, NPROJ, DM, F.G, (int)blockIdx.x);
        EpiProj E{PROJ, ssqq, ssqkv, rope, LF, args.in[8]};
        pg8::gemm_phase<EpiProj, pg8::DenseSched, false>(F.lds, F.tabs, DM, DM, S, E, F.wave);
    }
    SEAM(1);
    if (IN(2)) REPS(2) {
        const int GA = (F.G * 3) / 4, bx = (int)blockIdx.x;
        if (bx >= GA) { const int sid = bx - GA, ns = F.G - GA;
          if (F.wave == 0) for (int it = sid; it < 64; it += ns) { int ln = lane_id(); asm volatile("" : "+v"(ln)); p2_scan_item(LF, (float*)(ws + WS_CUM), (bf16*)(ws + WS_KAUG), it, ln); }
          for (int item = sid * NWAVES + F.wave; item < BATCH * 64; item += ns * NWAVES) {
          { int ln = lane_id(); asm volatile("" : "+v"(ln)); const int b = item >> 6, t = item & 63; const bf16* kr = PROJ + ((size_t)b * SEQ + t * 64 + ln) * NPROJ + C_FK; float* KN = (float*)(ws + WS_KN);
            for (int h = 0; h < 8; ++h) { float s2 = 0.f;
#pragma unroll
                for (int c = 0; c < 8; ++c) { const u32x4 w = *(const u32x4*)(kr + h * 64 + c * 8);
#pragma unroll
                    for (int j = 0; j < 4; ++j) { const float a_ = __uint_as_float(w[j] << 16), b_ = __uint_as_float(w[j] & 0xffff0000u); s2 += a_ * a_ + b_ * b_; } }
#pragma unroll
                for (int o_ = 1; o_ < 64; o_ <<= 1) s2 = fmaxf(s2, __shfl_xor(s2, o_));
                if (ln == 0) KN[(size_t)(b * 8 + h) * 64 + t] = sqrtf(s2); } } } }
        __syncthreads();
        if (F.G >= 8 && (F.G % 32) == 0) {
            if (bx < GA) {
                { pg8::DenseSched S; S.init(PROJ + C_QLAT, NPROJ, WqT, T, 768, 256, GA, bx); EpiScale<4, true> E{QM, 768, ssqq, 1.f / 256.f, rope}; pg8::gemm_phase<EpiScale<4, true>, pg8::DenseSched, false>(F.lds, F.tabs, 256, NPROJ, S, E, F.wave); }
                { pg8::DenseSched S; S.init(PROJ + C_KVLAT, NPROJ, WkvT, T, 1024, 128, GA, bx); EpiScale<4, false> E{KVM, 1024, ssqkv, 1.f / 128.f, nullptr}; pg8::gemm_phase<EpiScale<4, false>, pg8::DenseSched, false>(F.lds, F.tabs, 128, NPROJ, S, E, F.wave); }
            } else {
                pg8::DenseSched S; S.init(MEMN, DM, WmkvT, TM, 2048, DM, F.G - GA, bx - GA); EpiMemKV E{KVMEM, ws + WS_KM8}; pg8::gemm_phase<EpiMemKV, pg8::DenseSched, false>(F.lds, F.tabs, DM, DM, S, E, F.wave);
            }
        }
    }
    SEAM(2);
    if (IN(3)) REPS(3) {
        bf16* O = (bf16*)(ws + WS_O); float* SSO = (float*)(ws + WS_SSO); const bf16* KAUG = (const bf16*)(ws + WS_KAUG);
        for (int P = F.vcu; P < 512; P += F.G) {
            const int bh = P >> 3, pair = P & 7, b = bh >> 3, h = bh & 7;
            for (int j = 0; j < 2; ++j) {
                const int qb = j ? 15 - pair : pair; const size_t r0 = (size_t)b * SEQ, rq = r0 + (size_t)qb * 256;
                att::Src s; s.nt = 4 * (qb + 1); s.q0 = qb * 256; s.ldo = DM; s.kn = nullptr; s.cum = nullptr;
                s.q = QM + rq * 768 + h * 96; s.ldq = 768; s.k1 = KVM + r0 * 1024 + h * 128; s.ldk1 = 1024; s.k2 = PROJ + r0 * NPROJ + C_KPE; s.ldk2 = NPROJ; s.v = KVM + r0 * 1024 + h * 128 + 64; s.ldv = 1024;
                s.o = O + rq * DM + h * 64; s.sso = SSO + rq * 16 + h;
                att::unit<6, 8, 12, 2, true, false, false, true>(s, F.lds, F.wave); }
        }
        if (args.coop) {
            unsigned* fq = ctl + CW_FOXQ; volatile LAS unsigned* tk = F.MISC + 48; const bool lead = F.wave == 0 && lane_id() == 0;
            if (lead) tk[0] = __hip_atomic_fetch_add(fq, 1u, __ATOMIC_RELAXED, __HIP_MEMORY_SCOPE_AGENT);
            __syncthreads();
            unsigned cur = __builtin_amdgcn_readfirstlane(tk[0]);
            while (cur < 1024u) {
                unsigned nx = 0; if (lead) nx = __hip_atomic_fetch_add(fq, 1u, __ATOMIC_RELAXED, __HIP_MEMORY_SCOPE_AGENT);
                const int r = (int)(cur >> 7), qb = 15 - (int)((cur >> 3) & 15), b = (int)(cur & 7);
                const float* bfg = args.in[8]; int h = 0;
                for (int c = 0; c < 8; ++c) { int rk = 0; for (int j = 0; j < 8; ++j) rk += (bfg[j] > bfg[c] || (bfg[j] == bfg[c] && j < c)) ? 1 : 0; if (rk == r) h = c; }
                const size_t r0 = (size_t)b * SEQ, rq = r0 + (size_t)qb * 256;
                att::Src s; s.nt = 4 * (qb + 1); s.q0 = qb * 256; s.ldo = DM;
                s.q = PROJ + rq * NPROJ + C_FQ + h * 64; s.ldq = NPROJ; s.k1 = PROJ + r0 * NPROJ + C_FK + h * 64; s.ldk1 = NPROJ; s.k2 = KAUG + (size_t)(b * 8 + h) * SEQ * 8; s.ldk2 = 8; s.v = PROJ + r0 * NPROJ + C_FV + h * 64; s.ldv = NPROJ;
                s.o = O + rq * DM + 512 + h * 64; s.sso = SSO + rq * 16 + 8 + h; s.kn = (const float*)(ws + WS_KN) + (size_t)(b * 8 + h) * 64; s.cum = (const float*)(ws + WS_CUM) + (size_t)(b * 8 + h) * SEQ;
                att::unit<5, 8, 9, 2, true, true, true, true, true>(s, F.lds, F.wave);
                if (lead) tk[0] = nx;
                __syncthreads();
                cur = __builtin_amdgcn_readfirstlane(tk[0]);
            }
        }
    }
    SEAM(3);
    bf16 *WoT = (bf16*)(ws + WS_WO), *WxqT = (bf16*)(ws + WS_WXQ), *WxoT = (bf16*)(ws + WS_WXO), *XQ = (bf16*)(ws + WS_XQ), *XO = (bf16*)(ws + WS_XO);
    float* ssq1 = (float*)(ws + WS_SSQ1);
    if (IN(4)) REPS(4) {
        pg8::DenseSched S; S.init((const bf16*)(ws + WS_O), DM, WoT, T, DM, DM, F.G, (int)blockIdx.x);
        EpiWo E{(const float*)(ws + WS_SSO), args.in[0], args.out, XN, ssq1, ws + WS_H1F8};
        pg8::gemm_phase<EpiWo, pg8::DenseSched, false>(F.lds, F.tabs, DM, DM, S, E, F.wave);
    }
    SEAM(4);
    if (IN(5)) REPS(5) {
        pg8::DenseSched S; S.init((const bf16*)(ws + WS_H1F8), DM / 2, WxqT, T, DM, DM / 2, F.G, (int)blockIdx.x);
        { EpiXQ8 E{ws + WS_XQ, ssq1, XQ8_SCALE / (H8_SCALE * WXQ8_SCALE)}; pg8::gemm_phase<EpiXQ8, pg8::DenseSched, false, true>(F.lds, F.tabs, DM, DM, S, E, F.wave); }
        asm volatile("s_waitcnt vmcnt(0)" ::: "memory"); __syncthreads();
        __builtin_amdgcn_fence(__ATOMIC_ACQUIRE, "agent"); asm volatile("s_waitcnt vmcnt(0)" ::: "memory"); __syncthreads();
        pg8::Unit u; pg8::DenseSched S2; S2.init(XN, DM, WxqT, T, DM, DM, F.G, (int)blockIdx.x);
        for (int i = 0; S2.next(i, u); ++i) {
            const int b = u.row0 / SEQ, h = u.pn;
            { att::Src s; s.kn = nullptr; s.cum = nullptr; s.nt = MEMLEN / 64; s.q0 = 0; s.q = (const bf16*)(ws + WS_XQ + (size_t)u.row0 * DM + h * 256); s.ldq = DM; s.k1 = (const bf16*)(ws + WS_KM8 + (size_t)b * MEMLEN * 1024 + h * 256); s.ldk1 = 1024; s.k2 = s.k1; s.ldk2 = 1024;
              s.v = KVMEM + (size_t)b * MEMLEN * 2048 + 1024 + h * 256; s.ldv = 2048; s.o = (bf16*)(ws + WS_XOF8 + (size_t)u.row0 * DM + h * 256); s.ldo = DM; s.sso = nullptr;
              att::xunit(s, F.lds, F.wave); }
        }
    }
    SEAM(5);
    if (IN(6)) {
        pg8::DenseSched S; S.init((const bf16*)(ws + WS_XOF8), DM / 2, WxoT, T, DM, DM / 2, F.G, (int)blockIdx.x);
        EpiAddOut E{XN, 1.f / (XO8_SCALE * WXO8_SCALE)};
        pg8::gemm_phase<EpiAddOut, pg8::DenseSched, false, true>(F.lds, F.tabs, DM, DM, S, E, F.wave);
    }
    SEAM(6);
    int* cnt = (int*)(ws + WS_CTL) + CW_CNT; const int* list = (const int*)(ws + WS_LIST);
    if (IN(7)) { if ((PROBE_REP) == 7) p7_route(F, args, (size_t)(WS_KVM - WS_XF8)); p7_route(F, args, 0); }
    SEAM(7);
    if (IN(8)) REPS(8) {
        const int nMt = moe_tables(F, cnt);
        MoeSched S; S.o.init(nMt, 2048 / 256, F.G, (int)blockIdx.x); S.tables((const volatile LAS int*)(F.MISC + 64), (const volatile LAS int*)(F.MISC + 128));
        S.A = (const char*)(ws + WS_XF8); S.a_row_bytes = 0; S.Wt = (const char*)(ws + WS_WGU); S.w_exp_bytes = (size_t)2048 * DM; S.brow = DM; S.list = list; S.gather = true;
        EpiGateUp E{args.in[21], ws + WS_ACT};
        pg8::gemm_phase<EpiGateUp, MoeSched, true, true>(F.lds, F.tabs, DM, DM, S, E, F.wave);
    }
    SEAM(8);
    if (IN(9)) REPS(9) {
        const int nMt = __builtin_amdgcn_readfirstlane(((const volatile LAS int*)(F.MISC + 64))[NEXP]);
        MoeSched S; S.o.init(nMt, DM / 256, F.G, (int)blockIdx.x); S.tables((const volatile LAS int*)(F.MISC + 64), (const volatile LAS int*)(F.MISC + 128));
        S.A = (const char*)(ws + WS_ACT); S.a_row_bytes = (size_t)DEXP; S.Wt = (const char*)(ws + WS_WD); S.w_exp_bytes = (size_t)DM * DEXP; S.brow = DEXP; S.list = list; S.gather = false;
        EpiDown E{args.in[23], (const float*)(ws + WS_GSORT), list, ws + WS_Y};
        pg8::gemm_phase<EpiDown, MoeSched, false, true>(F.lds, F.tabs, DEXP, DEXP, S, E, F.wave);
    }
    SEAM(9);
    if (IN(10)) { if ((PROBE_REP) == 10) p10_combine(F, args, (float*)(ws + WS_XQ)); p10_combine(F, args, args.out); }
#undef IN
#undef SEAM
}
extern "C" void kernel_launch(void* const* d_in, const int* in_sizes, int n_in, void* d_out, int out_size, void* d_ws, size_t ws_size, hipStream_t stream) {
    if (n_in != 25 || ws_size < WS_END || out_size != T * DM) { fprintf(stderr, "kernel_launch: unexpected shapes n_in %d ws %zu out %d\n", n_in, ws_size, out_size); return; }
    static int grid = 0;
    if (grid == 0) {
        int dev = 0, cus = 0, per_cu = 0;
        if (hipGetDevice(&dev) != hipSuccess || hipDeviceGetAttribute(&cus, hipDeviceAttributeMultiprocessorCount, dev) != hipSuccess) { fprintf(stderr, "kernel_launch: device query failed\n"); grid = -1; return; }
        if (hipFuncSetAttribute((const void*)mega_fwd, hipFuncAttributeMaxDynamicSharedMemorySize, LDS_BYTES) != hipSuccess) { fprintf(stderr, "kernel_launch: hipFuncSetAttribute failed\n"); grid = -1; return; }
        if (hipOccupancyMaxActiveBlocksPerMultiprocessor(&per_cu, (const void*)mega_fwd, NWAVES * 64, LDS_BYTES) != hipSuccess || per_cu < 1) { fprintf(stderr, "kernel_launch: occupancy query says %d blocks per CU\n", per_cu); (void)hipGetLastError(); grid = -1; return; }
        grid = cus;
    }
    if (grid < 0) return;
    (void)hipMemsetAsync((char*)d_ws + WS_CTL, 0, 1 * MiB, stream);
    MegaArgs a{}; for (int i = 0; i < 25; ++i) a.in[i] = (const float*)d_in[i]; a.out = (float*)d_out; a.ws = (unsigned char*)d_ws; a.ph_lo = 0; a.ph_hi = N_PHASES; a.coop = 1;
    void* params[] = {&a};
    const hipError_t e = hipLaunchCooperativeKernel((const void*)mega_fwd, dim3(grid), dim3(NWAVES * 64), params, LDS_BYTES, stream);
    if (e != hipSuccess) fprintf(stderr, "cooperative launch failed: %s (grid %d)\n", hipGetErrorString(e), grid);
}
```

```cpp
#include <hip/hip_runtime.h>
#include <cstdio>
#include <cstdint>

constexpr int DM = 1024, BATCH = 8, SEQ = 4096, T = BATCH * SEQ, MEMLEN = 256, TM = BATCH * MEMLEN;
constexpr int NPROJ = 2048;
constexpr int C_QLAT = 0, C_KVLAT = 256, C_KPE = 384, C_FQ = 416, C_FK = 928, C_FV = 1440, C_FL = 1952, IN_COLS = 1960;
constexpr int NEXP = 32, TOPK = 4, DEXP = 1024;
constexpr float EPS = 1e-6f, LOG2E = 1.4426950408889634f;
constexpr float C2M = 0.10206207261596577f * LOG2E;
constexpr float C2F = 0.125f * LOG2E;
constexpr float C2X = 0.0625f * LOG2E;

typedef unsigned short bf16;
__device__ __forceinline__ float bf2f(bf16 v) { return __uint_as_float(((unsigned)v) << 16); }
__device__ __forceinline__ bf16 f2bf(float f) { unsigned u = __float_as_uint(f); return (bf16)((u + 0x7fffu + ((u >> 16) & 1u)) >> 16); }

constexpr size_t MiB = 1u << 20;
constexpr size_t WS_CTL = 0;
constexpr size_t WS_ROPE = 1 * MiB;
constexpr size_t WS_CUM = 2 * MiB;
constexpr size_t WS_KAUG = 3 * MiB;
constexpr size_t WS_SSQQ = 7 * MiB;
constexpr size_t WS_SSQKV = 7 * MiB + 512 * 1024;
constexpr size_t WS_SSO = 8 * MiB;
constexpr size_t WS_SSQ1 = 994 * MiB;
constexpr size_t WS_TOPI = 10 * MiB + 512 * 1024;
constexpr size_t WS_GATE = 11 * MiB;
constexpr size_t WS_SLOT = 11 * MiB + 512 * 1024;
constexpr size_t WS_LIST = 12 * MiB;
constexpr size_t WS_WIN = 16 * MiB;
constexpr size_t WS_WQ = 20 * MiB;
constexpr size_t WS_WKV = 20 * MiB + 512 * 1024;
constexpr size_t WS_WO = 21 * MiB;
constexpr size_t WS_WXQ = 23 * MiB;
constexpr size_t WS_WMKV = 25 * MiB;
constexpr size_t WS_WXO = 29 * MiB;
constexpr size_t WS_WGU = 32 * MiB;
constexpr size_t WS_WD = 160 * MiB;
constexpr size_t WS_XN = 224 * MiB;
constexpr size_t WS_PROJ = 288 * MiB;
constexpr size_t WS_QM = 416 * MiB;
constexpr size_t WS_KVM = 464 * MiB;
constexpr size_t WS_O = 528 * MiB;
constexpr size_t WS_XQ = 592 * MiB;
constexpr size_t WS_XO = 656 * MiB;
constexpr size_t WS_MEMN = 720 * MiB;
constexpr size_t WS_KVMEM = 724 * MiB;
constexpr size_t WS_ACT = 736 * MiB;
constexpr size_t WS_SC = 736 * MiB;
constexpr size_t WS_Y = 288 * MiB;
constexpr size_t WS_END = 1000 * MiB;
constexpr int CW_CNT = 64;

#include <hip/hip_cooperative_groups.h>
#include <type_traits>
namespace cg = cooperative_groups;
#define LAS __attribute__((address_space(3)))
#define GAS __attribute__((address_space(1)))
typedef short bf16x8 __attribute__((ext_vector_type(8)));
typedef short s16x4 __attribute__((ext_vector_type(4)));
typedef float f32x4 __attribute__((ext_vector_type(4)));
typedef float f32x2 __attribute__((ext_vector_type(2)));
typedef float f32x16 __attribute__((ext_vector_type(16)));
typedef unsigned u32x4 __attribute__((ext_vector_type(4)));
typedef unsigned u32x2 __attribute__((ext_vector_type(2)));
typedef __bf16 bf16x2_t __attribute__((ext_vector_type(2)));
__device__ __forceinline__ unsigned cvtpk(float lo, float hi) { f32x2 v = {lo, hi}; bf16x2_t b = __builtin_convertvector(v, bf16x2_t); return __builtin_bit_cast(unsigned, b); }
__device__ __forceinline__ int lane_id() { int l; asm volatile("v_mbcnt_lo_u32_b32 %0, -1, 0\n\tv_mbcnt_hi_u32_b32 %0, -1, %0" : "=v"(l)); return l; }
__device__ __forceinline__ float wave_sum(float v) {
#pragma unroll
    for (int o = 1; o < 64; o <<= 1) v += __shfl_xor(v, o);
    return v;
}

constexpr float XQ8_SCALE = 32.f;
constexpr float WXQ8_SCALE = 256.f, WXO8_SCALE = 32.f, H8_SCALE = 4.f, XO8_SCALE = 64.f;
namespace pg8 {
constexpr int BM = 256, BK = 64, HALF = 128, HTB = HALF * BK * 2  , STAGE_BYTES = 8 * HTB, NXCD = 8, WGM = 8;
__host__ __device__ __forceinline__ int lds_byte(int r, int c) { const int st = (r >> 4) * 2 + (c >> 5), rr = r & 15, cc = c & 31, ob = rr * 64 + cc * 2; return st * 1024 + (ob ^ (((ob >> 9) & 1) << 5)); }
__host__ __device__ __forceinline__ void stage_rc(int b, int& R, int& C) { const int st = b / 1024, sb = b % 1024, swz = sb ^ (((sb >> 9) & 1) << 5); R = (st >> 1) * 16 + swz / 64; C = (st & 1) * 32 + (swz % 64) / 2; }
__host__ __device__ __forceinline__ int perm32(int rho) { const int n = rho >> 4, i = rho & 15; return 8 * (i >> 2) + 4 * n + (i & 3); }

struct Unit { int row0, col0, rows, pn, e; const char* a; const char* b; const int* list; };

typedef int i32x8 __attribute__((ext_vector_type(8)));
typedef int i32x4 __attribute__((ext_vector_type(4)));
template <class Epi, class Sched, bool GATHER, bool F8 = false>
__device__ __forceinline__ void gemm_phase(LAS unsigned char* lds, LAS unsigned* tabs, const int K, const int lda, const Sched& S, const Epi& E, const int wave) {
    int tid_ = (wave << 6) | lane_id(); asm volatile("" : "+v"(tid_));
    const int tid = tid_, wid = __builtin_amdgcn_readfirstlane(tid >> 6), lane = tid & 63, wr = wid >> 2, wc = wid & 3, fr = lane & 15, fq = lane >> 4;
    const int nt = K / (F8 ? 128 : BK);
    const int rowA = F8 ? lda : 2 * lda, rowB = F8 ? K : 2 * K;
    unsigned vB[2], vA[2], vcu[2][2];
#pragma unroll
    for (int i = 0; i < 2; ++i) { int R, C; stage_rc(tid * 16 + i * 8192, R, C); const int Rb = Epi::PERM ? ((R & ~31) + perm32(R & 31)) : R;
        vB[i] = (unsigned)(Rb * rowB + 2 * C); vA[i] = (unsigned)(R * rowA + 2 * C);
#pragma unroll
        for (int h = 0; h < 2; ++h) vcu[h][i] = 0u; }
    const size_t hstepA = (size_t)HALF * rowA;
    const size_t kstep = (size_t)(BK * 2);
    const size_t hstepB = (size_t)HALF * rowB;
    const unsigned ldsw = (unsigned)wid * 1024u;
    const unsigned lds_u32 = (unsigned)__builtin_amdgcn_readfirstlane((int)(unsigned)(size_t)lds);
    const int aoff = lds_byte(wr * 64 + fr, F8 ? fq * 16 : fq * 8); int boff = lds_byte(wc * 32 + fr, F8 ? fq * 16 : fq * 8) + 4 * HTB;
    asm volatile("" : "+v"(boff));
#define PG8_SA(b, h) (((b) * 2 + (h)) * HTB)
#define PG8_SB(b, h) ((4 + (b) * 2 + (h)) * HTB)
#define PG8_STAGE(bufoff, gbase, voff) do { const unsigned long long _gb = (unsigned long long)(gbase); \
        const unsigned _glo = __builtin_amdgcn_readfirstlane((unsigned)_gb), _ghi = __builtin_amdgcn_readfirstlane((unsigned)(_gb >> 32)); const unsigned long long _sb = ((unsigned long long)_ghi << 32) | _glo; \
        _Pragma("unroll") for (int _i = 0; _i < 2; ++_i) { unsigned _keep; const unsigned _dst = lds_u32 + (unsigned)(bufoff) + ldsw + _i * 8192u; \
        asm volatile("s_mov_b32 %0, m0\n\ts_mov_b32 m0, %3\n\ts_nop 0\n\tglobal_load_lds_dwordx4 %1, %2\n\ts_mov_b32 m0, %0" : "=&s"(_keep) : "v"((voff)[_i]), "s"(_sb), "s"(_dst) : "memory"); } } while (0)
#define PG8_STAGE_A(bufoff, gbase, h, vsel) do { if constexpr (GATHER) { PG8_STAGE(bufoff, gbase, (vsel)[h]); } else { PG8_STAGE(bufoff, (gbase) + (h) * hstepA, vA); } } while (0)
#define PG8_RD8(dst, off) do { const i32x4 _l = *(const LAS i32x4*)(lds + (off)), _h = *(const LAS i32x4*)(lds + (off) + 16); dst = __builtin_shufflevector(_l, _h, 0, 1, 2, 3, 4, 5, 6, 7); } while (0)
#define PG8_LDA(dst, dst8, b, h) do { if constexpr (F8) { _Pragma("unroll") for (int m = 0; m < 4; ++m) PG8_RD8(dst8[m], PG8_SA(b, h) + aoff + m * 2048); } \
        else { _Pragma("unroll") for (int m = 0; m < 4; ++m) _Pragma("unroll") for (int k = 0; k < 2; ++k) dst[m][k] = *(const LAS bf16x8*)(lds + PG8_SA(b, h) + aoff + m * 2048 + k * 1024); } } while (0)
#define PG8_LDB(dst, dst8, b, h) do { if constexpr (F8) { _Pragma("unroll") for (int n = 0; n < 2; ++n) PG8_RD8(dst8[n], ((b) * 2 + (h)) * HTB + boff + n * 2048); } \
        else { _Pragma("unroll") for (int n = 0; n < 2; ++n) _Pragma("unroll") for (int k = 0; k < 2; ++k) dst[n][k] = *(const LAS bf16x8*)(lds + ((b) * 2 + (h)) * HTB + boff + n * 2048 + k * 1024); } } while (0)
#define PG8_MMA(ai, bj, At, At8, Bt, Bt8) do { __builtin_amdgcn_s_setprio(1); _Pragma("unroll") for (int m = 0; m < 4; ++m) _Pragma("unroll") for (int n = 0; n < 2; ++n) { \
        if constexpr (F8) acc[ai][bj][m][n] = __builtin_amdgcn_mfma_scale_f32_16x16x128_f8f6f4(Bt8[n], At8[m], acc[ai][bj][m][n], 0, 0, 0, 0x7F7F7F7F, 0, 0x7F7F7F7F); \
        else { _Pragma("unroll") for (int k = 0; k < 2; ++k) acc[ai][bj][m][n] = __builtin_amdgcn_mfma_f32_16x16x32_bf16(Bt[n][k], At[m][k], acc[ai][bj][m][n], 0, 0, 0); } } \
        __builtin_amdgcn_s_setprio(0); } while (0)
#define PG8_WAIT_V(n) asm volatile("s_waitcnt vmcnt(" #n ")" ::: "memory")
#define PG8_WAIT_L(n) asm volatile("s_waitcnt lgkmcnt(" #n ")" ::: "memory")
#define PG8_BAR __builtin_amdgcn_s_barrier()
#define PG8_SCHED __builtin_amdgcn_sched_barrier(0)
#define PG8_TABDMA(u, slot) __builtin_amdgcn_global_load_lds((const unsigned*)((u).list + lane_id() * 4), (LAS unsigned*)(tabs + (slot) * 256), 16, 0, 0)
#define PG8_TABOFF(dst, slot) do { const int _tid = (wid << 6) | lane_id(); _Pragma("unroll") for (int _i = 0; _i < 2; ++_i) { int _R, _C; stage_rc(_tid * 16 + _i * 8192, _R, _C); \
        _Pragma("unroll") for (int _h = 0; _h < 2; ++_h) { unsigned _t = tabs[(slot) * 256 + _h * HALF + _R] >> 2; _t = _t < (unsigned)(T - 1) ? _t : (unsigned)(T - 1); \
        dst[_h][_i] = _t * (unsigned)rowA + 2u * (unsigned)_C; } } } while (0)
    __builtin_amdgcn_s_waitcnt(0x0F70);
    Unit cur, nxt; int ui = 0;
    if (!S.next(0, cur)) return;
    if constexpr (GATHER) { PG8_TABDMA(cur, 0); PG8_WAIT_V(0); PG8_BAR; PG8_TABOFF(vcu, 0); PG8_WAIT_L(0); }
    f32x4 acc[2][2][4][2];
    bf16x8 At[4][2], B0[2][2], B1[2][2]; i32x8 At8[4], B08[2], B18[2];
    const char* cA = cur.a; const char* cB = cur.b;
    PG8_STAGE(PG8_SB(0, 0), cB, vB); PG8_STAGE(PG8_SB(0, 1), cB + hstepB, vB); PG8_STAGE_A(PG8_SA(0, 0), cA, 0, vcu); PG8_STAGE_A(PG8_SA(0, 1), cA, 1, vcu);
    if (wr == 1) PG8_BAR;
    PG8_WAIT_V(2); PG8_BAR;
    PG8_STAGE(PG8_SB(1, 0), cB + kstep, vB); PG8_STAGE_A(PG8_SA(1, 0), cA + kstep, 0, vcu); PG8_STAGE(PG8_SB(1, 1), cB + hstepB + kstep, vB);
    PG8_WAIT_V(6); PG8_BAR;
    asm volatile("" ::: "memory");
#pragma unroll
    for (int a = 0; a < 2; ++a)
#pragma unroll
        for (int b = 0; b < 2; ++b)
#pragma unroll
            for (int m = 0; m < 4; ++m)
#pragma unroll
                for (int n = 0; n < 2; ++n) acc[a][b][m][n] = (f32x4){0.f, 0.f, 0.f, 0.f};
    for (;;) {
        const bool has_next = S.next(ui + 1, nxt);
        if constexpr (GATHER) { if (has_next) PG8_TABDMA(nxt, (ui + 1) & 1); }
        const char* nA = has_next ? nxt.a : cA; const char* nB = has_next ? nxt.b : cB;
#pragma nounroll
        for (int t = 0; t < nt; t += 2) {
            const bool last = (t == nt - 2);
            if constexpr (Epi::MID) { if (t == nt / 2) { const int l2_ = lane_id(); E.mid(acc, cur, wr, l2_ & 15); } }
            unsigned v2[2][2];
#pragma unroll
            for (int h = 0; h < 2; ++h)
#pragma unroll
                for (int i = 0; i < 2; ++i) v2[h][i] = vcu[h][i];
            if constexpr (GATHER) { if (last && has_next) { PG8_TABOFF(v2, (ui + 1) & 1); PG8_WAIT_L(0); } }
            const char* a1 = cA + (size_t)(t + 1) * kstep;
            const char* a2 = last ? nA : cA + (size_t)(t + 2) * kstep; const char* b2 = last ? nB : cB + (size_t)(t + 2) * kstep;
            const char* a3 = a2 + kstep; const char* b3 = b2 + kstep;
            PG8_LDB(B0, B08, 0, 0); PG8_LDB(B1, B18, 0, 1); PG8_SCHED; PG8_LDA(At, At8, 0, 0); PG8_STAGE_A(PG8_SA(1, 1), a1, 1, vcu);
            PG8_WAIT_V(8); PG8_WAIT_L(0); PG8_BAR; PG8_MMA(0, 0, At, At8, B0, B08); PG8_MMA(0, 1, At, At8, B1, B18); PG8_BAR; PG8_SCHED;
            PG8_LDA(At, At8, 0, 1); PG8_STAGE(PG8_SB(0, 0), b2, vB); PG8_STAGE(PG8_SB(0, 1), b2 + hstepB, vB); PG8_STAGE_A(PG8_SA(0, 0), a2, 0, v2);
            PG8_WAIT_V(8); PG8_WAIT_L(0); PG8_BAR; PG8_MMA(1, 0, At, At8, B0, B08); PG8_MMA(1, 1, At, At8, B1, B18); PG8_BAR; PG8_SCHED;
            PG8_LDB(B0, B08, 1, 0); PG8_LDB(B1, B18, 1, 1); PG8_SCHED; PG8_LDA(At, At8, 1, 0); PG8_STAGE_A(PG8_SA(0, 1), a2, 1, v2);
            PG8_WAIT_V(8); PG8_WAIT_L(0); PG8_BAR; PG8_MMA(0, 0, At, At8, B0, B08); PG8_MMA(0, 1, At, At8, B1, B18); PG8_BAR; PG8_SCHED;
            PG8_LDA(At, At8, 1, 1); PG8_STAGE(PG8_SB(1, 0), b3, vB); PG8_STAGE(PG8_SB(1, 1), b3 + hstepB, vB); PG8_STAGE_A(PG8_SA(1, 0), a3, 0, v2);
            PG8_WAIT_V(8); PG8_WAIT_L(0); PG8_BAR; PG8_MMA(1, 0, At, At8, B0, B08); PG8_MMA(1, 1, At, At8, B1, B18); PG8_BAR; PG8_SCHED;
        }
        if (wr == 0) PG8_BAR;
        { const int l2_ = lane_id(); E(acc, cur, wr, wc, l2_ & 15, l2_ >> 4); }
        if (!has_next) break;
#pragma unroll
        for (int a = 0; a < 2; ++a)
#pragma unroll
            for (int b = 0; b < 2; ++b)
#pragma unroll
                for (int m = 0; m < 4; ++m)
#pragma unroll
                    for (int n = 0; n < 2; ++n) acc[a][b][m][n] = (f32x4){0.f, 0.f, 0.f, 0.f};
        cur = nxt; cA = nA; cB = nB; ++ui;
        if constexpr (GATHER) { PG8_TABOFF(vcu, ui & 1); PG8_WAIT_L(0); }
        if (wr == 1) PG8_BAR;
    }
    PG8_WAIT_V(0);
    PG8_BAR;
#undef PG8_SA
#undef PG8_SB
#undef PG8_STAGE
#undef PG8_STAGE_A
#undef PG8_RD8
#undef PG8_LDA
#undef PG8_LDB
#undef PG8_MMA
#undef PG8_TABDMA
#undef PG8_TABOFF
}
struct TileOrder {
    int nM, nN, nwg, G, c;
    __device__ __forceinline__ void init(int nM_, int nN_, int G_, int c_) { nM = nM_; nN = nN_; nwg = nM * nN; G = G_; c = c_; }
    __device__ __forceinline__ bool tile(int i, int& pm, int& pn) const {
        const int L = i * G + c; if (L >= nwg) return false;
        int wgid = L; { const int q = nwg / NXCD, r = nwg % NXCD, xcd = wgid % NXCD, off = wgid / NXCD; wgid = (xcd < r ? xcd * (q + 1) : r * (q + 1) + (xcd - r) * q) + off; }
        const int nig = WGM * nN, gid = wgid / nig, fm = gid * WGM, gsz = (nM - fm) < WGM ? (nM - fm) : WGM;
        pm = fm + ((wgid % nig) % gsz); pn = (wgid % nig) / gsz; return true;
    }
};
struct DenseSched {
    TileOrder o; const char* A; const char* Bt; int lda, K;
    __device__ __forceinline__ void init(const bf16* A_, int lda_, const bf16* Bt_, int M, int N, int K_, int G, int c) { o.init(M / BM, N / BM, G, c); A = (const char*)A_; Bt = (const char*)Bt_; lda = lda_; K = K_; }
    __device__ __forceinline__ bool next(int i, Unit& u) const { int pm, pn; if (!o.tile(i, pm, pn)) return false; u.row0 = pm * BM; u.col0 = pn * BM; u.rows = BM; u.pn = pn; u.e = 0;
        u.a = A + (size_t)pm * BM * lda * 2; u.b = Bt + (size_t)pn * BM * K * 2; u.list = nullptr; return true; }
};
}

__device__ __forceinline__ float sum4sq(const f32x4& v) { return (v[0] * v[0] + v[1] * v[1]) + (v[2] * v[2] + v[3] * v[3]); }
__device__ __forceinline__ void st_bf4(bf16* p, const f32x4& v) { u32x2 w; w.x = cvtpk(v[0], v[1]); w.y = cvtpk(v[2], v[3]); *(u32x2*)p = w; }
__device__ __forceinline__ int cofs8(int fq) { return 4 * fq + (fq & 1) * 12; }
__device__ __forceinline__ void st_bf8(bf16* p, const f32x4& v0, const f32x4& v1) {
    const unsigned a0 = cvtpk(v0[0], v0[1]), a1 = cvtpk(v0[2], v0[3]), b0 = cvtpk(v1[0], v1[1]), b1 = cvtpk(v1[2], v1[3]);
    const auto r0 = __builtin_amdgcn_permlane16_swap(a0, b0, false, false), r1 = __builtin_amdgcn_permlane16_swap(a1, b1, false, false);
    *(u32x4*)p = (u32x4){r0[0], r1[0], r0[1], r1[1]}; }
struct EpiProj {
    static constexpr bool PERM = false, MID = false;
    bf16* PROJ; float* ssqq; float* ssqkv; const float* rope; float* LF; const float* bfor;
    __device__ __forceinline__ void operator()(f32x4 (&acc)[2][2][4][2], const pg8::Unit& u, int wr, int wc, int fr, int fq) const {
        asm volatile("" : "+v"(fr), "+v"(fq));
        const bool rp1 = (u.pn == 1) && (wc == 0);
        f32x4 ca[8], cb[8];
        if (rp1) {
#pragma unroll
            for (int g = 0; g < 8; ++g) { const int pos = (u.row0 + (g >> 2) * 128 + wr * 64 + (g & 3) * 16 + fr) & (SEQ - 1); const float* q = rope + 2 * (pos * 16 + fq * 4); ca[g] = *(const f32x4*)q; cb[g] = *(const f32x4*)(q + 4); } }
#pragma unroll
        for (int ai = 0; ai < 2; ++ai)
#pragma unroll
            for (int m = 0; m < 4; ++m) {
                const int row = u.row0 + ai * 128 + wr * 64 + m * 16 + fr;
                if (u.pn == 0) { float s = (sum4sq(acc[ai][0][m][0]) + sum4sq(acc[ai][0][m][1])) + (sum4sq(acc[ai][1][m][0]) + sum4sq(acc[ai][1][m][1]));
                    s += __shfl_xor(s, 16); s += __shfl_xor(s, 32); if (fq == 0) ssqq[(size_t)row * 4 + wc] = s; }
                if (u.pn == 1) { float s = sum4sq(acc[ai][0][m][0]) + sum4sq(acc[ai][0][m][1]);
                    s += __shfl_xor(s, 16); s += __shfl_xor(s, 32); if (fq == 0) ssqkv[(size_t)row * 4 + wc] = s;
                    if (wc == 0) { const f32x4 x1 = acc[ai][1][m][0], x2 = acc[ai][1][m][1]; f32x4 y1, y2; const f32x4 c0 = ca[ai * 4 + m], c1 = cb[ai * 4 + m];
#pragma unroll
                        for (int e = 0; e < 4; ++e) { const float cx = e < 2 ? c0[2 * e] : c1[2 * e - 4], sx = e < 2 ? c0[2 * e + 1] : c1[2 * e - 3]; y1[e] = x1[e] * cx - x2[e] * sx; y2[e] = x2[e] * cx + x1[e] * sx; }
                        acc[ai][1][m][0] = y1; acc[ai][1][m][1] = y2; } }
                if (u.pn == 7 && wc == 1 && fq < 2) { const f32x4 z4 = acc[ai][1][m][0]; f32x4 lf;
#pragma unroll
                    for (int e = 0; e < 4; ++e) { const float z = z4[e] + bfor[fq * 4 + e]; lf[e] = fminf(z, 0.f) - 0.6931471805599453f * __builtin_amdgcn_logf(1.f + __builtin_amdgcn_exp2f(-LOG2E * fabsf(z))); }
                    *(f32x4*)(LF + (size_t)row * 8 + fq * 4) = lf; }
                bf16* rp = PROJ + (size_t)row * NPROJ + u.col0 + wc * 32 + cofs8(fq);
#pragma unroll
                for (int bj = 0; bj < 2; ++bj) st_bf8(rp + bj * 128, acc[ai][bj][m][0], acc[ai][bj][m][1]);
                asm volatile("" ::: "memory");
            }
    }
};
template <int NS, bool ROPE> struct EpiScale {
    static constexpr bool PERM = false, MID = false;
    bf16* C; int ldc; const float* ss; float inv_n; const float* rope; float osc = 1.f;
    __device__ __forceinline__ void operator()(f32x4 (&acc)[2][2][4][2], const pg8::Unit& u, int wr, int wc, int fr, int fq) const {
        asm volatile("" : "+v"(fr), "+v"(fq));
        const int rbase = u.row0 + wr * 64 + fr;
        f32x4 q[8], ca[8], cb[8]; int bjr = -1;
        if constexpr (ROPE) { const int g0 = (u.col0 >> 5) + wc; bjr = (g0 % 3 == 2) ? 0 : (((g0 + 4) % 3 == 2) ? 1 : -1);
            if (bjr >= 0) {
#pragma unroll
                for (int g = 0; g < 8; ++g) { const int pos = (rbase + (g >> 2) * 128 + (g & 3) * 16) & (SEQ - 1); const float* qq = rope + 2 * (pos * 16 + fq * 4); ca[g] = *(const f32x4*)qq; cb[g] = *(const f32x4*)(qq + 4); } } }
        float q1[8];
        if constexpr (NS == 16) {
#pragma unroll
            for (int g = 0; g < 8; ++g) q[g] = *(const f32x4*)(ss + (size_t)(rbase + (g >> 2) * 128 + (g & 3) * 16) * NS + 4 * fq); }
        if constexpr (NS == 4) {
#pragma unroll
            for (int g = 0; g < 8; ++g) q1[g] = ss[(size_t)(rbase + (g >> 2) * 128 + (g & 3) * 16) * 4 + fq]; }
#pragma unroll
        for (int g = 0; g < 8; ++g) { const int ai = g >> 2, m = g & 3;
                const int row = rbase + ai * 128 + m * 16; float sc = 1.f;
                if constexpr (NS > 0) { float t = NS == 16 ? (q[g][0] + q[g][1]) + (q[g][2] + q[g][3]) : q1[g];
                    t += __shfl_xor(t, 16); t += __shfl_xor(t, 32);
                    sc = rsqrtf(t * inv_n + EPS) * osc; }
                bf16* rp = C + (size_t)row * ldc + u.col0 + wc * 32 + cofs8(fq);
#pragma unroll
                for (int bj = 0; bj < 2; ++bj) {
                    f32x4 v0 = acc[ai][bj][m][0] * sc, v1 = acc[ai][bj][m][1] * sc;
                    if constexpr (ROPE) { if (bj == bjr) { f32x4 y1, y2; const f32x4 c0 = ca[g], c1 = cb[g];
#pragma unroll
                        for (int e = 0; e < 4; ++e) { const float cx = e < 2 ? c0[2 * e] : c1[2 * e - 4], sx = e < 2 ? c0[2 * e + 1] : c1[2 * e - 3]; y1[e] = v0[e] * cx - v1[e] * sx; y2[e] = v1[e] * cx + v0[e] * sx; }
                        v0 = y1; v1 = y2; } }
                    st_bf8(rp + bj * 128, v0, v1);
                }
                asm volatile("" ::: "memory");
            }
    }
};

__device__ __forceinline__ u32x2 pack8_f8(const f32x4& v0, const f32x4& v1, float sc) {
    f32x4 a0, a1;
#pragma unroll
    for (int e = 0; e < 4; ++e) { const auto r = __builtin_amdgcn_permlane16_swap(__float_as_uint(v0[e]), __float_as_uint(v1[e]), false, false); a0[e] = __uint_as_float(r[0]) * sc; a1[e] = __uint_as_float(r[1]) * sc; }
    int w0 = 0, w1 = 0; w0 = __builtin_amdgcn_cvt_pk_fp8_f32(a0[0], a0[1], w0, false); w0 = __builtin_amdgcn_cvt_pk_fp8_f32(a0[2], a0[3], w0, true);
    w1 = __builtin_amdgcn_cvt_pk_fp8_f32(a1[0], a1[1], w1, false); w1 = __builtin_amdgcn_cvt_pk_fp8_f32(a1[2], a1[3], w1, true); return (u32x2){(unsigned)w0, (unsigned)w1}; }
struct EpiMemKV {
    static constexpr bool PERM = false, MID = false;   static constexpr int NST = 16;
    bf16* C; unsigned char* k8;
    __device__ __forceinline__ void operator()(f32x4 (&acc)[2][2][4][2], const pg8::Unit& u, int wr, int wc, int fr, int fq) const {
        asm volatile("" : "+v"(fr), "+v"(fq));
        const int rbase = u.row0 + wr * 64 + fr;
#pragma unroll
        for (int g = 0; g < 8; ++g) { const int ai = g >> 2, m = g & 3; const int row = rbase + ai * 128 + m * 16; const int cc = u.col0 + wc * 32 + cofs8(fq);
#pragma unroll
            for (int bj = 0; bj < 2; ++bj) {
                if (u.pn < 4) *(u32x2*)(k8 + (size_t)row * 1024 + cc + bj * 128) = pack8_f8(acc[ai][bj][m][0], acc[ai][bj][m][1], 1.f);
                else st_bf8(C + (size_t)row * 2048 + cc + bj * 128, acc[ai][bj][m][0], acc[ai][bj][m][1]); }
            asm volatile("" ::: "memory"); }
    }
};
struct EpiXQ8 {
    static constexpr bool PERM = false, MID = false;   static constexpr int NST = 16;
    unsigned char* C8; const float* ss; float osc;
    __device__ __forceinline__ void operator()(f32x4 (&acc)[2][2][4][2], const pg8::Unit& u, int wr, int wc, int fr, int fq) const {
        asm volatile("" : "+v"(fr), "+v"(fq));
        const int rbase = u.row0 + wr * 64 + fr; f32x4 q[8];
#pragma unroll
        for (int g = 0; g < 8; ++g) q[g] = *(const f32x4*)(ss + (size_t)(rbase + (g >> 2) * 128 + (g & 3) * 16) * 16 + 4 * fq);
#pragma unroll
        for (int g = 0; g < 8; ++g) { const int ai = g >> 2, m = g & 3; const int row = rbase + ai * 128 + m * 16;
            float t = (q[g][0] + q[g][1]) + (q[g][2] + q[g][3]); t += __shfl_xor(t, 16); t += __shfl_xor(t, 32);
            const float sc = rsqrtf(t * (1.f / 1024.f) + EPS) * osc;
#pragma unroll
            for (int bj = 0; bj < 2; ++bj) *(u32x2*)(C8 + (size_t)row * DM + u.col0 + wc * 32 + cofs8(fq) + bj * 128) = pack8_f8(acc[ai][bj][m][0], acc[ai][bj][m][1], sc);
            asm volatile("" ::: "memory"); }
    }
};

struct EpiWo {
    static constexpr bool PERM = false, MID = true;
    const float* sso; const float* x; float* out; bf16* hb; float* ssq1; unsigned char* h8;
    __device__ __forceinline__ void mid(f32x4 (&acc)[2][2][4][2], const pg8::Unit& u, int wr, int fr) const {
        asm volatile("" : "+v"(fr));
        int fq = lane_id() >> 4; asm volatile("" : "+v"(fq));
        const int rbase = u.row0 + wr * 64 + fr; f32x4 p[8];
#pragma unroll
        for (int g = 0; g < 8; ++g) p[g] = *((const f32x4*)(sso + (size_t)(rbase + (g >> 2) * 128 + (g & 3) * 16) * 16) + fq);
#pragma unroll
        for (int g = 0; g < 8; ++g) { const int ai = g >> 2, m = g & 3;
            float t = (p[g][0] + p[g][1]) + (p[g][2] + p[g][3]); t += __shfl_xor(t, 16); const float o = __shfl_xor(t, 32);
            const float sm = fq < 2 ? t : o, sf = fq < 2 ? o : t;
            const float ratio = rsqrtf(sm * (1.f / 512.f) + EPS) / rsqrtf(sf * (1.f / 512.f) + EPS);
#pragma unroll
            for (int bj = 0; bj < 2; ++bj)
#pragma unroll
                for (int n = 0; n < 2; ++n) acc[ai][bj][m][n] *= ratio;
            asm volatile("" ::: "memory"); }
    }
    __device__ __forceinline__ void operator()(f32x4 (&acc)[2][2][4][2], const pg8::Unit& u, int wr, int wc, int fr, int fq) const {
        asm volatile("" : "+v"(fr), "+v"(fq));
        const int rbase = u.row0 + wr * 64 + fr; const int cb = u.col0 + wc * 32 + fq * 4;
        f32x4 xc[2][2], xn[2][2], sf4[8]; float ssg[8]; unsigned w8p[2][2];
#pragma unroll
        for (int g = 0; g < 8; ++g) sf4[g] = *((const f32x4*)(sso + (size_t)(rbase + (g >> 2) * 128 + (g & 3) * 16) * 16) + 2 + (fq & 1));
#pragma unroll
        for (int bj = 0; bj < 2; ++bj)
#pragma unroll
            for (int n = 0; n < 2; ++n) xc[bj][n] = *(const f32x4*)(x + (size_t)rbase * DM + cb + bj * 128 + n * 16);
#pragma unroll
        for (int g = 0; g < 8; ++g) { const int ai = g >> 2, m = g & 3; const int row = rbase + ai * 128 + m * 16;
            if (g + 1 < 8) { const int rn = rbase + ((g + 1) >> 2) * 128 + ((g + 1) & 3) * 16;
#pragma unroll
                for (int bj = 0; bj < 2; ++bj)
#pragma unroll
                    for (int n = 0; n < 2; ++n) xn[bj][n] = *(const f32x4*)(x + (size_t)rn * DM + cb + bj * 128 + n * 16); }
            float tf = (sf4[g][0] + sf4[g][1]) + (sf4[g][2] + sf4[g][3]); tf += __shfl_xor(tf, 16);
            const float rf = rsqrtf(tf * (1.f / 512.f) + EPS);
            const size_t off = (size_t)row * DM + u.col0 + wc * 32 + cofs8(fq); float ss = 0.f;
#pragma unroll
            for (int bj = 0; bj < 2; ++bj) { const f32x4 h0 = xc[bj][0] + acc[ai][bj][m][0] * rf, h1 = xc[bj][1] + acc[ai][bj][m][1] * rf; ss += sum4sq(h0) + sum4sq(h1);
                f32x4 a0, a1;
#pragma unroll
                for (int e = 0; e < 4; ++e) { const auto r = __builtin_amdgcn_permlane16_swap(__float_as_uint(h0[e]), __float_as_uint(h1[e]), false, false); a0[e] = __uint_as_float(r[0]); a1[e] = __uint_as_float(r[1]); }
                *(u32x4*)(hb + off + bj * 128) = (u32x4){cvtpk(a0[0], a0[1]), cvtpk(a0[2], a0[3]), cvtpk(a1[0], a1[1]), cvtpk(a1[2], a1[3])};
                int w0 = 0, w1 = 0; w0 = __builtin_amdgcn_cvt_pk_fp8_f32(a0[0] * H8_SCALE, a0[1] * H8_SCALE, w0, false); w0 = __builtin_amdgcn_cvt_pk_fp8_f32(a0[2] * H8_SCALE, a0[3] * H8_SCALE, w0, true);
                w1 = __builtin_amdgcn_cvt_pk_fp8_f32(a1[0] * H8_SCALE, a1[1] * H8_SCALE, w1, false); w1 = __builtin_amdgcn_cvt_pk_fp8_f32(a1[2] * H8_SCALE, a1[3] * H8_SCALE, w1, true);
                if ((g & 1) == 0) { w8p[bj][0] = (unsigned)w0; w8p[bj][1] = (unsigned)w1; }
                else {
                    const auto r0 = __builtin_amdgcn_permlane32_swap(w8p[bj][0], (unsigned)w0, false, false), r1 = __builtin_amdgcn_permlane32_swap(w8p[bj][1], (unsigned)w1, false, false);
                    const int rw = row - ((fq < 2) ? 16 : 0);
                    *(u32x4*)(h8 + (size_t)rw * DM + u.col0 + wc * 32 + (fq & 1) * 16 + bj * 128) = (u32x4){r0[0], r1[0], r0[1], r1[1]}; } }
            ss += __shfl_xor(ss, 16); ss += __shfl_xor(ss, 32); ssg[g] = ss;
            asm volatile("" ::: "memory");
#pragma unroll
            for (int bj = 0; bj < 2; ++bj)
#pragma unroll
                for (int n = 0; n < 2; ++n) xc[bj][n] = xn[bj][n]; }
        { const float s0 = fq == 0 ? ssg[0] : fq == 1 ? ssg[1] : fq == 2 ? ssg[2] : ssg[3], s1 = fq == 0 ? ssg[4] : fq == 1 ? ssg[5] : fq == 2 ? ssg[6] : ssg[7];
          float* sp = ssq1 + (size_t)(rbase + fq * 16) * 16 + u.pn * 4 + wc; sp[0] = s0; sp[128 * 16] = s1; }
    }
};
struct EpiAddOut {
    static constexpr bool PERM = false, MID = false;
    bf16* hb; float osc;
    __device__ __forceinline__ void operator()(f32x4 (&acc)[2][2][4][2], const pg8::Unit& u, int wr, int wc, int fr, int fq) const {
        asm volatile("" : "+v"(fr), "+v"(fq));
        const int rbase = u.row0 + wr * 64 + fr; const int cb = u.col0 + wc * 32 + cofs8(fq);
        u32x4 xc[2], xn[2];
#pragma unroll
        for (int bj = 0; bj < 2; ++bj) xc[bj] = *(const u32x4*)(hb + (size_t)rbase * DM + cb + bj * 128);
#pragma unroll
        for (int g = 0; g < 8; ++g) { const int ai = g >> 2, m = g & 3; const int row = rbase + ai * 128 + m * 16;
            if (g + 1 < 8) { const int rn = rbase + ((g + 1) >> 2) * 128 + ((g + 1) & 3) * 16;
#pragma unroll
                for (int bj = 0; bj < 2; ++bj) xn[bj] = *(const u32x4*)(hb + (size_t)rn * DM + cb + bj * 128); }
#pragma unroll
            for (int bj = 0; bj < 2; ++bj) { const u32x4 w = xc[bj]; f32x4 a0, a1;
#pragma unroll
                for (int e = 0; e < 4; ++e) { const auto r = __builtin_amdgcn_permlane16_swap(__float_as_uint(acc[ai][bj][m][0][e]), __float_as_uint(acc[ai][bj][m][1][e]), false, false); a0[e] = __uint_as_float(r[0]) * osc; a1[e] = __uint_as_float(r[1]) * osc; }
                const f32x4 h0 = (f32x4){__uint_as_float(w.x << 16), __uint_as_float(w.x & 0xffff0000u), __uint_as_float(w.y << 16), __uint_as_float(w.y & 0xffff0000u)} + a0;
                const f32x4 h1 = (f32x4){__uint_as_float(w.z << 16), __uint_as_float(w.z & 0xffff0000u), __uint_as_float(w.w << 16), __uint_as_float(w.w & 0xffff0000u)} + a1;
                *(u32x4*)(hb + (size_t)row * DM + cb + bj * 128) = (u32x4){cvtpk(h0[0], h0[1]), cvtpk(h0[2], h0[3]), cvtpk(h1[0], h1[1]), cvtpk(h1[2], h1[3])}; }
            asm volatile("" ::: "memory");
#pragma unroll
            for (int bj = 0; bj < 2; ++bj) xc[bj] = xn[bj]; }
    }
};

namespace att {
__device__ __forceinline__ int crow(int r, int hi) { return (r & 3) + 8 * (r >> 2) + 4 * hi; }
struct Src { const bf16* q; int ldq; const bf16* k1; int ldk1; const bf16* k2; int ldk2; const bf16* v; int ldv; bf16* o; int ldo; float* sso; int nt; int q0; const float* kn; const float* cum; };
typedef short v4i16_t __attribute__((ext_vector_type(4)));
__device__ __forceinline__ s16x4 vtr(const LAS unsigned char* p) { return __builtin_bit_cast(s16x4, __builtin_amdgcn_ds_read_tr16_b64_v4i16((LAS v4i16_t*)p)); }
__device__ __forceinline__ float rowmax32(const f32x16& p0, const f32x16& p1) {
    float a = fmaxf(fmaxf(p0[0], p0[1]), p1[0]), b = fmaxf(fmaxf(p0[2], p0[3]), p1[1]); a = fmaxf(fmaxf(a, p1[2]), p1[3]);
#pragma unroll
    for (int r = 4; r < 16; r += 4) { a = fmaxf(fmaxf(a, p0[r]), p0[r + 1]); b = fmaxf(fmaxf(b, p0[r + 2]), p0[r + 3]); a = fmaxf(fmaxf(a, p1[r]), p1[r + 1]); b = fmaxf(fmaxf(b, p1[r + 2]), p1[r + 3]); }
    const float m = fmaxf(a, b);
    auto rr = __builtin_amdgcn_permlane32_swap(__float_as_uint(m), __float_as_uint(m), false, false);
    return fmaxf(__uint_as_float(rr[0]), __uint_as_float(rr[1]));
}
template <int I, int N, class F> __device__ __forceinline__ void cfor(F&& f) { if constexpr (I < N) { f(std::integral_constant<int, I>{}); cfor<I + 1, N>(f); } }
template <int D0, int NKS, bool AUG> __device__ __forceinline__ void kread(bf16x8& f0, bf16x8& f1, unsigned base, unsigned abase) {
    if constexpr (AUG && D0 == NKS - 1) { asm volatile("ds_read_b128 %0, %1 offset:8192" : "=v"(f0) : "v"(abase)); asm volatile("ds_read_b128 %0, %1 offset:8704" : "=v"(f1) : "v"(abase)); }
    else { asm volatile("ds_read_b128 %0, %1 offset:%2" : "=v"(f0) : "v"(base), "n"(D0 * 2048)); asm volatile("ds_read_b128 %0, %1 offset:%2" : "=v"(f1) : "v"(base), "n"(D0 * 2048 + 512)); }
}
template <int NKS, int NC1, int NCH, int ND0, bool CAUSAL, bool AUG, bool REV, bool WSSO, bool EARLY = false, bool ASMK = true>
__device__ __forceinline__ void unit(const Src& s, LAS unsigned char* lds, const int wave) {
    int tid_ = (wave << 6) | lane_id(); asm volatile("" : "+v"(tid_));
    const int tid = tid_, lane = tid & 63, r32 = lane & 31, hi = lane >> 5, wid = __builtin_amdgcn_readfirstlane(tid >> 6);
    constexpr int KSL = NCH * 1024, VSL = ND0 * 4096, KPW = (NCH + 7) / 8, VPW = ND0 / 2;
    constexpr int VOFF = 2 * KSL, WSF = VOFF + 2 * VSL;
    constexpr float THR = 8.f;
    LAS float* wsf = (LAS float*)(lds + WSF) + wid * 64;
    bf16x8 qr[NKS];
    { const bf16* qw = s.q + (size_t)(wid * 32 + r32) * s.ldq + hi * 8;
#pragma unroll
      for (int d0 = 0; d0 < NKS; ++d0) { if (AUG && d0 == NKS - 1) { const short one = hi ? (short)0 : (short)0x3F80; qr[d0] = (bf16x8){one, one, one, 0, 0, 0, 0, 0}; } else qr[d0] = *(const bf16x8*)(qw + d0 * 16); } }
    LAS float* shf = (LAS float*)(lds + WSF + 2048);
    float thr = 0.f;
    if constexpr (EARLY) {
        float q2 = 0.f;
#pragma unroll
        for (int d0 = 0; d0 < NKS - 1; ++d0)
#pragma unroll
            for (int j = 0; j < 8; ++j) { const float f = __uint_as_float(((unsigned)(unsigned short)qr[d0][j]) << 16); q2 += f * f; }
        { auto rr = __builtin_amdgcn_permlane32_swap(__float_as_uint(q2), __float_as_uint(q2), false, false); q2 = __uint_as_float(rr[0]) + __uint_as_float(rr[1]); }
#pragma unroll
        for (int o_ = 1; o_ < 32; o_ <<= 1) q2 = fmaxf(q2, __shfl_xor(q2, o_));
        if (lane == 0) shf[wid] = q2;
        float kn = s.kn[lane];
#pragma unroll
        for (int o_ = 1; o_ < 64; o_ <<= 1) { const float up = __shfl_up(kn, o_); if (lane >= o_) kn = fmaxf(kn, up); }
        thr = kn;
    }
    u32x4 kreg[2][KPW], vreg[2][VPW];
#define ATT_LOAD(t, S_) do { \
    _Pragma("unroll") for (int i_ = 0; i_ < KPW; ++i_) { const int c_ = (wid + 8 * i_ < NCH) ? wid + 8 * i_ : wid; const size_t row_ = (size_t)(t) * 64 + lane;     \
        const bf16* g_ = (c_ < NC1) ? s.k1 + row_ * s.ldk1 + c_ * 8 : s.k2 + row_ * s.ldk2 + (c_ - NC1) * 8; kreg[S_][i_] = *(const u32x4*)g_; } \
    _Pragma("unroll") for (int i_ = 0; i_ < VPW; ++i_) { const int p_ = wid + 8 * i_; const int dh_ = p_ >> 2, rg_ = p_ & 3; \
        vreg[S_][i_] = *(const u32x4*)(s.v + ((size_t)(t) * 64 + 16 * rg_ + (lane >> 2)) * s.ldv + dh_ * 32 + (lane & 3) * 8); } } while (0)
#define ATT_WRITE(slot, S_) do { \
    _Pragma("unroll") for (int i_ = 0; i_ < KPW; ++i_) { const int c_ = (wid + 8 * i_ < NCH) ? wid + 8 * i_ : wid; *(LAS u32x4*)(lds + (slot) * KSL + c_ * 1024 + lane * 16) = kreg[S_][i_]; } \
    _Pragma("unroll") for (int i_ = 0; i_ < VPW; ++i_) { const int p_ = wid + 8 * i_; *(LAS u32x4*)(lds + VOFF + (slot) * VSL + p_ * 1024 + lane * 16) = vreg[S_][i_]; } } while (0)
    const int nt = s.nt;
    ATT_LOAD(REV ? nt - 1 : 0, 0); ATT_LOAD(REV ? nt - 2 : 1, 1); ATT_WRITE(0, 0);
    __syncthreads();
    if constexpr (EARLY) { float qm = shf[0];
#pragma unroll
        for (int w = 1; w < 8; ++w) qm = fmaxf(qm, shf[w]);
        thr = sqrtf(qm) * thr * 1.001f - s.cum[64 * lane + 63] * LOG2E; }
    float m = 0.f, l = 0.f; f32x16 o[ND0]; bool have = false;
    f32x16 negm = f32x16{};
#pragma unroll
    for (int d = 0; d < ND0; ++d) o[d] = f32x16{};
    const int qmin = s.q0 + wid * 32;
    auto body = [&](auto parc, const int i) -> bool { constexpr int PAR = decltype(parc)::value;
        const int t = REV ? nt - 1 - i : i; constexpr int cur = PAR;
        if constexpr (EARLY) { if (i > 0) { float mmin = shf[8 + (PAR ^ 1) * 8];
#pragma unroll
            for (int w = 1; w < 8; ++w) mmin = fminf(mmin, shf[8 + (PAR ^ 1) * 8 + w]);
            const float bound = __uint_as_float(__builtin_amdgcn_readlane(__float_as_uint(thr), t));
            if (bound - mmin < -40.f) return false; } }
        { const int t2 = REV ? (t >= 2 ? t - 2 : 0) : (t + 2 < nt ? t + 2 : nt - 1); ATT_LOAD(t2, PAR); }
        const bool skip = CAUSAL && (64 * t > qmin + 31);
        if (!skip) {
            const LAS unsigned char* kb = lds + cur * KSL + r32 * 16;
            f32x16 p0 = negm, p1 = negm;
            if constexpr (!ASMK) {
                const LAS unsigned char* kq = kb + hi * 1024; bf16x8 ka[8], kc[8];
#pragma unroll
                for (int d = 0; d < 4; ++d) { ka[2 * d] = *(const LAS bf16x8*)(kq + d * 2048); ka[2 * d + 1] = *(const LAS bf16x8*)(kq + d * 2048 + 512); }
#pragma unroll
                for (int g0 = 0; g0 < NKS; g0 += 4) {
                    if (g0 + 4 < NKS) {
#pragma unroll
                        for (int d = 0; d < 4; ++d) { kc[2 * d] = *(const LAS bf16x8*)(kq + (g0 + 4 + d) * 2048); kc[2 * d + 1] = *(const LAS bf16x8*)(kq + (g0 + 4 + d) * 2048 + 512); } }
                    __builtin_amdgcn_sched_group_barrier(0x100, 8, 0);
#pragma unroll
                    for (int d = 0; d < 4; ++d) { p0 = __builtin_amdgcn_mfma_f32_32x32x16_bf16(ka[2 * d], qr[g0 + d], p0, 0, 0, 0); p1 = __builtin_amdgcn_mfma_f32_32x32x16_bf16(ka[2 * d + 1], qr[g0 + d], p1, 0, 0, 0); }
                    __builtin_amdgcn_sched_group_barrier(0x008, 8, 0);
#pragma unroll
                    for (int z = 0; z < 8; ++z) ka[z] = kc[z];
                }
            } else {
            constexpr int KB = (NKS % 3 == 0 || NKS == 5) ? 3 : 4, NB = (NKS + KB - 1) / KB;
            const unsigned kbase = (unsigned)(size_t)(kb + hi * 1024), abase = (unsigned)(size_t)kb;
            bf16x8 kfa[2 * KB], kfb[2 * KB];
#pragma unroll
            for (int z_ = 0; z_ < 2 * KB; ++z_) { kfa[z_] = bf16x8{}; kfb[z_] = bf16x8{}; }
            cfor<0, KB>([&](auto ic) { constexpr int D = decltype(ic)::value; if constexpr (D < NKS) kread<D, NKS, AUG>(kfa[2 * D], kfa[2 * D + 1], kbase, abase); });
            cfor<0, NB>([&](auto bc) { constexpr int B = decltype(bc)::value;
                if constexpr (B % 2 == 0) { if constexpr (KB == 3) asm volatile("s_waitcnt lgkmcnt(0)" : "+v"(kfa[0]), "+v"(kfa[1]), "+v"(kfa[2]), "+v"(kfa[3]), "+v"(kfa[4]), "+v"(kfa[5]) :: "memory");
                                            else asm volatile("s_waitcnt lgkmcnt(0)" : "+v"(kfa[0]), "+v"(kfa[1]), "+v"(kfa[2]), "+v"(kfa[3]), "+v"(kfa[4]), "+v"(kfa[5]), "+v"(kfa[6]), "+v"(kfa[7]) :: "memory"); }
                else { if constexpr (KB == 3) asm volatile("s_waitcnt lgkmcnt(0)" : "+v"(kfb[0]), "+v"(kfb[1]), "+v"(kfb[2]), "+v"(kfb[3]), "+v"(kfb[4]), "+v"(kfb[5]) :: "memory");
                       else asm volatile("s_waitcnt lgkmcnt(0)" : "+v"(kfb[0]), "+v"(kfb[1]), "+v"(kfb[2]), "+v"(kfb[3]), "+v"(kfb[4]), "+v"(kfb[5]), "+v"(kfb[6]), "+v"(kfb[7]) :: "memory"); }
                __builtin_amdgcn_sched_barrier(0);
                if constexpr (B % 2 == 0) {
                    cfor<0, KB>([&](auto ic) { constexpr int D = (B + 1) * KB + decltype(ic)::value; if constexpr (D < NKS) kread<D, NKS, AUG>(kfb[2 * decltype(ic)::value], kfb[2 * decltype(ic)::value + 1], kbase, abase); });
                    __builtin_amdgcn_sched_barrier(0);
                    cfor<0, KB>([&](auto ic) { constexpr int D = B * KB + decltype(ic)::value; if constexpr (D < NKS) { p0 = __builtin_amdgcn_mfma_f32_32x32x16_bf16(kfa[2 * decltype(ic)::value], qr[D], p0, 0, 0, 0); p1 = __builtin_amdgcn_mfma_f32_32x32x16_bf16(kfa[2 * decltype(ic)::value + 1], qr[D], p1, 0, 0, 0); } });
                } else {
                    cfor<0, KB>([&](auto ic) { constexpr int D = (B + 1) * KB + decltype(ic)::value; if constexpr (D < NKS) kread<D, NKS, AUG>(kfa[2 * decltype(ic)::value], kfa[2 * decltype(ic)::value + 1], kbase, abase); });
                    __builtin_amdgcn_sched_barrier(0);
                    cfor<0, KB>([&](auto ic) { constexpr int D = B * KB + decltype(ic)::value; if constexpr (D < NKS) { p0 = __builtin_amdgcn_mfma_f32_32x32x16_bf16(kfb[2 * decltype(ic)::value], qr[D], p0, 0, 0, 0); p1 = __builtin_amdgcn_mfma_f32_32x32x16_bf16(kfb[2 * decltype(ic)::value + 1], qr[D], p1, 0, 0, 0); } });
                }
            });
            }
            const LAS unsigned char* vb = lds + VOFF + cur * VSL + ((lane >> 4) & 1) * 32 + (lane & 3) * 8 + (4 * hi + ((lane & 15) >> 2)) * 64;
            s16x4 vlo[2][4], vhi[2][4];
#pragma unroll
            for (int d = 0; d < 2; ++d)
#pragma unroll
                for (int ks = 0; ks < 4; ++ks) { vlo[d][ks] = vtr(vb + d * 4096 + ks * 1024); vhi[d][ks] = vtr(vb + d * 4096 + ks * 1024 + 512); }
            __builtin_amdgcn_sched_group_barrier(0x100, 16, 0);
            if (CAUSAL && (64 * t + 63 > qmin)) { const int q = qmin + r32, kv0 = 64 * t + 4 * hi;
#pragma unroll
                for (int r = 0; r < 16; ++r) { const int kv = kv0 + (r & 3) + 8 * (r >> 2); if (kv > q) p0[r] = -INFINITY; if (kv + 32 > q) p1[r] = -INFINITY; } }
            const float rmd = rowmax32(p0, p1);
            if (!have || __any(rmd > THR)) {
                const float dd = have ? fmaxf(rmd, 0.f) : rmd, alpha = have ? __builtin_amdgcn_exp2f(-dd) : 1.f; l *= alpha; m += dd;
#pragma unroll
                for (int r = 0; r < 16; ++r) { p0[r] -= dd; p1[r] -= dd; negm[r] = -m; }
                if (have) {
                    if (hi == 0) wsf[r32] = alpha;
                    asm volatile("s_waitcnt lgkmcnt(0)" ::: "memory");
#pragma unroll
                    for (int r = 0; r < 16; ++r) { const float a = wsf[crow(r, hi)];
#pragma unroll
                        for (int d = 0; d < ND0; ++d) o[d][r] *= a; } }
                have = true;
            }
            float sacc = 0.f;
#pragma unroll
            for (int r = 0; r < 16; ++r) { p0[r] = __builtin_amdgcn_exp2f(p0[r]); p1[r] = __builtin_amdgcn_exp2f(p1[r]); sacc += p0[r] + p1[r]; }
            l += sacc;
            u32x4 pw[4];
#pragma unroll
            for (int j = 0; j < 4; ++j) { pw[0][j] = cvtpk(p0[2 * j], p0[2 * j + 1]); pw[1][j] = cvtpk(p0[8 + 2 * j], p0[8 + 2 * j + 1]); pw[2][j] = cvtpk(p1[2 * j], p1[2 * j + 1]); pw[3][j] = cvtpk(p1[8 + 2 * j], p1[8 + 2 * j + 1]); }
#pragma unroll
            for (int d = 0; d < 2; ++d)
#pragma unroll
                for (int ks = 0; ks < 4; ++ks) { const bf16x8 vf = (bf16x8){vlo[d][ks][0], vlo[d][ks][1], vlo[d][ks][2], vlo[d][ks][3], vhi[d][ks][0], vhi[d][ks][1], vhi[d][ks][2], vhi[d][ks][3]};
                    o[d] = __builtin_amdgcn_mfma_f32_32x32x16_bf16(__builtin_bit_cast(bf16x8, pw[ks]), vf, o[d], 0, 0, 0); }
            if constexpr (ND0 > 2) {
#pragma unroll
                for (int d = 2; d < ND0; d += 2) { s16x4 wlo[2][4], whi[2][4];
#pragma unroll
                    for (int e = 0; e < 2; ++e)
#pragma unroll
                        for (int ks = 0; ks < 4; ++ks) { wlo[e][ks] = vtr(vb + (d + e) * 4096 + ks * 1024); whi[e][ks] = vtr(vb + (d + e) * 4096 + ks * 1024 + 512); }
#pragma unroll
                    for (int e = 0; e < 2; ++e)
#pragma unroll
                        for (int ks = 0; ks < 4; ++ks) { const bf16x8 vf = (bf16x8){wlo[e][ks][0], wlo[e][ks][1], wlo[e][ks][2], wlo[e][ks][3], whi[e][ks][0], whi[e][ks][1], whi[e][ks][2], whi[e][ks][3]};
                            o[d + e] = __builtin_amdgcn_mfma_f32_32x32x16_bf16(__builtin_bit_cast(bf16x8, pw[ks]), vf, o[d + e], 0, 0, 0); }
                    __builtin_amdgcn_sched_group_barrier(0x100, 16, 1); __builtin_amdgcn_sched_group_barrier(0x008, 8, 1); } }
        }
        ATT_WRITE(cur ^ 1, PAR ^ 1);
        if constexpr (EARLY) { float mw = have ? m : -1e30f;
#pragma unroll
            for (int o_ = 1; o_ < 32; o_ <<= 1) mw = fminf(mw, __shfl_xor(mw, o_));
            if (lane == 0) shf[8 + PAR * 8 + wid] = mw; }
        __syncthreads();
        return true;
    };
    for (int i = 0; i < nt; i += 2) { if (!body(std::integral_constant<int, 0>{}, i)) break; if (!body(std::integral_constant<int, 1>{}, i + 1)) break; }
    { auto rr = __builtin_amdgcn_permlane32_swap(__float_as_uint(l), __float_as_uint(l), false, false); l = __uint_as_float(rr[0]) + __uint_as_float(rr[1]); }
    if (hi == 0) wsf[32 + r32] = 1.f / l;
    asm volatile("s_waitcnt lgkmcnt(0)" ::: "memory");
    LAS bf16* stg = (LAS bf16*)(lds + wid * (ND0 * 2048));
#pragma unroll
    for (int r = 0; r < 16; ++r) { const float rl = wsf[32 + crow(r, hi)]; const int orow = crow(r, hi);
#pragma unroll
        for (int d = 0; d < ND0; ++d) stg[orow * (ND0 * 32) + d * 32 + r32] = f2bf(o[d][r] * rl); }
    asm volatile("s_waitcnt lgkmcnt(0)" ::: "memory");
    constexpr int CPR = ND0 * 4, RPI = 64 / CPR;
    bf16* ow = s.o + (size_t)(wid * 32) * s.ldo;
#pragma unroll
    for (int it = 0; it < 32 / RPI; ++it) { const int row = it * RPI + lane / CPR, ch = lane % CPR; const u32x4 v = *(const LAS u32x4*)(stg + row * (ND0 * 32) + ch * 8);
        *(u32x4*)(ow + (size_t)row * s.ldo + ch * 8) = v;
        if (WSSO) { float ss = 0.f;
#pragma unroll
            for (int j = 0; j < 4; ++j) { const float a = __uint_as_float(v[j] << 16), b = __uint_as_float(v[j] & 0xffff0000u); ss += a * a + b * b; }
#pragma unroll
            for (int sh = 1; sh < CPR; sh <<= 1) ss += __shfl_xor(ss, sh);
            if (ch == 0) s.sso[(size_t)(wid * 32 + row) * 16] = ss; } }
    __syncthreads();
#undef ATT_LOAD
#undef ATT_WRITE
}
__device__ __forceinline__ void xunit(const Src& s, LAS unsigned char* lds, const int wave) {
    int tid_ = (wave << 6) | lane_id(); asm volatile("" : "+v"(tid_));
    const int tid = tid_, lane = tid & 63, r32 = lane & 31, hi = lane >> 5, wid = __builtin_amdgcn_readfirstlane(tid >> 6);
    constexpr int KSL = 16384, VSL = 16384, VOFF = 2 * KSL, STG = VOFF + 2 * VSL;
    LAS float* wsf = (LAS float*)(lds + 131072) + wid * 64;
    f32x16 p[4][2];
#pragma unroll
    for (int t = 0; t < 4; ++t) { p[t][0] = f32x16{}; p[t][1] = f32x16{}; }
    typedef int xi4 __attribute__((ext_vector_type(4))); typedef int xi8 __attribute__((ext_vector_type(8)));
    u32x4 sreg[2][2];
#define X_LOAD(J) do { if constexpr ((J) < 4) { _Pragma("unroll") for (int i_ = 0; i_ < 2; ++i_) sreg[(J) & 1][i_] = *(const u32x4*)((const unsigned char*)s.k1 + (size_t)((J) * 64 + lane) * s.ldk1 + (wid + 8 * i_) * 16); } \
        else if constexpr ((J) < 12) { _Pragma("unroll") for (int i_ = 0; i_ < 2; ++i_) { const int p_ = wid + 8 * i_, dh_ = p_ >> 2, rg_ = p_ & 3; \
            sreg[(J) & 1][i_] = *(const u32x4*)(s.v + (size_t)(((J) & 3) * 64 + 16 * rg_ + (lane >> 2)) * s.ldv + (((J) - 4) >> 2) * 128 + dh_ * 32 + (lane & 3) * 8); } } } while (0)
#define X_WRITE(J) do { if constexpr ((J) < 12) { _Pragma("unroll") for (int i_ = 0; i_ < 2; ++i_) *(LAS u32x4*)(lds + ((J) < 4 ? 0 : VOFF) + ((J) & 1) * KSL + (wid + 8 * i_) * 1024 + lane * 16) = sreg[(J) & 1][i_]; } } while (0)
    X_LOAD(0); X_LOAD(1);
    xi8 q8[4];
    { const unsigned char* qw8 = (const unsigned char*)s.q + (size_t)(wid * 32 + r32) * s.ldq + hi * 32;
#pragma unroll
      for (int s_ = 0; s_ < 4; ++s_) { const xi4 lo_ = *(const xi4*)(qw8 + 64 * s_), hi_ = *(const xi4*)(qw8 + 64 * s_ + 16); q8[s_] = __builtin_shufflevector(lo_, hi_, 0, 1, 2, 3, 4, 5, 6, 7); } }
    X_WRITE(0);
    __syncthreads();
    cfor<0, 4>([&](auto ic) { constexpr int I = decltype(ic)::value;
        X_LOAD(I + 2);
        const LAS unsigned char* kq = lds + (I & 1) * KSL + r32 * 16 + hi * 2048; xi8 kf[8];
#pragma unroll
        for (int s_ = 0; s_ < 4; ++s_)
#pragma unroll
            for (int kb = 0; kb < 2; ++kb) { const xi4 lo_ = *(const LAS xi4*)(kq + s_ * 4096 + kb * 512), hi_ = *(const LAS xi4*)(kq + s_ * 4096 + 1024 + kb * 512); kf[2 * s_ + kb] = __builtin_shufflevector(lo_, hi_, 0, 1, 2, 3, 4, 5, 6, 7); }
#pragma unroll
        for (int s_ = 0; s_ < 4; ++s_) { p[I][0] = __builtin_amdgcn_mfma_scale_f32_32x32x64_f8f6f4(kf[2 * s_], q8[s_], p[I][0], 0, 0, 0, 0x7F7F7F7F, 0, 0x7F7F7F7F);
                                       p[I][1] = __builtin_amdgcn_mfma_scale_f32_32x32x64_f8f6f4(kf[2 * s_ + 1], q8[s_], p[I][1], 0, 0, 0, 0x7F7F7F7F, 0, 0x7F7F7F7F); }
        X_WRITE(I + 1);
        __syncthreads();
    });
    float m = rowmax32(p[0][0], p[0][1]);
#pragma unroll
    for (int t = 1; t < 4; ++t) m = fmaxf(m, rowmax32(p[t][0], p[t][1]));
    float l = 0.f; u32x4 pw[4][4];
#pragma unroll
    for (int t = 0; t < 4; ++t) { float sacc = 0.f;
#pragma unroll
        for (int r = 0; r < 16; ++r) { p[t][0][r] = __builtin_amdgcn_exp2f((p[t][0][r] - m) * (1.f / XQ8_SCALE)); p[t][1][r] = __builtin_amdgcn_exp2f((p[t][1][r] - m) * (1.f / XQ8_SCALE)); sacc += p[t][0][r] + p[t][1][r]; }
        l += sacc;
#pragma unroll
        for (int j = 0; j < 4; ++j) { pw[t][0][j] = cvtpk(p[t][0][2 * j], p[t][0][2 * j + 1]); pw[t][1][j] = cvtpk(p[t][0][8 + 2 * j], p[t][0][8 + 2 * j + 1]); pw[t][2][j] = cvtpk(p[t][1][2 * j], p[t][1][2 * j + 1]); pw[t][3][j] = cvtpk(p[t][1][8 + 2 * j], p[t][1][8 + 2 * j + 1]); } }
    { auto rr = __builtin_amdgcn_permlane32_swap(__float_as_uint(l), __float_as_uint(l), false, false); l = __uint_as_float(rr[0]) + __uint_as_float(rr[1]); }
    if (hi == 0) wsf[32 + r32] = 1.f / l;
    asm volatile("s_waitcnt lgkmcnt(0)" ::: "memory");
    f32x16 o[4];
    cfor<0, 8>([&](auto ic) { constexpr int I = decltype(ic)::value, TT = I & 3, DVH = I >> 2;
        X_LOAD(I + 6);
        if constexpr (TT == 0) {
#pragma unroll
            for (int d = 0; d < 4; ++d) o[d] = f32x16{}; }
        const LAS unsigned char* vb = lds + VOFF + (I & 1) * VSL + ((lane >> 4) & 1) * 32 + (lane & 3) * 8 + (4 * hi + ((lane & 15) >> 2)) * 64;
#pragma unroll
        for (int d = 0; d < 4; d += 2) { s16x4 vlo[2][4], vhi[2][4];
#pragma unroll
            for (int e = 0; e < 2; ++e)
#pragma unroll
                for (int ks = 0; ks < 4; ++ks) { vlo[e][ks] = vtr(vb + (d + e) * 4096 + ks * 1024); vhi[e][ks] = vtr(vb + (d + e) * 4096 + ks * 1024 + 512); }
#pragma unroll
            for (int e = 0; e < 2; ++e)
#pragma unroll
                for (int ks = 0; ks < 4; ++ks) { const bf16x8 vf = (bf16x8){vlo[e][ks][0], vlo[e][ks][1], vlo[e][ks][2], vlo[e][ks][3], vhi[e][ks][0], vhi[e][ks][1], vhi[e][ks][2], vhi[e][ks][3]};
                    o[d + e] = __builtin_amdgcn_mfma_f32_32x32x16_bf16(__builtin_bit_cast(bf16x8, pw[TT][ks]), vf, o[d + e], 0, 0, 0); } }
        X_WRITE(I + 5);
        if constexpr (TT == 3) {
            LAS bf16* stg = (LAS bf16*)(lds + STG + wid * 8192);
#pragma unroll
            for (int r = 0; r < 16; ++r) { const float rl = wsf[32 + crow(r, hi)]; const int orow = crow(r, hi);
#pragma unroll
                for (int d = 0; d < 4; ++d) stg[orow * 128 + d * 32 + r32] = f2bf(o[d][r] * rl); }
            asm volatile("s_waitcnt lgkmcnt(0)" ::: "memory");
            unsigned char* ow = (unsigned char*)s.o + (size_t)(wid * 32) * s.ldo + DVH * 128;
#pragma unroll
            for (int it = 0; it < 4; ++it) { const int row = it * 8 + (lane >> 3), ch = lane & 7; const u32x4 v0 = *(const LAS u32x4*)(stg + row * 128 + ch * 16), v1 = *(const LAS u32x4*)(stg + row * 128 + ch * 16 + 8); u32x4 f;
#pragma unroll
                for (int j = 0; j < 4; ++j) { const unsigned q_ = j < 2 ? v0[2 * j] : v1[2 * j - 4], r_ = j < 2 ? v0[2 * j + 1] : v1[2 * j - 3]; int w = 0;
                    w = __builtin_amdgcn_cvt_pk_fp8_f32(__uint_as_float(q_ << 16) * XO8_SCALE, __uint_as_float(q_ & 0xffff0000u) * XO8_SCALE, w, false);
                    w = __builtin_amdgcn_cvt_pk_fp8_f32(__uint_as_float(r_ << 16) * XO8_SCALE, __uint_as_float(r_ & 0xffff0000u) * XO8_SCALE, w, true); f[j] = (unsigned)w; }
                *(u32x4*)(ow + (size_t)row * s.ldo + ch * 16) = f; }
            asm volatile("s_waitcnt lgkmcnt(0)" ::: "memory"); }
        __syncthreads();
    });
#undef X_LOAD
#undef X_WRITE
}
}

#define XB_TMO      128
#define XB_XCNT(j)  (256  + 64 * (j))
#define XB_XSUB(j)  (1280 + 64 * (j))
#define XB_XGEN(j)  (2304 + 64 * (j))
#define XB_TOP      3328
#define XB_TOPGEN   3392
#define XCD_BAR_WORDS 3456
#define XB_SPIN_CAP (1u << 18)
__device__ __forceinline__ unsigned xb_ld(unsigned* p)              { return __hip_atomic_load(p, __ATOMIC_RELAXED, __HIP_MEMORY_SCOPE_AGENT); }
__device__ __forceinline__ unsigned xb_add(unsigned* p, unsigned v) { return __hip_atomic_fetch_add(p, v, __ATOMIC_RELAXED, __HIP_MEMORY_SCOPE_AGENT); }
__device__ __forceinline__ unsigned xb_xcc_id() { return (unsigned)__builtin_amdgcn_s_getreg((3 << 11) | 20) & 0xFu; }
#define XB_SPIN(cond, bar) do { unsigned _sp = 0; while (cond) { __builtin_amdgcn_s_sleep(1); \
    if ((++_sp & 255u) == 0u) { if (xb_ld(&(bar)[XB_TMO])) break; if (_sp > XB_SPIN_CAP) { atomicAdd(&(bar)[XB_TMO], 1u); break; } } } } while (0)
struct XcdBarrier { unsigned* bar; unsigned x; volatile LAS unsigned* st; bool wave0; };
__device__ __forceinline__ XcdBarrier xcd_barrier_post(unsigned* bar, volatile LAS unsigned* st, int wave) {
    XcdBarrier b; b.bar = bar; b.x = xb_xcc_id(); b.st = st; b.wave0 = (wave == 0);
    if (b.wave0 && lane_id() == 0) (void)xb_add(&bar[XB_XCNT(b.x)], 1u);
    return b;
}
__device__ __forceinline__ void xcd_barrier_complete(unsigned* bar, unsigned x, unsigned& nloc, unsigned& nx) {
    const unsigned G = gridDim.x * gridDim.y * gridDim.z;
    unsigned sum, cnt, mine, sp = 0u;
    for (;;) {
        sum = 0u; cnt = 0u; mine = 0u;
#pragma unroll
        for (unsigned j = 0; j < 16; ++j) { const unsigned c = xb_ld(&bar[XB_XCNT(j)]); sum += c; cnt += (c > 0u) ? 1u : 0u; mine = (j == x) ? c : mine; }
        if (sum == G) break;
        __builtin_amdgcn_s_sleep(1);
        if ((++sp & 255u) == 0u) { if (xb_ld(&bar[XB_TMO])) break; if (sp > XB_SPIN_CAP) { atomicAdd(&bar[XB_TMO], 1u); break; } }
    }
    nloc = mine > 0u ? mine : 1u; nx = cnt > 0u ? cnt : 1u;
}
__device__ __forceinline__ void xcd_barrier(const XcdBarrier& b) {
    asm volatile("s_waitcnt vmcnt(0)" ::: "memory");
    __syncthreads();
    if (b.wave0 && lane_id() == 0) {
        unsigned* bar = b.bar;
        __builtin_amdgcn_s_waitcnt(0);
        unsigned nloc = b.st[0], nx = b.st[1];
        if (nloc == 0u) { xcd_barrier_complete(bar, b.x, nloc, nx); b.st[0] = nloc; b.st[1] = nx; }
        const unsigned old = xb_add(&bar[XB_XSUB(b.x)], 1u);
        const unsigned gen = old / nloc;
        if (old + 1u == (gen + 1u) * nloc) {
            __builtin_amdgcn_fence(__ATOMIC_RELEASE, "agent");
            asm volatile("s_waitcnt vmcnt(0)" ::: "memory");
            const unsigned og = xb_add(&bar[XB_TOP], 1u);
            const unsigned tg = og / nx;
            if (og + 1u == (tg + 1u) * nx) xb_add(&bar[XB_TOPGEN], 1u);
            else XB_SPIN(xb_ld(&bar[XB_TOPGEN]) == tg, bar);
            __builtin_amdgcn_fence(__ATOMIC_ACQUIRE, "agent");
            xb_add(&bar[XB_XGEN(b.x)], 1u);
            asm volatile("s_waitcnt vmcnt(0)" ::: "memory");
        } else {
            XB_SPIN(xb_ld(&bar[XB_XGEN(b.x)]) == gen, bar);
            __builtin_amdgcn_fence(__ATOMIC_ACQUIRE, "agent");
            asm volatile("s_waitcnt vmcnt(0)" ::: "memory");
        }
    }
    __syncthreads();
}

constexpr int NWAVES = 8;
constexpr int RING_BYTES = 131072, TABS_OFF = RING_BYTES, MISC_OFF = TABS_OFF + 2048, LDS_BYTES = 147456;
constexpr int CW_FOXQ = 256;
constexpr int CW_BAR = 4096;
constexpr int N_PHASES = 11;
constexpr float W8_SCALE = 32.f, ACT8_SCALE = 4.f, Y8_SCALE = 16.f;
#ifndef PROBE_REP
#define PROBE_REP -1
#endif
#define REPS(k) for (int rep_ = 0; rep_ < ((PROBE_REP) == (k) ? 2 : 1); ++rep_)
struct MegaArgs {
    const float* in[25]; float* out; unsigned char* ws; int ph_lo, ph_hi; int coop; int pad;
};
struct Frame {
    LAS unsigned char* lds; volatile LAS unsigned* MISC; LAS unsigned* tabs;
    int wave, vcu, G;
};
struct P0Item { const float* W; bf16* WT; const float* kscale; const float* kscale2; int K, N, NT, c_lo, c_hi, item; float cscale; bool f8; };
__device__ __forceinline__ void p0_load(const P0Item& d, f32x4 (&v)[8], int lane) {
    const int nblk = d.NT / 32, kb = d.item / nblk, nb = d.item % nblk, k0 = 64 * kb, n0 = 32 * nb; const int r8 = lane >> 3, c4 = lane & 7, nn = n0 + 4 * c4;
#pragma unroll
    for (int i = 0; i < 8; ++i) { const int kk = i * 8 + r8; v[i] = (f32x4){0.f, 0.f, 0.f, 0.f}; if (nn < d.N) v[i] = __builtin_nontemporal_load((const f32x4*)(d.W + (size_t)(k0 + kk) * d.N + nn)); }
}
__device__ __forceinline__ void p0_finish(const P0Item& d, const f32x4 (&v)[8], LAS float* scr, int lane) {
    const int nblk = d.NT / 32, kb = d.item / nblk, nb = d.item % nblk, k0 = 64 * kb, n0 = 32 * nb; const int r8 = lane >> 3, c4 = lane & 7, nn = n0 + 4 * c4;
    const float cs = (nn >= d.c_lo && nn < d.c_hi) ? d.cscale : 1.f;
#pragma unroll
    for (int i = 0; i < 8; ++i) { const int kk = i * 8 + r8; float ks = cs; if (d.kscale) ks *= (d.kscale2 && k0 >= 512) ? d.kscale2[k0 + kk - 512] : d.kscale[k0 + kk];
        LAS float* p = scr + kk * 33 + 4 * c4; p[0] = v[i][0] * ks; p[1] = v[i][1] * ks; p[2] = v[i][2] * ks; p[3] = v[i][3] * ks; }
    asm volatile("s_waitcnt lgkmcnt(0)" ::: "memory");
    const int c = lane & 7;
#pragma unroll
    for (int j = 0; j < 4; ++j) { const int n = (lane >> 3) + 8 * j; const LAS float* s = scr + (8 * c) * 33 + n;
        if (d.f8) { int w0 = 0, w1 = 0; w0 = __builtin_amdgcn_cvt_pk_fp8_f32(s[0 * 33], s[1 * 33], w0, false); w0 = __builtin_amdgcn_cvt_pk_fp8_f32(s[2 * 33], s[3 * 33], w0, true);
            w1 = __builtin_amdgcn_cvt_pk_fp8_f32(s[4 * 33], s[5 * 33], w1, false); w1 = __builtin_amdgcn_cvt_pk_fp8_f32(s[6 * 33], s[7 * 33], w1, true);
            *(u32x2*)((unsigned char*)d.WT + (size_t)(n0 + n) * d.K + k0 + 8 * c) = (u32x2){(unsigned)w0, (unsigned)w1}; }
        else { u32x4 o; o.x = cvtpk(s[0 * 33], s[1 * 33]); o.y = cvtpk(s[2 * 33], s[3 * 33]); o.z = cvtpk(s[4 * 33], s[5 * 33]); o.w = cvtpk(s[6 * 33], s[7 * 33]);
            *(u32x4*)(d.WT + (size_t)(n0 + n) * d.K + k0 + 8 * c) = o; } }
    asm volatile("s_waitcnt lgkmcnt(0)" ::: "memory");
}
__device__ __forceinline__ void rms_row_to_bf16(const float* xrow, const float* g, bf16* orow, int lane) {
    const f32x4* xr = (const f32x4*)xrow + lane; const f32x4* gr = (const f32x4*)g + lane;
    f32x4 v[4]; float s = 0.f;
#pragma unroll
    for (int j = 0; j < 4; ++j) { v[j] = xr[64 * j]; s += sum4sq(v[j]); }
    const float r = rsqrtf(wave_sum(s) * (1.f / DM) + EPS);
#pragma unroll
    for (int j = 0; j < 4; ++j) { const f32x4 o = v[j] * r * gr[64 * j]; st_bf4(orow + 4 * lane + 256 * j, o); }
}
constexpr size_t WS_WRG = 31 * MiB;
constexpr size_t WS_KN = 1 * MiB + 512 * 1024;
constexpr size_t WS_XF8 = 416 * MiB;
constexpr size_t WS_H1F8 = 880 * MiB;
constexpr size_t WS_XOF8 = 912 * MiB;
constexpr size_t WS_KM8 = 944 * MiB;
constexpr size_t WS_GSORT = 868 * MiB;
constexpr size_t WS_LF = 996 * MiB;

__device__ __forceinline__ P0Item p0_decode(const MegaArgs& a, int it) {
    unsigned char* ws = a.ws;
    constexpr int I_IN = 16 * 64, I_Q = 4 * 24, I_KV = 2 * 32, I_SQ = 16 * 32, I_MKV = 16 * 64, I_GU = 16 * 64, I_D = 16 * 32;
    P0Item d; d.kscale = nullptr; d.kscale2 = nullptr; d.cscale = 1.f; d.c_lo = 0; d.c_hi = 0; d.f8 = false; int r = it;
    if (r < NEXP * I_GU) { const int e = r / I_GU; d.W = a.in[20] + (size_t)e * DM * 2048; d.K = DM; d.N = 2048; d.NT = 2048; d.WT = (bf16*)(ws + WS_WGU + (size_t)e * 2048 * DM); d.f8 = true; d.cscale = W8_SCALE; d.c_hi = 2048; d.item = r % I_GU; return d; } r -= NEXP * I_GU;
    if (r < NEXP * I_D) { const int e = r / I_D; d.W = a.in[22] + (size_t)e * DEXP * DM; d.K = DEXP; d.N = DM; d.NT = DM; d.WT = (bf16*)(ws + WS_WD + (size_t)e * DM * DEXP); d.f8 = true; d.cscale = W8_SCALE; d.c_hi = DM; d.item = r % I_D; return d; } r -= NEXP * I_D;
    if (r < I_IN) { d.W = a.in[3]; d.K = DM; d.N = IN_COLS; d.NT = NPROJ; d.WT = (bf16*)(ws + WS_WIN); d.cscale = C2F; d.c_lo = C_FQ; d.c_hi = C_FK; d.item = r; return d; } r -= I_IN;
    if (r < I_Q) { d.W = a.in[5]; d.K = 256; d.N = 768; d.NT = 768; d.WT = (bf16*)(ws + WS_WQ); d.kscale = a.in[4]; d.cscale = C2M; d.c_lo = 0; d.c_hi = 768; d.item = r; return d; } r -= I_Q;
    if (r < I_KV) { d.W = a.in[7]; d.K = 128; d.N = 1024; d.NT = 1024; d.WT = (bf16*)(ws + WS_WKV); d.kscale = a.in[6]; d.item = r; return d; } r -= I_KV;
    if (r < I_SQ) { d.W = a.in[11]; d.K = DM; d.N = DM; d.NT = DM; d.WT = (bf16*)(ws + WS_WO); d.kscale = a.in[9]; d.kscale2 = a.in[10]; d.item = r; return d; } r -= I_SQ;
    if (r < I_SQ) { d.W = a.in[14]; d.K = DM; d.N = DM; d.NT = DM; d.WT = (bf16*)(ws + WS_WXQ); d.kscale = a.in[12]; d.cscale = C2X * WXQ8_SCALE; d.c_lo = 0; d.c_hi = DM; d.f8 = true; d.item = r; return d; } r -= I_SQ;
    if (r < I_SQ) { d.W = a.in[16]; d.K = DM; d.N = DM; d.NT = DM; d.WT = (bf16*)(ws + WS_WXO); d.cscale = WXO8_SCALE; d.c_lo = 0; d.c_hi = DM; d.f8 = true; d.item = r; return d; } r -= I_SQ;
    d.W = a.in[15]; d.K = DM; d.N = 2048; d.NT = 2048; d.WT = (bf16*)(ws + WS_WMKV); d.item = r; return d;
}
constexpr int P0_NITEMS = 16 * 64 + 4 * 24 + 2 * 32 + 3 * 16 * 32 + 16 * 64 + NEXP * 16 * 64 + NEXP * 16 * 32;
constexpr int MOE_ITEMS = NEXP * 16 * 64 + NEXP * 16 * 32;
constexpr int WCHUNKS = 512, WCH_ITEMS = MOE_ITEMS / WCHUNKS;
__device__ __forceinline__ void rms_rows2_to_bf16(const float* x0, const float* x1, const float* g, bf16* o0, bf16* o1, int lane) {
    const f32x4* xa = (const f32x4*)x0 + lane; const f32x4* xb = (const f32x4*)x1 + lane; const f32x4* gr = (const f32x4*)g + lane;
    f32x4 va[4], vb[4]; float sa = 0.f, sb = 0.f;
#pragma unroll
    for (int j = 0; j < 4; ++j) { va[j] = __builtin_nontemporal_load(xa + 64 * j); vb[j] = __builtin_nontemporal_load(xb + 64 * j); }
#pragma unroll
    for (int j = 0; j < 4; ++j) { sa += sum4sq(va[j]); sb += sum4sq(vb[j]); }
    const float ra = rsqrtf(wave_sum(sa) * (1.f / DM) + EPS), rb = rsqrtf(wave_sum(sb) * (1.f / DM) + EPS);
#pragma unroll
    for (int j = 0; j < 4; ++j) { const f32x4 gg = gr[64 * j]; st_bf4(o0 + 4 * lane + 256 * j, va[j] * ra * gg); st_bf4(o1 + 4 * lane + 256 * j, vb[j] * rb * gg); }
}
__device__ __forceinline__ void p0_items(const MegaArgs& a, LAS float* scr, int lane, int first, const int end, const int step) {
    f32x4 va[8], vb[8]; int it = first;
    if (it < end) { P0Item da = p0_decode(a, it); p0_load(da, va, lane);
        for (;;) {
            const int itb = it + step; P0Item db; const bool hb = itb < end; if (hb) { db = p0_decode(a, itb); p0_load(db, vb, lane); }
            p0_finish(da, va, scr, lane);
            if (!hb) break;
            const int ita = itb + step; const bool ha = ita < end; if (ha) { da = p0_decode(a, ita); p0_load(da, va, lane); }
            p0_finish(db, vb, scr, lane);
            if (!ha) break;
            it = ita;
        } }
}
__device__ __forceinline__ void p0_chunk(const Frame& F, const MegaArgs& a, int chunk) {
    LAS float* scr = (LAS float*)(F.lds + F.wave * 16384); int lane = lane_id(); asm volatile("" : "+v"(lane));
    p0_items(a, scr, lane, chunk * WCH_ITEMS + F.wave, (chunk + 1) * WCH_ITEMS, NWAVES);
    __syncthreads();
}
__device__ __forceinline__ void p0_prologue(const Frame& F, const MegaArgs& a) {
    LAS float* scr = (LAS float*)(F.lds + F.wave * 16384);
    int lane = lane_id(); asm volatile("" : "+v"(lane)); const int gw = F.vcu * NWAVES + F.wave, NGW = F.G * NWAVES;
    unsigned char* ws = a.ws;
    p0_items(a, scr, lane, MOE_ITEMS + gw, P0_NITEMS, NGW);
    for (int m = 2 * gw; m < T; m += 2 * NGW) rms_rows2_to_bf16(a.in[0] + (size_t)m * DM, a.in[0] + (size_t)(m + 1) * DM, a.in[2], (bf16*)(ws + WS_XN) + (size_t)m * DM, (bf16*)(ws + WS_XN) + (size_t)(m + 1) * DM, lane);
    for (int m = 2 * gw; m < TM; m += 2 * NGW) rms_rows2_to_bf16(a.in[1] + (size_t)m * DM, a.in[1] + (size_t)(m + 1) * DM, a.in[13], (bf16*)(ws + WS_MEMN) + (size_t)m * DM, (bf16*)(ws + WS_MEMN) + (size_t)(m + 1) * DM, lane);
    { float* tab = (float*)(ws + WS_ROPE); for (int i = gw * 64 + lane; i < 4096 * 16; i += NGW * 64) { const int pos = i >> 4, j = i & 15; const float inv = powf(10000.f, -(float)j / 16.f); const float ang = (float)pos * inv; tab[2 * i] = cosf(ang); tab[2 * i + 1] = sinf(ang); } }
    { bf16* wh = (bf16*)(ws + WS_WRG); bf16* wl = wh + DM * NEXP;
      for (int i = gw * 64 + lane; i < DM * NEXP; i += NGW * 64) { const float w = a.in[18][i] * a.in[17][i >> 5]; const bf16 h = f2bf(w); const int o_ = (i & 31) * DM + (i >> 5); wh[o_] = h; wl[o_] = f2bf(w - bf2f(h)); } }
}
__device__ __forceinline__ void p2_scan_item(const float* LF, float* cum, bf16* kaug, int item, int lane) {
    const int b = item >> 3, ck = item & 7; const float* base = LF + (size_t)b * SEQ * 8;
    float carry[8];
#pragma unroll
    for (int h = 0; h < 8; ++h) carry[h] = 0.f;
    for (int p = lane; p < ck * 512; p += 64) { const f32x4 x0 = *(const f32x4*)(base + (size_t)p * 8), x1 = *(const f32x4*)(base + (size_t)p * 8 + 4);
#pragma unroll
        for (int e = 0; e < 4; ++e) { carry[e] += x0[e]; carry[4 + e] += x1[e]; } }
#pragma unroll
    for (int h = 0; h < 8; ++h) carry[h] = wave_sum(carry[h]);
    const int s0 = ck * 512 + lane * 8;
    float v[8][8];
#pragma unroll
    for (int i = 0; i < 8; ++i) { const f32x4 x0 = *(const f32x4*)(base + (size_t)(s0 + i) * 8), x1 = *(const f32x4*)(base + (size_t)(s0 + i) * 8 + 4);
#pragma unroll
        for (int e = 0; e < 4; ++e) { v[i][e] = x0[e]; v[i][4 + e] = x1[e]; } }
#pragma unroll
    for (int h = 0; h < 8; ++h) {
#pragma unroll
        for (int i = 1; i < 8; ++i) v[i][h] += v[i - 1][h];
        float tot = v[7][h], inc = tot;
#pragma unroll
        for (int o = 1; o < 64; o <<= 1) { const float up = __shfl_up(inc, o); if (lane >= o) inc += up; }
        const float off = carry[h] + (inc - tot);
#pragma unroll
        for (int i = 0; i < 8; ++i) v[i][h] += off;
    }
#pragma unroll
    for (int h = 0; h < 8; ++h) {
        float* cr = cum + (size_t)(b * 8 + h) * SEQ + s0; *(f32x4*)cr = (f32x4){v[0][h], v[1][h], v[2][h], v[3][h]}; *(f32x4*)(cr + 4) = (f32x4){v[4][h], v[5][h], v[6][h], v[7][h]};
        bf16* kr = kaug + ((size_t)(b * 8 + h) * SEQ + s0) * 8;
#pragma unroll
        for (int i = 0; i < 8; ++i) { const float x = -v[i][h] * LOG2E; const unsigned hi = cvtpk(x, 0.f) & 0xffffu; const float r1 = x - __uint_as_float(hi << 16); const unsigned mid = cvtpk(r1, 0.f) & 0xffffu;
            const float r2 = r1 - __uint_as_float(mid << 16); const unsigned lo = cvtpk(r2, 0.f) & 0xffffu; *(u32x4*)(kr + i * 8) = (u32x4){hi | (mid << 16), lo, 0u, 0u}; }
    }
}

struct EpiGateUp {
    static constexpr bool PERM = true, MID = false;
    const float* bias; unsigned char* ACT8;
    __device__ __forceinline__ void act(const f32x4 (&a4)[2][2], const f32x4 (&bv)[2][2], unsigned (&w)[2]) const {
        const f32x4 sv = (f32x4){1.f / W8_SCALE, ACT8_SCALE / W8_SCALE, 1.f / W8_SCALE, ACT8_SCALE / W8_SCALE};
#pragma unroll
        for (int bj = 0; bj < 2; ++bj) { const f32x4 v0 = a4[bj][0] * sv + bv[bj][0], v1 = a4[bj][1] * sv + bv[bj][1];
            const f32x4 G = (f32x4){fminf(v0[0], 7.f), fminf(v0[2], 7.f), fminf(v1[0], 7.f), fminf(v1[2], 7.f)};
            const f32x4 L = (f32x4){__builtin_amdgcn_fmed3f(v0[1], -6.f * ACT8_SCALE, 8.f * ACT8_SCALE), __builtin_amdgcn_fmed3f(v0[3], -6.f * ACT8_SCALE, 8.f * ACT8_SCALE),
                                    __builtin_amdgcn_fmed3f(v1[1], -6.f * ACT8_SCALE, 8.f * ACT8_SCALE), __builtin_amdgcn_fmed3f(v1[3], -6.f * ACT8_SCALE, 8.f * ACT8_SCALE)};
            const f32x4 tt = G * (-1.702f * LOG2E);
            const f32x4 dd = (f32x4){__builtin_amdgcn_exp2f(tt[0]), __builtin_amdgcn_exp2f(tt[1]), __builtin_amdgcn_exp2f(tt[2]), __builtin_amdgcn_exp2f(tt[3])} + 1.f;
            const f32x4 rr = (f32x4){__builtin_amdgcn_rcpf(dd[0]), __builtin_amdgcn_rcpf(dd[1]), __builtin_amdgcn_rcpf(dd[2]), __builtin_amdgcn_rcpf(dd[3])};
            const f32x4 a = (G * rr) * L;
            int x = 0; x = __builtin_amdgcn_cvt_pk_fp8_f32(a[0], a[1], x, false); x = __builtin_amdgcn_cvt_pk_fp8_f32(a[2], a[3], x, true); w[bj] = (unsigned)x; }
    }
    __device__ __forceinline__ void operator()(f32x4 (&acc)[2][2][4][2], const pg8::Unit& u, int wr, int wc, int fr, int fq) const {
        asm volatile("" : "+v"(fr), "+v"(fq));
        const int c0 = u.col0 + wc * 32 + fq * 8; const float* bp = bias + (size_t)u.e * 2048 + c0;
        const f32x4 bm = (f32x4){1.f, ACT8_SCALE, 1.f, ACT8_SCALE}, ba = (f32x4){0.f, ACT8_SCALE, 0.f, ACT8_SCALE};
        f32x4 bv[2][2];
#pragma unroll
        for (int bj = 0; bj < 2; ++bj) { bv[bj][0] = *(const f32x4*)(bp + bj * 128) * bm + ba; bv[bj][1] = *(const f32x4*)(bp + bj * 128 + 4) * bm + ba; }
#pragma unroll
        for (int ai = 0; ai < 2; ++ai)
#pragma unroll
            for (int mp = 0; mp < 2; ++mp) {
                asm volatile("" : "+v"(acc[ai][0][2 * mp][0]), "+v"(acc[ai][0][2 * mp][1]), "+v"(acc[ai][1][2 * mp][0]), "+v"(acc[ai][1][2 * mp][1]));
                unsigned d[2][2];
#pragma unroll
                for (int q = 0; q < 2; ++q) { const int m = 2 * mp + q; unsigned w[2]; const f32x4 a4[2][2] = {{acc[ai][0][m][0], acc[ai][0][m][1]}, {acc[ai][1][m][0], acc[ai][1][m][1]}}; act(a4, bv, w);
                    const auto r = __builtin_amdgcn_permlane16_swap(w[0], w[1], false, false); d[q][0] = r[0]; d[q][1] = r[1]; }
                const auto r0 = __builtin_amdgcn_permlane32_swap(d[0][0], d[1][0], false, false), r1 = __builtin_amdgcn_permlane32_swap(d[0][1], d[1][1], false, false);
                int f2 = fr, q2 = fq; asm volatile("" : "+v"(f2), "+v"(q2));
                const int rl = ai * 128 + wr * 64 + (2 * mp + (q2 >> 1)) * 16 + f2; const unsigned rowi = rl < u.rows ? (unsigned)(u.row0 + rl) : (unsigned)(T * 4 + rl);
                *(u32x4*)(ACT8 + (rowi * (unsigned)DEXP + (unsigned)((u.col0 >> 1) + wc * 16 + (q2 & 1) * 64))) = (u32x4){r0[0], r1[0], r0[1], r1[1]};
                asm volatile("" ::: "memory"); }
    }
};
struct EpiDown {
    static constexpr bool PERM = true, MID = false;
    const float* bias; const float* gsort; const int* list0; unsigned char* Y8;
    __device__ __forceinline__ void operator()(f32x4 (&acc)[2][2][4][2], const pg8::Unit& u, int wr, int wc, int fr, int fq) const {
        asm volatile("" : "+v"(fr), "+v"(fq));
        const int c0 = u.col0 + wc * 32 + fq * 8; const float* bp = bias + (size_t)u.e * DM + c0;
        const float* gp = gsort + (u.list - list0) + wr * 64 + fq * 16 + fr;
        const float g0 = gp[0] * Y8_SCALE, g1 = gp[128] * Y8_SCALE;
        f32x4 bv[2][2];
#pragma unroll
        for (int bj = 0; bj < 2; ++bj) { bv[bj][0] = *(const f32x4*)(bp + bj * 128); bv[bj][1] = *(const f32x4*)(bp + bj * 128 + 4); }
#pragma unroll
        for (int g = 0; g < 8; ++g) { const int ai = g >> 2, m = g & 3;
                int f2 = fr, q2 = fq; asm volatile("" : "+v"(f2), "+v"(q2));
                const float gg = __int_as_float(__builtin_amdgcn_ds_bpermute(4 * (m * 16 + f2), __float_as_int(ai ? g1 : g0)));
                const int rl = ai * 128 + wr * 64 + m * 16 + f2; const unsigned rowi = rl < u.rows ? (unsigned)(u.row0 + rl) : (unsigned)(T * 4 + rl);
                unsigned w[2][2];
#pragma unroll
                for (int bj = 0; bj < 2; ++bj) { const f32x4 v0 = (acc[ai][bj][m][0] * (1.f / (W8_SCALE * ACT8_SCALE)) + bv[bj][0]) * gg, v1 = (acc[ai][bj][m][1] * (1.f / (W8_SCALE * ACT8_SCALE)) + bv[bj][1]) * gg;
                    int w0 = 0, w1 = 0; w0 = __builtin_amdgcn_cvt_pk_fp8_f32(v0[0], v0[1], w0, false); w0 = __builtin_amdgcn_cvt_pk_fp8_f32(v0[2], v0[3], w0, true);
                    w1 = __builtin_amdgcn_cvt_pk_fp8_f32(v1[0], v1[1], w1, false); w1 = __builtin_amdgcn_cvt_pk_fp8_f32(v1[2], v1[3], w1, true); w[bj][0] = (unsigned)w0; w[bj][1] = (unsigned)w1; }
                const auto r0 = __builtin_amdgcn_permlane16_swap(w[0][0], w[1][0], false, false), r1 = __builtin_amdgcn_permlane16_swap(w[0][1], w[1][1], false, false);
                *(u32x4*)(Y8 + (rowi * (unsigned)DM + (unsigned)(u.col0 + wc * 32 + ((q2 & 1) ? 128 + 8 * (q2 - 1) : 8 * q2)))) = (u32x4){r0[0], r1[0], r0[1], r1[1]};
                asm volatile("" ::: "memory");
            }
    }
};
struct MoeSched {
    pg8::TileOrder o; const volatile LAS int* tpre; const volatile LAS int* roff;
    const char* A; size_t a_row_bytes; const char* Wt; size_t w_exp_bytes; int brow; const int* list; bool gather;
    __device__ __forceinline__ void tables(const volatile LAS int* tp, const volatile LAS int* ro) { tpre = tp; roff = ro; }
    __device__ __forceinline__ bool next(int i, pg8::Unit& u) const { int pm, pn; if (!o.tile(i, pm, pn)) return false;
        int l = lane_id(); const int j = l < 32 ? l : 32; const int tv = tpre[j], rv = roff[j];
        const unsigned long long mk = __ballot(l >= 1 && l < NEXP && tv <= pm); const int e = __builtin_popcountll(mk);
        const int tp = __builtin_amdgcn_readlane(tv, e), r0 = __builtin_amdgcn_readlane(rv, e), r1 = __builtin_amdgcn_readlane(rv, e + 1);
        const int mt = pm - tp, cnt = r1 - r0; u.row0 = r0 + mt * 256; u.rows = (cnt - mt * 256) < 256 ? (cnt - mt * 256) : 256; u.col0 = pn * 256; u.pn = pn; u.e = e;
        u.a = gather ? A : A + (size_t)u.row0 * a_row_bytes; u.b = Wt + (size_t)e * w_exp_bytes + (size_t)pn * 256 * brow; u.list = list + (size_t)e * T + mt * 256; return true; }
};
__device__ __forceinline__ int moe_tables(const Frame& F, const int* cnt) {
    volatile LAS int* tp = (volatile LAS int*)(F.MISC + 64); volatile LAS int* ro = (volatile LAS int*)(F.MISC + 128);
    __syncthreads();
    if (F.wave == 0 && lane_id() == 0) { int t = 0, r = 0; for (int e = 0; e < NEXP; ++e) { const int c = __hip_atomic_load(cnt + e, __ATOMIC_RELAXED, __HIP_MEMORY_SCOPE_AGENT); tp[e] = t; ro[e] = r; t += (c + 255) >> 8; r += c; } tp[NEXP] = t; ro[NEXP] = r; }
    __syncthreads();
    return __builtin_amdgcn_readfirstlane(tp[NEXP]);
}
__device__ __forceinline__ void p7_route(const Frame& F, const MegaArgs& a, const size_t dummy) {
    unsigned char* ws = a.ws; const float* wrg = (const float*)(ws + WS_WRG); const bf16* h2 = (const bf16*)(ws + WS_XN); const float* gln = a.in[17]; const float* br = a.in[19];
    unsigned char* XF8 = ws + WS_XF8 + dummy; int* cnt = (int*)(ws + WS_CTL) + CW_CNT + (dummy ? 64 : 0);   const size_t d2 = dummy ? (WS_QM - WS_TOPI) : 0; int* topi = (int*)(ws + WS_TOPI + d2); float* gate = (float*)(ws + WS_GATE + d2); int* slot = (int*)(ws + WS_SLOT + d2); int* list = (int*)(ws + WS_LIST + d2); float* gsort = (float*)(ws + WS_GSORT + (dummy ? 8 * MiB : 0));
    LAS float* W = (LAS float*)F.lds; int tid = (F.wave << 6) | lane_id(); asm volatile("" : "+v"(tid)); const int lane = tid & 63;
    volatile LAS int* lcnt = (volatile LAS int*)(F.MISC + 16); volatile LAS int* lbase = (volatile LAS int*)(F.MISC + 192); LAS int* rec = (LAS int*)(F.MISC + 256);
    { const bf16* wh = (const bf16*)wrg; LAS unsigned char* Wb = F.lds;
      for (int idx = tid; idx < 8192; idx += NWAVES * 64) { const int pc = idx >> 12, R = (idx >> 5) & 127, c = idx & 31, kq_ = R >> 5, e = R & 31;
          *(LAS u32x4*)(Wb + pc * 65536 + R * 512 + ((c ^ (R & 15)) << 4)) = *(const u32x4*)(wh + (size_t)pc * DM * NEXP + e * DM + 32 * c + 8 * kq_); } }
    if (tid < NEXP) lcnt[tid] = 0;
    __syncthreads();
    const int TPB = T / F.G, t0 = F.vcu * TPB, TPW = TPB / NWAVES;
    const int li = lane & 15, kq = lane >> 4, tw0 = t0 + F.wave * TPW;
    float rs;
    f32x4 d0 = (f32x4){0.f, 0.f, 0.f, 0.f}, d1 = (f32x4){0.f, 0.f, 0.f, 0.f};
    { const bf16* xrow = h2 + (size_t)(tw0 + li) * DM + 8 * kq; const LAS unsigned char* w0 = F.lds + (kq * 32 + li) * 512;
      float ssq = 0.f;
#pragma unroll
      for (int c = 0; c < 4; ++c) { u32x4 xr[8];
#pragma unroll
          for (int u = 0; u < 8; ++u) xr[u] = *(const u32x4*)(xrow + 32 * (8 * c + u));
#pragma unroll
          for (int u = 0; u < 8; ++u) { const int sw = ((8 * c + u) ^ li) << 4; const bf16x8 av = __builtin_bit_cast(bf16x8, xr[u]);
              const bf16x8 bh0 = *(const LAS bf16x8*)(w0 + sw), bl0 = *(const LAS bf16x8*)(w0 + 65536 + sw), bh1 = *(const LAS bf16x8*)(w0 + 8192 + sw), bl1 = *(const LAS bf16x8*)(w0 + 65536 + 8192 + sw);
              d0 = __builtin_amdgcn_mfma_f32_16x16x32_bf16(av, bh0, d0, 0, 0, 0); d1 = __builtin_amdgcn_mfma_f32_16x16x32_bf16(av, bh1, d1, 0, 0, 0);
              d0 = __builtin_amdgcn_mfma_f32_16x16x32_bf16(av, bl0, d0, 0, 0, 0); d1 = __builtin_amdgcn_mfma_f32_16x16x32_bf16(av, bl1, d1, 0, 0, 0);
#pragma unroll
              for (int j = 0; j < 4; ++j) { const float xl = __uint_as_float(xr[u][j] << 16), xh = __uint_as_float(xr[u][j] & 0xffff0000u); ssq += xl * xl + xh * xh; } } }
      ssq += __shfl_xor(ssq, 16); ssq += __shfl_xor(ssq, 32); rs = rsqrtf(ssq * (1.f / DM) + EPS); }
    { const float b0 = br[li], b1 = br[li + 16];
#pragma unroll
      for (int r = 0; r < 4; ++r) { const float rt = __shfl(rs, 4 * kq + r); float c0 = d0[r] * rt + b0, c1 = d1[r] * rt + b1;
        float tv[4]; int ti[4];
#pragma unroll
        for (int k = 0; k < 4; ++k) { float bv = c0; int bi = li; if (c1 > c0) { bv = c1; bi = li + 16; }
#pragma unroll
            for (int o = 1; o < 16; o <<= 1) { const float ov = __shfl_xor(bv, o); const int oi = __shfl_xor(bi, o); if (ov > bv || (ov == bv && oi < bi)) { bv = ov; bi = oi; } }
            tv[k] = bv; ti[k] = bi; if (bi == li) c0 = -INFINITY; if (bi == li + 16) c1 = -INFINITY; }
        const float e1 = __expf(tv[1] - tv[0]), e2 = __expf(tv[2] - tv[0]), e3 = __expf(tv[3] - tv[0]); const float inv = 1.f / (1.f + e1 + e2 + e3);
        const float gs[4] = {inv, e1 * inv, e2 * inv, e3 * inv};
        const int tok = F.wave * TPW + 4 * kq + r;
#pragma unroll
        for (int k = 0; k < 4; ++k) if ((ti[k] & 15) == li) { const int ex = ti[k]; const int ls = __hip_atomic_fetch_add((LAS int*)(lcnt + ex), 1, __ATOMIC_RELAXED, __HIP_MEMORY_SCOPE_WORKGROUP); LAS int* rr = rec + (tok * 4 + k) * 3; rr[0] = ex; rr[1] = __float_as_int(gs[k]); rr[2] = ls; } } }
    { f32x4 gv[4];
#pragma unroll
      for (int j = 0; j < 4; ++j) gv[j] = *(const f32x4*)(gln + 16 * lane + 4 * j);
#pragma unroll
      for (int tb = 0; tb < 16; tb += 8) { u32x4 xw[8][2];
#pragma unroll
          for (int tt = 0; tt < 8; ++tt)
#pragma unroll
              for (int j = 0; j < 2; ++j) xw[tt][j] = *(const u32x4*)(h2 + (size_t)(tw0 + tb + tt) * DM + 16 * lane + 8 * j);
#pragma unroll
          for (int tt = 0; tt < 8; ++tt) { const float rt = __shfl(rs, tb + tt); u32x4 f;
#pragma unroll
              for (int j = 0; j < 4; ++j) { const unsigned a0 = xw[tt][j >> 1][(j & 1) * 2], a1 = xw[tt][j >> 1][(j & 1) * 2 + 1];
                  const f32x4 y = (f32x4){__uint_as_float(a0 << 16), __uint_as_float(a0 & 0xffff0000u), __uint_as_float(a1 << 16), __uint_as_float(a1 & 0xffff0000u)} * rt * gv[j];
                  int w = 0; w = __builtin_amdgcn_cvt_pk_fp8_f32(y[0], y[1], w, false); w = __builtin_amdgcn_cvt_pk_fp8_f32(y[2], y[3], w, true); f[j] = (unsigned)w; }
              *(u32x4*)(XF8 + (size_t)(tw0 + tb + tt) * DM + 16 * lane) = f; } } }
    __syncthreads();
    if (tid < NEXP) lbase[tid] = atomicAdd(cnt + tid, (int)lcnt[tid]);
    __syncthreads();
    for (int idx = tid; idx < TPB * 4; idx += NWAVES * 64) { const LAS int* r = rec + idx * 3; const int e = r[0], sl = lbase[e] + r[2]; const int gi = t0 * 4 + idx;
        topi[gi] = e; gate[gi] = __int_as_float(r[1]); slot[gi] = sl; list[(size_t)e * T + sl] = gi; gsort[(size_t)e * T + sl] = __int_as_float(r[1]); }
}
__device__ __forceinline__ void p10_combine(const Frame& F, const MegaArgs& a, float* dst) {
    unsigned char* ws = a.ws; const unsigned char* Y8 = ws + WS_Y; const bf16* h2 = (const bf16*)(ws + WS_XN); const int* topi = (const int*)(ws + WS_TOPI); const int* slot = (const int*)(ws + WS_SLOT); const float* g = a.in[24];
    const volatile LAS int* ro = (const volatile LAS int*)(F.MISC + 128); int lane = lane_id(); asm volatile("" : "+v"(lane));
    const int t0 = F.vcu * NWAVES + F.wave, ts = F.G * NWAVES;
    f32x4 gv[4];
#pragma unroll
    for (int j = 0; j < 4; ++j) gv[j] = *(const f32x4*)(g + 16 * lane + 4 * j);
    constexpr int NB = 3;
    u32x4 yn[NB][4], hn[NB][2]; int en[NB], sn[NB];
#define P10_IDX(bt) do { _Pragma("unroll") for (int q_ = 0; q_ < NB; ++q_) { const int tt_ = (bt) + q_ * ts; en[q_] = 0; sn[q_] = 0; if (tt_ < T && lane < 4) { en[q_] = topi[tt_ * 4 + lane]; sn[q_] = slot[tt_ * 4 + lane]; } } } while (0)
#define P10_LOAD(bt) do { _Pragma("unroll") for (int q_ = 0; q_ < NB; ++q_) { const int tt_ = (bt) + q_ * ts; if (tt_ < T) { \
        const int pl_ = (lane < 4 ? ro[en[q_]] : 0) + sn[q_]; \
        _Pragma("unroll") for (int k = 0; k < 4; ++k) { const size_t pos = (size_t)__builtin_amdgcn_readlane(pl_, k); yn[q_][k] = *(const u32x4*)(Y8 + pos * DM + 16 * lane); } \
        _Pragma("unroll") for (int j = 0; j < 2; ++j) hn[q_][j] = *(const u32x4*)(h2 + (size_t)tt_ * DM + 16 * lane + 8 * j); } } } while (0)
    P10_IDX(t0); P10_LOAD(t0); P10_IDX(t0 + NB * ts);
    for (int tb = t0; tb < T; tb += NB * ts) {
        u32x4 y[NB][4], hw[NB][2];
#pragma unroll
        for (int q = 0; q < NB; ++q) {
#pragma unroll
            for (int k = 0; k < 4; ++k) y[q][k] = yn[q][k];
#pragma unroll
            for (int j = 0; j < 2; ++j) hw[q][j] = hn[q][j]; }
        if (tb + NB * ts < T) { P10_LOAD(tb + NB * ts); P10_IDX(tb + 2 * NB * ts); }
#pragma unroll
        for (int q = 0; q < NB; ++q) { const int t = tb + q * ts; if (t < T) {
            f32x4 v[4];
#pragma unroll
            for (int j = 0; j < 4; ++j) { f32x4 ys = (f32x4){0.f, 0.f, 0.f, 0.f};
#pragma unroll
                for (int k = 0; k < 4; ++k) { const f32x2 lo = __builtin_amdgcn_cvt_pk_f32_fp8((int)y[q][k][j], false), hi = __builtin_amdgcn_cvt_pk_f32_fp8((int)y[q][k][j], true); ys[0] += lo.x; ys[1] += lo.y; ys[2] += hi.x; ys[3] += hi.y; }
                const unsigned w0 = hw[q][j >> 1][(j & 1) * 2], w1 = hw[q][j >> 1][(j & 1) * 2 + 1];
                v[j] = (f32x4){__uint_as_float(w0 << 16), __uint_as_float(w0 & 0xffff0000u), __uint_as_float(w1 << 16), __uint_as_float(w1 & 0xffff0000u)} + ys * (1.f / Y8_SCALE); }
            float sq = 0.f;
#pragma unroll
            for (int j = 0; j < 4; ++j) sq += sum4sq(v[j]);
            const float r = rsqrtf(wave_sum(sq) * (1.f / DM) + EPS);
#pragma unroll
            for (int j = 0; j < 4; ++j) *(f32x4*)(dst + (size_t)t * DM + 16 * lane + 4 * j) = v[j] * r * gv[j]; } }
    }
#undef P10_LOAD
#undef P10_IDX
}
__global__ void __launch_bounds__(NWAVES * 64, 2) mega_fwd(MegaArgs args) {
    extern __shared__ __attribute__((aligned(16))) unsigned char lds_raw[];
    Frame F;
    F.lds = (LAS unsigned char*)lds_raw; F.MISC = (volatile LAS unsigned*)(F.lds + MISC_OFF); F.tabs = (LAS unsigned*)(F.lds + TABS_OFF);
    F.wave = __builtin_amdgcn_readfirstlane((int)threadIdx.x >> 6);
    F.G = gridDim.x; { const int bx = blockIdx.x; F.vcu = (F.G % 8 == 0) ? (bx % 8) * (F.G / 8) + bx / 8 : bx; }
    unsigned char* ws = args.ws;
    unsigned* ctl = (unsigned*)(ws + WS_CTL);
    for (int u = (F.wave << 6) | lane_id(); u < (LDS_BYTES - MISC_OFF) / 4; u += NWAVES * 64) ((LAS unsigned*)(F.lds + MISC_OFF))[u] = 0u;
    __syncthreads();
    XcdBarrier bar; bar.bar = ctl + CW_BAR; bar.x = 0; bar.st = nullptr; bar.wave0 = false;
    if (args.coop) bar = xcd_barrier_post(ctl + CW_BAR, F.MISC + 8, F.wave);
    const int lo = args.ph_lo, hi = args.ph_hi;
#define IN(k) (lo <= (k) && (k) < hi)
#define SEAM(k) do { if (args.coop && IN(k) && IN((k) + 1)) { xcd_barrier(bar); if ((PROBE_REP) == 100) xcd_barrier(bar); } } while (0)
    bf16 *WinT = (bf16*)(ws + WS_WIN), *WqT = (bf16*)(ws + WS_WQ), *WkvT = (bf16*)(ws + WS_WKV), *WmkvT = (bf16*)(ws + WS_WMKV);
    bf16 *XN = (bf16*)(ws + WS_XN), *PROJ = (bf16*)(ws + WS_PROJ), *QM = (bf16*)(ws + WS_QM), *KVM = (bf16*)(ws + WS_KVM), *MEMN = (bf16*)(ws + WS_MEMN), *KVMEM = (bf16*)(ws + WS_KVMEM);
    float *rope = (float*)(ws + WS_ROPE), *ssqq = (float*)(ws + WS_SSQQ), *ssqkv = (float*)(ws + WS_SSQKV), *LF = (float*)(ws + WS_LF);

    if (IN(0)) { REPS(0) p0_prologue(F, args); }
    if (args.coop == 2) cg::this_grid().sync();
    SEAM(0);
    if (IN(1)) REPS(1) {
        pg8::DenseSched S; S.init(XN, DM, WinT, T, NPROJ, DM, F.G, (int)blockIdx.x);
        EpiProj E{PROJ, ssqq, ssqkv, rope, LF, args.in[8]};
        pg8::gemm_phase<EpiProj, pg8::DenseSched, false>(F.lds, F.tabs, DM, DM, S, E, F.wave);
    }
    SEAM(1);
    if (IN(2)) REPS(2) {
        const int GA = (F.G * 3) / 4, bx = (int)blockIdx.x;
        if (bx >= GA) { const int sid = bx - GA, ns = F.G - GA;
          if (F.wave == 0) for (int it = sid; it < 64; it += ns) { int ln = lane_id(); asm volatile("" : "+v"(ln)); p2_scan_item(LF, (float*)(ws + WS_CUM), (bf16*)(ws + WS_KAUG), it, ln); }
          for (int item = sid * NWAVES + F.wave; item < BATCH * 64; item += ns * NWAVES) {
          { int ln = lane_id(); asm volatile("" : "+v"(ln)); const int b = item >> 6, t = item & 63; const bf16* kr = PROJ + ((size_t)b * SEQ + t * 64 + ln) * NPROJ + C_FK; float* KN = (float*)(ws + WS_KN);
            for (int h = 0; h < 8; ++h) { float s2 = 0.f;
#pragma unroll
                for (int c = 0; c < 8; ++c) { const u32x4 w = *(const u32x4*)(kr + h * 64 + c * 8);
#pragma unroll
                    for (int j = 0; j < 4; ++j) { const float a_ = __uint_as_float(w[j] << 16), b_ = __uint_as_float(w[j] & 0xffff0000u); s2 += a_ * a_ + b_ * b_; } }
#pragma unroll
                for (int o_ = 1; o_ < 64; o_ <<= 1) s2 = fmaxf(s2, __shfl_xor(s2, o_));
                if (ln == 0) KN[(size_t)(b * 8 + h) * 64 + t] = sqrtf(s2); } } } }
        __syncthreads();
        if (F.G >= 8 && (F.G % 32) == 0) {
            if (bx < GA) {
                { pg8::DenseSched S; S.init(PROJ + C_QLAT, NPROJ, WqT, T, 768, 256, GA, bx); EpiScale<4, true> E{QM, 768, ssqq, 1.f / 256.f, rope}; pg8::gemm_phase<EpiScale<4, true>, pg8::DenseSched, false>(F.lds, F.tabs, 256, NPROJ, S, E, F.wave); }
                { pg8::DenseSched S; S.init(PROJ + C_KVLAT, NPROJ, WkvT, T, 1024, 128, GA, bx); EpiScale<4, false> E{KVM, 1024, ssqkv, 1.f / 128.f, nullptr}; pg8::gemm_phase<EpiScale<4, false>, pg8::DenseSched, false>(F.lds, F.tabs, 128, NPROJ, S, E, F.wave); }
            } else {
                pg8::DenseSched S; S.init(MEMN, DM, WmkvT, TM, 2048, DM, F.G - GA, bx - GA); EpiMemKV E{KVMEM, ws + WS_KM8}; pg8::gemm_phase<EpiMemKV, pg8::DenseSched, false>(F.lds, F.tabs, DM, DM, S, E, F.wave);
            }
        }
    }
    SEAM(2);
    if (IN(3)) REPS(3) {
        bf16* O = (bf16*)(ws + WS_O); float* SSO = (float*)(ws + WS_SSO); const bf16* KAUG = (const bf16*)(ws + WS_KAUG);
        int upos = 0; unsigned chdone = 0u;
        for (int P = F.vcu; P < 512; P += F.G) {
            const int bh = P >> 3, pair = P & 7, b = bh >> 3, h = bh & 7;
            for (int j = 0; j < 2; ++j) {
                { const int q_ = upos & 3;
                  for (int i_ = 0; i_ < 2; ++i_) { const int ch = F.vcu + F.G * i_; if (ch < WCHUNKS && (((F.vcu & 3) + 2 * i_) & 3) == q_ && upos < 4) { p0_chunk(F, args, ch); chdone |= 1u << i_; } }
                  ++upos; }
                const int qb = j ? 15 - pair : pair; const size_t r0 = (size_t)b * SEQ, rq = r0 + (size_t)qb * 256;
                att::Src s; s.nt = 4 * (qb + 1); s.q0 = qb * 256; s.ldo = DM; s.kn = nullptr; s.cum = nullptr;
                s.q = QM + rq * 768 + h * 96; s.ldq = 768; s.k1 = KVM + r0 * 1024 + h * 128; s.ldk1 = 1024; s.k2 = PROJ + r0 * NPROJ + C_KPE; s.ldk2 = NPROJ; s.v = KVM + r0 * 1024 + h * 128 + 64; s.ldv = 1024;
                s.o = O + rq * DM + h * 64; s.sso = SSO + rq * 16 + h;
                att::unit<6, 8, 12, 2, true, false, false, true>(s, F.lds, F.wave); }
        }
        for (int i_ = 0; F.vcu + F.G * i_ < WCHUNKS; ++i_) if (i_ >= 2 || !((chdone >> i_) & 1u)) p0_chunk(F, args, F.vcu + F.G * i_);
        if (args.coop) {
            unsigned* fq = ctl + CW_FOXQ; volatile LAS unsigned* tk = F.MISC + 48; const bool lead = F.wave == 0 && lane_id() == 0;
            if (lead) tk[0] = __hip_atomic_fetch_add(fq, 1u, __ATOMIC_RELAXED, __HIP_MEMORY_SCOPE_AGENT);
            __syncthreads();
            unsigned cur = __builtin_amdgcn_readfirstlane(tk[0]);
            while (cur < 1024u) {
                unsigned nx = 0; if (lead) nx = __hip_atomic_fetch_add(fq, 1u, __ATOMIC_RELAXED, __HIP_MEMORY_SCOPE_AGENT);
                const int r = (int)(cur >> 7), qb = 15 - (int)((cur >> 3) & 15), b = (int)(cur & 7);
                const float* bfg = args.in[8]; int h = 0;
                for (int c = 0; c < 8; ++c) { int rk = 0; for (int j = 0; j < 8; ++j) rk += (bfg[j] > bfg[c] || (bfg[j] == bfg[c] && j < c)) ? 1 : 0; if (rk == r) h = c; }
                const size_t r0 = (size_t)b * SEQ, rq = r0 + (size_t)qb * 256;
                att::Src s; s.nt = 4 * (qb + 1); s.q0 = qb * 256; s.ldo = DM;
                s.q = PROJ + rq * NPROJ + C_FQ + h * 64; s.ldq = NPROJ; s.k1 = PROJ + r0 * NPROJ + C_FK + h * 64; s.ldk1 = NPROJ; s.k2 = KAUG + (size_t)(b * 8 + h) * SEQ * 8; s.ldk2 = 8; s.v = PROJ + r0 * NPROJ + C_FV + h * 64; s.ldv = NPROJ;
                s.o = O + rq * DM + 512 + h * 64; s.sso = SSO + rq * 16 + 8 + h; s.kn = (const float*)(ws + WS_KN) + (size_t)(b * 8 + h) * 64; s.cum = (const float*)(ws + WS_CUM) + (size_t)(b * 8 + h) * SEQ;
                att::unit<5, 8, 9, 2, true, true, true, true, true>(s, F.lds, F.wave);
                if (lead) tk[0] = nx;
                __syncthreads();
                cur = __builtin_amdgcn_readfirstlane(tk[0]);
            }
        }
    }
    SEAM(3);
    bf16 *WoT = (bf16*)(ws + WS_WO), *WxqT = (bf16*)(ws + WS_WXQ), *WxoT = (bf16*)(ws + WS_WXO), *XQ = (bf16*)(ws + WS_XQ), *XO = (bf16*)(ws + WS_XO);
    float* ssq1 = (float*)(ws + WS_SSQ1);
    if (IN(4)) REPS(4) {
        pg8::DenseSched S; S.init((const bf16*)(ws + WS_O), DM, WoT, T, DM, DM, F.G, (int)blockIdx.x);
        EpiWo E{(const float*)(ws + WS_SSO), args.in[0], args.out, XN, ssq1, ws + WS_H1F8};
        pg8::gemm_phase<EpiWo, pg8::DenseSched, false>(F.lds, F.tabs, DM, DM, S, E, F.wave);
    }
    SEAM(4);
    if (IN(5)) REPS(5) {
        pg8::DenseSched S; S.init((const bf16*)(ws + WS_H1F8), DM / 2, WxqT, T, DM, DM / 2, F.G, (int)blockIdx.x);
        { EpiXQ8 E{ws + WS_XQ, ssq1, XQ8_SCALE / (H8_SCALE * WXQ8_SCALE)}; pg8::gemm_phase<EpiXQ8, pg8::DenseSched, false, true>(F.lds, F.tabs, DM, DM, S, E, F.wave); }
        asm volatile("s_waitcnt vmcnt(0)" ::: "memory"); __syncthreads();
        __builtin_amdgcn_fence(__ATOMIC_ACQUIRE, "agent"); asm volatile("s_waitcnt vmcnt(0)" ::: "memory"); __syncthreads();
        pg8::Unit u; pg8::DenseSched S2; S2.init(XN, DM, WxqT, T, DM, DM, F.G, (int)blockIdx.x);
        for (int i = 0; S2.next(i, u); ++i) {
            const int b = u.row0 / SEQ, h = u.pn;
            { att::Src s; s.kn = nullptr; s.cum = nullptr; s.nt = MEMLEN / 64; s.q0 = 0; s.q = (const bf16*)(ws + WS_XQ + (size_t)u.row0 * DM + h * 256); s.ldq = DM; s.k1 = (const bf16*)(ws + WS_KM8 + (size_t)b * MEMLEN * 1024 + h * 256); s.ldk1 = 1024; s.k2 = s.k1; s.ldk2 = 1024;
              s.v = KVMEM + (size_t)b * MEMLEN * 2048 + 1024 + h * 256; s.ldv = 2048; s.o = (bf16*)(ws + WS_XOF8 + (size_t)u.row0 * DM + h * 256); s.ldo = DM; s.sso = nullptr;
              att::xunit(s, F.lds, F.wave); }
        }
    }
    SEAM(5);
    if (IN(6)) {
        pg8::DenseSched S; S.init((const bf16*)(ws + WS_XOF8), DM / 2, WxoT, T, DM, DM / 2, F.G, (int)blockIdx.x);
        EpiAddOut E{XN, 1.f / (XO8_SCALE * WXO8_SCALE)};
        pg8::gemm_phase<EpiAddOut, pg8::DenseSched, false, true>(F.lds, F.tabs, DM, DM, S, E, F.wave);
    }
    SEAM(6);
    int* cnt = (int*)(ws + WS_CTL) + CW_CNT; const int* list = (const int*)(ws + WS_LIST);
    if (IN(7)) { if ((PROBE_REP) == 7) p7_route(F, args, (size_t)(WS_KVM - WS_XF8)); p7_route(F, args, 0); }
    SEAM(7);
    if (IN(8)) REPS(8) {
        const int nMt = moe_tables(F, cnt);
        MoeSched S; S.o.init(nMt, 2048 / 256, F.G, (int)blockIdx.x); S.tables((const volatile LAS int*)(F.MISC + 64), (const volatile LAS int*)(F.MISC + 128));
        S.A = (const char*)(ws + WS_XF8); S.a_row_bytes = 0; S.Wt = (const char*)(ws + WS_WGU); S.w_exp_bytes = (size_t)2048 * DM; S.brow = DM; S.list = list; S.gather = true;
        EpiGateUp E{args.in[21], ws + WS_ACT};
        pg8::gemm_phase<EpiGateUp, MoeSched, true, true>(F.lds, F.tabs, DM, DM, S, E, F.wave);
    }
    SEAM(8);
    if (IN(9)) REPS(9) {
        const int nMt = __builtin_amdgcn_readfirstlane(((const volatile LAS int*)(F.MISC + 64))[NEXP]);
        MoeSched S; S.o.init(nMt, DM / 256, F.G, (int)blockIdx.x); S.tables((const volatile LAS int*)(F.MISC + 64), (const volatile LAS int*)(F.MISC + 128));
        S.A = (const char*)(ws + WS_ACT); S.a_row_bytes = (size_t)DEXP; S.Wt = (const char*)(ws + WS_WD); S.w_exp_bytes = (size_t)DM * DEXP; S.brow = DEXP; S.list = list; S.gather = false;
        EpiDown E{args.in[23], (const float*)(ws + WS_GSORT), list, ws + WS_Y};
        pg8::gemm_phase<EpiDown, MoeSched, false, true>(F.lds, F.tabs, DEXP, DEXP, S, E, F.wave);
    }
    SEAM(9);
    if (IN(10)) { if ((PROBE_REP) == 10) p10_combine(F, args, (float*)(ws + WS_XQ)); p10_combine(F, args, args.out); }
#undef IN
#undef SEAM
}
extern "C" void kernel_launch(void* const* d_in, const int* in_sizes, int n_in, void* d_out, int out_size, void* d_ws, size_t ws_size, hipStream_t stream) {
    if (n_in != 25 || ws_size < WS_END || out_size != T * DM) { fprintf(stderr, "kernel_launch: unexpected shapes n_in %d ws %zu out %d\n", n_in, ws_size, out_size); return; }
    static int grid = 0;
    if (grid == 0) {
        int dev = 0, cus = 0, per_cu = 0;
        if (hipGetDevice(&dev) != hipSuccess || hipDeviceGetAttribute(&cus, hipDeviceAttributeMultiprocessorCount, dev) != hipSuccess) { fprintf(stderr, "kernel_launch: device query failed\n"); grid = -1; return; }
        if (hipFuncSetAttribute((const void*)mega_fwd, hipFuncAttributeMaxDynamicSharedMemorySize, LDS_BYTES) != hipSuccess) { fprintf(stderr, "kernel_launch: hipFuncSetAttribute failed\n"); grid = -1; return; }
        if (hipOccupancyMaxActiveBlocksPerMultiprocessor(&per_cu, (const void*)mega_fwd, NWAVES * 64, LDS_BYTES) != hipSuccess || per_cu < 1) { fprintf(stderr, "kernel_launch: occupancy query says %d blocks per CU\n", per_cu); (void)hipGetLastError(); grid = -1; return; }
        grid = cus;
    }
    if (grid < 0) return;
    (void)hipMemsetAsync((char*)d_ws + WS_CTL, 0, 1 * MiB, stream);
    MegaArgs a{}; for (int i = 0; i < 25; ++i) a.in[i] = (const float*)d_in[i]; a.out = (float*)d_out; a.ws = (unsigned char*)d_ws; a.ph_lo = 0; a.ph_hi = N_PHASES; a.coop = 1;
    void* params[] = {&a};
    const hipError_t e = hipLaunchCooperativeKernel((const void*)mega_fwd, dim3(grid), dim3(NWAVES * 64), params, LDS_BYTES, stream);
    if (e != hipSuccess) fprintf(stderr, "cooperative launch failed: %s (grid %d)\n", hipGetErrorString(e), grid);
}
```

```cpp
#include <hip/hip_runtime.h>
#include <cstdio>
#include <cstdint>

constexpr int DM = 1024, BATCH = 8, SEQ = 4096, T = BATCH * SEQ, MEMLEN = 256, TM = BATCH * MEMLEN;
constexpr int NPROJ = 2048;
constexpr int C_QLAT = 0, C_KVLAT = 256, C_KPE = 384, C_FQ = 416, C_FK = 928, C_FV = 1440, C_FL = 1952, IN_COLS = 1960;
constexpr int NEXP = 32, TOPK = 4, DEXP = 1024;
constexpr float EPS = 1e-6f, LOG2E = 1.4426950408889634f;
constexpr float C2M = 0.10206207261596577f * LOG2E;
constexpr float C2F = 0.125f * LOG2E;
constexpr float C2X = 0.0625f * LOG2E;

typedef unsigned short bf16;
__device__ __forceinline__ float bf2f(bf16 v) { return __uint_as_float(((unsigned)v) << 16); }
__device__ __forceinline__ bf16 f2bf(float f) { unsigned u = __float_as_uint(f); return (bf16)((u + 0x7fffu + ((u >> 16) & 1u)) >> 16); }

constexpr size_t MiB = 1u << 20;
constexpr size_t WS_CTL = 0;
constexpr size_t WS_ROPE = 1 * MiB;
constexpr size_t WS_CUM = 2 * MiB;
constexpr size_t WS_KAUG = 3 * MiB;
constexpr size_t WS_SSQQ = 7 * MiB;
constexpr size_t WS_SSQKV = 7 * MiB + 512 * 1024;
constexpr size_t WS_SSO = 8 * MiB;
constexpr size_t WS_SSQ1 = 994 * MiB;
constexpr size_t WS_TOPI = 10 * MiB + 512 * 1024;
constexpr size_t WS_GATE = 11 * MiB;
constexpr size_t WS_SLOT = 11 * MiB + 512 * 1024;
constexpr size_t WS_LIST = 12 * MiB;
constexpr size_t WS_WIN = 16 * MiB;
constexpr size_t WS_WQ = 20 * MiB;
constexpr size_t WS_WKV = 20 * MiB + 512 * 1024;
constexpr size_t WS_WO = 21 * MiB;
constexpr size_t WS_WXQ = 23 * MiB;
constexpr size_t WS_WMKV = 25 * MiB;
constexpr size_t WS_WXO = 29 * MiB;
constexpr size_t WS_WGU = 32 * MiB;
constexpr size_t WS_WD = 160 * MiB;
constexpr size_t WS_XN = 224 * MiB;
constexpr size_t WS_PROJ = 288 * MiB;
constexpr size_t WS_QM = 416 * MiB;
constexpr size_t WS_KVM = 464 * MiB;
constexpr size_t WS_O = 528 * MiB;
constexpr size_t WS_XQ = 592 * MiB;
constexpr size_t WS_XO = 656 * MiB;
constexpr size_t WS_MEMN = 720 * MiB;
constexpr size_t WS_KVMEM = 724 * MiB;
constexpr size_t WS_ACT = 736 * MiB;
constexpr size_t WS_SC = 736 * MiB;
constexpr size_t WS_Y = 288 * MiB;
constexpr size_t WS_END = 1000 * MiB;
constexpr int CW_CNT = 64;

#include <hip/hip_cooperative_groups.h>
#include <type_traits>
namespace cg = cooperative_groups;
#define LAS __attribute__((address_space(3)))
#define GAS __attribute__((address_space(1)))
typedef short bf16x8 __attribute__((ext_vector_type(8)));
typedef short s16x4 __attribute__((ext_vector_type(4)));
typedef float f32x4 __attribute__((ext_vector_type(4)));
typedef float f32x2 __attribute__((ext_vector_type(2)));
typedef float f32x16 __attribute__((ext_vector_type(16)));
typedef unsigned u32x4 __attribute__((ext_vector_type(4)));
typedef unsigned u32x2 __attribute__((ext_vector_type(2)));
typedef __bf16 bf16x2_t __attribute__((ext_vector_type(2)));
__device__ __forceinline__ unsigned cvtpk(float lo, float hi) { f32x2 v = {lo, hi}; bf16x2_t b = __builtin_convertvector(v, bf16x2_t); return __builtin_bit_cast(unsigned, b); }
__device__ __forceinline__ int lane_id() { int l; asm volatile("v_mbcnt_lo_u32_b32 %0, -1, 0\n\tv_mbcnt_hi_u32_b32 %0, -1, %0" : "=v"(l)); return l; }
__device__ __forceinline__ float wave_sum(float v) {
#pragma unroll
    for (int o = 1; o < 64; o <<= 1) v += __shfl_xor(v, o);
    return v;
}

constexpr float XQ8_SCALE = 32.f;
constexpr float WXQ8_SCALE = 256.f, WXO8_SCALE = 32.f, H8_SCALE = 4.f, XO8_SCALE = 64.f;
namespace pg8 {
constexpr int BM = 256, BK = 64, HALF = 128, HTB = HALF * BK * 2  , STAGE_BYTES = 8 * HTB, NXCD = 8, WGM = 8;
__host__ __device__ __forceinline__ int lds_byte(int r, int c) { const int st = (r >> 4) * 2 + (c >> 5), rr = r & 15, cc = c & 31, ob = rr * 64 + cc * 2; return st * 1024 + (ob ^ (((ob >> 9) & 1) << 5)); }
__host__ __device__ __forceinline__ void stage_rc(int b, int& R, int& C) { const int st = b / 1024, sb = b % 1024, swz = sb ^ (((sb >> 9) & 1) << 5); R = (st >> 1) * 16 + swz / 64; C = (st & 1) * 32 + (swz % 64) / 2; }
__host__ __device__ __forceinline__ int perm32(int rho) { const int n = rho >> 4, i = rho & 15; return 8 * (i >> 2) + 4 * n + (i & 3); }

struct Unit { int row0, col0, rows, pn, e; const char* a; const char* b; const int* list; };

typedef int i32x8 __attribute__((ext_vector_type(8)));
typedef int i32x4 __attribute__((ext_vector_type(4)));
template <class Epi, class Sched, bool GATHER, bool F8 = false>
__device__ __forceinline__ void gemm_phase(LAS unsigned char* lds, LAS unsigned* tabs, const int K, const int lda, const Sched& S, const Epi& E, const int wave) {
    int tid_ = (wave << 6) | lane_id(); asm volatile("" : "+v"(tid_));
    const int tid = tid_, wid = __builtin_amdgcn_readfirstlane(tid >> 6), lane = tid & 63, wr = wid >> 2, wc = wid & 3, fr = lane & 15, fq = lane >> 4;
    const int nt = K / (F8 ? 128 : BK);
    const int rowA = F8 ? lda : 2 * lda, rowB = F8 ? K : 2 * K;
    unsigned vB[2], vA[2], vcu[2][2];
#pragma unroll
    for (int i = 0; i < 2; ++i) { int R, C; stage_rc(tid * 16 + i * 8192, R, C); const int Rb = Epi::PERM ? ((R & ~31) + perm32(R & 31)) : R;
        vB[i] = (unsigned)(Rb * rowB + 2 * C); vA[i] = (unsigned)(R * rowA + 2 * C);
#pragma unroll
        for (int h = 0; h < 2; ++h) vcu[h][i] = 0u; }
    const size_t hstepA = (size_t)HALF * rowA;
    const size_t kstep = (size_t)(BK * 2);
    const size_t hstepB = (size_t)HALF * rowB;
    const unsigned ldsw = (unsigned)wid * 1024u;
    const unsigned lds_u32 = (unsigned)__builtin_amdgcn_readfirstlane((int)(unsigned)(size_t)lds);
    const int aoff = lds_byte(wr * 64 + fr, F8 ? fq * 16 : fq * 8); int boff = lds_byte(wc * 32 + fr, F8 ? fq * 16 : fq * 8) + 4 * HTB;
    asm volatile("" : "+v"(boff));
#define PG8_SA(b, h) (((b) * 2 + (h)) * HTB)
#define PG8_SB(b, h) ((4 + (b) * 2 + (h)) * HTB)
#define PG8_STAGE(bufoff, gbase, voff) do { const unsigned long long _gb = (unsigned long long)(gbase); \
        const unsigned _glo = __builtin_amdgcn_readfirstlane((unsigned)_gb), _ghi = __builtin_amdgcn_readfirstlane((unsigned)(_gb >> 32)); const unsigned long long _sb = ((unsigned long long)_ghi << 32) | _glo; \
        _Pragma("unroll") for (int _i = 0; _i < 2; ++_i) { unsigned _keep; const unsigned _dst = lds_u32 + (unsigned)(bufoff) + ldsw + _i * 8192u; \
        asm volatile("s_mov_b32 %0, m0\n\ts_mov_b32 m0, %3\n\ts_nop 0\n\tglobal_load_lds_dwordx4 %1, %2\n\ts_mov_b32 m0, %0" : "=&s"(_keep) : "v"((voff)[_i]), "s"(_sb), "s"(_dst) : "memory"); } } while (0)
#define PG8_STAGE_A(bufoff, gbase, h, vsel) do { if constexpr (GATHER) { PG8_STAGE(bufoff, gbase, (vsel)[h]); } else { PG8_STAGE(bufoff, (gbase) + (h) * hstepA, vA); } } while (0)
#define PG8_RD8(dst, off) do { const i32x4 _l = *(const LAS i32x4*)(lds + (off)), _h = *(const LAS i32x4*)(lds + (off) + 16); dst = __builtin_shufflevector(_l, _h, 0, 1, 2, 3, 4, 5, 6, 7); } while (0)
#define PG8_LDA(dst, dst8, b, h) do { if constexpr (F8) { _Pragma("unroll") for (int m = 0; m < 4; ++m) PG8_RD8(dst8[m], PG8_SA(b, h) + aoff + m * 2048); } \
        else { _Pragma("unroll") for (int m = 0; m < 4; ++m) _Pragma("unroll") for (int k = 0; k < 2; ++k) dst[m][k] = *(const LAS bf16x8*)(lds + PG8_SA(b, h) + aoff + m * 2048 + k * 1024); } } while (0)
#define PG8_LDB(dst, dst8, b, h) do { if constexpr (F8) { _Pragma("unroll") for (int n = 0; n < 2; ++n) PG8_RD8(dst8[n], ((b) * 2 + (h)) * HTB + boff + n * 2048); } \
        else { _Pragma("unroll") for (int n = 0; n < 2; ++n) _Pragma("unroll") for (int k = 0; k < 2; ++k) dst[n][k] = *(const LAS bf16x8*)(lds + ((b) * 2 + (h)) * HTB + boff + n * 2048 + k * 1024); } } while (0)
#define PG8_MMA(ai, bj, At, At8, Bt, Bt8) do { __builtin_amdgcn_s_setprio(1); _Pragma("unroll") for (int m = 0; m < 4; ++m) _Pragma("unroll") for (int n = 0; n < 2; ++n) { \
        if constexpr (F8) acc[ai][bj][m][n] = __builtin_amdgcn_mfma_scale_f32_16x16x128_f8f6f4(Bt8[n], At8[m], acc[ai][bj][m][n], 0, 0, 0, 0x7F7F7F7F, 0, 0x7F7F7F7F); \
        else { _Pragma("unroll") for (int k = 0; k < 2; ++k) acc[ai][bj][m][n] = __builtin_amdgcn_mfma_f32_16x16x32_bf16(Bt[n][k], At[m][k], acc[ai][bj][m][n], 0, 0, 0); } } \
        __builtin_amdgcn_s_setprio(0); } while (0)
#define PG8_WAIT_V(n) asm volatile("s_waitcnt vmcnt(" #n ")" ::: "memory")
#define PG8_WAIT_L(n) asm volatile("s_waitcnt lgkmcnt(" #n ")" ::: "memory")
#define PG8_BAR __builtin_amdgcn_s_barrier()
#define PG8_SCHED __builtin_amdgcn_sched_barrier(0)
#define PG8_TABDMA(u, slot) __builtin_amdgcn_global_load_lds((const unsigned*)((u).list + lane_id() * 4), (LAS unsigned*)(tabs + (slot) * 256), 16, 0, 0)
#define PG8_TABOFF(dst, slot) do { const int _tid = (wid << 6) | lane_id(); _Pragma("unroll") for (int _i = 0; _i < 2; ++_i) { int _R, _C; stage_rc(_tid * 16 + _i * 8192, _R, _C); \
        _Pragma("unroll") for (int _h = 0; _h < 2; ++_h) { unsigned _t = tabs[(slot) * 256 + _h * HALF + _R] >> 2; _t = _t < (unsigned)(T - 1) ? _t : (unsigned)(T - 1); \
        dst[_h][_i] = _t * (unsigned)rowA + 2u * (unsigned)_C; } } } while (0)
    __builtin_amdgcn_s_waitcnt(0x0F70);
    Unit cur, nxt; int ui = 0;
    if (!S.next(0, cur)) return;
    if constexpr (GATHER) { PG8_TABDMA(cur, 0); PG8_WAIT_V(0); PG8_BAR; PG8_TABOFF(vcu, 0); PG8_WAIT_L(0); }
    f32x4 acc[2][2][4][2];
    bf16x8 At[4][2], B0[2][2], B1[2][2]; i32x8 At8[4], B08[2], B18[2];
    const char* cA = cur.a; const char* cB = cur.b;
    PG8_STAGE(PG8_SB(0, 0), cB, vB); PG8_STAGE(PG8_SB(0, 1), cB + hstepB, vB); PG8_STAGE_A(PG8_SA(0, 0), cA, 0, vcu); PG8_STAGE_A(PG8_SA(0, 1), cA, 1, vcu);
    if (wr == 1) PG8_BAR;
    PG8_WAIT_V(2); PG8_BAR;
    PG8_STAGE(PG8_SB(1, 0), cB + kstep, vB); PG8_STAGE_A(PG8_SA(1, 0), cA + kstep, 0, vcu); PG8_STAGE(PG8_SB(1, 1), cB + hstepB + kstep, vB);
    PG8_WAIT_V(6); PG8_BAR;
    asm volatile("" ::: "memory");
#pragma unroll
    for (int a = 0; a < 2; ++a)
#pragma unroll
        for (int b = 0; b < 2; ++b)
#pragma unroll
            for (int m = 0; m < 4; ++m)
#pragma unroll
                for (int n = 0; n < 2; ++n) acc[a][b][m][n] = (f32x4){0.f, 0.f, 0.f, 0.f};
    for (;;) {
        const bool has_next = S.next(ui + 1, nxt);
        if constexpr (GATHER) { if (has_next) PG8_TABDMA(nxt, (ui + 1) & 1); }
        const char* nA = has_next ? nxt.a : cA; const char* nB = has_next ? nxt.b : cB;
#pragma nounroll
        for (int t = 0; t < nt; t += 2) {
            const bool last = (t == nt - 2);
            if constexpr (Epi::MID) { if (t == nt / 2) { const int l2_ = lane_id(); E.mid(acc, cur, wr, l2_ & 15); } }
            unsigned v2[2][2];
#pragma unroll
            for (int h = 0; h < 2; ++h)
#pragma unroll
                for (int i = 0; i < 2; ++i) v2[h][i] = vcu[h][i];
            if constexpr (GATHER) { if (last && has_next) { PG8_TABOFF(v2, (ui + 1) & 1); PG8_WAIT_L(0); } }
            const char* a1 = cA + (size_t)(t + 1) * kstep;
            const char* a2 = last ? nA : cA + (size_t)(t + 2) * kstep; const char* b2 = last ? nB : cB + (size_t)(t + 2) * kstep;
            const char* a3 = a2 + kstep; const char* b3 = b2 + kstep;
            PG8_LDB(B0, B08, 0, 0); PG8_LDB(B1, B18, 0, 1); PG8_SCHED; PG8_LDA(At, At8, 0, 0); PG8_STAGE_A(PG8_SA(1, 1), a1, 1, vcu);
            PG8_WAIT_V(8); PG8_WAIT_L(0); PG8_BAR; PG8_MMA(0, 0, At, At8, B0, B08); PG8_MMA(0, 1, At, At8, B1, B18); PG8_BAR; PG8_SCHED;
            PG8_LDA(At, At8, 0, 1); PG8_STAGE(PG8_SB(0, 0), b2, vB); PG8_STAGE(PG8_SB(0, 1), b2 + hstepB, vB); PG8_STAGE_A(PG8_SA(0, 0), a2, 0, v2);
            PG8_WAIT_V(8); PG8_WAIT_L(0); PG8_BAR; PG8_MMA(1, 0, At, At8, B0, B08); PG8_MMA(1, 1, At, At8, B1, B18); PG8_BAR; PG8_SCHED;
            PG8_LDB(B0, B08, 1, 0); PG8_LDB(B1, B18, 1, 1); PG8_SCHED; PG8_LDA(At, At8, 1, 0); PG8_STAGE_A(PG8_SA(0, 1), a2, 1, v2);
            PG8_WAIT_V(8); PG8_WAIT_L(0); PG8_BAR; PG8_MMA(0, 0, At, At8, B0, B08); PG8_MMA(0, 1, At, At8, B1, B18); PG8_BAR; PG8_SCHED;
            PG8_LDA(At, At8, 1, 1); PG8_STAGE(PG8_SB(1, 0), b3, vB); PG8_STAGE(PG8_SB(1, 1), b3 + hstepB, vB); PG8_STAGE_A(PG8_SA(1, 0), a3, 0, v2);
            PG8_WAIT_V(8); PG8_WAIT_L(0); PG8_BAR; PG8_MMA(1, 0, At, At8, B0, B08); PG8_MMA(1, 1, At, At8, B1, B18); PG8_BAR; PG8_SCHED;
        }
        if (wr == 0) PG8_BAR;
        { const int l2_ = lane_id(); E(acc, cur, wr, wc, l2_ & 15, l2_ >> 4); }
        if (!has_next) break;
#pragma unroll
        for (int a = 0; a < 2; ++a)
#pragma unroll
            for (int b = 0; b < 2; ++b)
#pragma unroll
                for (int m = 0; m < 4; ++m)
#pragma unroll
                    for (int n = 0; n < 2; ++n) acc[a][b][m][n] = (f32x4){0.f, 0.f, 0.f, 0.f};
        cur = nxt; cA = nA; cB = nB; ++ui;
        if constexpr (GATHER) { PG8_TABOFF(vcu, ui & 1); PG8_WAIT_L(0); }
        if (wr == 1) PG8_BAR;
    }
    PG8_WAIT_V(0);
    PG8_BAR;
#undef PG8_SA
#undef PG8_SB
#undef PG8_STAGE
#undef PG8_STAGE_A
#undef PG8_RD8
#undef PG8_LDA
#undef PG8_LDB
#undef PG8_MMA
#undef PG8_TABDMA
#undef PG8_TABOFF
}
struct TileOrder {
    int nM, nN, nwg, G, c;
    __device__ __forceinline__ void init(int nM_, int nN_, int G_, int c_) { nM = nM_; nN = nN_; nwg = nM * nN; G = G_; c = c_; }
    __device__ __forceinline__ bool tile(int i, int& pm, int& pn) const {
        const int L = i * G + c; if (L >= nwg) return false;
        int wgid = L; { const int q = nwg / NXCD, r = nwg % NXCD, xcd = wgid % NXCD, off = wgid / NXCD; wgid = (xcd < r ? xcd * (q + 1) : r * (q + 1) + (xcd - r) * q) + off; }
        const int nig = WGM * nN, gid = wgid / nig, fm = gid * WGM, gsz = (nM - fm) < WGM ? (nM - fm) : WGM;
        pm = fm + ((wgid % nig) % gsz); pn = (wgid % nig) / gsz; return true;
    }
};
struct DenseSched {
    TileOrder o; const char* A; const char* Bt; int lda, K;
    __device__ __forceinline__ void init(const bf16* A_, int lda_, const bf16* Bt_, int M, int N, int K_, int G, int c) { o.init(M / BM, N / BM, G, c); A = (const char*)A_; Bt = (const char*)Bt_; lda = lda_; K = K_; }
    __device__ __forceinline__ bool next(int i, Unit& u) const { int pm, pn; if (!o.tile(i, pm, pn)) return false; u.row0 = pm * BM; u.col0 = pn * BM; u.rows = BM; u.pn = pn; u.e = 0;
        u.a = A + (size_t)pm * BM * lda * 2; u.b = Bt + (size_t)pn * BM * K * 2; u.list = nullptr; return true; }
};
}

__device__ __forceinline__ float sum4sq(const f32x4& v) { return (v[0] * v[0] + v[1] * v[1]) + (v[2] * v[2] + v[3] * v[3]); }
__device__ __forceinline__ void st_bf4(bf16* p, const f32x4& v) { u32x2 w; w.x = cvtpk(v[0], v[1]); w.y = cvtpk(v[2], v[3]); *(u32x2*)p = w; }
__device__ __forceinline__ int cofs8(int fq) { return 4 * fq + (fq & 1) * 12; }
__device__ __forceinline__ void st_bf8(bf16* p, const f32x4& v0, const f32x4& v1) {
    const unsigned a0 = cvtpk(v0[0], v0[1]), a1 = cvtpk(v0[2], v0[3]), b0 = cvtpk(v1[0], v1[1]), b1 = cvtpk(v1[2], v1[3]);
    const auto r0 = __builtin_amdgcn_permlane16_swap(a0, b0, false, false), r1 = __builtin_amdgcn_permlane16_swap(a1, b1, false, false);
    *(u32x4*)p = (u32x4){r0[0], r1[0], r0[1], r1[1]}; }
struct EpiProj {
    static constexpr bool PERM = false, MID = false;
    bf16* PROJ; float* ssqq; float* ssqkv; const float* rope; float* LF; const float* bfor;
    __device__ __forceinline__ void operator()(f32x4 (&acc)[2][2][4][2], const pg8::Unit& u, int wr, int wc, int fr, int fq) const {
        asm volatile("" : "+v"(fr), "+v"(fq));
        const bool rp1 = (u.pn == 1) && (wc == 0);
        f32x4 ca[8], cb[8];
        if (rp1) {
#pragma unroll
            for (int g = 0; g < 8; ++g) { const int pos = (u.row0 + (g >> 2) * 128 + wr * 64 + (g & 3) * 16 + fr) & (SEQ - 1); const float* q = rope + 2 * (pos * 16 + fq * 4); ca[g] = *(const f32x4*)q; cb[g] = *(const f32x4*)(q + 4); } }
#pragma unroll
        for (int ai = 0; ai < 2; ++ai)
#pragma unroll
            for (int m = 0; m < 4; ++m) {
                const int row = u.row0 + ai * 128 + wr * 64 + m * 16 + fr;
                if (u.pn == 0) { float s = (sum4sq(acc[ai][0][m][0]) + sum4sq(acc[ai][0][m][1])) + (sum4sq(acc[ai][1][m][0]) + sum4sq(acc[ai][1][m][1]));
                    s += __shfl_xor(s, 16); s += __shfl_xor(s, 32); if (fq == 0) ssqq[(size_t)row * 4 + wc] = s; }
                if (u.pn == 1) { float s = sum4sq(acc[ai][0][m][0]) + sum4sq(acc[ai][0][m][1]);
                    s += __shfl_xor(s, 16); s += __shfl_xor(s, 32); if (fq == 0) ssqkv[(size_t)row * 4 + wc] = s;
                    if (wc == 0) { const f32x4 x1 = acc[ai][1][m][0], x2 = acc[ai][1][m][1]; f32x4 y1, y2; const f32x4 c0 = ca[ai * 4 + m], c1 = cb[ai * 4 + m];
#pragma unroll
                        for (int e = 0; e < 4; ++e) { const float cx = e < 2 ? c0[2 * e] : c1[2 * e - 4], sx = e < 2 ? c0[2 * e + 1] : c1[2 * e - 3]; y1[e] = x1[e] * cx - x2[e] * sx; y2[e] = x2[e] * cx + x1[e] * sx; }
                        acc[ai][1][m][0] = y1; acc[ai][1][m][1] = y2; } }
                if (u.pn == 7 && wc == 1 && fq < 2) { const f32x4 z4 = acc[ai][1][m][0]; f32x4 lf;
#pragma unroll
                    for (int e = 0; e < 4; ++e) { const float z = z4[e] + bfor[fq * 4 + e]; lf[e] = fminf(z, 0.f) - 0.6931471805599453f * __builtin_amdgcn_logf(1.f + __builtin_amdgcn_exp2f(-LOG2E * fabsf(z))); }
                    *(f32x4*)(LF + (size_t)row * 8 + fq * 4) = lf; }
                bf16* rp = PROJ + (size_t)row * NPROJ + u.col0 + wc * 32 + cofs8(fq);
#pragma unroll
                for (int bj = 0; bj < 2; ++bj) st_bf8(rp + bj * 128, acc[ai][bj][m][0], acc[ai][bj][m][1]);
                asm volatile("" ::: "memory");
            }
    }
};
template <int NS, bool ROPE> struct EpiScale {
    static constexpr bool PERM = false, MID = false;
    bf16* C; int ldc; const float* ss; float inv_n; const float* rope; float osc = 1.f;
    __device__ __forceinline__ void operator()(f32x4 (&acc)[2][2][4][2], const pg8::Unit& u, int wr, int wc, int fr, int fq) const {
        asm volatile("" : "+v"(fr), "+v"(fq));
        const int rbase = u.row0 + wr * 64 + fr;
        f32x4 q[8], ca[8], cb[8]; int bjr = -1;
        if constexpr (ROPE) { const int g0 = (u.col0 >> 5) + wc; bjr = (g0 % 3 == 2) ? 0 : (((g0 + 4) % 3 == 2) ? 1 : -1);
            if (bjr >= 0) {
#pragma unroll
                for (int g = 0; g < 8; ++g) { const int pos = (rbase + (g >> 2) * 128 + (g & 3) * 16) & (SEQ - 1); const float* qq = rope + 2 * (pos * 16 + fq * 4); ca[g] = *(const f32x4*)qq; cb[g] = *(const f32x4*)(qq + 4); } } }
        float q1[8];
        if constexpr (NS == 16) {
#pragma unroll
            for (int g = 0; g < 8; ++g) q[g] = *(const f32x4*)(ss + (size_t)(rbase + (g >> 2) * 128 + (g & 3) * 16) * NS + 4 * fq); }
        if constexpr (NS == 4) {
#pragma unroll
            for (int g = 0; g < 8; ++g) q1[g] = ss[(size_t)(rbase + (g >> 2) * 128 + (g & 3) * 16) * 4 + fq]; }
#pragma unroll
        for (int g = 0; g < 8; ++g) { const int ai = g >> 2, m = g & 3;
                const int row = rbase + ai * 128 + m * 16; float sc = 1.f;
                if constexpr (NS > 0) { float t = NS == 16 ? (q[g][0] + q[g][1]) + (q[g][2] + q[g][3]) : q1[g];
                    t += __shfl_xor(t, 16); t += __shfl_xor(t, 32);
                    sc = rsqrtf(t * inv_n + EPS) * osc; }
                bf16* rp = C + (size_t)row * ldc + u.col0 + wc * 32 + cofs8(fq);
#pragma unroll
                for (int bj = 0; bj < 2; ++bj) {
                    f32x4 v0 = acc[ai][bj][m][0] * sc, v1 = acc[ai][bj][m][1] * sc;
                    if constexpr (ROPE) { if (bj == bjr) { f32x4 y1, y2; const f32x4 c0 = ca[g], c1 = cb[g];
#pragma unroll
                        for (int e = 0; e < 4; ++e) { const float cx = e < 2 ? c0[2 * e] : c1[2 * e - 4], sx = e < 2 ? c0[2 * e + 1] : c1[2 * e - 3]; y1[e] = v0[e] * cx - v1[e] * sx; y2[e] = v1[e] * cx + v0[e] * sx; }
                        v0 = y1; v1 = y2; } }
                    st_bf8(rp + bj * 128, v0, v1);
                }
                asm volatile("" ::: "memory");
            }
    }
};

__device__ __forceinline__ u32x2 pack8_f8(const f32x4& v0, const f32x4& v1, float sc) {
    f32x4 a0, a1;
#pragma unroll
    for (int e = 0; e < 4; ++e) { const auto r = __builtin_amdgcn_permlane16_swap(__float_as_uint(v0[e]), __float_as_uint(v1[e]), false, false); a0[e] = __uint_as_float(r[0]) * sc; a1[e] = __uint_as_float(r[1]) * sc; }
    int w0 = 0, w1 = 0; w0 = __builtin_amdgcn_cvt_pk_fp8_f32(a0[0], a0[1], w0, false); w0 = __builtin_amdgcn_cvt_pk_fp8_f32(a0[2], a0[3], w0, true);
    w1 = __builtin_amdgcn_cvt_pk_fp8_f32(a1[0], a1[1], w1, false); w1 = __builtin_amdgcn_cvt_pk_fp8_f32(a1[2], a1[3], w1, true); return (u32x2){(unsigned)w0, (unsigned)w1}; }
struct EpiMemKV {
    static constexpr bool PERM = false, MID = false;   static constexpr int NST = 16;
    bf16* C; unsigned char* k8;
    __device__ __forceinline__ void operator()(f32x4 (&acc)[2][2][4][2], const pg8::Unit& u, int wr, int wc, int fr, int fq) const {
        asm volatile("" : "+v"(fr), "+v"(fq));
        const int rbase = u.row0 + wr * 64 + fr;
#pragma unroll
        for (int g = 0; g < 8; ++g) { const int ai = g >> 2, m = g & 3; const int row = rbase + ai * 128 + m * 16; const int cc = u.col0 + wc * 32 + cofs8(fq);
#pragma unroll
            for (int bj = 0; bj < 2; ++bj) {
                if (u.pn < 4) *(u32x2*)(k8 + (size_t)row * 1024 + cc + bj * 128) = pack8_f8(acc[ai][bj][m][0], acc[ai][bj][m][1], 1.f);
                else st_bf8(C + (size_t)row * 2048 + cc + bj * 128, acc[ai][bj][m][0], acc[ai][bj][m][1]); }
            asm volatile("" ::: "memory"); }
    }
};
struct EpiXQ8 {
    static constexpr bool PERM = false, MID = false;   static constexpr int NST = 16;
    unsigned char* C8; const float* ss; float osc;
    __device__ __forceinline__ void operator()(f32x4 (&acc)[2][2][4][2], const pg8::Unit& u, int wr, int wc, int fr, int fq) const {
        asm volatile("" : "+v"(fr), "+v"(fq));
        const int rbase = u.row0 + wr * 64 + fr; f32x4 q[8];
#pragma unroll
        for (int g = 0; g < 8; ++g) q[g] = *(const f32x4*)(ss + (size_t)(rbase + (g >> 2) * 128 + (g & 3) * 16) * 16 + 4 * fq);
#pragma unroll
        for (int g = 0; g < 8; ++g) { const int ai = g >> 2, m = g & 3; const int row = rbase + ai * 128 + m * 16;
            float t = (q[g][0] + q[g][1]) + (q[g][2] + q[g][3]); t += __shfl_xor(t, 16); t += __shfl_xor(t, 32);
            const float sc = rsqrtf(t * (1.f / 1024.f) + EPS) * osc;
#pragma unroll
            for (int bj = 0; bj < 2; ++bj) *(u32x2*)(C8 + (size_t)row * DM + u.col0 + wc * 32 + cofs8(fq) + bj * 128) = pack8_f8(acc[ai][bj][m][0], acc[ai][bj][m][1], sc);
            asm volatile("" ::: "memory"); }
    }
};

struct EpiWo {
    static constexpr bool PERM = false, MID = true;
    const float* sso; const float* x; float* out; bf16* hb; float* ssq1; unsigned char* h8;
    __device__ __forceinline__ void mid(f32x4 (&acc)[2][2][4][2], const pg8::Unit& u, int wr, int fr) const {
        asm volatile("" : "+v"(fr));
        int fq = lane_id() >> 4; asm volatile("" : "+v"(fq));
        const int rbase = u.row0 + wr * 64 + fr; f32x4 p[8];
#pragma unroll
        for (int g = 0; g < 8; ++g) p[g] = *((const f32x4*)(sso + (size_t)(rbase + (g >> 2) * 128 + (g & 3) * 16) * 16) + fq);
#pragma unroll
        for (int g = 0; g < 8; ++g) { const int ai = g >> 2, m = g & 3;
            float t = (p[g][0] + p[g][1]) + (p[g][2] + p[g][3]); t += __shfl_xor(t, 16); const float o = __shfl_xor(t, 32);
            const float sm = fq < 2 ? t : o, sf = fq < 2 ? o : t;
            const float ratio = rsqrtf(sm * (1.f / 512.f) + EPS) / rsqrtf(sf * (1.f / 512.f) + EPS);
#pragma unroll
            for (int bj = 0; bj < 2; ++bj)
#pragma unroll
                for (int n = 0; n < 2; ++n) acc[ai][bj][m][n] *= ratio;
            asm volatile("" ::: "memory"); }
    }
    __device__ __forceinline__ void operator()(f32x4 (&acc)[2][2][4][2], const pg8::Unit& u, int wr, int wc, int fr, int fq) const {
        asm volatile("" : "+v"(fr), "+v"(fq));
        const int rbase = u.row0 + wr * 64 + fr; const int cb = u.col0 + wc * 32 + fq * 4;
        f32x4 xc[2][2], xn[2][2], sf4[8]; float ssg[8]; unsigned w8p[2][2];
#pragma unroll
        for (int g = 0; g < 8; ++g) sf4[g] = *((const f32x4*)(sso + (size_t)(rbase + (g >> 2) * 128 + (g & 3) * 16) * 16) + 2 + (fq & 1));
#pragma unroll
        for (int bj = 0; bj < 2; ++bj)
#pragma unroll
            for (int n = 0; n < 2; ++n) xc[bj][n] = *(const f32x4*)(x + (size_t)rbase * DM + cb + bj * 128 + n * 16);
#pragma unroll
        for (int g = 0; g < 8; ++g) { const int ai = g >> 2, m = g & 3; const int row = rbase + ai * 128 + m * 16;
            if (g + 1 < 8) { const int rn = rbase + ((g + 1) >> 2) * 128 + ((g + 1) & 3) * 16;
#pragma unroll
                for (int bj = 0; bj < 2; ++bj)
#pragma unroll
                    for (int n = 0; n < 2; ++n) xn[bj][n] = *(const f32x4*)(x + (size_t)rn * DM + cb + bj * 128 + n * 16); }
            float tf = (sf4[g][0] + sf4[g][1]) + (sf4[g][2] + sf4[g][3]); tf += __shfl_xor(tf, 16);
            const float rf = rsqrtf(tf * (1.f / 512.f) + EPS);
            const size_t off = (size_t)row * DM + u.col0 + wc * 32 + cofs8(fq); float ss = 0.f;
#pragma unroll
            for (int bj = 0; bj < 2; ++bj) { const f32x4 h0 = xc[bj][0] + acc[ai][bj][m][0] * rf, h1 = xc[bj][1] + acc[ai][bj][m][1] * rf; ss += sum4sq(h0) + sum4sq(h1);
                f32x4 a0, a1;
#pragma unroll
                for (int e = 0; e < 4; ++e) { const auto r = __builtin_amdgcn_permlane16_swap(__float_as_uint(h0[e]), __float_as_uint(h1[e]), false, false); a0[e] = __uint_as_float(r[0]); a1[e] = __uint_as_float(r[1]); }
                *(u32x4*)(hb + off + bj * 128) = (u32x4){cvtpk(a0[0], a0[1]), cvtpk(a0[2], a0[3]), cvtpk(a1[0], a1[1]), cvtpk(a1[2], a1[3])};
                int w0 = 0, w1 = 0; w0 = __builtin_amdgcn_cvt_pk_fp8_f32(a0[0] * H8_SCALE, a0[1] * H8_SCALE, w0, false); w0 = __builtin_amdgcn_cvt_pk_fp8_f32(a0[2] * H8_SCALE, a0[3] * H8_SCALE, w0, true);
                w1 = __builtin_amdgcn_cvt_pk_fp8_f32(a1[0] * H8_SCALE, a1[1] * H8_SCALE, w1, false); w1 = __builtin_amdgcn_cvt_pk_fp8_f32(a1[2] * H8_SCALE, a1[3] * H8_SCALE, w1, true);
                if ((g & 1) == 0) { w8p[bj][0] = (unsigned)w0; w8p[bj][1] = (unsigned)w1; }
                else {
                    const auto r0 = __builtin_amdgcn_permlane32_swap(w8p[bj][0], (unsigned)w0, false, false), r1 = __builtin_amdgcn_permlane32_swap(w8p[bj][1], (unsigned)w1, false, false);
                    const int rw = row - ((fq < 2) ? 16 : 0);
                    *(u32x4*)(h8 + (size_t)rw * DM + u.col0 + wc * 32 + (fq & 1) * 16 + bj * 128) = (u32x4){r0[0], r1[0], r0[1], r1[1]}; } }
            ss += __shfl_xor(ss, 16); ss += __shfl_xor(ss, 32); ssg[g] = ss;
            asm volatile("" ::: "memory");
#pragma unroll
            for (int bj = 0; bj < 2; ++bj)
#pragma unroll
                for (int n = 0; n < 2; ++n) xc[bj][n] = xn[bj][n]; }
        { const float s0 = fq == 0 ? ssg[0] : fq == 1 ? ssg[1] : fq == 2 ? ssg[2] : ssg[3], s1 = fq == 0 ? ssg[4] : fq == 1 ? ssg[5] : fq == 2 ? ssg[6] : ssg[7];
          float* sp = ssq1 + (size_t)(rbase + fq * 16) * 16 + u.pn * 4 + wc; sp[0] = s0; sp[128 * 16] = s1; }
    }
};
struct EpiAddOut {
    static constexpr bool PERM = false, MID = false;
    bf16* hb; float osc;
    __device__ __forceinline__ void operator()(f32x4 (&acc)[2][2][4][2], const pg8::Unit& u, int wr, int wc, int fr, int fq) const {
        asm volatile("" : "+v"(fr), "+v"(fq));
        const int rbase = u.row0 + wr * 64 + fr; const int cb = u.col0 + wc * 32 + cofs8(fq);
        u32x4 xc[2], xn[2];
#pragma unroll
        for (int bj = 0; bj < 2; ++bj) xc[bj] = *(const u32x4*)(hb + (size_t)rbase * DM + cb + bj * 128);
#pragma unroll
        for (int g = 0; g < 8; ++g) { const int ai = g >> 2, m = g & 3; const int row = rbase + ai * 128 + m * 16;
            if (g + 1 < 8) { const int rn = rbase + ((g + 1) >> 2) * 128 + ((g + 1) & 3) * 16;
#pragma unroll
                for (int bj = 0; bj < 2; ++bj) xn[bj] = *(const u32x4*)(hb + (size_t)rn * DM + cb + bj * 128); }
#pragma unroll
            for (int bj = 0; bj < 2; ++bj) { const u32x4 w = xc[bj]; f32x4 a0, a1;
#pragma unroll
                for (int e = 0; e < 4; ++e) { const auto r = __builtin_amdgcn_permlane16_swap(__float_as_uint(acc[ai][bj][m][0][e]), __float_as_uint(acc[ai][bj][m][1][e]), false, false); a0[e] = __uint_as_float(r[0]) * osc; a1[e] = __uint_as_float(r[1]) * osc; }
                const f32x4 h0 = (f32x4){__uint_as_float(w.x << 16), __uint_as_float(w.x & 0xffff0000u), __uint_as_float(w.y << 16), __uint_as_float(w.y & 0xffff0000u)} + a0;
                const f32x4 h1 = (f32x4){__uint_as_float(w.z << 16), __uint_as_float(w.z & 0xffff0000u), __uint_as_float(w.w << 16), __uint_as_float(w.w & 0xffff0000u)} + a1;
                *(u32x4*)(hb + (size_t)row * DM + cb + bj * 128) = (u32x4){cvtpk(h0[0], h0[1]), cvtpk(h0[2], h0[3]), cvtpk(h1[0], h1[1]), cvtpk(h1[2], h1[3])}; }
            asm volatile("" ::: "memory");
#pragma unroll
            for (int bj = 0; bj < 2; ++bj) xc[bj] = xn[bj]; }
    }
};

namespace att {
__device__ __forceinline__ int crow(int r, int hi) { return (r & 3) + 8 * (r >> 2) + 4 * hi; }
struct Src { const bf16* q; int ldq; const bf16* k1; int ldk1; const bf16* k2; int ldk2; const bf16* v; int ldv; bf16* o; int ldo; float* sso; int nt; int q0; const float* kn; const float* cum; };
typedef short v4i16_t __attribute__((ext_vector_type(4)));
__device__ __forceinline__ s16x4 vtr(const LAS unsigned char* p) { return __builtin_bit_cast(s16x4, __builtin_amdgcn_ds_read_tr16_b64_v4i16((LAS v4i16_t*)p)); }
__device__ __forceinline__ float rowmax32(const f32x16& p0, const f32x16& p1) {
    float a = fmaxf(fmaxf(p0[0], p0[1]), p1[0]), b = fmaxf(fmaxf(p0[2], p0[3]), p1[1]); a = fmaxf(fmaxf(a, p1[2]), p1[3]);
#pragma unroll
    for (int r = 4; r < 16; r += 4) { a = fmaxf(fmaxf(a, p0[r]), p0[r + 1]); b = fmaxf(fmaxf(b, p0[r + 2]), p0[r + 3]); a = fmaxf(fmaxf(a, p1[r]), p1[r + 1]); b = fmaxf(fmaxf(b, p1[r + 2]), p1[r + 3]); }
    const float m = fmaxf(a, b);
    auto rr = __builtin_amdgcn_permlane32_swap(__float_as_uint(m), __float_as_uint(m), false, false);
    return fmaxf(__uint_as_float(rr[0]), __uint_as_float(rr[1]));
}
template <int I, int N, class F> __device__ __forceinline__ void cfor(F&& f) { if constexpr (I < N) { f(std::integral_constant<int, I>{}); cfor<I + 1, N>(f); } }
template <int D0, int NKS, bool AUG> __device__ __forceinline__ void kread(bf16x8& f0, bf16x8& f1, unsigned base, unsigned abase) {
    if constexpr (AUG && D0 == NKS - 1) { asm volatile("ds_read_b128 %0, %1 offset:8192" : "=v"(f0) : "v"(abase)); asm volatile("ds_read_b128 %0, %1 offset:8704" : "=v"(f1) : "v"(abase)); }
    else { asm volatile("ds_read_b128 %0, %1 offset:%2" : "=v"(f0) : "v"(base), "n"(D0 * 2048)); asm volatile("ds_read_b128 %0, %1 offset:%2" : "=v"(f1) : "v"(base), "n"(D0 * 2048 + 512)); }
}
template <int NKS, int NC1, int NCH, int ND0, bool CAUSAL, bool AUG, bool REV, bool WSSO, bool EARLY = false, bool ASMK = true>
__device__ __forceinline__ void unit(const Src& s, LAS unsigned char* lds, const int wave) {
    int tid_ = (wave << 6) | lane_id(); asm volatile("" : "+v"(tid_));
    const int tid = tid_, lane = tid & 63, r32 = lane & 31, hi = lane >> 5, wid = __builtin_amdgcn_readfirstlane(tid >> 6);
    constexpr int KSL = NCH * 1024, VSL = ND0 * 4096, KPW = (NCH + 7) / 8, VPW = ND0 / 2;
    constexpr int VOFF = 2 * KSL, WSF = VOFF + 2 * VSL;
    constexpr float THR = 8.f;
    LAS float* wsf = (LAS float*)(lds + WSF) + wid * 64;
    bf16x8 qr[NKS];
    { const bf16* qw = s.q + (size_t)(wid * 32 + r32) * s.ldq + hi * 8;
#pragma unroll
      for (int d0 = 0; d0 < NKS; ++d0) { if (AUG && d0 == NKS - 1) { const short one = hi ? (short)0 : (short)0x3F80; qr[d0] = (bf16x8){one, one, one, 0, 0, 0, 0, 0}; } else qr[d0] = *(const bf16x8*)(qw + d0 * 16); } }
    LAS float* shf = (LAS float*)(lds + WSF + 2048);
    float thr = 0.f;
    if constexpr (EARLY) {
        float q2 = 0.f;
#pragma unroll
        for (int d0 = 0; d0 < NKS - 1; ++d0)
#pragma unroll
            for (int j = 0; j < 8; ++j) { const float f = __uint_as_float(((unsigned)(unsigned short)qr[d0][j]) << 16); q2 += f * f; }
        { auto rr = __builtin_amdgcn_permlane32_swap(__float_as_uint(q2), __float_as_uint(q2), false, false); q2 = __uint_as_float(rr[0]) + __uint_as_float(rr[1]); }
#pragma unroll
        for (int o_ = 1; o_ < 32; o_ <<= 1) q2 = fmaxf(q2, __shfl_xor(q2, o_));
        if (lane == 0) shf[wid] = q2;
        float kn = s.kn[lane];
#pragma unroll
        for (int o_ = 1; o_ < 64; o_ <<= 1) { const float up = __shfl_up(kn, o_); if (lane >= o_) kn = fmaxf(kn, up); }
        thr = kn;
    }
    u32x4 kreg[2][KPW], vreg[2][VPW];
#define ATT_LOAD(t, S_) do { \
    _Pragma("unroll") for (int i_ = 0; i_ < KPW; ++i_) { const int c_ = (wid + 8 * i_ < NCH) ? wid + 8 * i_ : wid; const size_t row_ = (size_t)(t) * 64 + lane;     \
        const bf16* g_ = (c_ < NC1) ? s.k1 + row_ * s.ldk1 + c_ * 8 : s.k2 + row_ * s.ldk2 + (c_ - NC1) * 8; kreg[S_][i_] = *(const u32x4*)g_; } \
    _Pragma("unroll") for (int i_ = 0; i_ < VPW; ++i_) { const int p_ = wid + 8 * i_; const int dh_ = p_ >> 2, rg_ = p_ & 3; \
        vreg[S_][i_] = *(const u32x4*)(s.v + ((size_t)(t) * 64 + 16 * rg_ + (lane >> 2)) * s.ldv + dh_ * 32 + (lane & 3) * 8); } } while (0)
#define ATT_WRITE(slot, S_) do { \
    _Pragma("unroll") for (int i_ = 0; i_ < KPW; ++i_) { const int c_ = (wid + 8 * i_ < NCH) ? wid + 8 * i_ : wid; *(LAS u32x4*)(lds + (slot) * KSL + c_ * 1024 + lane * 16) = kreg[S_][i_]; } \
    _Pragma("unroll") for (int i_ = 0; i_ < VPW; ++i_) { const int p_ = wid + 8 * i_; *(LAS u32x4*)(lds + VOFF + (slot) * VSL + p_ * 1024 + lane * 16) = vreg[S_][i_]; } } while (0)
    const int nt = s.nt;
    ATT_LOAD(REV ? nt - 1 : 0, 0); ATT_LOAD(REV ? nt - 2 : 1, 1); ATT_WRITE(0, 0);
    __syncthreads();
    if constexpr (EARLY) { float qm = shf[0];
#pragma unroll
        for (int w = 1; w < 8; ++w) qm = fmaxf(qm, shf[w]);
        thr = sqrtf(qm) * thr * 1.001f - s.cum[64 * lane + 63] * LOG2E; }
    float m = 0.f, l = 0.f; f32x16 o[ND0]; bool have = false;
    f32x16 negm = f32x16{};
#pragma unroll
    for (int d = 0; d < ND0; ++d) o[d] = f32x16{};
    const int qmin = s.q0 + wid * 32;
    auto body = [&](auto parc, const int i) -> bool { constexpr int PAR = decltype(parc)::value;
        const int t = REV ? nt - 1 - i : i; constexpr int cur = PAR;
        if constexpr (EARLY) { if (i > 0) { float mmin = shf[8 + (PAR ^ 1) * 8];
#pragma unroll
            for (int w = 1; w < 8; ++w) mmin = fminf(mmin, shf[8 + (PAR ^ 1) * 8 + w]);
            const float bound = __uint_as_float(__builtin_amdgcn_readlane(__float_as_uint(thr), t));
            if (bound - mmin < -40.f) return false; } }
        { const int t2 = REV ? (t >= 2 ? t - 2 : 0) : (t + 2 < nt ? t + 2 : nt - 1); ATT_LOAD(t2, PAR); }
        const bool skip = CAUSAL && (64 * t > qmin + 31);
        if (!skip) {
            const LAS unsigned char* kb = lds + cur * KSL + r32 * 16;
            f32x16 p0 = negm, p1 = negm;
            if constexpr (!ASMK) {
                const LAS unsigned char* kq = kb + hi * 1024; bf16x8 ka[8], kc[8];
#pragma unroll
                for (int d = 0; d < 4; ++d) { ka[2 * d] = *(const LAS bf16x8*)(kq + d * 2048); ka[2 * d + 1] = *(const LAS bf16x8*)(kq + d * 2048 + 512); }
#pragma unroll
                for (int g0 = 0; g0 < NKS; g0 += 4) {
                    if (g0 + 4 < NKS) {
#pragma unroll
                        for (int d = 0; d < 4; ++d) { kc[2 * d] = *(const LAS bf16x8*)(kq + (g0 + 4 + d) * 2048); kc[2 * d + 1] = *(const LAS bf16x8*)(kq + (g0 + 4 + d) * 2048 + 512); } }
                    __builtin_amdgcn_sched_group_barrier(0x100, 8, 0);
#pragma unroll
                    for (int d = 0; d < 4; ++d) { p0 = __builtin_amdgcn_mfma_f32_32x32x16_bf16(ka[2 * d], qr[g0 + d], p0, 0, 0, 0); p1 = __builtin_amdgcn_mfma_f32_32x32x16_bf16(ka[2 * d + 1], qr[g0 + d], p1, 0, 0, 0); }
                    __builtin_amdgcn_sched_group_barrier(0x008, 8, 0);
#pragma unroll
                    for (int z = 0; z < 8; ++z) ka[z] = kc[z];
                }
            } else {
            constexpr int KB = (NKS % 3 == 0 || NKS == 5) ? 3 : 4, NB = (NKS + KB - 1) / KB;
            const unsigned kbase = (unsigned)(size_t)(kb + hi * 1024), abase = (unsigned)(size_t)kb;
            bf16x8 kfa[2 * KB], kfb[2 * KB];
#pragma unroll
            for (int z_ = 0; z_ < 2 * KB; ++z_) { kfa[z_] = bf16x8{}; kfb[z_] = bf16x8{}; }
            cfor<0, KB>([&](auto ic) { constexpr int D = decltype(ic)::value; if constexpr (D < NKS) kread<D, NKS, AUG>(kfa[2 * D], kfa[2 * D + 1], kbase, abase); });
            cfor<0, NB>([&](auto bc) { constexpr int B = decltype(bc)::value;
                if constexpr (B % 2 == 0) { if constexpr (KB == 3) asm volatile("s_waitcnt lgkmcnt(0)" : "+v"(kfa[0]), "+v"(kfa[1]), "+v"(kfa[2]), "+v"(kfa[3]), "+v"(kfa[4]), "+v"(kfa[5]) :: "memory");
                                            else asm volatile("s_waitcnt lgkmcnt(0)" : "+v"(kfa[0]), "+v"(kfa[1]), "+v"(kfa[2]), "+v"(kfa[3]), "+v"(kfa[4]), "+v"(kfa[5]), "+v"(kfa[6]), "+v"(kfa[7]) :: "memory"); }
                else { if constexpr (KB == 3) asm volatile("s_waitcnt lgkmcnt(0)" : "+v"(kfb[0]), "+v"(kfb[1]), "+v"(kfb[2]), "+v"(kfb[3]), "+v"(kfb[4]), "+v"(kfb[5]) :: "memory");
                       else asm volatile("s_waitcnt lgkmcnt(0)" : "+v"(kfb[0]), "+v"(kfb[1]), "+v"(kfb[2]), "+v"(kfb[3]), "+v"(kfb[4]), "+v"(kfb[5]), "+v"(kfb[6]), "+v"(kfb[7]) :: "memory"); }
                __builtin_amdgcn_sched_barrier(0);
                if constexpr (B % 2 == 0) {
                    cfor<0, KB>([&](auto ic) { constexpr int D = (B + 1) * KB + decltype(ic)::value; if constexpr (D < NKS) kread<D, NKS, AUG>(kfb[2 * decltype(ic)::value], kfb[2 * decltype(ic)::value + 1], kbase, abase); });
                    __builtin_amdgcn_sched_barrier(0);
                    cfor<0, KB>([&](auto ic) { constexpr int D = B * KB + decltype(ic)::value; if constexpr (D < NKS) { p0 = __builtin_amdgcn_mfma_f32_32x32x16_bf16(kfa[2 * decltype(ic)::value], qr[D], p0, 0, 0, 0); p1 = __builtin_amdgcn_mfma_f32_32x32x16_bf16(kfa[2 * decltype(ic)::value + 1], qr[D], p1, 0, 0, 0); } });
                } else {
                    cfor<0, KB>([&](auto ic) { constexpr int D = (B + 1) * KB + decltype(ic)::value; if constexpr (D < NKS) kread<D, NKS, AUG>(kfa[2 * decltype(ic)::value], kfa[2 * decltype(ic)::value + 1], kbase, abase); });
                    __builtin_amdgcn_sched_barrier(0);
                    cfor<0, KB>([&](auto ic) { constexpr int D = B * KB + decltype(ic)::value; if constexpr (D < NKS) { p0 = __builtin_amdgcn_mfma_f32_32x32x16_bf16(kfb[2 * decltype(ic)::value], qr[D], p0, 0, 0, 0); p1 = __builtin_amdgcn_mfma_f32_32x32x16_bf16(kfb[2 * decltype(ic)::value + 1], qr[D], p1, 0, 0, 0); } });
                }
            });
            }
            const LAS unsigned char* vb = lds + VOFF + cur * VSL + ((lane >> 4) & 1) * 32 + (lane & 3) * 8 + (4 * hi + ((lane & 15) >> 2)) * 64;
            s16x4 vlo[2][4], vhi[2][4];
#pragma unroll
            for (int d = 0; d < 2; ++d)
#pragma unroll
                for (int ks = 0; ks < 4; ++ks) { vlo[d][ks] = vtr(vb + d * 4096 + ks * 1024); vhi[d][ks] = vtr(vb + d * 4096 + ks * 1024 + 512); }
            __builtin_amdgcn_sched_group_barrier(0x100, 16, 0);
            if (CAUSAL && (64 * t + 63 > qmin)) { const int q = qmin + r32, kv0 = 64 * t + 4 * hi;
#pragma unroll
                for (int r = 0; r < 16; ++r) { const int kv = kv0 + (r & 3) + 8 * (r >> 2); if (kv > q) p0[r] = -INFINITY; if (kv + 32 > q) p1[r] = -INFINITY; } }
            const float rmd = rowmax32(p0, p1);
            if (!have || __any(rmd > THR)) {
                const float dd = have ? fmaxf(rmd, 0.f) : rmd, alpha = have ? __builtin_amdgcn_exp2f(-dd) : 1.f; l *= alpha; m += dd;
#pragma unroll
                for (int r = 0; r < 16; ++r) { p0[r] -= dd; p1[r] -= dd; negm[r] = -m; }
                if (have) {
                    if (hi == 0) wsf[r32] = alpha;
                    asm volatile("s_waitcnt lgkmcnt(0)" ::: "memory");
#pragma unroll
                    for (int r = 0; r < 16; ++r) { const float a = wsf[crow(r, hi)];
#pragma unroll
                        for (int d = 0; d < ND0; ++d) o[d][r] *= a; } }
                have = true;
            }
            float sacc = 0.f;
#pragma unroll
            for (int r = 0; r < 16; ++r) { p0[r] = __builtin_amdgcn_exp2f(p0[r]); p1[r] = __builtin_amdgcn_exp2f(p1[r]); sacc += p0[r] + p1[r]; }
            l += sacc;
            u32x4 pw[4];
#pragma unroll
            for (int j = 0; j < 4; ++j) { pw[0][j] = cvtpk(p0[2 * j], p0[2 * j + 1]); pw[1][j] = cvtpk(p0[8 + 2 * j], p0[8 + 2 * j + 1]); pw[2][j] = cvtpk(p1[2 * j], p1[2 * j + 1]); pw[3][j] = cvtpk(p1[8 + 2 * j], p1[8 + 2 * j + 1]); }
#pragma unroll
            for (int d = 0; d < 2; ++d)
#pragma unroll
                for (int ks = 0; ks < 4; ++ks) { const bf16x8 vf = (bf16x8){vlo[d][ks][0], vlo[d][ks][1], vlo[d][ks][2], vlo[d][ks][3], vhi[d][ks][0], vhi[d][ks][1], vhi[d][ks][2], vhi[d][ks][3]};
                    o[d] = __builtin_amdgcn_mfma_f32_32x32x16_bf16(__builtin_bit_cast(bf16x8, pw[ks]), vf, o[d], 0, 0, 0); }
            if constexpr (ND0 > 2) {
#pragma unroll
                for (int d = 2; d < ND0; d += 2) { s16x4 wlo[2][4], whi[2][4];
#pragma unroll
                    for (int e = 0; e < 2; ++e)
#pragma unroll
                        for (int ks = 0; ks < 4; ++ks) { wlo[e][ks] = vtr(vb + (d + e) * 4096 + ks * 1024); whi[e][ks] = vtr(vb + (d + e) * 4096 + ks * 1024 + 512); }
#pragma unroll
                    for (int e = 0; e < 2; ++e)
#pragma unroll
                        for (int ks = 0; ks < 4; ++ks) { const bf16x8 vf = (bf16x8){wlo[e][ks][0], wlo[e][ks][1], wlo[e][ks][2], wlo[e][ks][3], whi[e][ks][0], whi[e][ks][1], whi[e][ks][2], whi[e][ks][3]};
                            o[d + e] = __builtin_amdgcn_mfma_f32_32x32x16_bf16(__builtin_bit_cast(bf16x8, pw[ks]), vf, o[d + e], 0, 0, 0); }
                    __builtin_amdgcn_sched_group_barrier(0x100, 16, 1); __builtin_amdgcn_sched_group_barrier(0x008, 8, 1); } }
        }
        ATT_WRITE(cur ^ 1, PAR ^ 1);
        if constexpr (EARLY) { float mw = have ? m : -1e30f;
#pragma unroll
            for (int o_ = 1; o_ < 32; o_ <<= 1) mw = fminf(mw, __shfl_xor(mw, o_));
            if (lane == 0) shf[8 + PAR * 8 + wid] = mw; }
        __syncthreads();
        return true;
    };
    for (int i = 0; i < nt; i += 2) { if (!body(std::integral_constant<int, 0>{}, i)) break; if (!body(std::integral_constant<int, 1>{}, i + 1)) break; }
    { auto rr = __builtin_amdgcn_permlane32_swap(__float_as_uint(l), __float_as_uint(l), false, false); l = __uint_as_float(rr[0]) + __uint_as_float(rr[1]); }
    if (hi == 0) wsf[32 + r32] = 1.f / l;
    asm volatile("s_waitcnt lgkmcnt(0)" ::: "memory");
    LAS bf16* stg = (LAS bf16*)(lds + wid * (ND0 * 2048));
#pragma unroll
    for (int r = 0; r < 16; ++r) { const float rl = wsf[32 + crow(r, hi)]; const int orow = crow(r, hi);
#pragma unroll
        for (int d = 0; d < ND0; ++d) stg[orow * (ND0 * 32) + d * 32 + r32] = f2bf(o[d][r] * rl); }
    asm volatile("s_waitcnt lgkmcnt(0)" ::: "memory");
    constexpr int CPR = ND0 * 4, RPI = 64 / CPR;
    bf16* ow = s.o + (size_t)(wid * 32) * s.ldo;
#pragma unroll
    for (int it = 0; it < 32 / RPI; ++it) { const int row = it * RPI + lane / CPR, ch = lane % CPR; const u32x4 v = *(const LAS u32x4*)(stg + row * (ND0 * 32) + ch * 8);
        *(u32x4*)(ow + (size_t)row * s.ldo + ch * 8) = v;
        if (WSSO) { float ss = 0.f;
#pragma unroll
            for (int j = 0; j < 4; ++j) { const float a = __uint_as_float(v[j] << 16), b = __uint_as_float(v[j] & 0xffff0000u); ss += a * a + b * b; }
#pragma unroll
            for (int sh = 1; sh < CPR; sh <<= 1) ss += __shfl_xor(ss, sh);
            if (ch == 0) s.sso[(size_t)(wid * 32 + row) * 16] = ss; } }
    __syncthreads();
#undef ATT_LOAD
#undef ATT_WRITE
}
__device__ __forceinline__ void xunit(const Src& s, LAS unsigned char* lds, const int wave) {
    int tid_ = (wave << 6) | lane_id(); asm volatile("" : "+v"(tid_));
    const int tid = tid_, lane = tid & 63, r32 = lane & 31, hi = lane >> 5, wid = __builtin_amdgcn_readfirstlane(tid >> 6);
    constexpr int KSL = 16384, VSL = 16384, VOFF = 2 * KSL, STG = VOFF + 2 * VSL;
    LAS float* wsf = (LAS float*)(lds + 131072) + wid * 64;
    f32x16 p[4][2];
#pragma unroll
    for (int t = 0; t < 4; ++t) { p[t][0] = f32x16{}; p[t][1] = f32x16{}; }
    typedef int xi4 __attribute__((ext_vector_type(4))); typedef int xi8 __attribute__((ext_vector_type(8)));
    u32x4 sreg[2][2];
#define X_LOAD(J) do { if constexpr ((J) < 4) { _Pragma("unroll") for (int i_ = 0; i_ < 2; ++i_) sreg[(J) & 1][i_] = *(const u32x4*)((const unsigned char*)s.k1 + (size_t)((J) * 64 + lane) * s.ldk1 + (wid + 8 * i_) * 16); } \
        else if constexpr ((J) < 12) { _Pragma("unroll") for (int i_ = 0; i_ < 2; ++i_) { const int p_ = wid + 8 * i_, dh_ = p_ >> 2, rg_ = p_ & 3; \
            sreg[(J) & 1][i_] = *(const u32x4*)(s.v + (size_t)(((J) & 3) * 64 + 16 * rg_ + (lane >> 2)) * s.ldv + (((J) - 4) >> 2) * 128 + dh_ * 32 + (lane & 3) * 8); } } } while (0)
#define X_WRITE(J) do { if constexpr ((J) < 12) { _Pragma("unroll") for (int i_ = 0; i_ < 2; ++i_) *(LAS u32x4*)(lds + ((J) < 4 ? 0 : VOFF) + ((J) & 1) * KSL + (wid + 8 * i_) * 1024 + lane * 16) = sreg[(J) & 1][i_]; } } while (0)
    X_LOAD(0); X_LOAD(1);
    xi8 q8[4];
    { const unsigned char* qw8 = (const unsigned char*)s.q + (size_t)(wid * 32 + r32) * s.ldq + hi * 32;
#pragma unroll
      for (int s_ = 0; s_ < 4; ++s_) { const xi4 lo_ = *(const xi4*)(qw8 + 64 * s_), hi_ = *(const xi4*)(qw8 + 64 * s_ + 16); q8[s_] = __builtin_shufflevector(lo_, hi_, 0, 1, 2, 3, 4, 5, 6, 7); } }
    X_WRITE(0);
    __syncthreads();
    cfor<0, 4>([&](auto ic) { constexpr int I = decltype(ic)::value;
        X_LOAD(I + 2);
        const LAS unsigned char* kq = lds + (I & 1) * KSL + r32 * 16 + hi * 2048; xi8 kf[8];
#pragma unroll
        for (int s_ = 0; s_ < 4; ++s_)
#pragma unroll
            for (int kb = 0; kb < 2; ++kb) { const xi4 lo_ = *(const LAS xi4*)(kq + s_ * 4096 + kb * 512), hi_ = *(const LAS xi4*)(kq + s_ * 4096 + 1024 + kb * 512); kf[2 * s_ + kb] = __builtin_shufflevector(lo_, hi_, 0, 1, 2, 3, 4, 5, 6, 7); }
#pragma unroll
        for (int s_ = 0; s_ < 4; ++s_) { p[I][0] = __builtin_amdgcn_mfma_scale_f32_32x32x64_f8f6f4(kf[2 * s_], q8[s_], p[I][0], 0, 0, 0, 0x7F7F7F7F, 0, 0x7F7F7F7F);
                                       p[I][1] = __builtin_amdgcn_mfma_scale_f32_32x32x64_f8f6f4(kf[2 * s_ + 1], q8[s_], p[I][1], 0, 0, 0, 0x7F7F7F7F, 0, 0x7F7F7F7F); }
        X_WRITE(I + 1);
        __syncthreads();
    });
    float m = rowmax32(p[0][0], p[0][1]);
#pragma unroll
    for (int t = 1; t < 4; ++t) m = fmaxf(m, rowmax32(p[t][0], p[t][1]));
    float l = 0.f; u32x4 pw[4][4];
#pragma unroll
    for (int t = 0; t < 4; ++t) { float sacc = 0.f;
#pragma unroll
        for (int r = 0; r < 16; ++r) { p[t][0][r] = __builtin_amdgcn_exp2f((p[t][0][r] - m) * (1.f / XQ8_SCALE)); p[t][1][r] = __builtin_amdgcn_exp2f((p[t][1][r] - m) * (1.f / XQ8_SCALE)); sacc += p[t][0][r] + p[t][1][r]; }
        l += sacc;
#pragma unroll
        for (int j = 0; j < 4; ++j) { pw[t][0][j] = cvtpk(p[t][0][2 * j], p[t][0][2 * j + 1]); pw[t][1][j] = cvtpk(p[t][0][8 + 2 * j], p[t][0][8 + 2 * j + 1]); pw[t][2][j] = cvtpk(p[t][1][2 * j], p[t][1][2 * j + 1]); pw[t][3][j] = cvtpk(p[t][1][8 + 2 * j], p[t][1][8 + 2 * j + 1]); } }
    { auto rr = __builtin_amdgcn_permlane32_swap(__float_as_uint(l), __float_as_uint(l), false, false); l = __uint_as_float(rr[0]) + __uint_as_float(rr[1]); }
    if (hi == 0) wsf[32 + r32] = 1.f / l;
    asm volatile("s_waitcnt lgkmcnt(0)" ::: "memory");
    f32x16 o[4];
    cfor<0, 8>([&](auto ic) { constexpr int I = decltype(ic)::value, TT = I & 3, DVH = I >> 2;
        X_LOAD(I + 6);
        if constexpr (TT == 0) {
#pragma unroll
            for (int d = 0; d < 4; ++d) o[d] = f32x16{}; }
        const LAS unsigned char* vb = lds + VOFF + (I & 1) * VSL + ((lane >> 4) & 1) * 32 + (lane & 3) * 8 + (4 * hi + ((lane & 15) >> 2)) * 64;
#pragma unroll
        for (int d = 0; d < 4; d += 2) { s16x4 vlo[2][4], vhi[2][4];
#pragma unroll
            for (int e = 0; e < 2; ++e)
#pragma unroll
                for (int ks = 0; ks < 4; ++ks) { vlo[e][ks] = vtr(vb + (d + e) * 4096 + ks * 1024); vhi[e][ks] = vtr(vb + (d + e) * 4096 + ks * 1024 + 512); }
#pragma unroll
            for (int e = 0; e < 2; ++e)
#pragma unroll
                for (int ks = 0; ks < 4; ++ks) { const bf16x8 vf = (bf16x8){vlo[e][ks][0], vlo[e][ks][1], vlo[e][ks][2], vlo[e][ks][3], vhi[e][ks][0], vhi[e][ks][1], vhi[e][ks][2], vhi[e][ks][3]};
                    o[d + e] = __builtin_amdgcn_mfma_f32_32x32x16_bf16(__builtin_bit_cast(bf16x8, pw[TT][ks]), vf, o[d + e], 0, 0, 0); } }
        X_WRITE(I + 5);
        if constexpr (TT == 3) {
            LAS bf16* stg = (LAS bf16*)(lds + STG + wid * 8192);
#pragma unroll
            for (int r = 0; r < 16; ++r) { const float rl = wsf[32 + crow(r, hi)]; const int orow = crow(r, hi);
#pragma unroll
                for (int d = 0; d < 4; ++d) stg[orow * 128 + d * 32 + r32] = f2bf(o[d][r] * rl); }
            asm volatile("s_waitcnt lgkmcnt(0)" ::: "memory");
            unsigned char* ow = (unsigned char*)s.o + (size_t)(wid * 32) * s.ldo + DVH * 128;
#pragma unroll
            for (int it = 0; it < 4; ++it) { const int row = it * 8 + (lane >> 3), ch = lane & 7; const u32x4 v0 = *(const LAS u32x4*)(stg + row * 128 + ch * 16), v1 = *(const LAS u32x4*)(stg + row * 128 + ch * 16 + 8); u32x4 f;
#pragma unroll
                for (int j = 0; j < 4; ++j) { const unsigned q_ = j < 2 ? v0[2 * j] : v1[2 * j - 4], r_ = j < 2 ? v0[2 * j + 1] : v1[2 * j - 3]; int w = 0;
                    w = __builtin_amdgcn_cvt_pk_fp8_f32(__uint_as_float(q_ << 16) * XO8_SCALE, __uint_as_float(q_ & 0xffff0000u) * XO8_SCALE, w, false);
                    w = __builtin_amdgcn_cvt_pk_fp8_f32(__uint_as_float(r_ << 16) * XO8_SCALE, __uint_as_float(r_ & 0xffff0000u) * XO8_SCALE, w, true); f[j] = (unsigned)w; }
                *(u32x4*)(ow + (size_t)row * s.ldo + ch * 16) = f; }
            asm volatile("s_waitcnt lgkmcnt(0)" ::: "memory"); }
        __syncthreads();
    });
#undef X_LOAD
#undef X_WRITE
}
}

#define XB_TMO      128
#define XB_XCNT(j)  (256  + 64 * (j))
#define XB_XSUB(j)  (1280 + 64 * (j))
#define XB_XGEN(j)  (2304 + 64 * (j))
#define XB_TOP      3328
#define XB_TOPGEN   3392
#define XCD_BAR_WORDS 3456
#define XB_SPIN_CAP (1u << 18)
__device__ __forceinline__ unsigned xb_ld(unsigned* p)              { return __hip_atomic_load(p, __ATOMIC_RELAXED, __HIP_MEMORY_SCOPE_AGENT); }
__device__ __forceinline__ unsigned xb_add(unsigned* p, unsigned v) { return __hip_atomic_fetch_add(p, v, __ATOMIC_RELAXED, __HIP_MEMORY_SCOPE_AGENT); }
__device__ __forceinline__ unsigned xb_xcc_id() { return (unsigned)__builtin_amdgcn_s_getreg((3 << 11) | 20) & 0xFu; }
#define XB_SPIN(cond, bar) do { unsigned _sp = 0; while (cond) { __builtin_amdgcn_s_sleep(1); \
    if ((++_sp & 255u) == 0u) { if (xb_ld(&(bar)[XB_TMO])) break; if (_sp > XB_SPIN_CAP) { atomicAdd(&(bar)[XB_TMO], 1u); break; } } } } while (0)
struct XcdBarrier { unsigned* bar; unsigned x; volatile LAS unsigned* st; bool wave0; };
__device__ __forceinline__ XcdBarrier xcd_barrier_post(unsigned* bar, volatile LAS unsigned* st, int wave) {
    XcdBarrier b; b.bar = bar; b.x = xb_xcc_id(); b.st = st; b.wave0 = (wave == 0);
    if (b.wave0 && lane_id() == 0) (void)xb_add(&bar[XB_XCNT(b.x)], 1u);
    return b;
}
__device__ __forceinline__ void xcd_barrier_complete(unsigned* bar, unsigned x, unsigned& nloc, unsigned& nx) {
    const unsigned G = gridDim.x * gridDim.y * gridDim.z;
    unsigned sum, cnt, mine, sp = 0u;
    for (;;) {
        sum = 0u; cnt = 0u; mine = 0u;
#pragma unroll
        for (unsigned j = 0; j < 16; ++j) { const unsigned c = xb_ld(&bar[XB_XCNT(j)]); sum += c; cnt += (c > 0u) ? 1u : 0u; mine = (j == x) ? c : mine; }
        if (sum == G) break;
        __builtin_amdgcn_s_sleep(1);
        if ((++sp & 255u) == 0u) { if (xb_ld(&bar[XB_TMO])) break; if (sp > XB_SPIN_CAP) { atomicAdd(&bar[XB_TMO], 1u); break; } }
    }
    nloc = mine > 0u ? mine : 1u; nx = cnt > 0u ? cnt : 1u;
}
__device__ __forceinline__ void xcd_barrier(const XcdBarrier& b) {
    asm volatile("s_waitcnt vmcnt(0)" ::: "memory");
    __syncthreads();
    if (b.wave0 && lane_id() == 0) {
        unsigned* bar = b.bar;
        __builtin_amdgcn_s_waitcnt(0);
        unsigned nloc = b.st[0], nx = b.st[1];
        if (nloc == 0u) { xcd_barrier_complete(bar, b.x, nloc, nx); b.st[0] = nloc; b.st[1] = nx; }
        const unsigned old = xb_add(&bar[XB_XSUB(b.x)], 1u);
        const unsigned gen = old / nloc;
        if (old + 1u == (gen + 1u) * nloc) {
            __builtin_amdgcn_fence(__ATOMIC_RELEASE, "agent");
            asm volatile("s_waitcnt vmcnt(0)" ::: "memory");
            const unsigned og = xb_add(&bar[XB_TOP], 1u);
            const unsigned tg = og / nx;
            if (og + 1u == (tg + 1u) * nx) xb_add(&bar[XB_TOPGEN], 1u);
            else XB_SPIN(xb_ld(&bar[XB_TOPGEN]) == tg, bar);
            __builtin_amdgcn_fence(__ATOMIC_ACQUIRE, "agent");
            xb_add(&bar[XB_XGEN(b.x)], 1u);
            asm volatile("s_waitcnt vmcnt(0)" ::: "memory");
        } else {
            XB_SPIN(xb_ld(&bar[XB_XGEN(b.x)]) == gen, bar);
            __builtin_amdgcn_fence(__ATOMIC_ACQUIRE, "agent");
            asm volatile("s_waitcnt vmcnt(0)" ::: "memory");
        }
    }
    __syncthreads();
}

constexpr int NWAVES = 8;
constexpr int RING_BYTES = 131072, TABS_OFF = RING_BYTES, MISC_OFF = TABS_OFF + 2048, LDS_BYTES = 147456;
constexpr int CW_FOXQ = 256;
constexpr int CW_BAR = 4096;
constexpr int N_PHASES = 11;
constexpr float W8_SCALE = 32.f, ACT8_SCALE = 4.f, Y8_SCALE = 16.f;
#ifndef PROBE_REP
#define PROBE_REP -1
#endif
#define REPS(k) for (int rep_ = 0; rep_ < ((PROBE_REP) == (k) ? 2 : 1); ++rep_)
struct MegaArgs {
    const float* in[25]; float* out; unsigned char* ws; int ph_lo, ph_hi; int coop; int pad;
};
struct Frame {
    LAS unsigned char* lds; volatile LAS unsigned* MISC; LAS unsigned* tabs;
    int wave, vcu, G;
};
struct P0Item { const float* W; bf16* WT; const float* kscale; const float* kscale2; int K, N, NT, c_lo, c_hi, item; float cscale; bool f8; };
__device__ __forceinline__ void p0_load(const P0Item& d, f32x4 (&v)[8], int lane) {
    const int nblk = d.NT / 32, kb = d.item / nblk, nb = d.item % nblk, k0 = 64 * kb, n0 = 32 * nb; const int r8 = lane >> 3, c4 = lane & 7, nn = n0 + 4 * c4;
#pragma unroll
    for (int i = 0; i < 8; ++i) { const int kk = i * 8 + r8; v[i] = (f32x4){0.f, 0.f, 0.f, 0.f}; if (nn < d.N) v[i] = __builtin_nontemporal_load((const f32x4*)(d.W + (size_t)(k0 + kk) * d.N + nn)); }
}
__device__ __forceinline__ void p0_finish(const P0Item& d, const f32x4 (&v)[8], LAS float* scr, int lane) {
    const int nblk = d.NT / 32, kb = d.item / nblk, nb = d.item % nblk, k0 = 64 * kb, n0 = 32 * nb; const int r8 = lane >> 3, c4 = lane & 7, nn = n0 + 4 * c4;
    const float cs = (nn >= d.c_lo && nn < d.c_hi) ? d.cscale : 1.f;
#pragma unroll
    for (int i = 0; i < 8; ++i) { const int kk = i * 8 + r8; float ks = cs; if (d.kscale) ks *= (d.kscale2 && k0 >= 512) ? d.kscale2[k0 + kk - 512] : d.kscale[k0 + kk];
        LAS float* p = scr + kk * 33 + 4 * c4; p[0] = v[i][0] * ks; p[1] = v[i][1] * ks; p[2] = v[i][2] * ks; p[3] = v[i][3] * ks; }
    asm volatile("s_waitcnt lgkmcnt(0)" ::: "memory");
    const int c = lane & 7;
#pragma unroll
    for (int j = 0; j < 4; ++j) { const int n = (lane >> 3) + 8 * j; const LAS float* s = scr + (8 * c) * 33 + n;
        if (d.f8) { int w0 = 0, w1 = 0; w0 = __builtin_amdgcn_cvt_pk_fp8_f32(s[0 * 33], s[1 * 33], w0, false); w0 = __builtin_amdgcn_cvt_pk_fp8_f32(s[2 * 33], s[3 * 33], w0, true);
            w1 = __builtin_amdgcn_cvt_pk_fp8_f32(s[4 * 33], s[5 * 33], w1, false); w1 = __builtin_amdgcn_cvt_pk_fp8_f32(s[6 * 33], s[7 * 33], w1, true);
            *(u32x2*)((unsigned char*)d.WT + (size_t)(n0 + n) * d.K + k0 + 8 * c) = (u32x2){(unsigned)w0, (unsigned)w1}; }
        else { u32x4 o; o.x = cvtpk(s[0 * 33], s[1 * 33]); o.y = cvtpk(s[2 * 33], s[3 * 33]); o.z = cvtpk(s[4 * 33], s[5 * 33]); o.w = cvtpk(s[6 * 33], s[7 * 33]);
            *(u32x4*)(d.WT + (size_t)(n0 + n) * d.K + k0 + 8 * c) = o; } }
    asm volatile("s_waitcnt lgkmcnt(0)" ::: "memory");
}
__device__ __forceinline__ void rms_row_to_bf16(const float* xrow, const float* g, bf16* orow, int lane) {
    const f32x4* xr = (const f32x4*)xrow + lane; const f32x4* gr = (const f32x4*)g + lane;
    f32x4 v[4]; float s = 0.f;
#pragma unroll
    for (int j = 0; j < 4; ++j) { v[j] = xr[64 * j]; s += sum4sq(v[j]); }
    const float r = rsqrtf(wave_sum(s) * (1.f / DM) + EPS);
#pragma unroll
    for (int j = 0; j < 4; ++j) { const f32x4 o = v[j] * r * gr[64 * j]; st_bf4(orow + 4 * lane + 256 * j, o); }
}
constexpr size_t WS_WRG = 31 * MiB;
constexpr size_t WS_KN = 1 * MiB + 512 * 1024;
constexpr size_t WS_XF8 = 416 * MiB;
constexpr size_t WS_H1F8 = 880 * MiB;
constexpr size_t WS_XOF8 = 912 * MiB;
constexpr size_t WS_KM8 = 944 * MiB;
constexpr size_t WS_GSORT = 868 * MiB;
constexpr size_t WS_LF = 996 * MiB;

__device__ __forceinline__ P0Item p0_decode(const MegaArgs& a, int it) {
    unsigned char* ws = a.ws;
    constexpr int I_IN = 16 * 64, I_Q = 4 * 24, I_KV = 2 * 32, I_SQ = 16 * 32, I_MKV = 16 * 64, I_GU = 16 * 64, I_D = 16 * 32;
    P0Item d; d.kscale = nullptr; d.kscale2 = nullptr; d.cscale = 1.f; d.c_lo = 0; d.c_hi = 0; d.f8 = false; int r = it;
    if (r < NEXP * I_GU) { const int e = r / I_GU; d.W = a.in[20] + (size_t)e * DM * 2048; d.K = DM; d.N = 2048; d.NT = 2048; d.WT = (bf16*)(ws + WS_WGU + (size_t)e * 2048 * DM); d.f8 = true; d.cscale = W8_SCALE; d.c_hi = 2048; d.item = r % I_GU; return d; } r -= NEXP * I_GU;
    if (r < NEXP * I_D) { const int e = r / I_D; d.W = a.in[22] + (size_t)e * DEXP * DM; d.K = DEXP; d.N = DM; d.NT = DM; d.WT = (bf16*)(ws + WS_WD + (size_t)e * DM * DEXP); d.f8 = true; d.cscale = W8_SCALE; d.c_hi = DM; d.item = r % I_D; return d; } r -= NEXP * I_D;
    if (r < I_IN) { d.W = a.in[3]; d.K = DM; d.N = IN_COLS; d.NT = NPROJ; d.WT = (bf16*)(ws + WS_WIN); d.cscale = C2F; d.c_lo = C_FQ; d.c_hi = C_FK; d.item = r; return d; } r -= I_IN;
    if (r < I_Q) { d.W = a.in[5]; d.K = 256; d.N = 768; d.NT = 768; d.WT = (bf16*)(ws + WS_WQ); d.kscale = a.in[4]; d.cscale = C2M; d.c_lo = 0; d.c_hi = 768; d.item = r; return d; } r -= I_Q;
    if (r < I_KV) { d.W = a.in[7]; d.K = 128; d.N = 1024; d.NT = 1024; d.WT = (bf16*)(ws + WS_WKV); d.kscale = a.in[6]; d.item = r; return d; } r -= I_KV;
    if (r < I_SQ) { d.W = a.in[11]; d.K = DM; d.N = DM; d.NT = DM; d.WT = (bf16*)(ws + WS_WO); d.kscale = a.in[9]; d.kscale2 = a.in[10]; d.item = r; return d; } r -= I_SQ;
    if (r < I_SQ) { d.W = a.in[14]; d.K = DM; d.N = DM; d.NT = DM; d.WT = (bf16*)(ws + WS_WXQ); d.kscale = a.in[12]; d.cscale = C2X * WXQ8_SCALE; d.c_lo = 0; d.c_hi = DM; d.f8 = true; d.item = r; return d; } r -= I_SQ;
    if (r < I_SQ) { d.W = a.in[16]; d.K = DM; d.N = DM; d.NT = DM; d.WT = (bf16*)(ws + WS_WXO); d.cscale = WXO8_SCALE; d.c_lo = 0; d.c_hi = DM; d.f8 = true; d.item = r; return d; } r -= I_SQ;
    d.W = a.in[15]; d.K = DM; d.N = 2048; d.NT = 2048; d.WT = (bf16*)(ws + WS_WMKV); d.item = r; return d;
}
constexpr int P0_NITEMS = 16 * 64 + 4 * 24 + 2 * 32 + 3 * 16 * 32 + 16 * 64 + NEXP * 16 * 64 + NEXP * 16 * 32;
constexpr int MOE_ITEMS = NEXP * 16 * 64 + NEXP * 16 * 32;
constexpr int WCHUNKS = 512, WCH_ITEMS = MOE_ITEMS / WCHUNKS;
__device__ __forceinline__ void rms_rows2_to_bf16(const float* x0, const float* x1, const float* g, bf16* o0, bf16* o1, int lane) {
    const f32x4* xa = (const f32x4*)x0 + lane; const f32x4* xb = (const f32x4*)x1 + lane; const f32x4* gr = (const f32x4*)g + lane;
    f32x4 va[4], vb[4]; float sa = 0.f, sb = 0.f;
#pragma unroll
    for (int j = 0; j < 4; ++j) { va[j] = __builtin_nontemporal_load(xa + 64 * j); vb[j] = __builtin_nontemporal_load(xb + 64 * j); }
#pragma unroll
    for (int j = 0; j < 4; ++j) { sa += sum4sq(va[j]); sb += sum4sq(vb[j]); }
    const float ra = rsqrtf(wave_sum(sa) * (1.f / DM) + EPS), rb = rsqrtf(wave_sum(sb) * (1.f / DM) + EPS);
#pragma unroll
    for (int j = 0; j < 4; ++j) { const f32x4 gg = gr[64 * j]; st_bf4(o0 + 4 * lane + 256 * j, va[j] * ra * gg); st_bf4(o1 + 4 * lane + 256 * j, vb[j] * rb * gg); }
}
__device__ __forceinline__ void p0_items(const MegaArgs& a, LAS float* scr, int lane, int first, const int end, const int step) {
    f32x4 va[8], vb[8]; int it = first;
    if (it < end) { P0Item da = p0_decode(a, it); p0_load(da, va, lane);
        for (;;) {
            const int itb = it + step; P0Item db; const bool hb = itb < end; if (hb) { db = p0_decode(a, itb); p0_load(db, vb, lane); }
            p0_finish(da, va, scr, lane);
            if (!hb) break;
            const int ita = itb + step; const bool ha = ita < end; if (ha) { da = p0_decode(a, ita); p0_load(da, va, lane); }
            p0_finish(db, vb, scr, lane);
            if (!ha) break;
            it = ita;
        } }
}
__device__ __forceinline__ void p0_items4(const MegaArgs& a, LAS float* scr, int lane, int first, const int end, const int step) {
    f32x4 v0[8], v1[8], v2[8], v3[8]; P0Item d0, d1, d2, d3; int it = first;
    if (it < end) { d0 = p0_decode(a, it); p0_load(d0, v0, lane); }
    if (it + step < end) { d1 = p0_decode(a, it + step); p0_load(d1, v1, lane); }
    if (it + 2 * step < end) { d2 = p0_decode(a, it + 2 * step); p0_load(d2, v2, lane); }
    if (it + 3 * step < end) { d3 = p0_decode(a, it + 3 * step); p0_load(d3, v3, lane); }
    for (;;) {
        if (!(it < end)) break; p0_finish(d0, v0, scr, lane); if (it + 4 * step < end) { d0 = p0_decode(a, it + 4 * step); p0_load(d0, v0, lane); }
        if (!(it + step < end)) break; p0_finish(d1, v1, scr, lane); if (it + 5 * step < end) { d1 = p0_decode(a, it + 5 * step); p0_load(d1, v1, lane); }
        if (!(it + 2 * step < end)) break; p0_finish(d2, v2, scr, lane); if (it + 6 * step < end) { d2 = p0_decode(a, it + 6 * step); p0_load(d2, v2, lane); }
        if (!(it + 3 * step < end)) break; p0_finish(d3, v3, scr, lane); if (it + 7 * step < end) { d3 = p0_decode(a, it + 7 * step); p0_load(d3, v3, lane); }
        it += 4 * step;
    }
}
__device__ __forceinline__ void p0_chunk(const Frame& F, const MegaArgs& a, int chunk) {
    LAS float* scr = (LAS float*)(F.lds + F.wave * 16384); int lane = lane_id(); asm volatile("" : "+v"(lane));
    p0_items4(a, scr, lane, chunk * WCH_ITEMS + F.wave, (chunk + 1) * WCH_ITEMS, NWAVES);
    __syncthreads();
}
__device__ __forceinline__ void p0_prologue(const Frame& F, const MegaArgs& a) {
    LAS float* scr = (LAS float*)(F.lds + F.wave * 16384);
    int lane = lane_id(); asm volatile("" : "+v"(lane)); const int gw = F.vcu * NWAVES + F.wave, NGW = F.G * NWAVES;
    unsigned char* ws = a.ws;
    p0_items(a, scr, lane, MOE_ITEMS + gw, P0_NITEMS, NGW);
    for (int m = 2 * gw; m < T; m += 2 * NGW) rms_rows2_to_bf16(a.in[0] + (size_t)m * DM, a.in[0] + (size_t)(m + 1) * DM, a.in[2], (bf16*)(ws + WS_XN) + (size_t)m * DM, (bf16*)(ws + WS_XN) + (size_t)(m + 1) * DM, lane);
    for (int m = 2 * gw; m < TM; m += 2 * NGW) rms_rows2_to_bf16(a.in[1] + (size_t)m * DM, a.in[1] + (size_t)(m + 1) * DM, a.in[13], (bf16*)(ws + WS_MEMN) + (size_t)m * DM, (bf16*)(ws + WS_MEMN) + (size_t)(m + 1) * DM, lane);
    { float* tab = (float*)(ws + WS_ROPE); for (int i = gw * 64 + lane; i < 4096 * 16; i += NGW * 64) { const int pos = i >> 4, j = i & 15; const float inv = powf(10000.f, -(float)j / 16.f); const float ang = (float)pos * inv; tab[2 * i] = cosf(ang); tab[2 * i + 1] = sinf(ang); } }
    { bf16* wh = (bf16*)(ws + WS_WRG); bf16* wl = wh + DM * NEXP;
      for (int i = gw * 64 + lane; i < DM * NEXP; i += NGW * 64) { const float w = a.in[18][i] * a.in[17][i >> 5]; const bf16 h = f2bf(w); const int o_ = (i & 31) * DM + (i >> 5); wh[o_] = h; wl[o_] = f2bf(w - bf2f(h)); } }
}
__device__ __forceinline__ void p2_scan_item(const float* LF, float* cum, bf16* kaug, int item, int lane) {
    const int b = item >> 3, ck = item & 7; const float* base = LF + (size_t)b * SEQ * 8;
    float carry[8];
#pragma unroll
    for (int h = 0; h < 8; ++h) carry[h] = 0.f;
    for (int p = lane; p < ck * 512; p += 64) { const f32x4 x0 = *(const f32x4*)(base + (size_t)p * 8), x1 = *(const f32x4*)(base + (size_t)p * 8 + 4);
#pragma unroll
        for (int e = 0; e < 4; ++e) { carry[e] += x0[e]; carry[4 + e] += x1[e]; } }
#pragma unroll
    for (int h = 0; h < 8; ++h) carry[h] = wave_sum(carry[h]);
    const int s0 = ck * 512 + lane * 8;
    float v[8][8];
#pragma unroll
    for (int i = 0; i < 8; ++i) { const f32x4 x0 = *(const f32x4*)(base + (size_t)(s0 + i) * 8), x1 = *(const f32x4*)(base + (size_t)(s0 + i) * 8 + 4);
#pragma unroll
        for (int e = 0; e < 4; ++e) { v[i][e] = x0[e]; v[i][4 + e] = x1[e]; } }
#pragma unroll
    for (int h = 0; h < 8; ++h) {
#pragma unroll
        for (int i = 1; i < 8; ++i) v[i][h] += v[i - 1][h];
        float tot = v[7][h], inc = tot;
#pragma unroll
        for (int o = 1; o < 64; o <<= 1) { const float up = __shfl_up(inc, o); if (lane >= o) inc += up; }
        const float off = carry[h] + (inc - tot);
#pragma unroll
        for (int i = 0; i < 8; ++i) v[i][h] += off;
    }
#pragma unroll
    for (int h = 0; h < 8; ++h) {
        float* cr = cum + (size_t)(b * 8 + h) * SEQ + s0; *(f32x4*)cr = (f32x4){v[0][h], v[1][h], v[2][h], v[3][h]}; *(f32x4*)(cr + 4) = (f32x4){v[4][h], v[5][h], v[6][h], v[7][h]};
        bf16* kr = kaug + ((size_t)(b * 8 + h) * SEQ + s0) * 8;
#pragma unroll
        for (int i = 0; i < 8; ++i) { const float x = -v[i][h] * LOG2E; const unsigned hi = cvtpk(x, 0.f) & 0xffffu; const float r1 = x - __uint_as_float(hi << 16); const unsigned mid = cvtpk(r1, 0.f) & 0xffffu;
            const float r2 = r1 - __uint_as_float(mid << 16); const unsigned lo = cvtpk(r2, 0.f) & 0xffffu; *(u32x4*)(kr + i * 8) = (u32x4){hi | (mid << 16), lo, 0u, 0u}; }
    }
}

struct EpiGateUp {
    static constexpr bool PERM = true, MID = false;
    const float* bias; unsigned char* ACT8;
    __device__ __forceinline__ void act(const f32x4 (&a4)[2][2], const f32x4 (&bv)[2][2], unsigned (&w)[2]) const {
        const f32x4 sv = (f32x4){1.f / W8_SCALE, ACT8_SCALE / W8_SCALE, 1.f / W8_SCALE, ACT8_SCALE / W8_SCALE};
#pragma unroll
        for (int bj = 0; bj < 2; ++bj) { const f32x4 v0 = a4[bj][0] * sv + bv[bj][0], v1 = a4[bj][1] * sv + bv[bj][1];
            const f32x4 G = (f32x4){fminf(v0[0], 7.f), fminf(v0[2], 7.f), fminf(v1[0], 7.f), fminf(v1[2], 7.f)};
            const f32x4 L = (f32x4){__builtin_amdgcn_fmed3f(v0[1], -6.f * ACT8_SCALE, 8.f * ACT8_SCALE), __builtin_amdgcn_fmed3f(v0[3], -6.f * ACT8_SCALE, 8.f * ACT8_SCALE),
                                    __builtin_amdgcn_fmed3f(v1[1], -6.f * ACT8_SCALE, 8.f * ACT8_SCALE), __builtin_amdgcn_fmed3f(v1[3], -6.f * ACT8_SCALE, 8.f * ACT8_SCALE)};
            const f32x4 tt = G * (-1.702f * LOG2E);
            const f32x4 dd = (f32x4){__builtin_amdgcn_exp2f(tt[0]), __builtin_amdgcn_exp2f(tt[1]), __builtin_amdgcn_exp2f(tt[2]), __builtin_amdgcn_exp2f(tt[3])} + 1.f;
            const f32x4 rr = (f32x4){__builtin_amdgcn_rcpf(dd[0]), __builtin_amdgcn_rcpf(dd[1]), __builtin_amdgcn_rcpf(dd[2]), __builtin_amdgcn_rcpf(dd[3])};
            const f32x4 a = (G * rr) * L;
            int x = 0; x = __builtin_amdgcn_cvt_pk_fp8_f32(a[0], a[1], x, false); x = __builtin_amdgcn_cvt_pk_fp8_f32(a[2], a[3], x, true); w[bj] = (unsigned)x; }
    }
    __device__ __forceinline__ void operator()(f32x4 (&acc)[2][2][4][2], const pg8::Unit& u, int wr, int wc, int fr, int fq) const {
        asm volatile("" : "+v"(fr), "+v"(fq));
        const int c0 = u.col0 + wc * 32 + fq * 8; const float* bp = bias + (size_t)u.e * 2048 + c0;
        const f32x4 bm = (f32x4){1.f, ACT8_SCALE, 1.f, ACT8_SCALE}, ba = (f32x4){0.f, ACT8_SCALE, 0.f, ACT8_SCALE};
        f32x4 bv[2][2];
#pragma unroll
        for (int bj = 0; bj < 2; ++bj) { bv[bj][0] = *(const f32x4*)(bp + bj * 128) * bm + ba; bv[bj][1] = *(const f32x4*)(bp + bj * 128 + 4) * bm + ba; }
#pragma unroll
        for (int ai = 0; ai < 2; ++ai)
#pragma unroll
            for (int mp = 0; mp < 2; ++mp) {
                asm volatile("" : "+v"(acc[ai][0][2 * mp][0]), "+v"(acc[ai][0][2 * mp][1]), "+v"(acc[ai][1][2 * mp][0]), "+v"(acc[ai][1][2 * mp][1]));
                unsigned d[2][2];
#pragma unroll
                for (int q = 0; q < 2; ++q) { const int m = 2 * mp + q; unsigned w[2]; const f32x4 a4[2][2] = {{acc[ai][0][m][0], acc[ai][0][m][1]}, {acc[ai][1][m][0], acc[ai][1][m][1]}}; act(a4, bv, w);
                    const auto r = __builtin_amdgcn_permlane16_swap(w[0], w[1], false, false); d[q][0] = r[0]; d[q][1] = r[1]; }
                const auto r0 = __builtin_amdgcn_permlane32_swap(d[0][0], d[1][0], false, false), r1 = __builtin_amdgcn_permlane32_swap(d[0][1], d[1][1], false, false);
                int f2 = fr, q2 = fq; asm volatile("" : "+v"(f2), "+v"(q2));
                const int rl = ai * 128 + wr * 64 + (2 * mp + (q2 >> 1)) * 16 + f2; const unsigned rowi = rl < u.rows ? (unsigned)(u.row0 + rl) : (unsigned)(T * 4 + rl);
                *(u32x4*)(ACT8 + (rowi * (unsigned)DEXP + (unsigned)((u.col0 >> 1) + wc * 16 + (q2 & 1) * 64))) = (u32x4){r0[0], r1[0], r0[1], r1[1]};
                asm volatile("" ::: "memory"); }
    }
};
struct EpiDown {
    static constexpr bool PERM = true, MID = false;
    const float* bias; const float* gsort; const int* list0; unsigned char* Y8;
    __device__ __forceinline__ void operator()(f32x4 (&acc)[2][2][4][2], const pg8::Unit& u, int wr, int wc, int fr, int fq) const {
        asm volatile("" : "+v"(fr), "+v"(fq));
        const int c0 = u.col0 + wc * 32 + fq * 8; const float* bp = bias + (size_t)u.e * DM + c0;
        const float* gp = gsort + (u.list - list0) + wr * 64 + fq * 16 + fr;
        const float g0 = gp[0] * Y8_SCALE, g1 = gp[128] * Y8_SCALE;
        f32x4 bv[2][2];
#pragma unroll
        for (int bj = 0; bj < 2; ++bj) { bv[bj][0] = *(const f32x4*)(bp + bj * 128); bv[bj][1] = *(const f32x4*)(bp + bj * 128 + 4); }
#pragma unroll
        for (int g = 0; g < 8; ++g) { const int ai = g >> 2, m = g & 3;
                int f2 = fr, q2 = fq; asm volatile("" : "+v"(f2), "+v"(q2));
                const float gg = __int_as_float(__builtin_amdgcn_ds_bpermute(4 * (m * 16 + f2), __float_as_int(ai ? g1 : g0)));
                const int rl = ai * 128 + wr * 64 + m * 16 + f2; const unsigned rowi = rl < u.rows ? (unsigned)(u.row0 + rl) : (unsigned)(T * 4 + rl);
                unsigned w[2][2];
#pragma unroll
                for (int bj = 0; bj < 2; ++bj) { const f32x4 v0 = (acc[ai][bj][m][0] * (1.f / (W8_SCALE * ACT8_SCALE)) + bv[bj][0]) * gg, v1 = (acc[ai][bj][m][1] * (1.f / (W8_SCALE * ACT8_SCALE)) + bv[bj][1]) * gg;
                    int w0 = 0, w1 = 0; w0 = __builtin_amdgcn_cvt_pk_fp8_f32(v0[0], v0[1], w0, false); w0 = __builtin_amdgcn_cvt_pk_fp8_f32(v0[2], v0[3], w0, true);
                    w1 = __builtin_amdgcn_cvt_pk_fp8_f32(v1[0], v1[1], w1, false); w1 = __builtin_amdgcn_cvt_pk_fp8_f32(v1[2], v1[3], w1, true); w[bj][0] = (unsigned)w0; w[bj][1] = (unsigned)w1; }
                const auto r0 = __builtin_amdgcn_permlane16_swap(w[0][0], w[1][0], false, false), r1 = __builtin_amdgcn_permlane16_swap(w[0][1], w[1][1], false, false);
                *(u32x4*)(Y8 + (rowi * (unsigned)DM + (unsigned)(u.col0 + wc * 32 + ((q2 & 1) ? 128 + 8 * (q2 - 1) : 8 * q2)))) = (u32x4){r0[0], r1[0], r0[1], r1[1]};
                asm volatile("" ::: "memory");
            }
    }
};
struct MoeSched {
    pg8::TileOrder o; const volatile LAS int* tpre; const volatile LAS int* roff;
    const char* A; size_t a_row_bytes; const char* Wt; size_t w_exp_bytes; int brow; const int* list; bool gather;
    __device__ __forceinline__ void tables(const volatile LAS int* tp, const volatile LAS int* ro) { tpre = tp; roff = ro; }
    __device__ __forceinline__ bool next(int i, pg8::Unit& u) const { int pm, pn; if (!o.tile(i, pm, pn)) return false;
        int l = lane_id(); const int j = l < 32 ? l : 32; const int tv = tpre[j], rv = roff[j];
        const unsigned long long mk = __ballot(l >= 1 && l < NEXP && tv <= pm); const int e = __builtin_popcountll(mk);
        const int tp = __builtin_amdgcn_readlane(tv, e), r0 = __builtin_amdgcn_readlane(rv, e), r1 = __builtin_amdgcn_readlane(rv, e + 1);
        const int mt = pm - tp, cnt = r1 - r0; u.row0 = r0 + mt * 256; u.rows = (cnt - mt * 256) < 256 ? (cnt - mt * 256) : 256; u.col0 = pn * 256; u.pn = pn; u.e = e;
        u.a = gather ? A : A + (size_t)u.row0 * a_row_bytes; u.b = Wt + (size_t)e * w_exp_bytes + (size_t)pn * 256 * brow; u.list = list + (size_t)e * T + mt * 256; return true; }
};
__device__ __forceinline__ int moe_tables(const Frame& F, const int* cnt) {
    volatile LAS int* tp = (volatile LAS int*)(F.MISC + 64); volatile LAS int* ro = (volatile LAS int*)(F.MISC + 128);
    __syncthreads();
    if (F.wave == 0 && lane_id() == 0) { int t = 0, r = 0; for (int e = 0; e < NEXP; ++e) { const int c = __hip_atomic_load(cnt + e, __ATOMIC_RELAXED, __HIP_MEMORY_SCOPE_AGENT); tp[e] = t; ro[e] = r; t += (c + 255) >> 8; r += c; } tp[NEXP] = t; ro[NEXP] = r; }
    __syncthreads();
    return __builtin_amdgcn_readfirstlane(tp[NEXP]);
}
__device__ __forceinline__ void p7_route(const Frame& F, const MegaArgs& a, const size_t dummy) {
    unsigned char* ws = a.ws; const float* wrg = (const float*)(ws + WS_WRG); const bf16* h2 = (const bf16*)(ws + WS_XN); const float* gln = a.in[17]; const float* br = a.in[19];
    unsigned char* XF8 = ws + WS_XF8 + dummy; int* cnt = (int*)(ws + WS_CTL) + CW_CNT + (dummy ? 64 : 0);   const size_t d2 = dummy ? (WS_QM - WS_TOPI) : 0; int* topi = (int*)(ws + WS_TOPI + d2); float* gate = (float*)(ws + WS_GATE + d2); int* slot = (int*)(ws + WS_SLOT + d2); int* list = (int*)(ws + WS_LIST + d2); float* gsort = (float*)(ws + WS_GSORT + (dummy ? 8 * MiB : 0));
    LAS float* W = (LAS float*)F.lds; int tid = (F.wave << 6) | lane_id(); asm volatile("" : "+v"(tid)); const int lane = tid & 63;
    volatile LAS int* lcnt = (volatile LAS int*)(F.MISC + 16); volatile LAS int* lbase = (volatile LAS int*)(F.MISC + 192); LAS int* rec = (LAS int*)(F.MISC + 256);
    { const bf16* wh = (const bf16*)wrg; LAS unsigned char* Wb = F.lds;
      for (int idx = tid; idx < 8192; idx += NWAVES * 64) { const int pc = idx >> 12, R = (idx >> 5) & 127, c = idx & 31, kq_ = R >> 5, e = R & 31;
          *(LAS u32x4*)(Wb + pc * 65536 + R * 512 + ((c ^ (R & 15)) << 4)) = *(const u32x4*)(wh + (size_t)pc * DM * NEXP + e * DM + 32 * c + 8 * kq_); } }
    if (tid < NEXP) lcnt[tid] = 0;
    __syncthreads();
    const int TPB = T / F.G, t0 = F.vcu * TPB, TPW = TPB / NWAVES;
    const int li = lane & 15, kq = lane >> 4, tw0 = t0 + F.wave * TPW;
    float rs;
    f32x4 d0 = (f32x4){0.f, 0.f, 0.f, 0.f}, d1 = (f32x4){0.f, 0.f, 0.f, 0.f};
    { const bf16* xrow = h2 + (size_t)(tw0 + li) * DM + 8 * kq; const LAS unsigned char* w0 = F.lds + (kq * 32 + li) * 512;
      float ssq = 0.f;
#pragma unroll
      for (int c = 0; c < 4; ++c) { u32x4 xr[8];
#pragma unroll
          for (int u = 0; u < 8; ++u) xr[u] = *(const u32x4*)(xrow + 32 * (8 * c + u));
#pragma unroll
          for (int u = 0; u < 8; ++u) { const int sw = ((8 * c + u) ^ li) << 4; const bf16x8 av = __builtin_bit_cast(bf16x8, xr[u]);
              const bf16x8 bh0 = *(const LAS bf16x8*)(w0 + sw), bl0 = *(const LAS bf16x8*)(w0 + 65536 + sw), bh1 = *(const LAS bf16x8*)(w0 + 8192 + sw), bl1 = *(const LAS bf16x8*)(w0 + 65536 + 8192 + sw);
              d0 = __builtin_amdgcn_mfma_f32_16x16x32_bf16(av, bh0, d0, 0, 0, 0); d1 = __builtin_amdgcn_mfma_f32_16x16x32_bf16(av, bh1, d1, 0, 0, 0);
              d0 = __builtin_amdgcn_mfma_f32_16x16x32_bf16(av, bl0, d0, 0, 0, 0); d1 = __builtin_amdgcn_mfma_f32_16x16x32_bf16(av, bl1, d1, 0, 0, 0);
#pragma unroll
              for (int j = 0; j < 4; ++j) { const float xl = __uint_as_float(xr[u][j] << 16), xh = __uint_as_float(xr[u][j] & 0xffff0000u); ssq += xl * xl + xh * xh; } } }
      ssq += __shfl_xor(ssq, 16); ssq += __shfl_xor(ssq, 32); rs = rsqrtf(ssq * (1.f / DM) + EPS); }
    { const float b0 = br[li], b1 = br[li + 16];
#pragma unroll
      for (int r = 0; r < 4; ++r) { const float rt = __shfl(rs, 4 * kq + r); float c0 = d0[r] * rt + b0, c1 = d1[r] * rt + b1;
        float tv[4]; int ti[4];
#pragma unroll
        for (int k = 0; k < 4; ++k) { float bv = c0; int bi = li; if (c1 > c0) { bv = c1; bi = li + 16; }
#pragma unroll
            for (int o = 1; o < 16; o <<= 1) { const float ov = __shfl_xor(bv, o); const int oi = __shfl_xor(bi, o); if (ov > bv || (ov == bv && oi < bi)) { bv = ov; bi = oi; } }
            tv[k] = bv; ti[k] = bi; if (bi == li) c0 = -INFINITY; if (bi == li + 16) c1 = -INFINITY; }
        const float e1 = __expf(tv[1] - tv[0]), e2 = __expf(tv[2] - tv[0]), e3 = __expf(tv[3] - tv[0]); const float inv = 1.f / (1.f + e1 + e2 + e3);
        const float gs[4] = {inv, e1 * inv, e2 * inv, e3 * inv};
        const int tok = F.wave * TPW + 4 * kq + r;
#pragma unroll
        for (int k = 0; k < 4; ++k) if ((ti[k] & 15) == li) { const int ex = ti[k]; const int ls = __hip_atomic_fetch_add((LAS int*)(lcnt + ex), 1, __ATOMIC_RELAXED, __HIP_MEMORY_SCOPE_WORKGROUP); LAS int* rr = rec + (tok * 4 + k) * 3; rr[0] = ex; rr[1] = __float_as_int(gs[k]); rr[2] = ls; } } }
    { f32x4 gv[4];
#pragma unroll
      for (int j = 0; j < 4; ++j) gv[j] = *(const f32x4*)(gln + 16 * lane + 4 * j);
#pragma unroll
      for (int tb = 0; tb < 16; tb += 8) { u32x4 xw[8][2];
#pragma unroll
          for (int tt = 0; tt < 8; ++tt)
#pragma unroll
              for (int j = 0; j < 2; ++j) xw[tt][j] = *(const u32x4*)(h2 + (size_t)(tw0 + tb + tt) * DM + 16 * lane + 8 * j);
#pragma unroll
          for (int tt = 0; tt < 8; ++tt) { const float rt = __shfl(rs, tb + tt); u32x4 f;
#pragma unroll
              for (int j = 0; j < 4; ++j) { const unsigned a0 = xw[tt][j >> 1][(j & 1) * 2], a1 = xw[tt][j >> 1][(j & 1) * 2 + 1];
                  const f32x4 y = (f32x4){__uint_as_float(a0 << 16), __uint_as_float(a0 & 0xffff0000u), __uint_as_float(a1 << 16), __uint_as_float(a1 & 0xffff0000u)} * rt * gv[j];
                  int w = 0; w = __builtin_amdgcn_cvt_pk_fp8_f32(y[0], y[1], w, false); w = __builtin_amdgcn_cvt_pk_fp8_f32(y[2], y[3], w, true); f[j] = (unsigned)w; }
              *(u32x4*)(XF8 + (size_t)(tw0 + tb + tt) * DM + 16 * lane) = f; } } }
    __syncthreads();
    if (tid < NEXP) lbase[tid] = atomicAdd(cnt + tid, (int)lcnt[tid]);
    __syncthreads();
    for (int idx = tid; idx < TPB * 4; idx += NWAVES * 64) { const LAS int* r = rec + idx * 3; const int e = r[0], sl = lbase[e] + r[2]; const int gi = t0 * 4 + idx;
        topi[gi] = e; gate[gi] = __int_as_float(r[1]); slot[gi] = sl; list[(size_t)e * T + sl] = gi; gsort[(size_t)e * T + sl] = __int_as_float(r[1]); }
}
__device__ __forceinline__ void p10_combine(const Frame& F, const MegaArgs& a, float* dst) {
    unsigned char* ws = a.ws; const unsigned char* Y8 = ws + WS_Y; const bf16* h2 = (const bf16*)(ws + WS_XN); const int* topi = (const int*)(ws + WS_TOPI); const int* slot = (const int*)(ws + WS_SLOT); const float* g = a.in[24];
    const volatile LAS int* ro = (const volatile LAS int*)(F.MISC + 128); int lane = lane_id(); asm volatile("" : "+v"(lane));
    const int t0 = F.vcu * NWAVES + F.wave, ts = F.G * NWAVES;
    f32x4 gv[4];
#pragma unroll
    for (int j = 0; j < 4; ++j) gv[j] = *(const f32x4*)(g + 16 * lane + 4 * j);
    constexpr int NB = 3;
    u32x4 yn[NB][4], hn[NB][2]; int en[NB], sn[NB];
#define P10_IDX(bt) do { _Pragma("unroll") for (int q_ = 0; q_ < NB; ++q_) { const int tt_ = (bt) + q_ * ts; en[q_] = 0; sn[q_] = 0; if (tt_ < T && lane < 4) { en[q_] = topi[tt_ * 4 + lane]; sn[q_] = slot[tt_ * 4 + lane]; } } } while (0)
#define P10_LOAD(bt) do { _Pragma("unroll") for (int q_ = 0; q_ < NB; ++q_) { const int tt_ = (bt) + q_ * ts; if (tt_ < T) { \
        const int pl_ = (lane < 4 ? ro[en[q_]] : 0) + sn[q_]; \
        _Pragma("unroll") for (int k = 0; k < 4; ++k) { const size_t pos = (size_t)__builtin_amdgcn_readlane(pl_, k); yn[q_][k] = *(const u32x4*)(Y8 + pos * DM + 16 * lane); } \
        _Pragma("unroll") for (int j = 0; j < 2; ++j) hn[q_][j] = *(const u32x4*)(h2 + (size_t)tt_ * DM + 16 * lane + 8 * j); } } } while (0)
    P10_IDX(t0); P10_LOAD(t0); P10_IDX(t0 + NB * ts);
    for (int tb = t0; tb < T; tb += NB * ts) {
        u32x4 y[NB][4], hw[NB][2];
#pragma unroll
        for (int q = 0; q < NB; ++q) {
#pragma unroll
            for (int k = 0; k < 4; ++k) y[q][k] = yn[q][k];
#pragma unroll
            for (int j = 0; j < 2; ++j) hw[q][j] = hn[q][j]; }
        if (tb + NB * ts < T) { P10_LOAD(tb + NB * ts); P10_IDX(tb + 2 * NB * ts); }
#pragma unroll
        for (int q = 0; q < NB; ++q) { const int t = tb + q * ts; if (t < T) {
            f32x4 v[4];
#pragma unroll
            for (int j = 0; j < 4; ++j) { f32x4 ys = (f32x4){0.f, 0.f, 0.f, 0.f};
#pragma unroll
                for (int k = 0; k < 4; ++k) { const f32x2 lo = __builtin_amdgcn_cvt_pk_f32_fp8((int)y[q][k][j], false), hi = __builtin_amdgcn_cvt_pk_f32_fp8((int)y[q][k][j], true); ys[0] += lo.x; ys[1] += lo.y; ys[2] += hi.x; ys[3] += hi.y; }
                const unsigned w0 = hw[q][j >> 1][(j & 1) * 2], w1 = hw[q][j >> 1][(j & 1) * 2 + 1];
                v[j] = (f32x4){__uint_as_float(w0 << 16), __uint_as_float(w0 & 0xffff0000u), __uint_as_float(w1 << 16), __uint_as_float(w1 & 0xffff0000u)} + ys * (1.f / Y8_SCALE); }
            float sq = 0.f;
#pragma unroll
            for (int j = 0; j < 4; ++j) sq += sum4sq(v[j]);
            const float r = rsqrtf(wave_sum(sq) * (1.f / DM) + EPS);
#pragma unroll
            for (int j = 0; j < 4; ++j) *(f32x4*)(dst + (size_t)t * DM + 16 * lane + 4 * j) = v[j] * r * gv[j]; } }
    }
#undef P10_LOAD
#undef P10_IDX
}
__global__ void __launch_bounds__(NWAVES * 64, 2) mega_fwd(MegaArgs args) {
    extern __shared__ __attribute__((aligned(16))) unsigned char lds_raw[];
    Frame F;
    F.lds = (LAS unsigned char*)lds_raw; F.MISC = (volatile LAS unsigned*)(F.lds + MISC_OFF); F.tabs = (LAS unsigned*)(F.lds + TABS_OFF);
    F.wave = __builtin_amdgcn_readfirstlane((int)threadIdx.x >> 6);
    F.G = gridDim.x; { const int bx = blockIdx.x; F.vcu = (F.G % 8 == 0) ? (bx % 8) * (F.G / 8) + bx / 8 : bx; }
    unsigned char* ws = args.ws;
    unsigned* ctl = (unsigned*)(ws + WS_CTL);
    for (int u = (F.wave << 6) | lane_id(); u < (LDS_BYTES - MISC_OFF) / 4; u += NWAVES * 64) ((LAS unsigned*)(F.lds + MISC_OFF))[u] = 0u;
    __syncthreads();
    XcdBarrier bar; bar.bar = ctl + CW_BAR; bar.x = 0; bar.st = nullptr; bar.wave0 = false;
    if (args.coop) bar = xcd_barrier_post(ctl + CW_BAR, F.MISC + 8, F.wave);
    const int lo = args.ph_lo, hi = args.ph_hi;
#define IN(k) (lo <= (k) && (k) < hi)
#define SEAM(k) do { if (args.coop && IN(k) && IN((k) + 1)) { xcd_barrier(bar); if ((PROBE_REP) == 100) xcd_barrier(bar); } } while (0)
    bf16 *WinT = (bf16*)(ws + WS_WIN), *WqT = (bf16*)(ws + WS_WQ), *WkvT = (bf16*)(ws + WS_WKV), *WmkvT = (bf16*)(ws + WS_WMKV);
    bf16 *XN = (bf16*)(ws + WS_XN), *PROJ = (bf16*)(ws + WS_PROJ), *QM = (bf16*)(ws + WS_QM), *KVM = (bf16*)(ws + WS_KVM), *MEMN = (bf16*)(ws + WS_MEMN), *KVMEM = (bf16*)(ws + WS_KVMEM);
    float *rope = (float*)(ws + WS_ROPE), *ssqq = (float*)(ws + WS_SSQQ), *ssqkv = (float*)(ws + WS_SSQKV), *LF = (float*)(ws + WS_LF);

    if (IN(0)) { REPS(0) p0_prologue(F, args); }
    if (args.coop == 2) cg::this_grid().sync();
    SEAM(0);
    if (IN(1)) REPS(1) {
        pg8::DenseSched S; S.init(XN, DM, WinT, T, NPROJ, DM, F.G, (int)blockIdx.x);
        EpiProj E{PROJ, ssqq, ssqkv, rope, LF, args.in[8]};
        pg8::gemm_phase<EpiProj, pg8::DenseSched, false>(F.lds, F.tabs, DM, DM, S, E, F.wave);
    }
    SEAM(1);
    if (IN(2)) REPS(2) {
        const int GA = (F.G * 3) / 4, bx = (int)blockIdx.x;
        if (bx >= GA) { const int sid = bx - GA, ns = F.G - GA;
          if (F.wave == 0) for (int it = sid; it < 64; it += ns) { int ln = lane_id(); asm volatile("" : "+v"(ln)); p2_scan_item(LF, (float*)(ws + WS_CUM), (bf16*)(ws + WS_KAUG), it, ln); }
          for (int item = sid * NWAVES + F.wave; item < BATCH * 64; item += ns * NWAVES) {
          { int ln = lane_id(); asm volatile("" : "+v"(ln)); const int b = item >> 6, t = item & 63; const bf16* kr = PROJ + ((size_t)b * SEQ + t * 64 + ln) * NPROJ + C_FK; float* KN = (float*)(ws + WS_KN);
            for (int h = 0; h < 8; ++h) { float s2 = 0.f;
#pragma unroll
                for (int c = 0; c < 8; ++c) { const u32x4 w = *(const u32x4*)(kr + h * 64 + c * 8);
#pragma unroll
                    for (int j = 0; j < 4; ++j) { const float a_ = __uint_as_float(w[j] << 16), b_ = __uint_as_float(w[j] & 0xffff0000u); s2 += a_ * a_ + b_ * b_; } }
#pragma unroll
                for (int o_ = 1; o_ < 64; o_ <<= 1) s2 = fmaxf(s2, __shfl_xor(s2, o_));
                if (ln == 0) KN[(size_t)(b * 8 + h) * 64 + t] = sqrtf(s2); } } } }
        __syncthreads();
        if (F.G >= 8 && (F.G % 32) == 0) {
            if (bx < GA) {
                { pg8::DenseSched S; S.init(PROJ + C_QLAT, NPROJ, WqT, T, 768, 256, GA, bx); EpiScale<4, true> E{QM, 768, ssqq, 1.f / 256.f, rope}; pg8::gemm_phase<EpiScale<4, true>, pg8::DenseSched, false>(F.lds, F.tabs, 256, NPROJ, S, E, F.wave); }
                { pg8::DenseSched S; S.init(PROJ + C_KVLAT, NPROJ, WkvT, T, 1024, 128, GA, bx); EpiScale<4, false> E{KVM, 1024, ssqkv, 1.f / 128.f, nullptr}; pg8::gemm_phase<EpiScale<4, false>, pg8::DenseSched, false>(F.lds, F.tabs, 128, NPROJ, S, E, F.wave); }
            } else {
                pg8::DenseSched S; S.init(MEMN, DM, WmkvT, TM, 2048, DM, F.G - GA, bx - GA); EpiMemKV E{KVMEM, ws + WS_KM8}; pg8::gemm_phase<EpiMemKV, pg8::DenseSched, false>(F.lds, F.tabs, DM, DM, S, E, F.wave);
            }
        }
    }
    SEAM(2);
    if (IN(3)) REPS(3) {
        bf16* O = (bf16*)(ws + WS_O); float* SSO = (float*)(ws + WS_SSO); const bf16* KAUG = (const bf16*)(ws + WS_KAUG);
        int upos = 0; unsigned chdone = 0u;
        for (int P = F.vcu; P < 512; P += F.G) {
            const int bh = P >> 3, pair = P & 7, b = bh >> 3, h = bh & 7;
            for (int j = 0; j < 2; ++j) {
                { const int q_ = upos & 3;
                  for (int i_ = 0; i_ < 2; ++i_) { const int ch = F.vcu + F.G * i_; if (ch < WCHUNKS && (((F.vcu & 3) + 2 * i_) & 3) == q_ && upos < 4) { p0_chunk(F, args, ch); chdone |= 1u << i_; } }
                  ++upos; }
                const int qb = j ? 15 - pair : pair; const size_t r0 = (size_t)b * SEQ, rq = r0 + (size_t)qb * 256;
                att::Src s; s.nt = 4 * (qb + 1); s.q0 = qb * 256; s.ldo = DM; s.kn = nullptr; s.cum = nullptr;
                s.q = QM + rq * 768 + h * 96; s.ldq = 768; s.k1 = KVM + r0 * 1024 + h * 128; s.ldk1 = 1024; s.k2 = PROJ + r0 * NPROJ + C_KPE; s.ldk2 = NPROJ; s.v = KVM + r0 * 1024 + h * 128 + 64; s.ldv = 1024;
                s.o = O + rq * DM + h * 64; s.sso = SSO + rq * 16 + h;
                att::unit<6, 8, 12, 2, true, false, false, true>(s, F.lds, F.wave); }
        }
        for (int i_ = 0; F.vcu + F.G * i_ < WCHUNKS; ++i_) if (i_ >= 2 || !((chdone >> i_) & 1u)) p0_chunk(F, args, F.vcu + F.G * i_);
        if (args.coop) {
            unsigned* fq = ctl + CW_FOXQ; volatile LAS unsigned* tk = F.MISC + 48; const bool lead = F.wave == 0 && lane_id() == 0;
            if (lead) tk[0] = __hip_atomic_fetch_add(fq, 1u, __ATOMIC_RELAXED, __HIP_MEMORY_SCOPE_AGENT);
            __syncthreads();
            unsigned cur = __builtin_amdgcn_readfirstlane(tk[0]);
            while (cur < 1024u) {
                unsigned nx = 0; if (lead) nx = __hip_atomic_fetch_add(fq, 1u, __ATOMIC_RELAXED, __HIP_MEMORY_SCOPE_AGENT);
                const int r = (int)(cur >> 7), qb = 15 - (int)((cur >> 3) & 15), b = (int)(cur & 7);
                const float* bfg = args.in[8]; int h = 0;
                for (int c = 0; c < 8; ++c) { int rk = 0; for (int j = 0; j < 8; ++j) rk += (bfg[j] > bfg[c] || (bfg[j] == bfg[c] && j < c)) ? 1 : 0; if (rk == r) h = c; }
                const size_t r0 = (size_t)b * SEQ, rq = r0 + (size_t)qb * 256;
                att::Src s; s.nt = 4 * (qb + 1); s.q0 = qb * 256; s.ldo = DM;
                s.q = PROJ + rq * NPROJ + C_FQ + h * 64; s.ldq = NPROJ; s.k1 = PROJ + r0 * NPROJ + C_FK + h * 64; s.ldk1 = NPROJ; s.k2 = KAUG + (size_t)(b * 8 + h) * SEQ * 8; s.ldk2 = 8; s.v = PROJ + r0 * NPROJ + C_FV + h * 64; s.ldv = NPROJ;
                s.o = O + rq * DM + 512 + h * 64; s.sso = SSO + rq * 16 + 8 + h; s.kn = (const float*)(ws + WS_KN) + (size_t)(b * 8 + h) * 64; s.cum = (const float*)(ws + WS_CUM) + (size_t)(b * 8 + h) * SEQ;
                att::unit<5, 8, 9, 2, true, true, true, true, true>(s, F.lds, F.wave);
                if (lead) tk[0] = nx;
                __syncthreads();
                cur = __builtin_amdgcn_readfirstlane(tk[0]);
            }
        }
    }
    SEAM(3);
    bf16 *WoT = (bf16*)(ws + WS_WO), *WxqT = (bf16*)(ws + WS_WXQ), *WxoT = (bf16*)(ws + WS_WXO), *XQ = (bf16*)(ws + WS_XQ), *XO = (bf16*)(ws + WS_XO);
    float* ssq1 = (float*)(ws + WS_SSQ1);
    if (IN(4)) REPS(4) {
        pg8::DenseSched S; S.init((const bf16*)(ws + WS_O), DM, WoT, T, DM, DM, F.G, (int)blockIdx.x);
        EpiWo E{(const float*)(ws + WS_SSO), args.in[0], args.out, XN, ssq1, ws + WS_H1F8};
        pg8::gemm_phase<EpiWo, pg8::DenseSched, false>(F.lds, F.tabs, DM, DM, S, E, F.wave);
    }
    SEAM(4);
    if (IN(5)) REPS(5) {
        pg8::DenseSched S; S.init((const bf16*)(ws + WS_H1F8), DM / 2, WxqT, T, DM, DM / 2, F.G, (int)blockIdx.x);
        { EpiXQ8 E{ws + WS_XQ, ssq1, XQ8_SCALE / (H8_SCALE * WXQ8_SCALE)}; pg8::gemm_phase<EpiXQ8, pg8::DenseSched, false, true>(F.lds, F.tabs, DM, DM, S, E, F.wave); }
        asm volatile("s_waitcnt vmcnt(0)" ::: "memory"); __syncthreads();
        __builtin_amdgcn_fence(__ATOMIC_ACQUIRE, "agent"); asm volatile("s_waitcnt vmcnt(0)" ::: "memory"); __syncthreads();
        pg8::Unit u; pg8::DenseSched S2; S2.init(XN, DM, WxqT, T, DM, DM, F.G, (int)blockIdx.x);
        for (int i = 0; S2.next(i, u); ++i) {
            const int b = u.row0 / SEQ, h = u.pn;
            { att::Src s; s.kn = nullptr; s.cum = nullptr; s.nt = MEMLEN / 64; s.q0 = 0; s.q = (const bf16*)(ws + WS_XQ + (size_t)u.row0 * DM + h * 256); s.ldq = DM; s.k1 = (const bf16*)(ws + WS_KM8 + (size_t)b * MEMLEN * 1024 + h * 256); s.ldk1 = 1024; s.k2 = s.k1; s.ldk2 = 1024;
              s.v = KVMEM + (size_t)b * MEMLEN * 2048 + 1024 + h * 256; s.ldv = 2048; s.o = (bf16*)(ws + WS_XOF8 + (size_t)u.row0 * DM + h * 256); s.ldo = DM; s.sso = nullptr;
              att::xunit(s, F.lds, F.wave); }
        }
    }
    SEAM(5);
    if (IN(6)) {
        pg8::DenseSched S; S.init((const bf16*)(ws + WS_XOF8), DM / 2, WxoT, T, DM, DM / 2, F.G, (int)blockIdx.x);
        EpiAddOut E{XN, 1.f / (XO8_SCALE * WXO8_SCALE)};
        pg8::gemm_phase<EpiAddOut, pg8::DenseSched, false, true>(F.lds, F.tabs, DM, DM, S, E, F.wave);
    }
    SEAM(6);
    int* cnt = (int*)(ws + WS_CTL) + CW_CNT; const int* list = (const int*)(ws + WS_LIST);
    if (IN(7)) { if ((PROBE_REP) == 7) p7_route(F, args, (size_t)(WS_KVM - WS_XF8)); p7_route(F, args, 0); }
    SEAM(7);
    if (IN(8)) REPS(8) {
        const int nMt = moe_tables(F, cnt);
        MoeSched S; S.o.init(nMt, 2048 / 256, F.G, (int)blockIdx.x); S.tables((const volatile LAS int*)(F.MISC + 64), (const volatile LAS int*)(F.MISC + 128));
        S.A = (const char*)(ws + WS_XF8); S.a_row_bytes = 0; S.Wt = (const char*)(ws + WS_WGU); S.w_exp_bytes = (size_t)2048 * DM; S.brow = DM; S.list = list; S.gather = true;
        EpiGateUp E{args.in[21], ws + WS_ACT};
        pg8::gemm_phase<EpiGateUp, MoeSched, true, true>(F.lds, F.tabs, DM, DM, S, E, F.wave);
    }
    SEAM(8);
    if (IN(9)) REPS(9) {
        const int nMt = __builtin_amdgcn_readfirstlane(((const volatile LAS int*)(F.MISC + 64))[NEXP]);
        MoeSched S; S.o.init(nMt, DM / 256, F.G, (int)blockIdx.x); S.tables((const volatile LAS int*)(F.MISC + 64), (const volatile LAS int*)(F.MISC + 128));
        S.A = (const char*)(ws + WS_ACT); S.a_row_bytes = (size_t)DEXP; S.Wt = (const char*)(ws + WS_WD); S.w_exp_bytes = (size_t)DM * DEXP; S.brow = DEXP; S.list = list; S.gather = false;
        EpiDown E{args.in[23], (const float*)(ws + WS_GSORT), list, ws + WS_Y};
        pg8::gemm_phase<EpiDown, MoeSched, false, true>(F.lds, F.tabs, DEXP, DEXP, S, E, F.wave);
    }
    SEAM(9);
    if (IN(10)) { if ((PROBE_REP) == 10) p10_combine(F, args, (float*)(ws + WS_XQ)); p10_combine(F, args, args.out); }
#undef IN
#undef SEAM
}
extern "C" void kernel_launch(void* const* d_in, const int* in_sizes, int n_in, void* d_out, int out_size, void* d_ws, size_t ws_size, hipStream_t stream) {
    if (n_in != 25 || ws_size < WS_END || out_size != T * DM) { fprintf(stderr, "kernel_launch: unexpected shapes n_in %d ws %zu out %d\n", n_in, ws_size, out_size); return; }
    static int grid = 0;
    if (grid == 0) {
        int dev = 0, cus = 0, per_cu = 0;
        if (hipGetDevice(&dev) != hipSuccess || hipDeviceGetAttribute(&cus, hipDeviceAttributeMultiprocessorCount, dev) != hipSuccess) { fprintf(stderr, "kernel_launch: device query failed\n"); grid = -1; return; }
        if (hipFuncSetAttribute((const void*)mega_fwd, hipFuncAttributeMaxDynamicSharedMemorySize, LDS_BYTES) != hipSuccess) { fprintf(stderr, "kernel_launch: hipFuncSetAttribute failed\n"); grid = -1; return; }
        if (hipOccupancyMaxActiveBlocksPerMultiprocessor(&per_cu, (const void*)mega_fwd, NWAVES * 64, LDS_BYTES) != hipSuccess || per_cu < 1) { fprintf(stderr, "kernel_launch: occupancy query says %d blocks per CU\n", per_cu); (void)hipGetLastError(); grid = -1; return; }
        grid = cus;
    }
    if (grid < 0) return;
    (void)hipMemsetAsync((char*)d_ws + WS_CTL, 0, 1 * MiB, stream);
    MegaArgs a{}; for (int i = 0; i < 25; ++i) a.in[i] = (const float*)d_in[i]; a.out = (float*)d_out; a.ws = (unsigned char*)d_ws; a.ph_lo = 0; a.ph_hi = N_PHASES; a.coop = 1;
    void* params[] = {&a};
    const hipError_t e = hipLaunchCooperativeKernel((const void*)mega_fwd, dim3(grid), dim3(NWAVES * 64), params, LDS_BYTES, stream);
    if (e != hipSuccess) fprintf(stderr, "cooperative launch failed: %s (grid %d)\n", hipGetErrorString(e), grid);
}
```

```cpp
#include <hip/hip_runtime.h>
#include <cstdio>
#include <cstdint>

constexpr int DM = 1024, BATCH = 8, SEQ = 4096, T = BATCH * SEQ, MEMLEN = 256, TM = BATCH * MEMLEN;
constexpr int NPROJ = 2048;
constexpr int C_QLAT = 0, C_KVLAT = 256, C_KPE = 384, C_FQ = 416, C_FK = 928, C_FV = 1440, C_FL = 1952, IN_COLS = 1960;
constexpr int NEXP = 32, TOPK = 4, DEXP = 1024;
constexpr float EPS = 1e-6f, LOG2E = 1.4426950408889634f;
constexpr float C2M = 0.10206207261596577f * LOG2E;
constexpr float C2F = 0.125f * LOG2E;
constexpr float C2X = 0.0625f * LOG2E;

typedef unsigned short bf16;
__device__ __forceinline__ float bf2f(bf16 v) { return __uint_as_float(((unsigned)v) << 16); }
__device__ __forceinline__ bf16 f2bf(float f) { unsigned u = __float_as_uint(f); return (bf16)((u + 0x7fffu + ((u >> 16) & 1u)) >> 16); }

constexpr size_t MiB = 1u << 20;
constexpr size_t WS_CTL = 0;
constexpr size_t WS_ROPE = 1 * MiB;
constexpr size_t WS_CUM = 2 * MiB;
constexpr size_t WS_KAUG = 3 * MiB;
constexpr size_t WS_SSQQ = 7 * MiB;
constexpr size_t WS_SSQKV = 7 * MiB + 512 * 1024;
constexpr size_t WS_SSO = 8 * MiB;
constexpr size_t WS_SSQ1 = 994 * MiB;
constexpr size_t WS_TOPI = 10 * MiB + 512 * 1024;
constexpr size_t WS_GATE = 11 * MiB;
constexpr size_t WS_SLOT = 11 * MiB + 512 * 1024;
constexpr size_t WS_LIST = 12 * MiB;
constexpr size_t WS_WIN = 16 * MiB;
constexpr size_t WS_WQ = 20 * MiB;
constexpr size_t WS_WKV = 20 * MiB + 512 * 1024;
constexpr size_t WS_WO = 21 * MiB;
constexpr size_t WS_WXQ = 23 * MiB;
constexpr size_t WS_WMKV = 25 * MiB;
constexpr size_t WS_WXO = 29 * MiB;
constexpr size_t WS_WGU = 32 * MiB;
constexpr size_t WS_WD = 160 * MiB;
constexpr size_t WS_XN = 224 * MiB;
constexpr size_t WS_PROJ = 288 * MiB;
constexpr size_t WS_QM = 416 * MiB;
constexpr size_t WS_KVM = 464 * MiB;
constexpr size_t WS_O = 528 * MiB;
constexpr size_t WS_XQ = 592 * MiB;
constexpr size_t WS_XO = 656 * MiB;
constexpr size_t WS_MEMN = 720 * MiB;
constexpr size_t WS_KVMEM = 724 * MiB;
constexpr size_t WS_ACT = 736 * MiB;
constexpr size_t WS_SC = 736 * MiB;
constexpr size_t WS_Y = 288 * MiB;
constexpr size_t WS_END = 1000 * MiB;
constexpr int CW_CNT = 64;

#include <hip/hip_cooperative_groups.h>
#include <type_traits>
namespace cg = cooperative_groups;
#define LAS __attribute__((address_space(3)))
#define GAS __attribute__((address_space(1)))
typedef short bf16x8 __attribute__((ext_vector_type(8)));
typedef short s16x4 __attribute__((ext_vector_type(4)));
typedef float f32x4 __attribute__((ext_vector_type(4)));
typedef float f32x2 __attribute__((ext_vector_type(2)));
typedef float f32x16 __attribute__((ext_vector_type(16)));
typedef unsigned u32x4 __attribute__((ext_vector_type(4)));
typedef unsigned u32x2 __attribute__((ext_vector_type(2)));
typedef __bf16 bf16x2_t __attribute__((ext_vector_type(2)));
__device__ __forceinline__ unsigned cvtpk(float lo, float hi) { f32x2 v = {lo, hi}; bf16x2_t b = __builtin_convertvector(v, bf16x2_t); return __builtin_bit_cast(unsigned, b); }
__device__ __forceinline__ int lane_id() { int l; asm volatile("v_mbcnt_lo_u32_b32 %0, -1, 0\n\tv_mbcnt_hi_u32_b32 %0, -1, %0" : "=v"(l)); return l; }
__device__ __forceinline__ float wave_sum(float v) {
#pragma unroll
    for (int o = 1; o < 64; o <<= 1) v += __shfl_xor(v, o);
    return v;
}

constexpr float XQ8_SCALE = 32.f;
constexpr float WXQ8_SCALE = 256.f, WXO8_SCALE = 32.f, H8_SCALE = 4.f, XO8_SCALE = 64.f;
namespace pg8 {
constexpr int BM = 256, BK = 64, HALF = 128, HTB = HALF * BK * 2  , STAGE_BYTES = 8 * HTB, NXCD = 8, WGM = 8;
__host__ __device__ __forceinline__ int lds_byte(int r, int c) { const int st = (r >> 4) * 2 + (c >> 5), rr = r & 15, cc = c & 31, ob = rr * 64 + cc * 2; return st * 1024 + (ob ^ (((ob >> 9) & 1) << 5)); }
__host__ __device__ __forceinline__ void stage_rc(int b, int& R, int& C) { const int st = b / 1024, sb = b % 1024, swz = sb ^ (((sb >> 9) & 1) << 5); R = (st >> 1) * 16 + swz / 64; C = (st & 1) * 32 + (swz % 64) / 2; }
__host__ __device__ __forceinline__ int perm32(int rho) { const int n = rho >> 4, i = rho & 15; return 8 * (i >> 2) + 4 * n + (i & 3); }

struct Unit { int row0, col0, rows, pn, e; const char* a; const char* b; const int* list; };

typedef int i32x8 __attribute__((ext_vector_type(8)));
typedef int i32x4 __attribute__((ext_vector_type(4)));
template <class Epi, class Sched, bool GATHER, bool F8 = false>
__device__ __forceinline__ void gemm_phase(LAS unsigned char* lds, LAS unsigned* tabs, const int K, const int lda, const Sched& S, const Epi& E, const int wave) {
    int tid_ = (wave << 6) | lane_id(); asm volatile("" : "+v"(tid_));
    const int tid = tid_, wid = __builtin_amdgcn_readfirstlane(tid >> 6), lane = tid & 63, wr = wid >> 2, wc = wid & 3, fr = lane & 15, fq = lane >> 4;
    const int nt = K / (F8 ? 128 : BK);
    const int rowA = F8 ? lda : 2 * lda, rowB = F8 ? K : 2 * K;
    unsigned vB[2], vA[2], vcu[2][2];
#pragma unroll
    for (int i = 0; i < 2; ++i) { int R, C; stage_rc(tid * 16 + i * 8192, R, C); const int Rb = Epi::PERM ? ((R & ~31) + perm32(R & 31)) : R;
        vB[i] = (unsigned)(Rb * rowB + 2 * C); vA[i] = (unsigned)(R * rowA + 2 * C);
#pragma unroll
        for (int h = 0; h < 2; ++h) vcu[h][i] = 0u; }
    const size_t hstepA = (size_t)HALF * rowA;
    const size_t kstep = (size_t)(BK * 2);
    const size_t hstepB = (size_t)HALF * rowB;
    const unsigned ldsw = (unsigned)wid * 1024u;
    const unsigned lds_u32 = (unsigned)__builtin_amdgcn_readfirstlane((int)(unsigned)(size_t)lds);
    const int aoff = lds_byte(wr * 64 + fr, F8 ? fq * 16 : fq * 8); int boff = lds_byte(wc * 32 + fr, F8 ? fq * 16 : fq * 8) + 4 * HTB;
    asm volatile("" : "+v"(boff));
#define PG8_SA(b, h) (((b) * 2 + (h)) * HTB)
#define PG8_SB(b, h) ((4 + (b) * 2 + (h)) * HTB)
#define PG8_STAGE(bufoff, gbase, voff) do { const unsigned long long _gb = (unsigned long long)(gbase); \
        const unsigned _glo = __builtin_amdgcn_readfirstlane((unsigned)_gb), _ghi = __builtin_amdgcn_readfirstlane((unsigned)(_gb >> 32)); const unsigned long long _sb = ((unsigned long long)_ghi << 32) | _glo; \
        _Pragma("unroll") for (int _i = 0; _i < 2; ++_i) { unsigned _keep; const unsigned _dst = lds_u32 + (unsigned)(bufoff) + ldsw + _i * 8192u; \
        asm volatile("s_mov_b32 %0, m0\n\ts_mov_b32 m0, %3\n\ts_nop 0\n\tglobal_load_lds_dwordx4 %1, %2\n\ts_mov_b32 m0, %0" : "=&s"(_keep) : "v"((voff)[_i]), "s"(_sb), "s"(_dst) : "memory"); } } while (0)
#define PG8_STAGE_A(bufoff, gbase, h, vsel) do { if constexpr (GATHER) { PG8_STAGE(bufoff, gbase, (vsel)[h]); } else { PG8_STAGE(bufoff, (gbase) + (h) * hstepA, vA); } } while (0)
#define PG8_RD8(dst, off) do { const i32x4 _l = *(const LAS i32x4*)(lds + (off)), _h = *(const LAS i32x4*)(lds + (off) + 16); dst = __builtin_shufflevector(_l, _h, 0, 1, 2, 3, 4, 5, 6, 7); } while (0)
#define PG8_LDA(dst, dst8, b, h) do { if constexpr (F8) { _Pragma("unroll") for (int m = 0; m < 4; ++m) PG8_RD8(dst8[m], PG8_SA(b, h) + aoff + m * 2048); } \
        else { _Pragma("unroll") for (int m = 0; m < 4; ++m) _Pragma("unroll") for (int k = 0; k < 2; ++k) dst[m][k] = *(const LAS bf16x8*)(lds + PG8_SA(b, h) + aoff + m * 2048 + k * 1024); } } while (0)
#define PG8_LDB(dst, dst8, b, h) do { if constexpr (F8) { _Pragma("unroll") for (int n = 0; n < 2; ++n) PG8_RD8(dst8[n], ((b) * 2 + (h)) * HTB + boff + n * 2048); } \
        else { _Pragma("unroll") for (int n = 0; n < 2; ++n) _Pragma("unroll") for (int k = 0; k < 2; ++k) dst[n][k] = *(const LAS bf16x8*)(lds + ((b) * 2 + (h)) * HTB + boff + n * 2048 + k * 1024); } } while (0)
#define PG8_MMA(ai, bj, At, At8, Bt, Bt8) do { __builtin_amdgcn_s_setprio(1); _Pragma("unroll") for (int m = 0; m < 4; ++m) _Pragma("unroll") for (int n = 0; n < 2; ++n) { \
        if constexpr (F8) acc[ai][bj][m][n] = __builtin_amdgcn_mfma_scale_f32_16x16x128_f8f6f4(Bt8[n], At8[m], acc[ai][bj][m][n], 0, 0, 0, 0x7F7F7F7F, 0, 0x7F7F7F7F); \
        else { _Pragma("unroll") for (int k = 0; k < 2; ++k) acc[ai][bj][m][n] = __builtin_amdgcn_mfma_f32_16x16x32_bf16(Bt[n][k], At[m][k], acc[ai][bj][m][n], 0, 0, 0); } } \
        __builtin_amdgcn_s_setprio(0); } while (0)
#define PG8_WAIT_V(n) asm volatile("s_waitcnt vmcnt(" #n ")" ::: "memory")
#define PG8_WAIT_L(n) asm volatile("s_waitcnt lgkmcnt(" #n ")" ::: "memory")
#define PG8_BAR __builtin_amdgcn_s_barrier()
#define PG8_SCHED __builtin_amdgcn_sched_barrier(0)
#define PG8_TABDMA(u, slot) __builtin_amdgcn_global_load_lds((const unsigned*)((u).list + lane_id() * 4), (LAS unsigned*)(tabs + (slot) * 256), 16, 0, 0)
#define PG8_TABOFF(dst, slot) do { const int _tid = (wid << 6) | lane_id(); _Pragma("unroll") for (int _i = 0; _i < 2; ++_i) { int _R, _C; stage_rc(_tid * 16 + _i * 8192, _R, _C); \
        _Pragma("unroll") for (int _h = 0; _h < 2; ++_h) { unsigned _t = tabs[(slot) * 256 + _h * HALF + _R] >> 2; _t = _t < (unsigned)(T - 1) ? _t : (unsigned)(T - 1); \
        dst[_h][_i] = _t * (unsigned)rowA + 2u * (unsigned)_C; } } } while (0)
    __builtin_amdgcn_s_waitcnt(0x0F70);
    Unit cur, nxt; int ui = 0;
    if (!S.next(0, cur)) return;
    if constexpr (GATHER) { PG8_TABDMA(cur, 0); PG8_WAIT_V(0); PG8_BAR; PG8_TABOFF(vcu, 0); PG8_WAIT_L(0); }
    f32x4 acc[2][2][4][2];
    bf16x8 At[4][2], B0[2][2], B1[2][2]; i32x8 At8[4], B08[2], B18[2];
    const char* cA = cur.a; const char* cB = cur.b;
    PG8_STAGE(PG8_SB(0, 0), cB, vB); PG8_STAGE(PG8_SB(0, 1), cB + hstepB, vB); PG8_STAGE_A(PG8_SA(0, 0), cA, 0, vcu); PG8_STAGE_A(PG8_SA(0, 1), cA, 1, vcu);
    if (wr == 1) PG8_BAR;
    PG8_WAIT_V(2); PG8_BAR;
    PG8_STAGE(PG8_SB(1, 0), cB + kstep, vB); PG8_STAGE_A(PG8_SA(1, 0), cA + kstep, 0, vcu); PG8_STAGE(PG8_SB(1, 1), cB + hstepB + kstep, vB);
    PG8_WAIT_V(6); PG8_BAR;
    asm volatile("" ::: "memory");
#pragma unroll
    for (int a = 0; a < 2; ++a)
#pragma unroll
        for (int b = 0; b < 2; ++b)
#pragma unroll
            for (int m = 0; m < 4; ++m)
#pragma unroll
                for (int n = 0; n < 2; ++n) acc[a][b][m][n] = (f32x4){0.f, 0.f, 0.f, 0.f};
    for (;;) {
        const bool has_next = S.next(ui + 1, nxt);
        if constexpr (GATHER) { if (has_next) PG8_TABDMA(nxt, (ui + 1) & 1); }
        const char* nA = has_next ? nxt.a : cA; const char* nB = has_next ? nxt.b : cB;
#pragma nounroll
        for (int t = 0; t < nt; t += 2) {
            const bool last = (t == nt - 2);
            if constexpr (Epi::MID) { if (t == nt / 2) { const int l2_ = lane_id(); E.mid(acc, cur, wr, l2_ & 15); } }
            unsigned v2[2][2];
#pragma unroll
            for (int h = 0; h < 2; ++h)
#pragma unroll
                for (int i = 0; i < 2; ++i) v2[h][i] = vcu[h][i];
            if constexpr (GATHER) { if (last && has_next) { PG8_TABOFF(v2, (ui + 1) & 1); PG8_WAIT_L(0); } }
            const char* a1 = cA + (size_t)(t + 1) * kstep;
            const char* a2 = last ? nA : cA + (size_t)(t + 2) * kstep; const char* b2 = last ? nB : cB + (size_t)(t + 2) * kstep;
            const char* a3 = a2 + kstep; const char* b3 = b2 + kstep;
            PG8_LDB(B0, B08, 0, 0); PG8_LDB(B1, B18, 0, 1); PG8_SCHED; PG8_LDA(At, At8, 0, 0); PG8_STAGE_A(PG8_SA(1, 1), a1, 1, vcu);
            PG8_WAIT_V(8); PG8_WAIT_L(0); PG8_BAR; PG8_MMA(0, 0, At, At8, B0, B08); PG8_MMA(0, 1, At, At8, B1, B18); PG8_BAR; PG8_SCHED;
            PG8_LDA(At, At8, 0, 1); PG8_STAGE(PG8_SB(0, 0), b2, vB); PG8_STAGE(PG8_SB(0, 1), b2 + hstepB, vB); PG8_STAGE_A(PG8_SA(0, 0), a2, 0, v2);
            PG8_WAIT_V(8); PG8_WAIT_L(0); PG8_BAR; PG8_MMA(1, 0, At, At8, B0, B08); PG8_MMA(1, 1, At, At8, B1, B18); PG8_BAR; PG8_SCHED;
            PG8_LDB(B0, B08, 1, 0); PG8_LDB(B1, B18, 1, 1); PG8_SCHED; PG8_LDA(At, At8, 1, 0); PG8_STAGE_A(PG8_SA(0, 1), a2, 1, v2);
            PG8_WAIT_V(8); PG8_WAIT_L(0); PG8_BAR; PG8_MMA(0, 0, At, At8, B0, B08); PG8_MMA(0, 1, At, At8, B1, B18); PG8_BAR; PG8_SCHED;
            PG8_LDA(At, At8, 1, 1); PG8_STAGE(PG8_SB(1, 0), b3, vB); PG8_STAGE(PG8_SB(1, 1), b3 + hstepB, vB); PG8_STAGE_A(PG8_SA(1, 0), a3, 0, v2);
            PG8_WAIT_V(8); PG8_WAIT_L(0); PG8_BAR; PG8_MMA(1, 0, At, At8, B0, B08); PG8_MMA(1, 1, At, At8, B1, B18); PG8_BAR; PG8_SCHED;
        }
        if (wr == 0) PG8_BAR;
        { const int l2_ = lane_id(); E(acc, cur, wr, wc, l2_ & 15, l2_ >> 4); }
        if (!has_next) break;
#pragma unroll
        for (int a = 0; a < 2; ++a)
#pragma unroll
            for (int b = 0; b < 2; ++b)
#pragma unroll
                for (int m = 0; m < 4; ++m)
#pragma unroll
                    for (int n = 0; n < 2; ++n) acc[a][b][m][n] = (f32x4){0.f, 0.f, 0.f, 0.f};
        cur = nxt; cA = nA; cB = nB; ++ui;
        if constexpr (GATHER) { PG8_TABOFF(vcu, ui & 1); PG8_WAIT_L(0); }
        if (wr == 1) PG8_BAR;
    }
    PG8_WAIT_V(0);
    PG8_BAR;
#undef PG8_SA
#undef PG8_SB
#undef PG8_STAGE
#undef PG8_STAGE_A
#undef PG8_RD8
#undef PG8_LDA
#undef PG8_LDB
#undef PG8_MMA
#undef PG8_TABDMA
#undef PG8_TABOFF
}
struct TileOrder {
    int nM, nN, nwg, G, c;
    __device__ __forceinline__ void init(int nM_, int nN_, int G_, int c_) { nM = nM_; nN = nN_; nwg = nM * nN; G = G_; c = c_; }
    __device__ __forceinline__ bool tile(int i, int& pm, int& pn) const {
        const int L = i * G + c; if (L >= nwg) return false;
        int wgid = L; { const int q = nwg / NXCD, r = nwg % NXCD, xcd = wgid % NXCD, off = wgid / NXCD; wgid = (xcd < r ? xcd * (q + 1) : r * (q + 1) + (xcd - r) * q) + off; }
        const int nig = WGM * nN, gid = wgid / nig, fm = gid * WGM, gsz = (nM - fm) < WGM ? (nM - fm) : WGM;
        pm = fm + ((wgid % nig) % gsz); pn = (wgid % nig) / gsz; return true;
    }
};
struct DenseSched {
    TileOrder o; const char* A; const char* Bt; int lda, K;
    __device__ __forceinline__ void init(const bf16* A_, int lda_, const bf16* Bt_, int M, int N, int K_, int G, int c) { o.init(M / BM, N / BM, G, c); A = (const char*)A_; Bt = (const char*)Bt_; lda = lda_; K = K_; }
    __device__ __forceinline__ bool next(int i, Unit& u) const { int pm, pn; if (!o.tile(i, pm, pn)) return false; u.row0 = pm * BM; u.col0 = pn * BM; u.rows = BM; u.pn = pn; u.e = 0;
        u.a = A + (size_t)pm * BM * lda * 2; u.b = Bt + (size_t)pn * BM * K * 2; u.list = nullptr; return true; }
};
}

__device__ __forceinline__ float sum4sq(const f32x4& v) { return (v[0] * v[0] + v[1] * v[1]) + (v[2] * v[2] + v[3] * v[3]); }
__device__ __forceinline__ void st_bf4(bf16* p, const f32x4& v) { u32x2 w; w.x = cvtpk(v[0], v[1]); w.y = cvtpk(v[2], v[3]); *(u32x2*)p = w; }
__device__ __forceinline__ int cofs8(int fq) { return 4 * fq + (fq & 1) * 12; }
__device__ __forceinline__ void st_bf8(bf16* p, const f32x4& v0, const f32x4& v1) {
    const unsigned a0 = cvtpk(v0[0], v0[1]), a1 = cvtpk(v0[2], v0[3]), b0 = cvtpk(v1[0], v1[1]), b1 = cvtpk(v1[2], v1[3]);
    const auto r0 = __builtin_amdgcn_permlane16_swap(a0, b0, false, false), r1 = __builtin_amdgcn_permlane16_swap(a1, b1, false, false);
    *(u32x4*)p = (u32x4){r0[0], r1[0], r0[1], r1[1]}; }
struct EpiProj {
    static constexpr bool PERM = false, MID = false;
    bf16* PROJ; float* ssqq; float* ssqkv; const float* rope; float* LF; const float* bfor;
    __device__ __forceinline__ void operator()(f32x4 (&acc)[2][2][4][2], const pg8::Unit& u, int wr, int wc, int fr, int fq) const {
        asm volatile("" : "+v"(fr), "+v"(fq));
        const bool rp1 = (u.pn == 1) && (wc == 0);
        f32x4 ca[8], cb[8];
        if (rp1) {
#pragma unroll
            for (int g = 0; g < 8; ++g) { const int pos = (u.row0 + (g >> 2) * 128 + wr * 64 + (g & 3) * 16 + fr) & (SEQ - 1); const float* q = rope + 2 * (pos * 16 + fq * 4); ca[g] = *(const f32x4*)q; cb[g] = *(const f32x4*)(q + 4); } }
#pragma unroll
        for (int ai = 0; ai < 2; ++ai)
#pragma unroll
            for (int m = 0; m < 4; ++m) {
                const int row = u.row0 + ai * 128 + wr * 64 + m * 16 + fr;
                if (u.pn == 0) { float s = (sum4sq(acc[ai][0][m][0]) + sum4sq(acc[ai][0][m][1])) + (sum4sq(acc[ai][1][m][0]) + sum4sq(acc[ai][1][m][1]));
                    s += __shfl_xor(s, 16); s += __shfl_xor(s, 32); if (fq == 0) ssqq[(size_t)row * 4 + wc] = s; }
                if (u.pn == 1) { float s = sum4sq(acc[ai][0][m][0]) + sum4sq(acc[ai][0][m][1]);
                    s += __shfl_xor(s, 16); s += __shfl_xor(s, 32); if (fq == 0) ssqkv[(size_t)row * 4 + wc] = s;
                    if (wc == 0) { const f32x4 x1 = acc[ai][1][m][0], x2 = acc[ai][1][m][1]; f32x4 y1, y2; const f32x4 c0 = ca[ai * 4 + m], c1 = cb[ai * 4 + m];
#pragma unroll
                        for (int e = 0; e < 4; ++e) { const float cx = e < 2 ? c0[2 * e] : c1[2 * e - 4], sx = e < 2 ? c0[2 * e + 1] : c1[2 * e - 3]; y1[e] = x1[e] * cx - x2[e] * sx; y2[e] = x2[e] * cx + x1[e] * sx; }
                        acc[ai][1][m][0] = y1; acc[ai][1][m][1] = y2; } }
                if (u.pn == 7 && wc == 1 && fq < 2) { const f32x4 z4 = acc[ai][1][m][0]; f32x4 lf;
#pragma unroll
                    for (int e = 0; e < 4; ++e) { const float z = z4[e] + bfor[fq * 4 + e]; lf[e] = fminf(z, 0.f) - 0.6931471805599453f * __builtin_amdgcn_logf(1.f + __builtin_amdgcn_exp2f(-LOG2E * fabsf(z))); }
                    *(f32x4*)(LF + (size_t)row * 8 + fq * 4) = lf; }
                bf16* rp = PROJ + (size_t)row * NPROJ + u.col0 + wc * 32 + cofs8(fq);
#pragma unroll
                for (int bj = 0; bj < 2; ++bj) st_bf8(rp + bj * 128, acc[ai][bj][m][0], acc[ai][bj][m][1]);
                asm volatile("" ::: "memory");
            }
    }
};
template <int NS, bool ROPE> struct EpiScale {
    static constexpr bool PERM = false, MID = false;
    bf16* C; int ldc; const float* ss; float inv_n; const float* rope; float osc = 1.f;
    __device__ __forceinline__ void operator()(f32x4 (&acc)[2][2][4][2], const pg8::Unit& u, int wr, int wc, int fr, int fq) const {
        asm volatile("" : "+v"(fr), "+v"(fq));
        const int rbase = u.row0 + wr * 64 + fr;
        f32x4 q[8], ca[8], cb[8]; int bjr = -1;
        if constexpr (ROPE) { const int g0 = (u.col0 >> 5) + wc; bjr = (g0 % 3 == 2) ? 0 : (((g0 + 4) % 3 == 2) ? 1 : -1);
            if (bjr >= 0) {
#pragma unroll
                for (int g = 0; g < 8; ++g) { const int pos = (rbase + (g >> 2) * 128 + (g & 3) * 16) & (SEQ - 1); const float* qq = rope + 2 * (pos * 16 + fq * 4); ca[g] = *(const f32x4*)qq; cb[g] = *(const f32x4*)(qq + 4); } } }
        float q1[8];
        if constexpr (NS == 16) {
#pragma unroll
            for (int g = 0; g < 8; ++g) q[g] = *(const f32x4*)(ss + (size_t)(rbase + (g >> 2) * 128 + (g & 3) * 16) * NS + 4 * fq); }
        if constexpr (NS == 4) {
#pragma unroll
            for (int g = 0; g < 8; ++g) q1[g] = ss[(size_t)(rbase + (g >> 2) * 128 + (g & 3) * 16) * 4 + fq]; }
#pragma unroll
        for (int g = 0; g < 8; ++g) { const int ai = g >> 2, m = g & 3;
                const int row = rbase + ai * 128 + m * 16; float sc = 1.f;
                if constexpr (NS > 0) { float t = NS == 16 ? (q[g][0] + q[g][1]) + (q[g][2] + q[g][3]) : q1[g];
                    t += __shfl_xor(t, 16); t += __shfl_xor(t, 32);
                    sc = rsqrtf(t * inv_n + EPS) * osc; }
                bf16* rp = C + (size_t)row * ldc + u.col0 + wc * 32 + cofs8(fq);
#pragma unroll
                for (int bj = 0; bj < 2; ++bj) {
                    f32x4 v0 = acc[ai][bj][m][0] * sc, v1 = acc[ai][bj][m][1] * sc;
                    if constexpr (ROPE) { if (bj == bjr) { f32x4 y1, y2; const f32x4 c0 = ca[g], c1 = cb[g];
#pragma unroll
                        for (int e = 0; e < 4; ++e) { const float cx = e < 2 ? c0[2 * e] : c1[2 * e - 4], sx = e < 2 ? c0[2 * e + 1] : c1[2 * e - 3]; y1[e] = v0[e] * cx - v1[e] * sx; y2[e] = v1[e] * cx + v0[e] * sx; }
                        v0 = y1; v1 = y2; } }
                    st_bf8(rp + bj * 128, v0, v1);
                }
                asm volatile("" ::: "memory");
            }
    }
};

__device__ __forceinline__ u32x2 pack8_f8(const f32x4& v0, const f32x4& v1, float sc) {
    f32x4 a0, a1;
#pragma unroll
    for (int e = 0; e < 4; ++e) { const auto r = __builtin_amdgcn_permlane16_swap(__float_as_uint(v0[e]), __float_as_uint(v1[e]), false, false); a0[e] = __uint_as_float(r[0]) * sc; a1[e] = __uint_as_float(r[1]) * sc; }
    int w0 = 0, w1 = 0; w0 = __builtin_amdgcn_cvt_pk_fp8_f32(a0[0], a0[1], w0, false); w0 = __builtin_amdgcn_cvt_pk_fp8_f32(a0[2], a0[3], w0, true);
    w1 = __builtin_amdgcn_cvt_pk_fp8_f32(a1[0], a1[1], w1, false); w1 = __builtin_amdgcn_cvt_pk_fp8_f32(a1[2], a1[3], w1, true); return (u32x2){(unsigned)w0, (unsigned)w1}; }
struct EpiMemKV {
    static constexpr bool PERM = false, MID = false;   static constexpr int NST = 16;
    bf16* C; unsigned char* k8;
    __device__ __forceinline__ void operator()(f32x4 (&acc)[2][2][4][2], const pg8::Unit& u, int wr, int wc, int fr, int fq) const {
        asm volatile("" : "+v"(fr), "+v"(fq));
        const int rbase = u.row0 + wr * 64 + fr;
#pragma unroll
        for (int g = 0; g < 8; ++g) { const int ai = g >> 2, m = g & 3; const int row = rbase + ai * 128 + m * 16; const int cc = u.col0 + wc * 32 + cofs8(fq);
#pragma unroll
            for (int bj = 0; bj < 2; ++bj) {
                if (u.pn < 4) *(u32x2*)(k8 + (size_t)row * 1024 + cc + bj * 128) = pack8_f8(acc[ai][bj][m][0], acc[ai][bj][m][1], 1.f);
                else st_bf8(C + (size_t)row * 2048 + cc + bj * 128, acc[ai][bj][m][0], acc[ai][bj][m][1]); }
            asm volatile("" ::: "memory"); }
    }
};
struct EpiXQ8 {
    static constexpr bool PERM = false, MID = false;   static constexpr int NST = 16;
    unsigned char* C8; const float* ss; float osc;
    __device__ __forceinline__ void operator()(f32x4 (&acc)[2][2][4][2], const pg8::Unit& u, int wr, int wc, int fr, int fq) const {
        asm volatile("" : "+v"(fr), "+v"(fq));
        const int rbase = u.row0 + wr * 64 + fr; f32x4 q[8];
#pragma unroll
        for (int g = 0; g < 8; ++g) q[g] = *(const f32x4*)(ss + (size_t)(rbase + (g >> 2) * 128 + (g & 3) * 16) * 16 + 4 * fq);
#pragma unroll
        for (int g = 0; g < 8; ++g) { const int ai = g >> 2, m = g & 3; const int row = rbase + ai * 128 + m * 16;
            float t = (q[g][0] + q[g][1]) + (q[g][2] + q[g][3]); t += __shfl_xor(t, 16); t += __shfl_xor(t, 32);
            const float sc = rsqrtf(t * (1.f / 1024.f) + EPS) * osc;
#pragma unroll
            for (int bj = 0; bj < 2; ++bj) *(u32x2*)(C8 + (size_t)row * DM + u.col0 + wc * 32 + cofs8(fq) + bj * 128) = pack8_f8(acc[ai][bj][m][0], acc[ai][bj][m][1], sc);
            asm volatile("" ::: "memory"); }
    }
};

struct EpiWo {
    static constexpr bool PERM = false, MID = true;
    const float* sso; const float* rmsx; const float* gmix; bf16* hb; float* ssq1; unsigned char* h8;
    __device__ __forceinline__ void mid(f32x4 (&acc)[2][2][4][2], const pg8::Unit& u, int wr, int fr) const {
        asm volatile("" : "+v"(fr));
        int fq = lane_id() >> 4; asm volatile("" : "+v"(fq));
        const int rbase = u.row0 + wr * 64 + fr; f32x4 p[8];
#pragma unroll
        for (int g = 0; g < 8; ++g) p[g] = *((const f32x4*)(sso + (size_t)(rbase + (g >> 2) * 128 + (g & 3) * 16) * 16) + fq);
#pragma unroll
        for (int g = 0; g < 8; ++g) { const int ai = g >> 2, m = g & 3;
            float t = (p[g][0] + p[g][1]) + (p[g][2] + p[g][3]); t += __shfl_xor(t, 16); const float o = __shfl_xor(t, 32);
            const float sm = fq < 2 ? t : o, sf = fq < 2 ? o : t;
            const float ratio = rsqrtf(sm * (1.f / 512.f) + EPS) / rsqrtf(sf * (1.f / 512.f) + EPS);
#pragma unroll
            for (int bj = 0; bj < 2; ++bj)
#pragma unroll
                for (int n = 0; n < 2; ++n) acc[ai][bj][m][n] *= ratio;
            asm volatile("" ::: "memory"); }
    }
    __device__ __forceinline__ void operator()(f32x4 (&acc)[2][2][4][2], const pg8::Unit& u, int wr, int wc, int fr, int fq) const {
        asm volatile("" : "+v"(fr), "+v"(fq));
        const int rbase = u.row0 + wr * 64 + fr; const int cs = u.col0 + wc * 32 + cofs8(fq);
        u32x4 xc[2], xn[2]; f32x4 sf4[8]; float ssg[8], rmx[8]; unsigned w8p[2][2]; f32x4 ig[2][2];
#pragma unroll
        for (int g = 0; g < 8; ++g) { const int rr_ = rbase + (g >> 2) * 128 + (g & 3) * 16; sf4[g] = *((const f32x4*)(sso + (size_t)rr_ * 16) + 2 + (fq & 1)); rmx[g] = rmsx[rr_]; }
#pragma unroll
        for (int bj = 0; bj < 2; ++bj) { xc[bj] = *(const u32x4*)(hb + (size_t)rbase * DM + cs + bj * 128);
#pragma unroll
            for (int n = 0; n < 2; ++n) { const f32x4 gg = *(const f32x4*)(gmix + cs + bj * 128 + 4 * n); ig[bj][n] = (f32x4){__builtin_amdgcn_rcpf(gg[0]), __builtin_amdgcn_rcpf(gg[1]), __builtin_amdgcn_rcpf(gg[2]), __builtin_amdgcn_rcpf(gg[3])}; } }
#pragma unroll
        for (int g = 0; g < 8; ++g) { const int ai = g >> 2, m = g & 3; const int row = rbase + ai * 128 + m * 16;
            if (g + 1 < 8) { const int rn = rbase + ((g + 1) >> 2) * 128 + ((g + 1) & 3) * 16;
#pragma unroll
                for (int bj = 0; bj < 2; ++bj) xn[bj] = *(const u32x4*)(hb + (size_t)rn * DM + cs + bj * 128); }
            float tf = (sf4[g][0] + sf4[g][1]) + (sf4[g][2] + sf4[g][3]); tf += __shfl_xor(tf, 16);
            const float rf = rsqrtf(tf * (1.f / 512.f) + EPS), rx = rmx[g];
            const size_t off = (size_t)row * DM + cs; float ss = 0.f;
#pragma unroll
            for (int bj = 0; bj < 2; ++bj) { const u32x4 w = xc[bj];
                f32x4 a0, a1;
#pragma unroll
                for (int e = 0; e < 4; ++e) { const auto r = __builtin_amdgcn_permlane16_swap(__float_as_uint(acc[ai][bj][m][0][e]), __float_as_uint(acc[ai][bj][m][1][e]), false, false); a0[e] = __uint_as_float(r[0]) * rf; a1[e] = __uint_as_float(r[1]) * rf; }
                a0 += (f32x4){__uint_as_float(w.x << 16), __uint_as_float(w.x & 0xffff0000u), __uint_as_float(w.y << 16), __uint_as_float(w.y & 0xffff0000u)} * ig[bj][0] * rx;
                a1 += (f32x4){__uint_as_float(w.z << 16), __uint_as_float(w.z & 0xffff0000u), __uint_as_float(w.w << 16), __uint_as_float(w.w & 0xffff0000u)} * ig[bj][1] * rx;
                ss += sum4sq(a0) + sum4sq(a1);
                *(u32x4*)(hb + off + bj * 128) = (u32x4){cvtpk(a0[0], a0[1]), cvtpk(a0[2], a0[3]), cvtpk(a1[0], a1[1]), cvtpk(a1[2], a1[3])};
                int w0 = 0, w1 = 0; w0 = __builtin_amdgcn_cvt_pk_fp8_f32(a0[0] * H8_SCALE, a0[1] * H8_SCALE, w0, false); w0 = __builtin_amdgcn_cvt_pk_fp8_f32(a0[2] * H8_SCALE, a0[3] * H8_SCALE, w0, true);
                w1 = __builtin_amdgcn_cvt_pk_fp8_f32(a1[0] * H8_SCALE, a1[1] * H8_SCALE, w1, false); w1 = __builtin_amdgcn_cvt_pk_fp8_f32(a1[2] * H8_SCALE, a1[3] * H8_SCALE, w1, true);
                if ((g & 1) == 0) { w8p[bj][0] = (unsigned)w0; w8p[bj][1] = (unsigned)w1; }
                else {
                    const auto r0 = __builtin_amdgcn_permlane32_swap(w8p[bj][0], (unsigned)w0, false, false), r1 = __builtin_amdgcn_permlane32_swap(w8p[bj][1], (unsigned)w1, false, false);
                    const int rw = row - ((fq < 2) ? 16 : 0);
                    *(u32x4*)(h8 + (size_t)rw * DM + u.col0 + wc * 32 + (fq & 1) * 16 + bj * 128) = (u32x4){r0[0], r1[0], r0[1], r1[1]}; } }
            ss += __shfl_xor(ss, 16); ss += __shfl_xor(ss, 32); ssg[g] = ss;
            asm volatile("" ::: "memory");
#pragma unroll
            for (int bj = 0; bj < 2; ++bj) xc[bj] = xn[bj]; }
        { const float s0 = fq == 0 ? ssg[0] : fq == 1 ? ssg[1] : fq == 2 ? ssg[2] : ssg[3], s1 = fq == 0 ? ssg[4] : fq == 1 ? ssg[5] : fq == 2 ? ssg[6] : ssg[7];
          float* sp = ssq1 + (size_t)(rbase + fq * 16) * 16 + u.pn * 4 + wc; sp[0] = s0; sp[128 * 16] = s1; }
    }
};
struct EpiAddOut {
    static constexpr bool PERM = false, MID = false;
    bf16* hb; float osc;
    __device__ __forceinline__ void operator()(f32x4 (&acc)[2][2][4][2], const pg8::Unit& u, int wr, int wc, int fr, int fq) const {
        asm volatile("" : "+v"(fr), "+v"(fq));
        const int rbase = u.row0 + wr * 64 + fr; const int cb = u.col0 + wc * 32 + cofs8(fq);
        u32x4 xc[2], xn[2];
#pragma unroll
        for (int bj = 0; bj < 2; ++bj) xc[bj] = *(const u32x4*)(hb + (size_t)rbase * DM + cb + bj * 128);
#pragma unroll
        for (int g = 0; g < 8; ++g) { const int ai = g >> 2, m = g & 3; const int row = rbase + ai * 128 + m * 16;
            if (g + 1 < 8) { const int rn = rbase + ((g + 1) >> 2) * 128 + ((g + 1) & 3) * 16;
#pragma unroll
                for (int bj = 0; bj < 2; ++bj) xn[bj] = *(const u32x4*)(hb + (size_t)rn * DM + cb + bj * 128); }
#pragma unroll
            for (int bj = 0; bj < 2; ++bj) { const u32x4 w = xc[bj]; f32x4 a0, a1;
#pragma unroll
                for (int e = 0; e < 4; ++e) { const auto r = __builtin_amdgcn_permlane16_swap(__float_as_uint(acc[ai][bj][m][0][e]), __float_as_uint(acc[ai][bj][m][1][e]), false, false); a0[e] = __uint_as_float(r[0]) * osc; a1[e] = __uint_as_float(r[1]) * osc; }
                const f32x4 h0 = (f32x4){__uint_as_float(w.x << 16), __uint_as_float(w.x & 0xffff0000u), __uint_as_float(w.y << 16), __uint_as_float(w.y & 0xffff0000u)} + a0;
                const f32x4 h1 = (f32x4){__uint_as_float(w.z << 16), __uint_as_float(w.z & 0xffff0000u), __uint_as_float(w.w << 16), __uint_as_float(w.w & 0xffff0000u)} + a1;
                *(u32x4*)(hb + (size_t)row * DM + cb + bj * 128) = (u32x4){cvtpk(h0[0], h0[1]), cvtpk(h0[2], h0[3]), cvtpk(h1[0], h1[1]), cvtpk(h1[2], h1[3])}; }
            asm volatile("" ::: "memory");
#pragma unroll
            for (int bj = 0; bj < 2; ++bj) xc[bj] = xn[bj]; }
    }
};

namespace att {
__device__ __forceinline__ int crow(int r, int hi) { return (r & 3) + 8 * (r >> 2) + 4 * hi; }
struct Src { const bf16* q; int ldq; const bf16* k1; int ldk1; const bf16* k2; int ldk2; const bf16* v; int ldv; bf16* o; int ldo; float* sso; int nt; int q0; const float* kn; const float* cum; };
typedef short v4i16_t __attribute__((ext_vector_type(4)));
__device__ __forceinline__ s16x4 vtr(const LAS unsigned char* p) { return __builtin_bit_cast(s16x4, __builtin_amdgcn_ds_read_tr16_b64_v4i16((LAS v4i16_t*)p)); }
__device__ __forceinline__ float rowmax32(const f32x16& p0, const f32x16& p1) {
    float a = fmaxf(fmaxf(p0[0], p0[1]), p1[0]), b = fmaxf(fmaxf(p0[2], p0[3]), p1[1]); a = fmaxf(fmaxf(a, p1[2]), p1[3]);
#pragma unroll
    for (int r = 4; r < 16; r += 4) { a = fmaxf(fmaxf(a, p0[r]), p0[r + 1]); b = fmaxf(fmaxf(b, p0[r + 2]), p0[r + 3]); a = fmaxf(fmaxf(a, p1[r]), p1[r + 1]); b = fmaxf(fmaxf(b, p1[r + 2]), p1[r + 3]); }
    const float m = fmaxf(a, b);
    auto rr = __builtin_amdgcn_permlane32_swap(__float_as_uint(m), __float_as_uint(m), false, false);
    return fmaxf(__uint_as_float(rr[0]), __uint_as_float(rr[1]));
}
template <int I, int N, class F> __device__ __forceinline__ void cfor(F&& f) { if constexpr (I < N) { f(std::integral_constant<int, I>{}); cfor<I + 1, N>(f); } }
template <int D0, int NKS, bool AUG> __device__ __forceinline__ void kread(bf16x8& f0, bf16x8& f1, unsigned base, unsigned abase) {
    if constexpr (AUG && D0 == NKS - 1) { asm volatile("ds_read_b128 %0, %1 offset:8192" : "=v"(f0) : "v"(abase)); asm volatile("ds_read_b128 %0, %1 offset:8704" : "=v"(f1) : "v"(abase)); }
    else { asm volatile("ds_read_b128 %0, %1 offset:%2" : "=v"(f0) : "v"(base), "n"(D0 * 2048)); asm volatile("ds_read_b128 %0, %1 offset:%2" : "=v"(f1) : "v"(base), "n"(D0 * 2048 + 512)); }
}
template <int NKS, int NC1, int NCH, int ND0, bool CAUSAL, bool AUG, bool REV, bool WSSO, bool EARLY = false, bool ASMK = true>
__device__ __forceinline__ void unit(const Src& s, LAS unsigned char* lds, const int wave) {
    int tid_ = (wave << 6) | lane_id(); asm volatile("" : "+v"(tid_));
    const int tid = tid_, lane = tid & 63, r32 = lane & 31, hi = lane >> 5, wid = __builtin_amdgcn_readfirstlane(tid >> 6);
    constexpr int KSL = NCH * 1024, VSL = ND0 * 4096, KPW = (NCH + 7) / 8, VPW = ND0 / 2;
    constexpr int VOFF = 2 * KSL, WSF = VOFF + 2 * VSL;
    constexpr float THR = 8.f;
    LAS float* wsf = (LAS float*)(lds + WSF) + wid * 64;
    bf16x8 qr[NKS];
    { const bf16* qw = s.q + (size_t)(wid * 32 + r32) * s.ldq + hi * 8;
#pragma unroll
      for (int d0 = 0; d0 < NKS; ++d0) { if (AUG && d0 == NKS - 1) { const short one = hi ? (short)0 : (short)0x3F80; qr[d0] = (bf16x8){one, one, one, 0, 0, 0, 0, 0}; } else qr[d0] = *(const bf16x8*)(qw + d0 * 16); } }
    LAS float* shf = (LAS float*)(lds + WSF + 2048);
    float thr = 0.f;
    if constexpr (EARLY) {
        float q2 = 0.f;
#pragma unroll
        for (int d0 = 0; d0 < NKS - 1; ++d0)
#pragma unroll
            for (int j = 0; j < 8; ++j) { const float f = __uint_as_float(((unsigned)(unsigned short)qr[d0][j]) << 16); q2 += f * f; }
        { auto rr = __builtin_amdgcn_permlane32_swap(__float_as_uint(q2), __float_as_uint(q2), false, false); q2 = __uint_as_float(rr[0]) + __uint_as_float(rr[1]); }
#pragma unroll
        for (int o_ = 1; o_ < 32; o_ <<= 1) q2 = fmaxf(q2, __shfl_xor(q2, o_));
        if (lane == 0) shf[wid] = q2;
        float kn = s.kn[lane];
#pragma unroll
        for (int o_ = 1; o_ < 64; o_ <<= 1) { const float up = __shfl_up(kn, o_); if (lane >= o_) kn = fmaxf(kn, up); }
        thr = kn;
    }
    u32x4 kreg[2][KPW], vreg[2][VPW];
#define ATT_LOAD(t, S_) do { \
    _Pragma("unroll") for (int i_ = 0; i_ < KPW; ++i_) { const int c_ = (wid + 8 * i_ < NCH) ? wid + 8 * i_ : wid; const size_t row_ = (size_t)(t) * 64 + lane;     \
        const bf16* g_ = (c_ < NC1) ? s.k1 + row_ * s.ldk1 + c_ * 8 : s.k2 + row_ * s.ldk2 + (c_ - NC1) * 8; kreg[S_][i_] = *(const u32x4*)g_; } \
    _Pragma("unroll") for (int i_ = 0; i_ < VPW; ++i_) { const int p_ = wid + 8 * i_; const int dh_ = p_ >> 2, rg_ = p_ & 3; \
        vreg[S_][i_] = *(const u32x4*)(s.v + ((size_t)(t) * 64 + 16 * rg_ + (lane >> 2)) * s.ldv + dh_ * 32 + (lane & 3) * 8); } } while (0)
#define ATT_WRITE(slot, S_) do { \
    _Pragma("unroll") for (int i_ = 0; i_ < KPW; ++i_) { const int c_ = (wid + 8 * i_ < NCH) ? wid + 8 * i_ : wid; *(LAS u32x4*)(lds + (slot) * KSL + c_ * 1024 + lane * 16) = kreg[S_][i_]; } \
    _Pragma("unroll") for (int i_ = 0; i_ < VPW; ++i_) { const int p_ = wid + 8 * i_; *(LAS u32x4*)(lds + VOFF + (slot) * VSL + p_ * 1024 + lane * 16) = vreg[S_][i_]; } } while (0)
    const int nt = s.nt;
    ATT_LOAD(REV ? nt - 1 : 0, 0); ATT_LOAD(REV ? nt - 2 : 1, 1); ATT_WRITE(0, 0);
    __syncthreads();
    if constexpr (EARLY) { float qm = shf[0];
#pragma unroll
        for (int w = 1; w < 8; ++w) qm = fmaxf(qm, shf[w]);
        thr = sqrtf(qm) * thr * 1.001f - s.cum[64 * lane + 63] * LOG2E; }
    float m = 0.f, l = 0.f; f32x16 o[ND0]; bool have = false;
    f32x16 negm = f32x16{};
#pragma unroll
    for (int d = 0; d < ND0; ++d) o[d] = f32x16{};
    const int qmin = s.q0 + wid * 32;
    auto body = [&](auto parc, const int i) -> bool { constexpr int PAR = decltype(parc)::value;
        const int t = REV ? nt - 1 - i : i; constexpr int cur = PAR;
        if constexpr (EARLY) { if (i > 0) { float mmin = shf[8 + (PAR ^ 1) * 8];
#pragma unroll
            for (int w = 1; w < 8; ++w) mmin = fminf(mmin, shf[8 + (PAR ^ 1) * 8 + w]);
            const float bound = __uint_as_float(__builtin_amdgcn_readlane(__float_as_uint(thr), t));
            if (bound - mmin < -40.f) return false; } }
        { const int t2 = REV ? (t >= 2 ? t - 2 : 0) : (t + 2 < nt ? t + 2 : nt - 1); ATT_LOAD(t2, PAR); }
        const bool skip = CAUSAL && (64 * t > qmin + 31);
        if (!skip) {
            const LAS unsigned char* kb = lds + cur * KSL + r32 * 16;
            f32x16 p0 = negm, p1 = negm;
            if constexpr (!ASMK) {
                const LAS unsigned char* kq = kb + hi * 1024; bf16x8 ka[8], kc[8];
#pragma unroll
                for (int d = 0; d < 4; ++d) { ka[2 * d] = *(const LAS bf16x8*)(kq + d * 2048); ka[2 * d + 1] = *(const LAS bf16x8*)(kq + d * 2048 + 512); }
#pragma unroll
                for (int g0 = 0; g0 < NKS; g0 += 4) {
                    if (g0 + 4 < NKS) {
#pragma unroll
                        for (int d = 0; d < 4; ++d) { kc[2 * d] = *(const LAS bf16x8*)(kq + (g0 + 4 + d) * 2048); kc[2 * d + 1] = *(const LAS bf16x8*)(kq + (g0 + 4 + d) * 2048 + 512); } }
                    __builtin_amdgcn_sched_group_barrier(0x100, 8, 0);
#pragma unroll
                    for (int d = 0; d < 4; ++d) { p0 = __builtin_amdgcn_mfma_f32_32x32x16_bf16(ka[2 * d], qr[g0 + d], p0, 0, 0, 0); p1 = __builtin_amdgcn_mfma_f32_32x32x16_bf16(ka[2 * d + 1], qr[g0 + d], p1, 0, 0, 0); }
                    __builtin_amdgcn_sched_group_barrier(0x008, 8, 0);
#pragma unroll
                    for (int z = 0; z < 8; ++z) ka[z] = kc[z];
                }
            } else {
            constexpr int KB = (NKS % 3 == 0 || NKS == 5) ? 3 : 4, NB = (NKS + KB - 1) / KB;
            const unsigned kbase = (unsigned)(size_t)(kb + hi * 1024), abase = (unsigned)(size_t)kb;
            bf16x8 kfa[2 * KB], kfb[2 * KB];
#pragma unroll
            for (int z_ = 0; z_ < 2 * KB; ++z_) { kfa[z_] = bf16x8{}; kfb[z_] = bf16x8{}; }
            cfor<0, KB>([&](auto ic) { constexpr int D = decltype(ic)::value; if constexpr (D < NKS) kread<D, NKS, AUG>(kfa[2 * D], kfa[2 * D + 1], kbase, abase); });
            cfor<0, NB>([&](auto bc) { constexpr int B = decltype(bc)::value;
                if constexpr (B % 2 == 0) { if constexpr (KB == 3) asm volatile("s_waitcnt lgkmcnt(0)" : "+v"(kfa[0]), "+v"(kfa[1]), "+v"(kfa[2]), "+v"(kfa[3]), "+v"(kfa[4]), "+v"(kfa[5]) :: "memory");
                                            else asm volatile("s_waitcnt lgkmcnt(0)" : "+v"(kfa[0]), "+v"(kfa[1]), "+v"(kfa[2]), "+v"(kfa[3]), "+v"(kfa[4]), "+v"(kfa[5]), "+v"(kfa[6]), "+v"(kfa[7]) :: "memory"); }
                else { if constexpr (KB == 3) asm volatile("s_waitcnt lgkmcnt(0)" : "+v"(kfb[0]), "+v"(kfb[1]), "+v"(kfb[2]), "+v"(kfb[3]), "+v"(kfb[4]), "+v"(kfb[5]) :: "memory");
                       else asm volatile("s_waitcnt lgkmcnt(0)" : "+v"(kfb[0]), "+v"(kfb[1]), "+v"(kfb[2]), "+v"(kfb[3]), "+v"(kfb[4]), "+v"(kfb[5]), "+v"(kfb[6]), "+v"(kfb[7]) :: "memory"); }
                __builtin_amdgcn_sched_barrier(0);
                if constexpr (B % 2 == 0) {
                    cfor<0, KB>([&](auto ic) { constexpr int D = (B + 1) * KB + decltype(ic)::value; if constexpr (D < NKS) kread<D, NKS, AUG>(kfb[2 * decltype(ic)::value], kfb[2 * decltype(ic)::value + 1], kbase, abase); });
                    __builtin_amdgcn_sched_barrier(0);
                    cfor<0, KB>([&](auto ic) { constexpr int D = B * KB + decltype(ic)::value; if constexpr (D < NKS) { p0 = __builtin_amdgcn_mfma_f32_32x32x16_bf16(kfa[2 * decltype(ic)::value], qr[D], p0, 0, 0, 0); p1 = __builtin_amdgcn_mfma_f32_32x32x16_bf16(kfa[2 * decltype(ic)::value + 1], qr[D], p1, 0, 0, 0); } });
                } else {
                    cfor<0, KB>([&](auto ic) { constexpr int D = (B + 1) * KB + decltype(ic)::value; if constexpr (D < NKS) kread<D, NKS, AUG>(kfa[2 * decltype(ic)::value], kfa[2 * decltype(ic)::value + 1], kbase, abase); });
                    __builtin_amdgcn_sched_barrier(0);
                    cfor<0, KB>([&](auto ic) { constexpr int D = B * KB + decltype(ic)::value; if constexpr (D < NKS) { p0 = __builtin_amdgcn_mfma_f32_32x32x16_bf16(kfb[2 * decltype(ic)::value], qr[D], p0, 0, 0, 0); p1 = __builtin_amdgcn_mfma_f32_32x32x16_bf16(kfb[2 * decltype(ic)::value + 1], qr[D], p1, 0, 0, 0); } });
                }
            });
            }
            const LAS unsigned char* vb = lds + VOFF + cur * VSL + ((lane >> 4) & 1) * 32 + (lane & 3) * 8 + (4 * hi + ((lane & 15) >> 2)) * 64;
            s16x4 vlo[2][4], vhi[2][4];
#pragma unroll
            for (int d = 0; d < 2; ++d)
#pragma unroll
                for (int ks = 0; ks < 4; ++ks) { vlo[d][ks] = vtr(vb + d * 4096 + ks * 1024); vhi[d][ks] = vtr(vb + d * 4096 + ks * 1024 + 512); }
            __builtin_amdgcn_sched_group_barrier(0x100, 16, 0);
            if (CAUSAL && (64 * t + 63 > qmin)) { const int q = qmin + r32, kv0 = 64 * t + 4 * hi;
#pragma unroll
                for (int r = 0; r < 16; ++r) { const int kv = kv0 + (r & 3) + 8 * (r >> 2); if (kv > q) p0[r] = -INFINITY; if (kv + 32 > q) p1[r] = -INFINITY; } }
            const float rmd = rowmax32(p0, p1);
            if (!have || __any(rmd > THR)) {
                const float dd = have ? fmaxf(rmd, 0.f) : rmd, alpha = have ? __builtin_amdgcn_exp2f(-dd) : 1.f; l *= alpha; m += dd;
#pragma unroll
                for (int r = 0; r < 16; ++r) { p0[r] -= dd; p1[r] -= dd; negm[r] = -m; }
                if (have) {
                    if (hi == 0) wsf[r32] = alpha;
                    asm volatile("s_waitcnt lgkmcnt(0)" ::: "memory");
#pragma unroll
                    for (int r = 0; r < 16; ++r) { const float a = wsf[crow(r, hi)];
#pragma unroll
                        for (int d = 0; d < ND0; ++d) o[d][r] *= a; } }
                have = true;
            }
            float sacc = 0.f;
#pragma unroll
            for (int r = 0; r < 16; ++r) { p0[r] = __builtin_amdgcn_exp2f(p0[r]); p1[r] = __builtin_amdgcn_exp2f(p1[r]); sacc += p0[r] + p1[r]; }
            l += sacc;
            u32x4 pw[4];
#pragma unroll
            for (int j = 0; j < 4; ++j) { pw[0][j] = cvtpk(p0[2 * j], p0[2 * j + 1]); pw[1][j] = cvtpk(p0[8 + 2 * j], p0[8 + 2 * j + 1]); pw[2][j] = cvtpk(p1[2 * j], p1[2 * j + 1]); pw[3][j] = cvtpk(p1[8 + 2 * j], p1[8 + 2 * j + 1]); }
#pragma unroll
            for (int d = 0; d < 2; ++d)
#pragma unroll
                for (int ks = 0; ks < 4; ++ks) { const bf16x8 vf = (bf16x8){vlo[d][ks][0], vlo[d][ks][1], vlo[d][ks][2], vlo[d][ks][3], vhi[d][ks][0], vhi[d][ks][1], vhi[d][ks][2], vhi[d][ks][3]};
                    o[d] = __builtin_amdgcn_mfma_f32_32x32x16_bf16(__builtin_bit_cast(bf16x8, pw[ks]), vf, o[d], 0, 0, 0); }
            if constexpr (ND0 > 2) {
#pragma unroll
                for (int d = 2; d < ND0; d += 2) { s16x4 wlo[2][4], whi[2][4];
#pragma unroll
                    for (int e = 0; e < 2; ++e)
#pragma unroll
                        for (int ks = 0; ks < 4; ++ks) { wlo[e][ks] = vtr(vb + (d + e) * 4096 + ks * 1024); whi[e][ks] = vtr(vb + (d + e) * 4096 + ks * 1024 + 512); }
#pragma unroll
                    for (int e = 0; e < 2; ++e)
#pragma unroll
                        for (int ks = 0; ks < 4; ++ks) { const bf16x8 vf = (bf16x8){wlo[e][ks][0], wlo[e][ks][1], wlo[e][ks][2], wlo[e][ks][3], whi[e][ks][0], whi[e][ks][1], whi[e][ks][2], whi[e][ks][3]};
                            o[d + e] = __builtin_amdgcn_mfma_f32_32x32x16_bf16(__builtin_bit_cast(bf16x8, pw[ks]), vf, o[d + e], 0, 0, 0); }
                    __builtin_amdgcn_sched_group_barrier(0x100, 16, 1); __builtin_amdgcn_sched_group_barrier(0x008, 8, 1); } }
        }
        ATT_WRITE(cur ^ 1, PAR ^ 1);
        if constexpr (EARLY) { float mw = have ? m : -1e30f;
#pragma unroll
            for (int o_ = 1; o_ < 32; o_ <<= 1) mw = fminf(mw, __shfl_xor(mw, o_));
            if (lane == 0) shf[8 + PAR * 8 + wid] = mw; }
        __syncthreads();
        return true;
    };
    for (int i = 0; i < nt; i += 2) { if (!body(std::integral_constant<int, 0>{}, i)) break; if (!body(std::integral_constant<int, 1>{}, i + 1)) break; }
    { auto rr = __builtin_amdgcn_permlane32_swap(__float_as_uint(l), __float_as_uint(l), false, false); l = __uint_as_float(rr[0]) + __uint_as_float(rr[1]); }
    if (hi == 0) wsf[32 + r32] = 1.f / l;
    asm volatile("s_waitcnt lgkmcnt(0)" ::: "memory");
    LAS bf16* stg = (LAS bf16*)(lds + wid * (ND0 * 2048));
#pragma unroll
    for (int r = 0; r < 16; ++r) { const float rl = wsf[32 + crow(r, hi)]; const int orow = crow(r, hi);
#pragma unroll
        for (int d = 0; d < ND0; ++d) stg[orow * (ND0 * 32) + d * 32 + r32] = f2bf(o[d][r] * rl); }
    asm volatile("s_waitcnt lgkmcnt(0)" ::: "memory");
    constexpr int CPR = ND0 * 4, RPI = 64 / CPR;
    bf16* ow = s.o + (size_t)(wid * 32) * s.ldo;
#pragma unroll
    for (int it = 0; it < 32 / RPI; ++it) { const int row = it * RPI + lane / CPR, ch = lane % CPR; const u32x4 v = *(const LAS u32x4*)(stg + row * (ND0 * 32) + ch * 8);
        *(u32x4*)(ow + (size_t)row * s.ldo + ch * 8) = v;
        if (WSSO) { float ss = 0.f;
#pragma unroll
            for (int j = 0; j < 4; ++j) { const float a = __uint_as_float(v[j] << 16), b = __uint_as_float(v[j] & 0xffff0000u); ss += a * a + b * b; }
#pragma unroll
            for (int sh = 1; sh < CPR; sh <<= 1) ss += __shfl_xor(ss, sh);
            if (ch == 0) s.sso[(size_t)(wid * 32 + row) * 16] = ss; } }
    __syncthreads();
#undef ATT_LOAD
#undef ATT_WRITE
}
__device__ __forceinline__ void xunit(const Src& s, LAS unsigned char* lds, const int wave) {
    int tid_ = (wave << 6) | lane_id(); asm volatile("" : "+v"(tid_));
    const int tid = tid_, lane = tid & 63, r32 = lane & 31, hi = lane >> 5, wid = __builtin_amdgcn_readfirstlane(tid >> 6);
    constexpr int KSL = 16384, VSL = 16384, VOFF = 2 * KSL, STG = VOFF + 2 * VSL;
    LAS float* wsf = (LAS float*)(lds + 131072) + wid * 64;
    f32x16 p[4][2];
#pragma unroll
    for (int t = 0; t < 4; ++t) { p[t][0] = f32x16{}; p[t][1] = f32x16{}; }
    typedef int xi4 __attribute__((ext_vector_type(4))); typedef int xi8 __attribute__((ext_vector_type(8)));
    u32x4 sreg[2][2];
#define X_LOAD(J) do { if constexpr ((J) < 4) { _Pragma("unroll") for (int i_ = 0; i_ < 2; ++i_) sreg[(J) & 1][i_] = *(const u32x4*)((const unsigned char*)s.k1 + (size_t)((J) * 64 + lane) * s.ldk1 + (wid + 8 * i_) * 16); } \
        else if constexpr ((J) < 12) { _Pragma("unroll") for (int i_ = 0; i_ < 2; ++i_) { const int p_ = wid + 8 * i_, dh_ = p_ >> 2, rg_ = p_ & 3; \
            sreg[(J) & 1][i_] = *(const u32x4*)(s.v + (size_t)(((J) & 3) * 64 + 16 * rg_ + (lane >> 2)) * s.ldv + (((J) - 4) >> 2) * 128 + dh_ * 32 + (lane & 3) * 8); } } } while (0)
#define X_WRITE(J) do { if constexpr ((J) < 12) { _Pragma("unroll") for (int i_ = 0; i_ < 2; ++i_) *(LAS u32x4*)(lds + ((J) < 4 ? 0 : VOFF) + ((J) & 1) * KSL + (wid + 8 * i_) * 1024 + lane * 16) = sreg[(J) & 1][i_]; } } while (0)
    X_LOAD(0); X_LOAD(1);
    xi8 q8[4];
    { const unsigned char* qw8 = (const unsigned char*)s.q + (size_t)(wid * 32 + r32) * s.ldq + hi * 32;
#pragma unroll
      for (int s_ = 0; s_ < 4; ++s_) { const xi4 lo_ = *(const xi4*)(qw8 + 64 * s_), hi_ = *(const xi4*)(qw8 + 64 * s_ + 16); q8[s_] = __builtin_shufflevector(lo_, hi_, 0, 1, 2, 3, 4, 5, 6, 7); } }
    X_WRITE(0);
    __syncthreads();
    cfor<0, 4>([&](auto ic) { constexpr int I = decltype(ic)::value;
        X_LOAD(I + 2);
        const LAS unsigned char* kq = lds + (I & 1) * KSL + r32 * 16 + hi * 2048; xi8 kf[8];
#pragma unroll
        for (int s_ = 0; s_ < 4; ++s_)
#pragma unroll
            for (int kb = 0; kb < 2; ++kb) { const xi4 lo_ = *(const LAS xi4*)(kq + s_ * 4096 + kb * 512), hi_ = *(const LAS xi4*)(kq + s_ * 4096 + 1024 + kb * 512); kf[2 * s_ + kb] = __builtin_shufflevector(lo_, hi_, 0, 1, 2, 3, 4, 5, 6, 7); }
#pragma unroll
        for (int s_ = 0; s_ < 4; ++s_) { p[I][0] = __builtin_amdgcn_mfma_scale_f32_32x32x64_f8f6f4(kf[2 * s_], q8[s_], p[I][0], 0, 0, 0, 0x7F7F7F7F, 0, 0x7F7F7F7F);
                                       p[I][1] = __builtin_amdgcn_mfma_scale_f32_32x32x64_f8f6f4(kf[2 * s_ + 1], q8[s_], p[I][1], 0, 0, 0, 0x7F7F7F7F, 0, 0x7F7F7F7F); }
        X_WRITE(I + 1);
        __syncthreads();
    });
    float m = rowmax32(p[0][0], p[0][1]);
#pragma unroll
    for (int t = 1; t < 4; ++t) m = fmaxf(m, rowmax32(p[t][0], p[t][1]));
    float l = 0.f; u32x4 pw[4][4];
#pragma unroll
    for (int t = 0; t < 4; ++t) { float sacc = 0.f;
#pragma unroll
        for (int r = 0; r < 16; ++r) { p[t][0][r] = __builtin_amdgcn_exp2f((p[t][0][r] - m) * (1.f / XQ8_SCALE)); p[t][1][r] = __builtin_amdgcn_exp2f((p[t][1][r] - m) * (1.f / XQ8_SCALE)); sacc += p[t][0][r] + p[t][1][r]; }
        l += sacc;
#pragma unroll
        for (int j = 0; j < 4; ++j) { pw[t][0][j] = cvtpk(p[t][0][2 * j], p[t][0][2 * j + 1]); pw[t][1][j] = cvtpk(p[t][0][8 + 2 * j], p[t][0][8 + 2 * j + 1]); pw[t][2][j] = cvtpk(p[t][1][2 * j], p[t][1][2 * j + 1]); pw[t][3][j] = cvtpk(p[t][1][8 + 2 * j], p[t][1][8 + 2 * j + 1]); } }
    { auto rr = __builtin_amdgcn_permlane32_swap(__float_as_uint(l), __float_as_uint(l), false, false); l = __uint_as_float(rr[0]) + __uint_as_float(rr[1]); }
    if (hi == 0) wsf[32 + r32] = 1.f / l;
    asm volatile("s_waitcnt lgkmcnt(0)" ::: "memory");
    f32x16 o[4];
    cfor<0, 8>([&](auto ic) { constexpr int I = decltype(ic)::value, TT = I & 3, DVH = I >> 2;
        X_LOAD(I + 6);
        if constexpr (TT == 0) {
#pragma unroll
            for (int d = 0; d < 4; ++d) o[d] = f32x16{}; }
        const LAS unsigned char* vb = lds + VOFF + (I & 1) * VSL + ((lane >> 4) & 1) * 32 + (lane & 3) * 8 + (4 * hi + ((lane & 15) >> 2)) * 64;
#pragma unroll
        for (int d = 0; d < 4; d += 2) { s16x4 vlo[2][4], vhi[2][4];
#pragma unroll
            for (int e = 0; e < 2; ++e)
#pragma unroll
                for (int ks = 0; ks < 4; ++ks) { vlo[e][ks] = vtr(vb + (d + e) * 4096 + ks * 1024); vhi[e][ks] = vtr(vb + (d + e) * 4096 + ks * 1024 + 512); }
#pragma unroll
            for (int e = 0; e < 2; ++e)
#pragma unroll
                for (int ks = 0; ks < 4; ++ks) { const bf16x8 vf = (bf16x8){vlo[e][ks][0], vlo[e][ks][1], vlo[e][ks][2], vlo[e][ks][3], vhi[e][ks][0], vhi[e][ks][1], vhi[e][ks][2], vhi[e][ks][3]};
                    o[d + e] = __builtin_amdgcn_mfma_f32_32x32x16_bf16(__builtin_bit_cast(bf16x8, pw[TT][ks]), vf, o[d + e], 0, 0, 0); } }
        X_WRITE(I + 5);
        if constexpr (TT == 3) {
            LAS bf16* stg = (LAS bf16*)(lds + STG + wid * 8192);
#pragma unroll
            for (int r = 0; r < 16; ++r) { const float rl = wsf[32 + crow(r, hi)]; const int orow = crow(r, hi);
#pragma unroll
                for (int d = 0; d < 4; ++d) stg[orow * 128 + d * 32 + r32] = f2bf(o[d][r] * rl); }
            asm volatile("s_waitcnt lgkmcnt(0)" ::: "memory");
            unsigned char* ow = (unsigned char*)s.o + (size_t)(wid * 32) * s.ldo + DVH * 128;
#pragma unroll
            for (int it = 0; it < 4; ++it) { const int row = it * 8 + (lane >> 3), ch = lane & 7; const u32x4 v0 = *(const LAS u32x4*)(stg + row * 128 + ch * 16), v1 = *(const LAS u32x4*)(stg + row * 128 + ch * 16 + 8); u32x4 f;
#pragma unroll
                for (int j = 0; j < 4; ++j) { const unsigned q_ = j < 2 ? v0[2 * j] : v1[2 * j - 4], r_ = j < 2 ? v0[2 * j + 1] : v1[2 * j - 3]; int w = 0;
                    w = __builtin_amdgcn_cvt_pk_fp8_f32(__uint_as_float(q_ << 16) * XO8_SCALE, __uint_as_float(q_ & 0xffff0000u) * XO8_SCALE, w, false);
                    w = __builtin_amdgcn_cvt_pk_fp8_f32(__uint_as_float(r_ << 16) * XO8_SCALE, __uint_as_float(r_ & 0xffff0000u) * XO8_SCALE, w, true); f[j] = (unsigned)w; }
                *(u32x4*)(ow + (size_t)row * s.ldo + ch * 16) = f; }
            asm volatile("s_waitcnt lgkmcnt(0)" ::: "memory"); }
        __syncthreads();
    });
#undef X_LOAD
#undef X_WRITE
}
}

#define XB_TMO      128
#define XB_XCNT(j)  (256  + 64 * (j))
#define XB_XSUB(j)  (1280 + 64 * (j))
#define XB_XGEN(j)  (2304 + 64 * (j))
#define XB_TOP      3328
#define XB_TOPGEN   3392
#define XCD_BAR_WORDS 3456
#define XB_SPIN_CAP (1u << 18)
__device__ __forceinline__ unsigned xb_ld(unsigned* p)              { return __hip_atomic_load(p, __ATOMIC_RELAXED, __HIP_MEMORY_SCOPE_AGENT); }
__device__ __forceinline__ unsigned xb_add(unsigned* p, unsigned v) { return __hip_atomic_fetch_add(p, v, __ATOMIC_RELAXED, __HIP_MEMORY_SCOPE_AGENT); }
__device__ __forceinline__ unsigned xb_xcc_id() { return (unsigned)__builtin_amdgcn_s_getreg((3 << 11) | 20) & 0xFu; }
#define XB_SPIN(cond, bar) do { unsigned _sp = 0; while (cond) { __builtin_amdgcn_s_sleep(1); \
    if ((++_sp & 255u) == 0u) { if (xb_ld(&(bar)[XB_TMO])) break; if (_sp > XB_SPIN_CAP) { atomicAdd(&(bar)[XB_TMO], 1u); break; } } } } while (0)
struct XcdBarrier { unsigned* bar; unsigned x; volatile LAS unsigned* st; bool wave0; };
__device__ __forceinline__ XcdBarrier xcd_barrier_post(unsigned* bar, volatile LAS unsigned* st, int wave) {
    XcdBarrier b; b.bar = bar; b.x = xb_xcc_id(); b.st = st; b.wave0 = (wave == 0);
    if (b.wave0 && lane_id() == 0) (void)xb_add(&bar[XB_XCNT(b.x)], 1u);
    return b;
}
__device__ __forceinline__ void xcd_barrier_complete(unsigned* bar, unsigned x, unsigned& nloc, unsigned& nx) {
    const unsigned G = gridDim.x * gridDim.y * gridDim.z;
    unsigned sum, cnt, mine, sp = 0u;
    for (;;) {
        sum = 0u; cnt = 0u; mine = 0u;
#pragma unroll
        for (unsigned j = 0; j < 16; ++j) { const unsigned c = xb_ld(&bar[XB_XCNT(j)]); sum += c; cnt += (c > 0u) ? 1u : 0u; mine = (j == x) ? c : mine; }
        if (sum == G) break;
        __builtin_amdgcn_s_sleep(1);
        if ((++sp & 255u) == 0u) { if (xb_ld(&bar[XB_TMO])) break; if (sp > XB_SPIN_CAP) { atomicAdd(&bar[XB_TMO], 1u); break; } }
    }
    nloc = mine > 0u ? mine : 1u; nx = cnt > 0u ? cnt : 1u;
}
__device__ __forceinline__ void xcd_barrier(const XcdBarrier& b) {
    asm volatile("s_waitcnt vmcnt(0)" ::: "memory");
    __syncthreads();
    if (b.wave0 && lane_id() == 0) {
        unsigned* bar = b.bar;
        __builtin_amdgcn_s_waitcnt(0);
        unsigned nloc = b.st[0], nx = b.st[1];
        if (nloc == 0u) { xcd_barrier_complete(bar, b.x, nloc, nx); b.st[0] = nloc; b.st[1] = nx; }
        const unsigned old = xb_add(&bar[XB_XSUB(b.x)], 1u);
        const unsigned gen = old / nloc;
        if (old + 1u == (gen + 1u) * nloc) {
            __builtin_amdgcn_fence(__ATOMIC_RELEASE, "agent");
            asm volatile("s_waitcnt vmcnt(0)" ::: "memory");
            const unsigned og = xb_add(&bar[XB_TOP], 1u);
            const unsigned tg = og / nx;
            if (og + 1u == (tg + 1u) * nx) xb_add(&bar[XB_TOPGEN], 1u);
            else XB_SPIN(xb_ld(&bar[XB_TOPGEN]) == tg, bar);
            __builtin_amdgcn_fence(__ATOMIC_ACQUIRE, "agent");
            xb_add(&bar[XB_XGEN(b.x)], 1u);
            asm volatile("s_waitcnt vmcnt(0)" ::: "memory");
        } else {
            XB_SPIN(xb_ld(&bar[XB_XGEN(b.x)]) == gen, bar);
            __builtin_amdgcn_fence(__ATOMIC_ACQUIRE, "agent");
            asm volatile("s_waitcnt vmcnt(0)" ::: "memory");
        }
    }
    __syncthreads();
}

constexpr int NWAVES = 8;
constexpr int RING_BYTES = 131072, TABS_OFF = RING_BYTES, MISC_OFF = TABS_OFF + 2048, LDS_BYTES = 147456;
constexpr int CW_FOXQ = 256;
constexpr int CW_BAR = 4096;
constexpr int N_PHASES = 11;
constexpr float W8_SCALE = 32.f, ACT8_SCALE = 4.f, Y8_SCALE = 16.f;
#ifndef PROBE_REP
#define PROBE_REP -1
#endif
#define REPS(k) for (int rep_ = 0; rep_ < ((PROBE_REP) == (k) ? 2 : 1); ++rep_)
struct MegaArgs {
    const float* in[25]; float* out; unsigned char* ws; int ph_lo, ph_hi; int coop; int pad;
};
struct Frame {
    LAS unsigned char* lds; volatile LAS unsigned* MISC; LAS unsigned* tabs;
    int wave, vcu, G;
};
struct P0Item { const float* W; bf16* WT; const float* kscale; const float* kscale2; int K, N, NT, c_lo, c_hi, item; float cscale; bool f8; };
__device__ __forceinline__ void p0_load(const P0Item& d, f32x4 (&v)[8], int lane) {
    const int nblk = d.NT / 32, kb = d.item / nblk, nb = d.item % nblk, k0 = 64 * kb, n0 = 32 * nb; const int r8 = lane >> 3, c4 = lane & 7, nn = n0 + 4 * c4;
#pragma unroll
    for (int i = 0; i < 8; ++i) { const int kk = i * 8 + r8; v[i] = (f32x4){0.f, 0.f, 0.f, 0.f}; if (nn < d.N) v[i] = __builtin_nontemporal_load((const f32x4*)(d.W + (size_t)(k0 + kk) * d.N + nn)); }
}
__device__ __forceinline__ void p0_finish(const P0Item& d, const f32x4 (&v)[8], LAS float* scr, int lane) {
    const int nblk = d.NT / 32, kb = d.item / nblk, nb = d.item % nblk, k0 = 64 * kb, n0 = 32 * nb; const int r8 = lane >> 3, c4 = lane & 7, nn = n0 + 4 * c4;
    const float cs = (nn >= d.c_lo && nn < d.c_hi) ? d.cscale : 1.f;
#pragma unroll
    for (int i = 0; i < 8; ++i) { const int kk = i * 8 + r8; float ks = cs; if (d.kscale) ks *= (d.kscale2 && k0 >= 512) ? d.kscale2[k0 + kk - 512] : d.kscale[k0 + kk];
        LAS float* p = scr + kk * 33 + 4 * c4; p[0] = v[i][0] * ks; p[1] = v[i][1] * ks; p[2] = v[i][2] * ks; p[3] = v[i][3] * ks; }
    asm volatile("s_waitcnt lgkmcnt(0)" ::: "memory");
    const int c = lane & 7;
#pragma unroll
    for (int j = 0; j < 4; ++j) { const int n = (lane >> 3) + 8 * j; const LAS float* s = scr + (8 * c) * 33 + n;
        if (d.f8) { int w0 = 0, w1 = 0; w0 = __builtin_amdgcn_cvt_pk_fp8_f32(s[0 * 33], s[1 * 33], w0, false); w0 = __builtin_amdgcn_cvt_pk_fp8_f32(s[2 * 33], s[3 * 33], w0, true);
            w1 = __builtin_amdgcn_cvt_pk_fp8_f32(s[4 * 33], s[5 * 33], w1, false); w1 = __builtin_amdgcn_cvt_pk_fp8_f32(s[6 * 33], s[7 * 33], w1, true);
            *(u32x2*)((unsigned char*)d.WT + (size_t)(n0 + n) * d.K + k0 + 8 * c) = (u32x2){(unsigned)w0, (unsigned)w1}; }
        else { u32x4 o; o.x = cvtpk(s[0 * 33], s[1 * 33]); o.y = cvtpk(s[2 * 33], s[3 * 33]); o.z = cvtpk(s[4 * 33], s[5 * 33]); o.w = cvtpk(s[6 * 33], s[7 * 33]);
            *(u32x4*)(d.WT + (size_t)(n0 + n) * d.K + k0 + 8 * c) = o; } }
    asm volatile("s_waitcnt lgkmcnt(0)" ::: "memory");
}
__device__ __forceinline__ void rms_row_to_bf16(const float* xrow, const float* g, bf16* orow, int lane) {
    const f32x4* xr = (const f32x4*)xrow + lane; const f32x4* gr = (const f32x4*)g + lane;
    f32x4 v[4]; float s = 0.f;
#pragma unroll
    for (int j = 0; j < 4; ++j) { v[j] = xr[64 * j]; s += sum4sq(v[j]); }
    const float r = rsqrtf(wave_sum(s) * (1.f / DM) + EPS);
#pragma unroll
    for (int j = 0; j < 4; ++j) { const f32x4 o = v[j] * r * gr[64 * j]; st_bf4(orow + 4 * lane + 256 * j, o); }
}
constexpr size_t WS_WRG = 31 * MiB;
constexpr size_t WS_KN = 1 * MiB + 512 * 1024;
constexpr size_t WS_XF8 = 416 * MiB;
constexpr size_t WS_H1F8 = 880 * MiB;
constexpr size_t WS_XOF8 = 912 * MiB;
constexpr size_t WS_KM8 = 944 * MiB;
constexpr size_t WS_RMSX = 866 * MiB;
constexpr size_t WS_GSORT = 868 * MiB;
constexpr size_t WS_LF = 996 * MiB;

__device__ __forceinline__ P0Item p0_decode(const MegaArgs& a, int it) {
    unsigned char* ws = a.ws;
    constexpr int I_IN = 16 * 64, I_Q = 4 * 24, I_KV = 2 * 32, I_SQ = 16 * 32, I_MKV = 16 * 64, I_GU = 16 * 64, I_D = 16 * 32;
    P0Item d; d.kscale = nullptr; d.kscale2 = nullptr; d.cscale = 1.f; d.c_lo = 0; d.c_hi = 0; d.f8 = false; int r = it;
    if (r < NEXP * I_GU) { const int e = r / I_GU; d.W = a.in[20] + (size_t)e * DM * 2048; d.K = DM; d.N = 2048; d.NT = 2048; d.WT = (bf16*)(ws + WS_WGU + (size_t)e * 2048 * DM); d.f8 = true; d.cscale = W8_SCALE; d.c_hi = 2048; d.item = r % I_GU; return d; } r -= NEXP * I_GU;
    if (r < NEXP * I_D) { const int e = r / I_D; d.W = a.in[22] + (size_t)e * DEXP * DM; d.K = DEXP; d.N = DM; d.NT = DM; d.WT = (bf16*)(ws + WS_WD + (size_t)e * DM * DEXP); d.f8 = true; d.cscale = W8_SCALE; d.c_hi = DM; d.item = r % I_D; return d; } r -= NEXP * I_D;
    if (r < I_IN) { d.W = a.in[3]; d.K = DM; d.N = IN_COLS; d.NT = NPROJ; d.WT = (bf16*)(ws + WS_WIN); d.cscale = C2F; d.c_lo = C_FQ; d.c_hi = C_FK; d.item = r; return d; } r -= I_IN;
    if (r < I_Q) { d.W = a.in[5]; d.K = 256; d.N = 768; d.NT = 768; d.WT = (bf16*)(ws + WS_WQ); d.kscale = a.in[4]; d.cscale = C2M; d.c_lo = 0; d.c_hi = 768; d.item = r; return d; } r -= I_Q;
    if (r < I_KV) { d.W = a.in[7]; d.K = 128; d.N = 1024; d.NT = 1024; d.WT = (bf16*)(ws + WS_WKV); d.kscale = a.in[6]; d.item = r; return d; } r -= I_KV;
    if (r < I_SQ) { d.W = a.in[11]; d.K = DM; d.N = DM; d.NT = DM; d.WT = (bf16*)(ws + WS_WO); d.kscale = a.in[9]; d.kscale2 = a.in[10]; d.item = r; return d; } r -= I_SQ;
    if (r < I_SQ) { d.W = a.in[14]; d.K = DM; d.N = DM; d.NT = DM; d.WT = (bf16*)(ws + WS_WXQ); d.kscale = a.in[12]; d.cscale = C2X * WXQ8_SCALE; d.c_lo = 0; d.c_hi = DM; d.f8 = true; d.item = r; return d; } r -= I_SQ;
    if (r < I_SQ) { d.W = a.in[16]; d.K = DM; d.N = DM; d.NT = DM; d.WT = (bf16*)(ws + WS_WXO); d.cscale = WXO8_SCALE; d.c_lo = 0; d.c_hi = DM; d.f8 = true; d.item = r; return d; } r -= I_SQ;
    d.W = a.in[15]; d.K = DM; d.N = 2048; d.NT = 2048; d.WT = (bf16*)(ws + WS_WMKV); d.item = r; return d;
}
constexpr int P0_NITEMS = 16 * 64 + 4 * 24 + 2 * 32 + 3 * 16 * 32 + 16 * 64 + NEXP * 16 * 64 + NEXP * 16 * 32;
constexpr int MOE_ITEMS = NEXP * 16 * 64 + NEXP * 16 * 32;
constexpr int WCHUNKS = 512, WCH_ITEMS = MOE_ITEMS / WCHUNKS;
__device__ __forceinline__ void rms_rows2_to_bf16(const float* x0, const float* x1, const float* g, bf16* o0, bf16* o1, int lane, float* rms = nullptr) {
    const f32x4* xa = (const f32x4*)x0 + lane; const f32x4* xb = (const f32x4*)x1 + lane; const f32x4* gr = (const f32x4*)g + lane;
    f32x4 va[4], vb[4]; float sa = 0.f, sb = 0.f;
#pragma unroll
    for (int j = 0; j < 4; ++j) { va[j] = __builtin_nontemporal_load(xa + 64 * j); vb[j] = __builtin_nontemporal_load(xb + 64 * j); }
#pragma unroll
    for (int j = 0; j < 4; ++j) { sa += sum4sq(va[j]); sb += sum4sq(vb[j]); }
    const float ra = rsqrtf(wave_sum(sa) * (1.f / DM) + EPS), rb = rsqrtf(wave_sum(sb) * (1.f / DM) + EPS);
    if (rms && lane == 0) { rms[0] = 1.f / ra; rms[1] = 1.f / rb; }
#pragma unroll
    for (int j = 0; j < 4; ++j) { const f32x4 gg = gr[64 * j]; st_bf4(o0 + 4 * lane + 256 * j, va[j] * ra * gg); st_bf4(o1 + 4 * lane + 256 * j, vb[j] * rb * gg); }
}
__device__ __forceinline__ void p0_items(const MegaArgs& a, LAS float* scr, int lane, int first, const int end, const int step) {
    f32x4 va[8], vb[8]; int it = first;
    if (it < end) { P0Item da = p0_decode(a, it); p0_load(da, va, lane);
        for (;;) {
            const int itb = it + step; P0Item db; const bool hb = itb < end; if (hb) { db = p0_decode(a, itb); p0_load(db, vb, lane); }
            p0_finish(da, va, scr, lane);
            if (!hb) break;
            const int ita = itb + step; const bool ha = ita < end; if (ha) { da = p0_decode(a, ita); p0_load(da, va, lane); }
            p0_finish(db, vb, scr, lane);
            if (!ha) break;
            it = ita;
        } }
}
__device__ __forceinline__ void p0_items4(const MegaArgs& a, LAS float* scr, int lane, int first, const int end, const int step) {
    f32x4 v0[8], v1[8], v2[8], v3[8]; P0Item d0, d1, d2, d3; int it = first;
    if (it < end) { d0 = p0_decode(a, it); p0_load(d0, v0, lane); }
    if (it + step < end) { d1 = p0_decode(a, it + step); p0_load(d1, v1, lane); }
    if (it + 2 * step < end) { d2 = p0_decode(a, it + 2 * step); p0_load(d2, v2, lane); }
    if (it + 3 * step < end) { d3 = p0_decode(a, it + 3 * step); p0_load(d3, v3, lane); }
    for (;;) {
        if (!(it < end)) break; p0_finish(d0, v0, scr, lane); if (it + 4 * step < end) { d0 = p0_decode(a, it + 4 * step); p0_load(d0, v0, lane); }
        if (!(it + step < end)) break; p0_finish(d1, v1, scr, lane); if (it + 5 * step < end) { d1 = p0_decode(a, it + 5 * step); p0_load(d1, v1, lane); }
        if (!(it + 2 * step < end)) break; p0_finish(d2, v2, scr, lane); if (it + 6 * step < end) { d2 = p0_decode(a, it + 6 * step); p0_load(d2, v2, lane); }
        if (!(it + 3 * step < end)) break; p0_finish(d3, v3, scr, lane); if (it + 7 * step < end) { d3 = p0_decode(a, it + 7 * step); p0_load(d3, v3, lane); }
        it += 4 * step;
    }
}
__device__ __forceinline__ void p0_chunk(const Frame& F, const MegaArgs& a, int chunk) {
    LAS float* scr = (LAS float*)(F.lds + F.wave * 16384); int lane = lane_id(); asm volatile("" : "+v"(lane));
    p0_items4(a, scr, lane, chunk * WCH_ITEMS + F.wave, (chunk + 1) * WCH_ITEMS, NWAVES);
    __syncthreads();
}
__device__ __forceinline__ void p0_prologue(const Frame& F, const MegaArgs& a) {
    LAS float* scr = (LAS float*)(F.lds + F.wave * 16384);
    int lane = lane_id(); asm volatile("" : "+v"(lane)); const int gw = F.vcu * NWAVES + F.wave, NGW = F.G * NWAVES;
    unsigned char* ws = a.ws;
    p0_items(a, scr, lane, MOE_ITEMS + gw, P0_NITEMS, NGW);
    for (int m = 2 * gw; m < T; m += 2 * NGW) rms_rows2_to_bf16(a.in[0] + (size_t)m * DM, a.in[0] + (size_t)(m + 1) * DM, a.in[2], (bf16*)(ws + WS_XN) + (size_t)m * DM, (bf16*)(ws + WS_XN) + (size_t)(m + 1) * DM, lane, (float*)(ws + WS_RMSX) + m);
    for (int m = 2 * gw; m < TM; m += 2 * NGW) rms_rows2_to_bf16(a.in[1] + (size_t)m * DM, a.in[1] + (size_t)(m + 1) * DM, a.in[13], (bf16*)(ws + WS_MEMN) + (size_t)m * DM, (bf16*)(ws + WS_MEMN) + (size_t)(m + 1) * DM, lane);
    { float* tab = (float*)(ws + WS_ROPE); for (int i = gw * 64 + lane; i < 4096 * 16; i += NGW * 64) { const int pos = i >> 4, j = i & 15; const float inv = powf(10000.f, -(float)j / 16.f); const float ang = (float)pos * inv; tab[2 * i] = cosf(ang); tab[2 * i + 1] = sinf(ang); } }
    { bf16* wh = (bf16*)(ws + WS_WRG); bf16* wl = wh + DM * NEXP;
      for (int i = gw * 64 + lane; i < DM * NEXP; i += NGW * 64) { const float w = a.in[18][i] * a.in[17][i >> 5]; const bf16 h = f2bf(w); const int o_ = (i & 31) * DM + (i >> 5); wh[o_] = h; wl[o_] = f2bf(w - bf2f(h)); } }
}
__device__ __forceinline__ void p2_scan_item(const float* LF, float* cum, bf16* kaug, int item, int lane) {
    const int b = item >> 3, ck = item & 7; const float* base = LF + (size_t)b * SEQ * 8;
    float carry[8];
#pragma unroll
    for (int h = 0; h < 8; ++h) carry[h] = 0.f;
    for (int p = lane; p < ck * 512; p += 64) { const f32x4 x0 = *(const f32x4*)(base + (size_t)p * 8), x1 = *(const f32x4*)(base + (size_t)p * 8 + 4);
#pragma unroll
        for (int e = 0; e < 4; ++e) { carry[e] += x0[e]; carry[4 + e] += x1[e]; } }
#pragma unroll
    for (int h = 0; h < 8; ++h) carry[h] = wave_sum(carry[h]);
    const int s0 = ck * 512 + lane * 8;
    float v[8][8];
#pragma unroll
    for (int i = 0; i < 8; ++i) { const f32x4 x0 = *(const f32x4*)(base + (size_t)(s0 + i) * 8), x1 = *(const f32x4*)(base + (size_t)(s0 + i) * 8 + 4);
#pragma unroll
        for (int e = 0; e < 4; ++e) { v[i][e] = x0[e]; v[i][4 + e] = x1[e]; } }
#pragma unroll
    for (int h = 0; h < 8; ++h) {
#pragma unroll
        for (int i = 1; i < 8; ++i) v[i][h] += v[i - 1][h];
        float tot = v[7][h], inc = tot;
#pragma unroll
        for (int o = 1; o < 64; o <<= 1) { const float up = __shfl_up(inc, o); if (lane >= o) inc += up; }
        const float off = carry[h] + (inc - tot);
#pragma unroll
        for (int i = 0; i < 8; ++i) v[i][h] += off;
    }
#pragma unroll
    for (int h = 0; h < 8; ++h) {
        float* cr = cum + (size_t)(b * 8 + h) * SEQ + s0; *(f32x4*)cr = (f32x4){v[0][h], v[1][h], v[2][h], v[3][h]}; *(f32x4*)(cr + 4) = (f32x4){v[4][h], v[5][h], v[6][h], v[7][h]};
        bf16* kr = kaug + ((size_t)(b * 8 + h) * SEQ + s0) * 8;
#pragma unroll
        for (int i = 0; i < 8; ++i) { const float x = -v[i][h] * LOG2E; const unsigned hi = cvtpk(x, 0.f) & 0xffffu; const float r1 = x - __uint_as_float(hi << 16); const unsigned mid = cvtpk(r1, 0.f) & 0xffffu;
            const float r2 = r1 - __uint_as_float(mid << 16); const unsigned lo = cvtpk(r2, 0.f) & 0xffffu; *(u32x4*)(kr + i * 8) = (u32x4){hi | (mid << 16), lo, 0u, 0u}; }
    }
}

struct EpiGateUp {
    static constexpr bool PERM = true, MID = false;
    const float* bias; unsigned char* ACT8;
    __device__ __forceinline__ void act(const f32x4 (&a4)[2][2], const f32x4 (&bv)[2][2], unsigned (&w)[2]) const {
        const f32x4 sv = (f32x4){1.f / W8_SCALE, ACT8_SCALE / W8_SCALE, 1.f / W8_SCALE, ACT8_SCALE / W8_SCALE};
#pragma unroll
        for (int bj = 0; bj < 2; ++bj) { const f32x4 v0 = a4[bj][0] * sv + bv[bj][0], v1 = a4[bj][1] * sv + bv[bj][1];
            const f32x4 G = (f32x4){fminf(v0[0], 7.f), fminf(v0[2], 7.f), fminf(v1[0], 7.f), fminf(v1[2], 7.f)};
            const f32x4 L = (f32x4){__builtin_amdgcn_fmed3f(v0[1], -6.f * ACT8_SCALE, 8.f * ACT8_SCALE), __builtin_amdgcn_fmed3f(v0[3], -6.f * ACT8_SCALE, 8.f * ACT8_SCALE),
                                    __builtin_amdgcn_fmed3f(v1[1], -6.f * ACT8_SCALE, 8.f * ACT8_SCALE), __builtin_amdgcn_fmed3f(v1[3], -6.f * ACT8_SCALE, 8.f * ACT8_SCALE)};
            const f32x4 tt = G * (-1.702f * LOG2E);
            const f32x4 dd = (f32x4){__builtin_amdgcn_exp2f(tt[0]), __builtin_amdgcn_exp2f(tt[1]), __builtin_amdgcn_exp2f(tt[2]), __builtin_amdgcn_exp2f(tt[3])} + 1.f;
            const f32x4 rr = (f32x4){__builtin_amdgcn_rcpf(dd[0]), __builtin_amdgcn_rcpf(dd[1]), __builtin_amdgcn_rcpf(dd[2]), __builtin_amdgcn_rcpf(dd[3])};
            const f32x4 a = (G * rr) * L;
            int x = 0; x = __builtin_amdgcn_cvt_pk_fp8_f32(a[0], a[1], x, false); x = __builtin_amdgcn_cvt_pk_fp8_f32(a[2], a[3], x, true); w[bj] = (unsigned)x; }
    }
    __device__ __forceinline__ void operator()(f32x4 (&acc)[2][2][4][2], const pg8::Unit& u, int wr, int wc, int fr, int fq) const {
        asm volatile("" : "+v"(fr), "+v"(fq));
        const int c0 = u.col0 + wc * 32 + fq * 8; const float* bp = bias + (size_t)u.e * 2048 + c0;
        const f32x4 bm = (f32x4){1.f, ACT8_SCALE, 1.f, ACT8_SCALE}, ba = (f32x4){0.f, ACT8_SCALE, 0.f, ACT8_SCALE};
        f32x4 bv[2][2];
#pragma unroll
        for (int bj = 0; bj < 2; ++bj) { bv[bj][0] = *(const f32x4*)(bp + bj * 128) * bm + ba; bv[bj][1] = *(const f32x4*)(bp + bj * 128 + 4) * bm + ba; }
#pragma unroll
        for (int ai = 0; ai < 2; ++ai)
#pragma unroll
            for (int mp = 0; mp < 2; ++mp) {
                asm volatile("" : "+v"(acc[ai][0][2 * mp][0]), "+v"(acc[ai][0][2 * mp][1]), "+v"(acc[ai][1][2 * mp][0]), "+v"(acc[ai][1][2 * mp][1]));
                unsigned d[2][2];
#pragma unroll
                for (int q = 0; q < 2; ++q) { const int m = 2 * mp + q; unsigned w[2]; const f32x4 a4[2][2] = {{acc[ai][0][m][0], acc[ai][0][m][1]}, {acc[ai][1][m][0], acc[ai][1][m][1]}}; act(a4, bv, w);
                    const auto r = __builtin_amdgcn_permlane16_swap(w[0], w[1], false, false); d[q][0] = r[0]; d[q][1] = r[1]; }
                const auto r0 = __builtin_amdgcn_permlane32_swap(d[0][0], d[1][0], false, false), r1 = __builtin_amdgcn_permlane32_swap(d[0][1], d[1][1], false, false);
                int f2 = fr, q2 = fq; asm volatile("" : "+v"(f2), "+v"(q2));
                const int rl = ai * 128 + wr * 64 + (2 * mp + (q2 >> 1)) * 16 + f2; const unsigned rowi = rl < u.rows ? (unsigned)(u.row0 + rl) : (unsigned)(T * 4 + rl);
                *(u32x4*)(ACT8 + (rowi * (unsigned)DEXP + (unsigned)((u.col0 >> 1) + wc * 16 + (q2 & 1) * 64))) = (u32x4){r0[0], r1[0], r0[1], r1[1]};
                asm volatile("" ::: "memory"); }
    }
};
struct EpiDown {
    static constexpr bool PERM = true, MID = false;
    const float* bias; const float* gsort; const int* list0; unsigned char* Y8;
    __device__ __forceinline__ void operator()(f32x4 (&acc)[2][2][4][2], const pg8::Unit& u, int wr, int wc, int fr, int fq) const {
        asm volatile("" : "+v"(fr), "+v"(fq));
        const int c0 = u.col0 + wc * 32 + fq * 8; const float* bp = bias + (size_t)u.e * DM + c0;
        const float* gp = gsort + (u.list - list0) + wr * 64 + fq * 16 + fr;
        const float g0 = gp[0] * Y8_SCALE, g1 = gp[128] * Y8_SCALE;
        f32x4 bv[2][2];
#pragma unroll
        for (int bj = 0; bj < 2; ++bj) { bv[bj][0] = *(const f32x4*)(bp + bj * 128); bv[bj][1] = *(const f32x4*)(bp + bj * 128 + 4); }
#pragma unroll
        for (int g = 0; g < 8; ++g) { const int ai = g >> 2, m = g & 3;
                int f2 = fr, q2 = fq; asm volatile("" : "+v"(f2), "+v"(q2));
                const float gg = __int_as_float(__builtin_amdgcn_ds_bpermute(4 * (m * 16 + f2), __float_as_int(ai ? g1 : g0)));
                const int rl = ai * 128 + wr * 64 + m * 16 + f2; const unsigned rowi = rl < u.rows ? (unsigned)(u.row0 + rl) : (unsigned)(T * 4 + rl);
                unsigned w[2][2];
#pragma unroll
                for (int bj = 0; bj < 2; ++bj) { const f32x4 v0 = (acc[ai][bj][m][0] * (1.f / (W8_SCALE * ACT8_SCALE)) + bv[bj][0]) * gg, v1 = (acc[ai][bj][m][1] * (1.f / (W8_SCALE * ACT8_SCALE)) + bv[bj][1]) * gg;
                    int w0 = 0, w1 = 0; w0 = __builtin_amdgcn_cvt_pk_fp8_f32(v0[0], v0[1], w0, false); w0 = __builtin_amdgcn_cvt_pk_fp8_f32(v0[2], v0[3], w0, true);
                    w1 = __builtin_amdgcn_cvt_pk_fp8_f32(v1[0], v1[1], w1, false); w1 = __builtin_amdgcn_cvt_pk_fp8_f32(v1[2], v1[3], w1, true); w[bj][0] = (unsigned)w0; w[bj][1] = (unsigned)w1; }
                const auto r0 = __builtin_amdgcn_permlane16_swap(w[0][0], w[1][0], false, false), r1 = __builtin_amdgcn_permlane16_swap(w[0][1], w[1][1], false, false);
                *(u32x4*)(Y8 + (rowi * (unsigned)DM + (unsigned)(u.col0 + wc * 32 + ((q2 & 1) ? 128 + 8 * (q2 - 1) : 8 * q2)))) = (u32x4){r0[0], r1[0], r0[1], r1[1]};
                asm volatile("" ::: "memory");
            }
    }
};
struct MoeSched {
    pg8::TileOrder o; const volatile LAS int* tpre; const volatile LAS int* roff;
    const char* A; size_t a_row_bytes; const char* Wt; size_t w_exp_bytes; int brow; const int* list; bool gather;
    __device__ __forceinline__ void tables(const volatile LAS int* tp, const volatile LAS int* ro) { tpre = tp; roff = ro; }
    __device__ __forceinline__ bool next(int i, pg8::Unit& u) const { int pm, pn; if (!o.tile(i, pm, pn)) return false;
        int l = lane_id(); const int j = l < 32 ? l : 32; const int tv = tpre[j], rv = roff[j];
        const unsigned long long mk = __ballot(l >= 1 && l < NEXP && tv <= pm); const int e = __builtin_popcountll(mk);
        const int tp = __builtin_amdgcn_readlane(tv, e), r0 = __builtin_amdgcn_readlane(rv, e), r1 = __builtin_amdgcn_readlane(rv, e + 1);
        const int mt = pm - tp, cnt = r1 - r0; u.row0 = r0 + mt * 256; u.rows = (cnt - mt * 256) < 256 ? (cnt - mt * 256) : 256; u.col0 = pn * 256; u.pn = pn; u.e = e;
        u.a = gather ? A : A + (size_t)u.row0 * a_row_bytes; u.b = Wt + (size_t)e * w_exp_bytes + (size_t)pn * 256 * brow; u.list = list + (size_t)e * T + mt * 256; return true; }
};
__device__ __forceinline__ int moe_tables(const Frame& F, const int* cnt) {
    volatile LAS int* tp = (volatile LAS int*)(F.MISC + 64); volatile LAS int* ro = (volatile LAS int*)(F.MISC + 128);
    __syncthreads();
    if (F.wave == 0 && lane_id() == 0) { int t = 0, r = 0; for (int e = 0; e < NEXP; ++e) { const int c = __hip_atomic_load(cnt + e, __ATOMIC_RELAXED, __HIP_MEMORY_SCOPE_AGENT); tp[e] = t; ro[e] = r; t += (c + 255) >> 8; r += c; } tp[NEXP] = t; ro[NEXP] = r; }
    __syncthreads();
    return __builtin_amdgcn_readfirstlane(tp[NEXP]);
}
__device__ __forceinline__ void p7_route(const Frame& F, const MegaArgs& a, const size_t dummy) {
    unsigned char* ws = a.ws; const float* wrg = (const float*)(ws + WS_WRG); const bf16* h2 = (const bf16*)(ws + WS_XN); const float* gln = a.in[17]; const float* br = a.in[19];
    unsigned char* XF8 = ws + WS_XF8 + dummy; int* cnt = (int*)(ws + WS_CTL) + CW_CNT + (dummy ? 64 : 0);   const size_t d2 = dummy ? (WS_QM - WS_TOPI) : 0; int* topi = (int*)(ws + WS_TOPI + d2); float* gate = (float*)(ws + WS_GATE + d2); int* slot = (int*)(ws + WS_SLOT + d2); int* list = (int*)(ws + WS_LIST + d2); float* gsort = (float*)(ws + WS_GSORT + (dummy ? 8 * MiB : 0));
    LAS float* W = (LAS float*)F.lds; int tid = (F.wave << 6) | lane_id(); asm volatile("" : "+v"(tid)); const int lane = tid & 63;
    volatile LAS int* lcnt = (volatile LAS int*)(F.MISC + 16); volatile LAS int* lbase = (volatile LAS int*)(F.MISC + 192); LAS int* rec = (LAS int*)(F.MISC + 256);
    { const bf16* wh = (const bf16*)wrg; LAS unsigned char* Wb = F.lds;
      for (int idx = tid; idx < 8192; idx += NWAVES * 64) { const int pc = idx >> 12, R = (idx >> 5) & 127, c = idx & 31, kq_ = R >> 5, e = R & 31;
          *(LAS u32x4*)(Wb + pc * 65536 + R * 512 + ((c ^ (R & 15)) << 4)) = *(const u32x4*)(wh + (size_t)pc * DM * NEXP + e * DM + 32 * c + 8 * kq_); } }
    if (tid < NEXP) lcnt[tid] = 0;
    __syncthreads();
    const int TPB = T / F.G, t0 = F.vcu * TPB, TPW = TPB / NWAVES;
    const int li = lane & 15, kq = lane >> 4, tw0 = t0 + F.wave * TPW;
    float rs;
    f32x4 d0 = (f32x4){0.f, 0.f, 0.f, 0.f}, d1 = (f32x4){0.f, 0.f, 0.f, 0.f};
    { const bf16* xrow = h2 + (size_t)(tw0 + li) * DM + 8 * kq; const LAS unsigned char* w0 = F.lds + (kq * 32 + li) * 512;
      float ssq = 0.f;
#pragma unroll
      for (int c = 0; c < 4; ++c) { u32x4 xr[8];
#pragma unroll
          for (int u = 0; u < 8; ++u) xr[u] = *(const u32x4*)(xrow + 32 * (8 * c + u));
#pragma unroll
          for (int u = 0; u < 8; ++u) { const int sw = ((8 * c + u) ^ li) << 4; const bf16x8 av = __builtin_bit_cast(bf16x8, xr[u]);
              const bf16x8 bh0 = *(const LAS bf16x8*)(w0 + sw), bl0 = *(const LAS bf16x8*)(w0 + 65536 + sw), bh1 = *(const LAS bf16x8*)(w0 + 8192 + sw), bl1 = *(const LAS bf16x8*)(w0 + 65536 + 8192 + sw);
              d0 = __builtin_amdgcn_mfma_f32_16x16x32_bf16(av, bh0, d0, 0, 0, 0); d1 = __builtin_amdgcn_mfma_f32_16x16x32_bf16(av, bh1, d1, 0, 0, 0);
              d0 = __builtin_amdgcn_mfma_f32_16x16x32_bf16(av, bl0, d0, 0, 0, 0); d1 = __builtin_amdgcn_mfma_f32_16x16x32_bf16(av, bl1, d1, 0, 0, 0);
#pragma unroll
              for (int j = 0; j < 4; ++j) { const float xl = __uint_as_float(xr[u][j] << 16), xh = __uint_as_float(xr[u][j] & 0xffff0000u); ssq += xl * xl + xh * xh; } } }
      ssq += __shfl_xor(ssq, 16); ssq += __shfl_xor(ssq, 32); rs = rsqrtf(ssq * (1.f / DM) + EPS); }
    { const float b0 = br[li], b1 = br[li + 16];
#pragma unroll
      for (int r = 0; r < 4; ++r) { const float rt = __shfl(rs, 4 * kq + r); float c0 = d0[r] * rt + b0, c1 = d1[r] * rt + b1;
        float tv[4]; int ti[4];
#pragma unroll
        for (int k = 0; k < 4; ++k) { float bv = c0; int bi = li; if (c1 > c0) { bv = c1; bi = li + 16; }
#pragma unroll
            for (int o = 1; o < 16; o <<= 1) { const float ov = __shfl_xor(bv, o); const int oi = __shfl_xor(bi, o); if (ov > bv || (ov == bv && oi < bi)) { bv = ov; bi = oi; } }
            tv[k] = bv; ti[k] = bi; if (bi == li) c0 = -INFINITY; if (bi == li + 16) c1 = -INFINITY; }
        const float e1 = __expf(tv[1] - tv[0]), e2 = __expf(tv[2] - tv[0]), e3 = __expf(tv[3] - tv[0]); const float inv = 1.f / (1.f + e1 + e2 + e3);
        const float gs[4] = {inv, e1 * inv, e2 * inv, e3 * inv};
        const int tok = F.wave * TPW + 4 * kq + r;
#pragma unroll
        for (int k = 0; k < 4; ++k) if ((ti[k] & 15) == li) { const int ex = ti[k]; const int ls = __hip_atomic_fetch_add((LAS int*)(lcnt + ex), 1, __ATOMIC_RELAXED, __HIP_MEMORY_SCOPE_WORKGROUP); LAS int* rr = rec + (tok * 4 + k) * 3; rr[0] = ex; rr[1] = __float_as_int(gs[k]); rr[2] = ls; } } }
    { f32x4 gv[4];
#pragma unroll
      for (int j = 0; j < 4; ++j) gv[j] = *(const f32x4*)(gln + 16 * lane + 4 * j);
#pragma unroll
      for (int tb = 0; tb < 16; tb += 8) { u32x4 xw[8][2];
#pragma unroll
          for (int tt = 0; tt < 8; ++tt)
#pragma unroll
              for (int j = 0; j < 2; ++j) xw[tt][j] = *(const u32x4*)(h2 + (size_t)(tw0 + tb + tt) * DM + 16 * lane + 8 * j);
#pragma unroll
          for (int tt = 0; tt < 8; ++tt) { const float rt = __shfl(rs, tb + tt); u32x4 f;
#pragma unroll
              for (int j = 0; j < 4; ++j) { const unsigned a0 = xw[tt][j >> 1][(j & 1) * 2], a1 = xw[tt][j >> 1][(j & 1) * 2 + 1];
                  const f32x4 y = (f32x4){__uint_as_float(a0 << 16), __uint_as_float(a0 & 0xffff0000u), __uint_as_float(a1 << 16), __uint_as_float(a1 & 0xffff0000u)} * rt * gv[j];
                  int w = 0; w = __builtin_amdgcn_cvt_pk_fp8_f32(y[0], y[1], w, false); w = __builtin_amdgcn_cvt_pk_fp8_f32(y[2], y[3], w, true); f[j] = (unsigned)w; }
              *(u32x4*)(XF8 + (size_t)(tw0 + tb + tt) * DM + 16 * lane) = f; } } }
    __syncthreads();
    if (tid < NEXP) lbase[tid] = atomicAdd(cnt + tid, (int)lcnt[tid]);
    __syncthreads();
    for (int idx = tid; idx < TPB * 4; idx += NWAVES * 64) { const LAS int* r = rec + idx * 3; const int e = r[0], sl = lbase[e] + r[2]; const int gi = t0 * 4 + idx;
        topi[gi] = e; gate[gi] = __int_as_float(r[1]); slot[gi] = sl; list[(size_t)e * T + sl] = gi; gsort[(size_t)e * T + sl] = __int_as_float(r[1]); }
}
__device__ __forceinline__ void p10_combine(const Frame& F, const MegaArgs& a, float* dst) {
    unsigned char* ws = a.ws; const unsigned char* Y8 = ws + WS_Y; const bf16* h2 = (const bf16*)(ws + WS_XN); const int* topi = (const int*)(ws + WS_TOPI); const int* slot = (const int*)(ws + WS_SLOT); const float* g = a.in[24];
    const volatile LAS int* ro = (const volatile LAS int*)(F.MISC + 128); int lane = lane_id(); asm volatile("" : "+v"(lane));
    const int t0 = F.vcu * NWAVES + F.wave, ts = F.G * NWAVES;
    f32x4 gv[4];
#pragma unroll
    for (int j = 0; j < 4; ++j) gv[j] = *(const f32x4*)(g + 16 * lane + 4 * j);
    constexpr int NB = 3;
    u32x4 yn[NB][4], hn[NB][2]; int en[NB], sn[NB];
#define P10_IDX(bt) do { _Pragma("unroll") for (int q_ = 0; q_ < NB; ++q_) { const int tt_ = (bt) + q_ * ts; en[q_] = 0; sn[q_] = 0; if (tt_ < T && lane < 4) { en[q_] = topi[tt_ * 4 + lane]; sn[q_] = slot[tt_ * 4 + lane]; } } } while (0)
#define P10_LOAD(bt) do { _Pragma("unroll") for (int q_ = 0; q_ < NB; ++q_) { const int tt_ = (bt) + q_ * ts; if (tt_ < T) { \
        const int pl_ = (lane < 4 ? ro[en[q_]] : 0) + sn[q_]; \
        _Pragma("unroll") for (int k = 0; k < 4; ++k) { const size_t pos = (size_t)__builtin_amdgcn_readlane(pl_, k); yn[q_][k] = *(const u32x4*)(Y8 + pos * DM + 16 * lane); } \
        _Pragma("unroll") for (int j = 0; j < 2; ++j) hn[q_][j] = *(const u32x4*)(h2 + (size_t)tt_ * DM + 16 * lane + 8 * j); } } } while (0)
    P10_IDX(t0); P10_LOAD(t0); P10_IDX(t0 + NB * ts);
    for (int tb = t0; tb < T; tb += NB * ts) {
        u32x4 y[NB][4], hw[NB][2];
#pragma unroll
        for (int q = 0; q < NB; ++q) {
#pragma unroll
            for (int k = 0; k < 4; ++k) y[q][k] = yn[q][k];
#pragma unroll
            for (int j = 0; j < 2; ++j) hw[q][j] = hn[q][j]; }
        if (tb + NB * ts < T) { P10_LOAD(tb + NB * ts); P10_IDX(tb + 2 * NB * ts); }
#pragma unroll
        for (int q = 0; q < NB; ++q) { const int t = tb + q * ts; if (t < T) {
            f32x4 v[4];
#pragma unroll
            for (int j = 0; j < 4; ++j) { f32x4 ys = (f32x4){0.f, 0.f, 0.f, 0.f};
#pragma unroll
                for (int k = 0; k < 4; ++k) { const f32x2 lo = __builtin_amdgcn_cvt_pk_f32_fp8((int)y[q][k][j], false), hi = __builtin_amdgcn_cvt_pk_f32_fp8((int)y[q][k][j], true); ys[0] += lo.x; ys[1] += lo.y; ys[2] += hi.x; ys[3] += hi.y; }
                const unsigned w0 = hw[q][j >> 1][(j & 1) * 2], w1 = hw[q][j >> 1][(j & 1) * 2 + 1];
                v[j] = (f32x4){__uint_as_float(w0 << 16), __uint_as_float(w0 & 0xffff0000u), __uint_as_float(w1 << 16), __uint_as_float(w1 & 0xffff0000u)} + ys * (1.f / Y8_SCALE); }
            float sq = 0.f;
#pragma unroll
            for (int j = 0; j < 4; ++j) sq += sum4sq(v[j]);
            const float r = rsqrtf(wave_sum(sq) * (1.f / DM) + EPS);
#pragma unroll
            for (int j = 0; j < 4; ++j) *(f32x4*)(dst + (size_t)t * DM + 16 * lane + 4 * j) = v[j] * r * gv[j]; } }
    }
#undef P10_LOAD
#undef P10_IDX
}
__global__ void __launch_bounds__(NWAVES * 64, 2) mega_fwd(MegaArgs args) {
    extern __shared__ __attribute__((aligned(16))) unsigned char lds_raw[];
    Frame F;
    F.lds = (LAS unsigned char*)lds_raw; F.MISC = (volatile LAS unsigned*)(F.lds + MISC_OFF); F.tabs = (LAS unsigned*)(F.lds + TABS_OFF);
    F.wave = __builtin_amdgcn_readfirstlane((int)threadIdx.x >> 6);
    F.G = gridDim.x; { const int bx = blockIdx.x; F.vcu = (F.G % 8 == 0) ? (bx % 8) * (F.G / 8) + bx / 8 : bx; }
    unsigned char* ws = args.ws;
    unsigned* ctl = (unsigned*)(ws + WS_CTL);
    for (int u = (F.wave << 6) | lane_id(); u < (LDS_BYTES - MISC_OFF) / 4; u += NWAVES * 64) ((LAS unsigned*)(F.lds + MISC_OFF))[u] = 0u;
    __syncthreads();
    XcdBarrier bar; bar.bar = ctl + CW_BAR; bar.x = 0; bar.st = nullptr; bar.wave0 = false;
    if (args.coop) bar = xcd_barrier_post(ctl + CW_BAR, F.MISC + 8, F.wave);
    const int lo = args.ph_lo, hi = args.ph_hi;
#define IN(k) (lo <= (k) && (k) < hi)
#define SEAM(k) do { if (args.coop && IN(k) && IN((k) + 1)) { xcd_barrier(bar); if ((PROBE_REP) == 100) xcd_barrier(bar); } } while (0)
    bf16 *WinT = (bf16*)(ws + WS_WIN), *WqT = (bf16*)(ws + WS_WQ), *WkvT = (bf16*)(ws + WS_WKV), *WmkvT = (bf16*)(ws + WS_WMKV);
    bf16 *XN = (bf16*)(ws + WS_XN), *PROJ = (bf16*)(ws + WS_PROJ), *QM = (bf16*)(ws + WS_QM), *KVM = (bf16*)(ws + WS_KVM), *MEMN = (bf16*)(ws + WS_MEMN), *KVMEM = (bf16*)(ws + WS_KVMEM);
    float *rope = (float*)(ws + WS_ROPE), *ssqq = (float*)(ws + WS_SSQQ), *ssqkv = (float*)(ws + WS_SSQKV), *LF = (float*)(ws + WS_LF);

    if (IN(0)) { REPS(0) p0_prologue(F, args); }
    if (args.coop == 2) cg::this_grid().sync();
    SEAM(0);
    if (IN(1)) REPS(1) {
        pg8::DenseSched S; S.init(XN, DM, WinT, T, NPROJ, DM, F.G, (int)blockIdx.x);
        EpiProj E{PROJ, ssqq, ssqkv, rope, LF, args.in[8]};
        pg8::gemm_phase<EpiProj, pg8::DenseSched, false>(F.lds, F.tabs, DM, DM, S, E, F.wave);
    }
    SEAM(1);
    if (IN(2)) REPS(2) {
        const int GA = (F.G * 3) / 4, bx = (int)blockIdx.x;
        if (bx >= GA) { const int sid = bx - GA, ns = F.G - GA;
          if (F.wave == 0) for (int it = sid; it < 64; it += ns) { int ln = lane_id(); asm volatile("" : "+v"(ln)); p2_scan_item(LF, (float*)(ws + WS_CUM), (bf16*)(ws + WS_KAUG), it, ln); }
          for (int item = sid * NWAVES + F.wave; item < BATCH * 64; item += ns * NWAVES) {
          { int ln = lane_id(); asm volatile("" : "+v"(ln)); const int b = item >> 6, t = item & 63; const bf16* kr = PROJ + ((size_t)b * SEQ + t * 64 + ln) * NPROJ + C_FK; float* KN = (float*)(ws + WS_KN);
            for (int h = 0; h < 8; ++h) { float s2 = 0.f;
#pragma unroll
                for (int c = 0; c < 8; ++c) { const u32x4 w = *(const u32x4*)(kr + h * 64 + c * 8);
#pragma unroll
                    for (int j = 0; j < 4; ++j) { const float a_ = __uint_as_float(w[j] << 16), b_ = __uint_as_float(w[j] & 0xffff0000u); s2 += a_ * a_ + b_ * b_; } }
#pragma unroll
                for (int o_ = 1; o_ < 64; o_ <<= 1) s2 = fmaxf(s2, __shfl_xor(s2, o_));
                if (ln == 0) KN[(size_t)(b * 8 + h) * 64 + t] = sqrtf(s2); } } } }
        __syncthreads();
        if (F.G >= 8 && (F.G % 32) == 0) {
            if (bx < GA) {
                { pg8::DenseSched S; S.init(PROJ + C_QLAT, NPROJ, WqT, T, 768, 256, GA, bx); EpiScale<4, true> E{QM, 768, ssqq, 1.f / 256.f, rope}; pg8::gemm_phase<EpiScale<4, true>, pg8::DenseSched, false>(F.lds, F.tabs, 256, NPROJ, S, E, F.wave); }
                { pg8::DenseSched S; S.init(PROJ + C_KVLAT, NPROJ, WkvT, T, 1024, 128, GA, bx); EpiScale<4, false> E{KVM, 1024, ssqkv, 1.f / 128.f, nullptr}; pg8::gemm_phase<EpiScale<4, false>, pg8::DenseSched, false>(F.lds, F.tabs, 128, NPROJ, S, E, F.wave); }
            } else {
                pg8::DenseSched S; S.init(MEMN, DM, WmkvT, TM, 2048, DM, F.G - GA, bx - GA); EpiMemKV E{KVMEM, ws + WS_KM8}; pg8::gemm_phase<EpiMemKV, pg8::DenseSched, false>(F.lds, F.tabs, DM, DM, S, E, F.wave);
            }
        }
    }
    SEAM(2);
    if (IN(3)) REPS(3) {
        bf16* O = (bf16*)(ws + WS_O); float* SSO = (float*)(ws + WS_SSO); const bf16* KAUG = (const bf16*)(ws + WS_KAUG);
        int upos = 0; unsigned chdone = 0u;
        for (int P = F.vcu; P < 512; P += F.G) {
            const int bh = P >> 3, pair = P & 7, b = bh >> 3, h = bh & 7;
            for (int j = 0; j < 2; ++j) {
                { const int q_ = upos & 3;
                  for (int i_ = 0; i_ < 2; ++i_) { const int ch = F.vcu + F.G * i_; if (ch < WCHUNKS && (((F.vcu & 3) + 2 * i_) & 3) == q_ && upos < 4) { p0_chunk(F, args, ch); chdone |= 1u << i_; } }
                  ++upos; }
                const int qb = j ? 15 - pair : pair; const size_t r0 = (size_t)b * SEQ, rq = r0 + (size_t)qb * 256;
                att::Src s; s.nt = 4 * (qb + 1); s.q0 = qb * 256; s.ldo = DM; s.kn = nullptr; s.cum = nullptr;
                s.q = QM + rq * 768 + h * 96; s.ldq = 768; s.k1 = KVM + r0 * 1024 + h * 128; s.ldk1 = 1024; s.k2 = PROJ + r0 * NPROJ + C_KPE; s.ldk2 = NPROJ; s.v = KVM + r0 * 1024 + h * 128 + 64; s.ldv = 1024;
                s.o = O + rq * DM + h * 64; s.sso = SSO + rq * 16 + h;
                att::unit<6, 8, 12, 2, true, false, false, true>(s, F.lds, F.wave); }
        }
        for (int i_ = 0; F.vcu + F.G * i_ < WCHUNKS; ++i_) if (i_ >= 2 || !((chdone >> i_) & 1u)) p0_chunk(F, args, F.vcu + F.G * i_);
        if (args.coop) {
            unsigned* fq = ctl + CW_FOXQ; volatile LAS unsigned* tk = F.MISC + 48; const bool lead = F.wave == 0 && lane_id() == 0;
            if (lead) tk[0] = __hip_atomic_fetch_add(fq, 1u, __ATOMIC_RELAXED, __HIP_MEMORY_SCOPE_AGENT);
            __syncthreads();
            unsigned cur = __builtin_amdgcn_readfirstlane(tk[0]);
            while (cur < 1024u) {
                unsigned nx = 0; if (lead) nx = __hip_atomic_fetch_add(fq, 1u, __ATOMIC_RELAXED, __HIP_MEMORY_SCOPE_AGENT);
                const int r = (int)(cur >> 7), qb = 15 - (int)((cur >> 3) & 15), b = (int)(cur & 7);
                const float* bfg = args.in[8]; int h = 0;
                for (int c = 0; c < 8; ++c) { int rk = 0; for (int j = 0; j < 8; ++j) rk += (bfg[j] > bfg[c] || (bfg[j] == bfg[c] && j < c)) ? 1 : 0; if (rk == r) h = c; }
                const size_t r0 = (size_t)b * SEQ, rq = r0 + (size_t)qb * 256;
                att::Src s; s.nt = 4 * (qb + 1); s.q0 = qb * 256; s.ldo = DM;
                s.q = PROJ + rq * NPROJ + C_FQ + h * 64; s.ldq = NPROJ; s.k1 = PROJ + r0 * NPROJ + C_FK + h * 64; s.ldk1 = NPROJ; s.k2 = KAUG + (size_t)(b * 8 + h) * SEQ * 8; s.ldk2 = 8; s.v = PROJ + r0 * NPROJ + C_FV + h * 64; s.ldv = NPROJ;
                s.o = O + rq * DM + 512 + h * 64; s.sso = SSO + rq * 16 + 8 + h; s.kn = (const float*)(ws + WS_KN) + (size_t)(b * 8 + h) * 64; s.cum = (const float*)(ws + WS_CUM) + (size_t)(b * 8 + h) * SEQ;
                att::unit<5, 8, 9, 2, true, true, true, true, true>(s, F.lds, F.wave);
                if (lead) tk[0] = nx;
                __syncthreads();
                cur = __builtin_amdgcn_readfirstlane(tk[0]);
            }
        }
    }
    SEAM(3);
    bf16 *WoT = (bf16*)(ws + WS_WO), *WxqT = (bf16*)(ws + WS_WXQ), *WxoT = (bf16*)(ws + WS_WXO), *XQ = (bf16*)(ws + WS_XQ), *XO = (bf16*)(ws + WS_XO);
    float* ssq1 = (float*)(ws + WS_SSQ1);
    if (IN(4)) REPS(4) {
        pg8::DenseSched S; S.init((const bf16*)(ws + WS_O), DM, WoT, T, DM, DM, F.G, (int)blockIdx.x);
        EpiWo E{(const float*)(ws + WS_SSO), (const float*)(ws + WS_RMSX), args.in[2], XN, ssq1, ws + WS_H1F8};
        pg8::gemm_phase<EpiWo, pg8::DenseSched, false>(F.lds, F.tabs, DM, DM, S, E, F.wave);
    }
    SEAM(4);
    if (IN(5)) REPS(5) {
        pg8::DenseSched S; S.init((const bf16*)(ws + WS_H1F8), DM / 2, WxqT, T, DM, DM / 2, F.G, (int)blockIdx.x);
        { EpiXQ8 E{ws + WS_XQ, ssq1, XQ8_SCALE / (H8_SCALE * WXQ8_SCALE)}; pg8::gemm_phase<EpiXQ8, pg8::DenseSched, false, true>(F.lds, F.tabs, DM, DM, S, E, F.wave); }
        asm volatile("s_waitcnt vmcnt(0)" ::: "memory"); __syncthreads();
        __builtin_amdgcn_fence(__ATOMIC_ACQUIRE, "agent"); asm volatile("s_waitcnt vmcnt(0)" ::: "memory"); __syncthreads();
        pg8::Unit u; pg8::DenseSched S2; S2.init(XN, DM, WxqT, T, DM, DM, F.G, (int)blockIdx.x);
        for (int i = 0; S2.next(i, u); ++i) {
            const int b = u.row0 / SEQ, h = u.pn;
            { att::Src s; s.kn = nullptr; s.cum = nullptr; s.nt = MEMLEN / 64; s.q0 = 0; s.q = (const bf16*)(ws + WS_XQ + (size_t)u.row0 * DM + h * 256); s.ldq = DM; s.k1 = (const bf16*)(ws + WS_KM8 + (size_t)b * MEMLEN * 1024 + h * 256); s.ldk1 = 1024; s.k2 = s.k1; s.ldk2 = 1024;
              s.v = KVMEM + (size_t)b * MEMLEN * 2048 + 1024 + h * 256; s.ldv = 2048; s.o = (bf16*)(ws + WS_XOF8 + (size_t)u.row0 * DM + h * 256); s.ldo = DM; s.sso = nullptr;
              att::xunit(s, F.lds, F.wave); }
        }
    }
    SEAM(5);
    if (IN(6)) {
        pg8::DenseSched S; S.init((const bf16*)(ws + WS_XOF8), DM / 2, WxoT, T, DM, DM / 2, F.G, (int)blockIdx.x);
        EpiAddOut E{XN, 1.f / (XO8_SCALE * WXO8_SCALE)};
        pg8::gemm_phase<EpiAddOut, pg8::DenseSched, false, true>(F.lds, F.tabs, DM, DM, S, E, F.wave);
    }
    SEAM(6);
    int* cnt = (int*)(ws + WS_CTL) + CW_CNT; const int* list = (const int*)(ws + WS_LIST);
    if (IN(7)) { if ((PROBE_REP) == 7) p7_route(F, args, (size_t)(WS_KVM - WS_XF8)); p7_route(F, args, 0); }
    SEAM(7);
    if (IN(8)) REPS(8) {
        const int nMt = moe_tables(F, cnt);
        MoeSched S; S.o.init(nMt, 2048 / 256, F.G, (int)blockIdx.x); S.tables((const volatile LAS int*)(F.MISC + 64), (const volatile LAS int*)(F.MISC + 128));
        S.A = (const char*)(ws + WS_XF8); S.a_row_bytes = 0; S.Wt = (const char*)(ws + WS_WGU); S.w_exp_bytes = (size_t)2048 * DM; S.brow = DM; S.list = list; S.gather = true;
        EpiGateUp E{args.in[21], ws + WS_ACT};
        pg8::gemm_phase<EpiGateUp, MoeSched, true, true>(F.lds, F.tabs, DM, DM, S, E, F.wave);
    }
    SEAM(8);
    if (IN(9)) REPS(9) {
        const int nMt = __builtin_amdgcn_readfirstlane(((const volatile LAS int*)(F.MISC + 64))[NEXP]);
        MoeSched S; S.o.init(nMt, DM / 256, F.G, (int)blockIdx.x); S.tables((const volatile LAS int*)(F.MISC + 64), (const volatile LAS int*)(F.MISC + 128));
        S.A = (const char*)(ws + WS_ACT); S.a_row_bytes = (size_t)DEXP; S.Wt = (const char*)(ws + WS_WD); S.w_exp_bytes = (size_t)DM * DEXP; S.brow = DEXP; S.list = list; S.gather = false;
        EpiDown E{args.in[23], (const float*)(ws + WS_GSORT), list, ws + WS_Y};
        pg8::gemm_phase<EpiDown, MoeSched, false, true>(F.lds, F.tabs, DEXP, DEXP, S, E, F.wave);
    }
    SEAM(9);
    if (IN(10)) { if ((PROBE_REP) == 10) p10_combine(F, args, (float*)(ws + WS_XQ)); p10_combine(F, args, args.out); }
#undef IN
#undef SEAM
}
extern "C" void kernel_launch(void* const* d_in, const int* in_sizes, int n_in, void* d_out, int out_size, void* d_ws, size_t ws_size, hipStream_t stream) {
    if (n_in != 25 || ws_size < WS_END || out_size != T * DM) { fprintf(stderr, "kernel_launch: unexpected shapes n_in %d ws %zu out %d\n", n_in, ws_size, out_size); return; }
    static int grid = 0;
    if (grid == 0) {
        int dev = 0, cus = 0, per_cu = 0;
        if (hipGetDevice(&dev) != hipSuccess || hipDeviceGetAttribute(&cus, hipDeviceAttributeMultiprocessorCount, dev) != hipSuccess) { fprintf(stderr, "kernel_launch: device query failed\n"); grid = -1; return; }
        if (hipFuncSetAttribute((const void*)mega_fwd, hipFuncAttributeMaxDynamicSharedMemorySize, LDS_BYTES) != hipSuccess) { fprintf(stderr, "kernel_launch: hipFuncSetAttribute failed\n"); grid = -1; return; }
        if (hipOccupancyMaxActiveBlocksPerMultiprocessor(&per_cu, (const void*)mega_fwd, NWAVES * 64, LDS_BYTES) != hipSuccess || per_cu < 1) { fprintf(stderr, "kernel_launch: occupancy query says %d blocks per CU\n", per_cu); (void)hipGetLastError(); grid = -1; return; }
        grid = cus;
    }
    if (grid < 0) return;
    (void)hipMemsetAsync((char*)d_ws + WS_CTL, 0, 1 * MiB, stream);
    MegaArgs a{}; for (int i = 0; i < 25; ++i) a.in[i] = (const float*)d_in[i]; a.out = (float*)d_out; a.ws = (unsigned char*)d_ws; a.ph_lo = 0; a.ph_hi = N_PHASES; a.coop = 1;
    void* params[] = {&a};
    const hipError_t e = hipLaunchCooperativeKernel((const void*)mega_fwd, dim3(grid), dim3(NWAVES * 64), params, LDS_BYTES, stream);
    if (e != hipSuccess) fprintf(stderr, "cooperative launch failed: %s (grid %d)\n", hipGetErrorString(e), grid);
}
```

```cpp
#include <hip/hip_runtime.h>
#include <cstdio>
#include <cstdint>

constexpr int DM = 1024, BATCH = 8, SEQ = 4096, T = BATCH * SEQ, MEMLEN = 256, TM = BATCH * MEMLEN;
constexpr int NPROJ = 2048;
constexpr int C_QLAT = 0, C_KVLAT = 256, C_KPE = 384, C_FQ = 416, C_FK = 928, C_FV = 1440, C_FL = 1952, IN_COLS = 1960;
constexpr int NEXP = 32, TOPK = 4, DEXP = 1024;
constexpr float EPS = 1e-6f, LOG2E = 1.4426950408889634f;
constexpr float C2M = 0.10206207261596577f * LOG2E;
constexpr float C2F = 0.125f * LOG2E;
constexpr float C2X = 0.0625f * LOG2E;

typedef unsigned short bf16;
__device__ __forceinline__ float bf2f(bf16 v) { return __uint_as_float(((unsigned)v) << 16); }
__device__ __forceinline__ bf16 f2bf(float f) { unsigned u = __float_as_uint(f); return (bf16)((u + 0x7fffu + ((u >> 16) & 1u)) >> 16); }

constexpr size_t MiB = 1u << 20;
constexpr size_t WS_CTL = 0;
constexpr size_t WS_ROPE = 1 * MiB;
constexpr size_t WS_CUM = 2 * MiB;
constexpr size_t WS_KAUG = 3 * MiB;
constexpr size_t WS_SSQQ = 7 * MiB;
constexpr size_t WS_SSQKV = 7 * MiB + 512 * 1024;
constexpr size_t WS_SSO = 8 * MiB;
constexpr size_t WS_SSQ1 = 994 * MiB;
constexpr size_t WS_TOPI = 10 * MiB + 512 * 1024;
constexpr size_t WS_GATE = 11 * MiB;
constexpr size_t WS_SLOT = 11 * MiB + 512 * 1024;
constexpr size_t WS_LIST = 12 * MiB;
constexpr size_t WS_WIN = 16 * MiB;
constexpr size_t WS_WQ = 20 * MiB;
constexpr size_t WS_WKV = 20 * MiB + 512 * 1024;
constexpr size_t WS_WO = 21 * MiB;
constexpr size_t WS_WXQ = 23 * MiB;
constexpr size_t WS_WMKV = 25 * MiB;
constexpr size_t WS_WXO = 29 * MiB;
constexpr size_t WS_WGU = 32 * MiB;
constexpr size_t WS_WD = 160 * MiB;
constexpr size_t WS_XN = 224 * MiB;
constexpr size_t WS_PROJ = 288 * MiB;
constexpr size_t WS_QM = 416 * MiB;
constexpr size_t WS_KVM = 464 * MiB;
constexpr size_t WS_O = 528 * MiB;
constexpr size_t WS_XQ = 592 * MiB;
constexpr size_t WS_XO = 656 * MiB;
constexpr size_t WS_MEMN = 720 * MiB;
constexpr size_t WS_KVMEM = 724 * MiB;
constexpr size_t WS_ACT = 736 * MiB;
constexpr size_t WS_SC = 736 * MiB;
constexpr size_t WS_Y = 288 * MiB;
constexpr size_t WS_END = 1000 * MiB;
constexpr int CW_CNT = 64;

#include <hip/hip_cooperative_groups.h>
#include <type_traits>
namespace cg = cooperative_groups;
#define LAS __attribute__((address_space(3)))
#define GAS __attribute__((address_space(1)))
typedef short bf16x8 __attribute__((ext_vector_type(8)));
typedef short s16x4 __attribute__((ext_vector_type(4)));
typedef float f32x4 __attribute__((ext_vector_type(4)));
typedef float f32x2 __attribute__((ext_vector_type(2)));
typedef float f32x16 __attribute__((ext_vector_type(16)));
typedef unsigned u32x4 __attribute__((ext_vector_type(4)));
typedef unsigned u32x2 __attribute__((ext_vector_type(2)));
typedef __bf16 bf16x2_t __attribute__((ext_vector_type(2)));
__device__ __forceinline__ unsigned cvtpk(float lo, float hi) { f32x2 v = {lo, hi}; bf16x2_t b = __builtin_convertvector(v, bf16x2_t); return __builtin_bit_cast(unsigned, b); }
__device__ __forceinline__ int lane_id() { int l; asm volatile("v_mbcnt_lo_u32_b32 %0, -1, 0\n\tv_mbcnt_hi_u32_b32 %0, -1, %0" : "=v"(l)); return l; }
__device__ __forceinline__ float wave_sum(float v) {
#pragma unroll
    for (int o = 1; o < 64; o <<= 1) v += __shfl_xor(v, o);
    return v;
}

constexpr float XQ8_SCALE = 32.f;
constexpr float WXQ8_SCALE = 256.f, WXO8_SCALE = 32.f, H8_SCALE = 4.f, XO8_SCALE = 64.f;
namespace pg8 {
constexpr int BM = 256, BK = 64, HALF = 128, HTB = HALF * BK * 2  , STAGE_BYTES = 8 * HTB, NXCD = 8, WGM = 8;
__host__ __device__ __forceinline__ int lds_byte(int r, int c) { const int st = (r >> 4) * 2 + (c >> 5), rr = r & 15, cc = c & 31, ob = rr * 64 + cc * 2; return st * 1024 + (ob ^ (((ob >> 9) & 1) << 5)); }
__host__ __device__ __forceinline__ void stage_rc(int b, int& R, int& C) { const int st = b / 1024, sb = b % 1024, swz = sb ^ (((sb >> 9) & 1) << 5); R = (st >> 1) * 16 + swz / 64; C = (st & 1) * 32 + (swz % 64) / 2; }
__host__ __device__ __forceinline__ int perm32(int rho) { const int n = rho >> 4, i = rho & 15; return 8 * (i >> 2) + 4 * n + (i & 3); }

struct Unit { int row0, col0, rows, pn, e; const char* a; const char* b; const int* list; };

typedef int i32x8 __attribute__((ext_vector_type(8)));
typedef int i32x4 __attribute__((ext_vector_type(4)));
template <class Epi, class Sched, bool GATHER, bool F8 = false>
__device__ __forceinline__ void gemm_phase(LAS unsigned char* lds, LAS unsigned* tabs, const int K, const int lda, const Sched& S, const Epi& E, const int wave) {
    int tid_ = (wave << 6) | lane_id(); asm volatile("" : "+v"(tid_));
    const int tid = tid_, wid = __builtin_amdgcn_readfirstlane(tid >> 6), lane = tid & 63, wr = wid >> 2, wc = wid & 3, fr = lane & 15, fq = lane >> 4;
    const int nt = K / (F8 ? 128 : BK);
    const int rowA = F8 ? lda : 2 * lda, rowB = F8 ? K : 2 * K;
    unsigned vB[2], vA[2], vcu[2][2];
#pragma unroll
    for (int i = 0; i < 2; ++i) { int R, C; stage_rc(tid * 16 + i * 8192, R, C); const int Rb = Epi::PERM ? ((R & ~31) + perm32(R & 31)) : R;
        vB[i] = (unsigned)(Rb * rowB + 2 * C); vA[i] = (unsigned)(R * rowA + 2 * C);
#pragma unroll
        for (int h = 0; h < 2; ++h) vcu[h][i] = 0u; }
    const size_t hstepA = (size_t)HALF * rowA;
    const size_t kstep = (size_t)(BK * 2);
    const size_t hstepB = (size_t)HALF * rowB;
    const unsigned ldsw = (unsigned)wid * 1024u;
    const unsigned lds_u32 = (unsigned)__builtin_amdgcn_readfirstlane((int)(unsigned)(size_t)lds);
    const int aoff = lds_byte(wr * 64 + fr, F8 ? fq * 16 : fq * 8); int boff = lds_byte(wc * 32 + fr, F8 ? fq * 16 : fq * 8) + 4 * HTB;
    asm volatile("" : "+v"(boff));
#define PG8_SA(b, h) (((b) * 2 + (h)) * HTB)
#define PG8_SB(b, h) ((4 + (b) * 2 + (h)) * HTB)
#define PG8_STAGE(bufoff, gbase, voff) do { const unsigned long long _gb = (unsigned long long)(gbase); \
        const unsigned _glo = __builtin_amdgcn_readfirstlane((unsigned)_gb), _ghi = __builtin_amdgcn_readfirstlane((unsigned)(_gb >> 32)); const unsigned long long _sb = ((unsigned long long)_ghi << 32) | _glo; \
        _Pragma("unroll") for (int _i = 0; _i < 2; ++_i) { unsigned _keep; const unsigned _dst = lds_u32 + (unsigned)(bufoff) + ldsw + _i * 8192u; \
        asm volatile("s_mov_b32 %0, m0\n\ts_mov_b32 m0, %3\n\ts_nop 0\n\tglobal_load_lds_dwordx4 %1, %2\n\ts_mov_b32 m0, %0" : "=&s"(_keep) : "v"((voff)[_i]), "s"(_sb), "s"(_dst) : "memory"); } } while (0)
#define PG8_STAGE_A(bufoff, gbase, h, vsel) do { if constexpr (GATHER) { PG8_STAGE(bufoff, gbase, (vsel)[h]); } else { PG8_STAGE(bufoff, (gbase) + (h) * hstepA, vA); } } while (0)
#define PG8_RD8(dst, off) do { const i32x4 _l = *(const LAS i32x4*)(lds + (off)), _h = *(const LAS i32x4*)(lds + (off) + 16); dst = __builtin_shufflevector(_l, _h, 0, 1, 2, 3, 4, 5, 6, 7); } while (0)
#define PG8_LDA(dst, dst8, b, h) do { if constexpr (F8) { _Pragma("unroll") for (int m = 0; m < 4; ++m) PG8_RD8(dst8[m], PG8_SA(b, h) + aoff + m * 2048); } \
        else { _Pragma("unroll") for (int m = 0; m < 4; ++m) _Pragma("unroll") for (int k = 0; k < 2; ++k) dst[m][k] = *(const LAS bf16x8*)(lds + PG8_SA(b, h) + aoff + m * 2048 + k * 1024); } } while (0)
#define PG8_LDB(dst, dst8, b, h) do { if constexpr (F8) { _Pragma("unroll") for (int n = 0; n < 2; ++n) PG8_RD8(dst8[n], ((b) * 2 + (h)) * HTB + boff + n * 2048); } \
        else { _Pragma("unroll") for (int n = 0; n < 2; ++n) _Pragma("unroll") for (int k = 0; k < 2; ++k) dst[n][k] = *(const LAS bf16x8*)(lds + ((b) * 2 + (h)) * HTB + boff + n * 2048 + k * 1024); } } while (0)
#define PG8_MMA(ai, bj, At, At8, Bt, Bt8) do { __builtin_amdgcn_s_setprio(1); _Pragma("unroll") for (int m = 0; m < 4; ++m) _Pragma("unroll") for (int n = 0; n < 2; ++n) { \
        if constexpr (F8) acc[ai][bj][m][n] = __builtin_amdgcn_mfma_scale_f32_16x16x128_f8f6f4(Bt8[n], At8[m], acc[ai][bj][m][n], 0, 0, 0, 0x7F7F7F7F, 0, 0x7F7F7F7F); \
        else { _Pragma("unroll") for (int k = 0; k < 2; ++k) acc[ai][bj][m][n] = __builtin_amdgcn_mfma_f32_16x16x32_bf16(Bt[n][k], At[m][k], acc[ai][bj][m][n], 0, 0, 0); } } \
        __builtin_amdgcn_s_setprio(0); } while (0)
#define PG8_WAIT_V(n) asm volatile("s_waitcnt vmcnt(" #n ")" ::: "memory")
#define PG8_WAIT_L(n) asm volatile("s_waitcnt lgkmcnt(" #n ")" ::: "memory")
#define PG8_BAR __builtin_amdgcn_s_barrier()
#define PG8_SCHED __builtin_amdgcn_sched_barrier(0)
#define PG8_TABDMA(u, slot) __builtin_amdgcn_global_load_lds((const unsigned*)((u).list + lane_id() * 4), (LAS unsigned*)(tabs + (slot) * 256), 16, 0, 0)
#define PG8_TABOFF(dst, slot) do { const int _tid = (wid << 6) | lane_id(); _Pragma("unroll") for (int _i = 0; _i < 2; ++_i) { int _R, _C; stage_rc(_tid * 16 + _i * 8192, _R, _C); \
        _Pragma("unroll") for (int _h = 0; _h < 2; ++_h) { unsigned _t = tabs[(slot) * 256 + _h * HALF + _R] >> 2; _t = _t < (unsigned)(T - 1) ? _t : (unsigned)(T - 1); \
        dst[_h][_i] = _t * (unsigned)rowA + 2u * (unsigned)_C; } } } while (0)
    __builtin_amdgcn_s_waitcnt(0x0F70);
    Unit cur, nxt; int ui = 0;
    if (!S.next(0, cur)) return;
    if constexpr (GATHER) { PG8_TABDMA(cur, 0); PG8_WAIT_V(0); PG8_BAR; PG8_TABOFF(vcu, 0); PG8_WAIT_L(0); }
    f32x4 acc[2][2][4][2];
    bf16x8 At[4][2], B0[2][2], B1[2][2]; i32x8 At8[4], B08[2], B18[2];
    const char* cA = cur.a; const char* cB = cur.b;
    PG8_STAGE(PG8_SB(0, 0), cB, vB); PG8_STAGE(PG8_SB(0, 1), cB + hstepB, vB); PG8_STAGE_A(PG8_SA(0, 0), cA, 0, vcu); PG8_STAGE_A(PG8_SA(0, 1), cA, 1, vcu);
    if (wr == 1) PG8_BAR;
    PG8_WAIT_V(2); PG8_BAR;
    PG8_STAGE(PG8_SB(1, 0), cB + kstep, vB); PG8_STAGE_A(PG8_SA(1, 0), cA + kstep, 0, vcu); PG8_STAGE(PG8_SB(1, 1), cB + hstepB + kstep, vB);
    PG8_WAIT_V(6); PG8_BAR;
    asm volatile("" ::: "memory");
#pragma unroll
    for (int a = 0; a < 2; ++a)
#pragma unroll
        for (int b = 0; b < 2; ++b)
#pragma unroll
            for (int m = 0; m < 4; ++m)
#pragma unroll
                for (int n = 0; n < 2; ++n) acc[a][b][m][n] = (f32x4){0.f, 0.f, 0.f, 0.f};
    for (;;) {
        const bool has_next = S.next(ui + 1, nxt);
        if constexpr (GATHER) { if (has_next) PG8_TABDMA(nxt, (ui + 1) & 1); }
        const char* nA = has_next ? nxt.a : cA; const char* nB = has_next ? nxt.b : cB;
#pragma nounroll
        for (int t = 0; t < nt; t += 2) {
            const bool last = (t == nt - 2);
            if constexpr (Epi::MID) { if (t == nt / 2) { const int l2_ = lane_id(); E.mid(acc, cur, wr, l2_ & 15); } }
            unsigned v2[2][2];
#pragma unroll
            for (int h = 0; h < 2; ++h)
#pragma unroll
                for (int i = 0; i < 2; ++i) v2[h][i] = vcu[h][i];
            if constexpr (GATHER) { if (last && has_next) { PG8_TABOFF(v2, (ui + 1) & 1); PG8_WAIT_L(0); } }
            const char* a1 = cA + (size_t)(t + 1) * kstep;
            const char* a2 = last ? nA : cA + (size_t)(t + 2) * kstep; const char* b2 = last ? nB : cB + (size_t)(t + 2) * kstep;
            const char* a3 = a2 + kstep; const char* b3 = b2 + kstep;
            PG8_LDB(B0, B08, 0, 0); PG8_LDB(B1, B18, 0, 1); PG8_SCHED; PG8_LDA(At, At8, 0, 0); PG8_STAGE_A(PG8_SA(1, 1), a1, 1, vcu);
            PG8_WAIT_V(8); PG8_WAIT_L(0); PG8_BAR; PG8_MMA(0, 0, At, At8, B0, B08); PG8_MMA(0, 1, At, At8, B1, B18); PG8_BAR; PG8_SCHED;
            PG8_LDA(At, At8, 0, 1); PG8_STAGE(PG8_SB(0, 0), b2, vB); PG8_STAGE(PG8_SB(0, 1), b2 + hstepB, vB); PG8_STAGE_A(PG8_SA(0, 0), a2, 0, v2);
            PG8_WAIT_V(8); PG8_WAIT_L(0); PG8_BAR; PG8_MMA(1, 0, At, At8, B0, B08); PG8_MMA(1, 1, At, At8, B1, B18); PG8_BAR; PG8_SCHED;
            PG8_LDB(B0, B08, 1, 0); PG8_LDB(B1, B18, 1, 1); PG8_SCHED; PG8_LDA(At, At8, 1, 0); PG8_STAGE_A(PG8_SA(0, 1), a2, 1, v2);
            PG8_WAIT_V(8); PG8_WAIT_L(0); PG8_BAR; PG8_MMA(0, 0, At, At8, B0, B08); PG8_MMA(0, 1, At, At8, B1, B18); PG8_BAR; PG8_SCHED;
            PG8_LDA(At, At8, 1, 1); PG8_STAGE(PG8_SB(1, 0), b3, vB); PG8_STAGE(PG8_SB(1, 1), b3 + hstepB, vB); PG8_STAGE_A(PG8_SA(1, 0), a3, 0, v2);
            PG8_WAIT_V(8); PG8_WAIT_L(0); PG8_BAR; PG8_MMA(1, 0, At, At8, B0, B08); PG8_MMA(1, 1, At, At8, B1, B18); PG8_BAR; PG8_SCHED;
        }
        if (wr == 0) PG8_BAR;
        { const int l2_ = lane_id(); E(acc, cur, wr, wc, l2_ & 15, l2_ >> 4); }
        if (!has_next) break;
#pragma unroll
        for (int a = 0; a < 2; ++a)
#pragma unroll
            for (int b = 0; b < 2; ++b)
#pragma unroll
                for (int m = 0; m < 4; ++m)
#pragma unroll
                    for (int n = 0; n < 2; ++n) acc[a][b][m][n] = (f32x4){0.f, 0.f, 0.f, 0.f};
        cur = nxt; cA = nA; cB = nB; ++ui;
        if constexpr (GATHER) { PG8_TABOFF(vcu, ui & 1); PG8_WAIT_L(0); }
        if (wr == 1) PG8_BAR;
    }
    PG8_WAIT_V(0);
    PG8_BAR;
#undef PG8_SA
#undef PG8_SB
#undef PG8_STAGE
#undef PG8_STAGE_A
#undef PG8_RD8
#undef PG8_LDA
#undef PG8_LDB
#undef PG8_MMA
#undef PG8_TABDMA
#undef PG8_TABOFF
}
struct TileOrder {
    int nM, nN, nwg, G, c;
    __device__ __forceinline__ void init(int nM_, int nN_, int G_, int c_) { nM = nM_; nN = nN_; nwg = nM * nN; G = G_; c = c_; }
    __device__ __forceinline__ bool tile(int i, int& pm, int& pn) const {
        const int L = i * G + c; if (L >= nwg) return false;
        int wgid = L; { const int q = nwg / NXCD, r = nwg % NXCD, xcd = wgid % NXCD, off = wgid / NXCD; wgid = (xcd < r ? xcd * (q + 1) : r * (q + 1) + (xcd - r) * q) + off; }
        const int nig = WGM * nN, gid = wgid / nig, fm = gid * WGM, gsz = (nM - fm) < WGM ? (nM - fm) : WGM;
        pm = fm + ((wgid % nig) % gsz); pn = (wgid % nig) / gsz; return true;
    }
};
struct DenseSched {
    TileOrder o; const char* A; const char* Bt; int lda, K;
    __device__ __forceinline__ void init(const bf16* A_, int lda_, const bf16* Bt_, int M, int N, int K_, int G, int c) { o.init(M / BM, N / BM, G, c); A = (const char*)A_; Bt = (const char*)Bt_; lda = lda_; K = K_; }
    __device__ __forceinline__ bool next(int i, Unit& u) const { int pm, pn; if (!o.tile(i, pm, pn)) return false; u.row0 = pm * BM; u.col0 = pn * BM; u.rows = BM; u.pn = pn; u.e = 0;
        u.a = A + (size_t)pm * BM * lda * 2; u.b = Bt + (size_t)pn * BM * K * 2; u.list = nullptr; return true; }
};
}

__device__ __forceinline__ float sum4sq(const f32x4& v) { return (v[0] * v[0] + v[1] * v[1]) + (v[2] * v[2] + v[3] * v[3]); }
__device__ __forceinline__ void st_bf4(bf16* p, const f32x4& v) { u32x2 w; w.x = cvtpk(v[0], v[1]); w.y = cvtpk(v[2], v[3]); *(u32x2*)p = w; }
__device__ __forceinline__ int cofs8(int fq) { return 4 * fq + (fq & 1) * 12; }
__device__ __forceinline__ void st_bf8(bf16* p, const f32x4& v0, const f32x4& v1) {
    const unsigned a0 = cvtpk(v0[0], v0[1]), a1 = cvtpk(v0[2], v0[3]), b0 = cvtpk(v1[0], v1[1]), b1 = cvtpk(v1[2], v1[3]);
    const auto r0 = __builtin_amdgcn_permlane16_swap(a0, b0, false, false), r1 = __builtin_amdgcn_permlane16_swap(a1, b1, false, false);
    *(u32x4*)p = (u32x4){r0[0], r1[0], r0[1], r1[1]}; }
struct EpiProj {
    static constexpr bool PERM = false, MID = false;
    bf16* PROJ; float* ssqq; float* ssqkv; const float* rope; float* LF; const float* bfor;
    __device__ __forceinline__ void operator()(f32x4 (&acc)[2][2][4][2], const pg8::Unit& u, int wr, int wc, int fr, int fq) const {
        asm volatile("" : "+v"(fr), "+v"(fq));
        const bool rp1 = (u.pn == 1) && (wc == 0);
        f32x4 ca[8], cb[8];
        if (rp1) {
#pragma unroll
            for (int g = 0; g < 8; ++g) { const int pos = (u.row0 + (g >> 2) * 128 + wr * 64 + (g & 3) * 16 + fr) & (SEQ - 1); const float* q = rope + 2 * (pos * 16 + fq * 4); ca[g] = *(const f32x4*)q; cb[g] = *(const f32x4*)(q + 4); } }
#pragma unroll
        for (int ai = 0; ai < 2; ++ai)
#pragma unroll
            for (int m = 0; m < 4; ++m) {
                const int row = u.row0 + ai * 128 + wr * 64 + m * 16 + fr;
                if (u.pn == 0) { float s = (sum4sq(acc[ai][0][m][0]) + sum4sq(acc[ai][0][m][1])) + (sum4sq(acc[ai][1][m][0]) + sum4sq(acc[ai][1][m][1]));
                    s += __shfl_xor(s, 16); s += __shfl_xor(s, 32); if (fq == 0) ssqq[(size_t)row * 4 + wc] = s; }
                if (u.pn == 1) { float s = sum4sq(acc[ai][0][m][0]) + sum4sq(acc[ai][0][m][1]);
                    s += __shfl_xor(s, 16); s += __shfl_xor(s, 32); if (fq == 0) ssqkv[(size_t)row * 4 + wc] = s;
                    if (wc == 0) { const f32x4 x1 = acc[ai][1][m][0], x2 = acc[ai][1][m][1]; f32x4 y1, y2; const f32x4 c0 = ca[ai * 4 + m], c1 = cb[ai * 4 + m];
#pragma unroll
                        for (int e = 0; e < 4; ++e) { const float cx = e < 2 ? c0[2 * e] : c1[2 * e - 4], sx = e < 2 ? c0[2 * e + 1] : c1[2 * e - 3]; y1[e] = x1[e] * cx - x2[e] * sx; y2[e] = x2[e] * cx + x1[e] * sx; }
                        acc[ai][1][m][0] = y1; acc[ai][1][m][1] = y2; } }
                if (u.pn == 7 && wc == 1 && fq < 2) { const f32x4 z4 = acc[ai][1][m][0]; f32x4 lf;
#pragma unroll
                    for (int e = 0; e < 4; ++e) { const float z = z4[e] + bfor[fq * 4 + e]; lf[e] = fminf(z, 0.f) - 0.6931471805599453f * __builtin_amdgcn_logf(1.f + __builtin_amdgcn_exp2f(-LOG2E * fabsf(z))); }
                    *(f32x4*)(LF + (size_t)row * 8 + fq * 4) = lf; }
                bf16* rp = PROJ + (size_t)row * NPROJ + u.col0 + wc * 32 + cofs8(fq);
#pragma unroll
                for (int bj = 0; bj < 2; ++bj) st_bf8(rp + bj * 128, acc[ai][bj][m][0], acc[ai][bj][m][1]);
                asm volatile("" ::: "memory");
            }
    }
};
template <int NS, bool ROPE> struct EpiScale {
    static constexpr bool PERM = false, MID = false;
    bf16* C; int ldc; const float* ss; float inv_n; const float* rope; float osc = 1.f;
    __device__ __forceinline__ void operator()(f32x4 (&acc)[2][2][4][2], const pg8::Unit& u, int wr, int wc, int fr, int fq) const {
        asm volatile("" : "+v"(fr), "+v"(fq));
        const int rbase = u.row0 + wr * 64 + fr;
        f32x4 q[8], ca[8], cb[8]; int bjr = -1;
        if constexpr (ROPE) { const int g0 = (u.col0 >> 5) + wc; bjr = (g0 % 3 == 2) ? 0 : (((g0 + 4) % 3 == 2) ? 1 : -1);
            if (bjr >= 0) {
#pragma unroll
                for (int g = 0; g < 8; ++g) { const int pos = (rbase + (g >> 2) * 128 + (g & 3) * 16) & (SEQ - 1); const float* qq = rope + 2 * (pos * 16 + fq * 4); ca[g] = *(const f32x4*)qq; cb[g] = *(const f32x4*)(qq + 4); } } }
        float q1[8];
        if constexpr (NS == 16) {
#pragma unroll
            for (int g = 0; g < 8; ++g) q[g] = *(const f32x4*)(ss + (size_t)(rbase + (g >> 2) * 128 + (g & 3) * 16) * NS + 4 * fq); }
        if constexpr (NS == 4) {
#pragma unroll
            for (int g = 0; g < 8; ++g) q1[g] = ss[(size_t)(rbase + (g >> 2) * 128 + (g & 3) * 16) * 4 + fq]; }
#pragma unroll
        for (int g = 0; g < 8; ++g) { const int ai = g >> 2, m = g & 3;
                const int row = rbase + ai * 128 + m * 16; float sc = 1.f;
                if constexpr (NS > 0) { float t = NS == 16 ? (q[g][0] + q[g][1]) + (q[g][2] + q[g][3]) : q1[g];
                    t += __shfl_xor(t, 16); t += __shfl_xor(t, 32);
                    sc = rsqrtf(t * inv_n + EPS) * osc; }
                bf16* rp = C + (size_t)row * ldc + u.col0 + wc * 32 + cofs8(fq);
#pragma unroll
                for (int bj = 0; bj < 2; ++bj) {
                    f32x4 v0 = acc[ai][bj][m][0] * sc, v1 = acc[ai][bj][m][1] * sc;
                    if constexpr (ROPE) { if (bj == bjr) { f32x4 y1, y2; const f32x4 c0 = ca[g], c1 = cb[g];
#pragma unroll
                        for (int e = 0; e < 4; ++e) { const float cx = e < 2 ? c0[2 * e] : c1[2 * e - 4], sx = e < 2 ? c0[2 * e + 1] : c1[2 * e - 3]; y1[e] = v0[e] * cx - v1[e] * sx; y2[e] = v1[e] * cx + v0[e] * sx; }
                        v0 = y1; v1 = y2; } }
                    st_bf8(rp + bj * 128, v0, v1);
                }
                asm volatile("" ::: "memory");
            }
    }
};

__device__ __forceinline__ u32x2 pack8_f8(const f32x4& v0, const f32x4& v1, float sc) {
    f32x4 a0, a1;
#pragma unroll
    for (int e = 0; e < 4; ++e) { const auto r = __builtin_amdgcn_permlane16_swap(__float_as_uint(v0[e]), __float_as_uint(v1[e]), false, false); a0[e] = __uint_as_float(r[0]) * sc; a1[e] = __uint_as_float(r[1]) * sc; }
    int w0 = 0, w1 = 0; w0 = __builtin_amdgcn_cvt_pk_fp8_f32(a0[0], a0[1], w0, false); w0 = __builtin_amdgcn_cvt_pk_fp8_f32(a0[2], a0[3], w0, true);
    w1 = __builtin_amdgcn_cvt_pk_fp8_f32(a1[0], a1[1], w1, false); w1 = __builtin_amdgcn_cvt_pk_fp8_f32(a1[2], a1[3], w1, true); return (u32x2){(unsigned)w0, (unsigned)w1}; }
struct EpiMemKV {
    static constexpr bool PERM = false, MID = false;   static constexpr int NST = 16;
    bf16* C; unsigned char* k8;
    __device__ __forceinline__ void operator()(f32x4 (&acc)[2][2][4][2], const pg8::Unit& u, int wr, int wc, int fr, int fq) const {
        asm volatile("" : "+v"(fr), "+v"(fq));
        const int rbase = u.row0 + wr * 64 + fr;
#pragma unroll
        for (int g = 0; g < 8; ++g) { const int ai = g >> 2, m = g & 3; const int row = rbase + ai * 128 + m * 16; const int cc = u.col0 + wc * 32 + cofs8(fq);
#pragma unroll
            for (int bj = 0; bj < 2; ++bj) {
                if (u.pn < 4) *(u32x2*)(k8 + (size_t)row * 1024 + cc + bj * 128) = pack8_f8(acc[ai][bj][m][0], acc[ai][bj][m][1], 1.f);
                else st_bf8(C + (size_t)row * 2048 + cc + bj * 128, acc[ai][bj][m][0], acc[ai][bj][m][1]); }
            asm volatile("" ::: "memory"); }
    }
};
struct EpiXQ8 {
    static constexpr bool PERM = false, MID = false;   static constexpr int NST = 16;
    unsigned char* C8; const float* ss; float osc;
    __device__ __forceinline__ void operator()(f32x4 (&acc)[2][2][4][2], const pg8::Unit& u, int wr, int wc, int fr, int fq) const {
        asm volatile("" : "+v"(fr), "+v"(fq));
        const int rbase = u.row0 + wr * 64 + fr; f32x4 q[8];
#pragma unroll
        for (int g = 0; g < 8; ++g) q[g] = *(const f32x4*)(ss + (size_t)(rbase + (g >> 2) * 128 + (g & 3) * 16) * 16 + 4 * fq);
#pragma unroll
        for (int g = 0; g < 8; ++g) { const int ai = g >> 2, m = g & 3; const int row = rbase + ai * 128 + m * 16;
            float t = (q[g][0] + q[g][1]) + (q[g][2] + q[g][3]); t += __shfl_xor(t, 16); t += __shfl_xor(t, 32);
            const float sc = rsqrtf(t * (1.f / 1024.f) + EPS) * osc;
#pragma unroll
            for (int bj = 0; bj < 2; ++bj) *(u32x2*)(C8 + (size_t)row * DM + u.col0 + wc * 32 + cofs8(fq) + bj * 128) = pack8_f8(acc[ai][bj][m][0], acc[ai][bj][m][1], sc);
            asm volatile("" ::: "memory"); }
    }
};

struct EpiWo {
    static constexpr bool PERM = false, MID = true;
    const float* sso; const float* rmsx; const float* gmix; bf16* hb; float* ssq1; unsigned char* h8;
    __device__ __forceinline__ void mid(f32x4 (&acc)[2][2][4][2], const pg8::Unit& u, int wr, int fr) const {
        asm volatile("" : "+v"(fr));
        int fq = lane_id() >> 4; asm volatile("" : "+v"(fq));
        const int rbase = u.row0 + wr * 64 + fr; f32x4 p[8];
#pragma unroll
        for (int g = 0; g < 8; ++g) p[g] = *((const f32x4*)(sso + (size_t)(rbase + (g >> 2) * 128 + (g & 3) * 16) * 16) + fq);
#pragma unroll
        for (int g = 0; g < 8; ++g) { const int ai = g >> 2, m = g & 3;
            float t = (p[g][0] + p[g][1]) + (p[g][2] + p[g][3]); t += __shfl_xor(t, 16); const float o = __shfl_xor(t, 32);
            const float sm = fq < 2 ? t : o, sf = fq < 2 ? o : t;
            const float ratio = rsqrtf(sm * (1.f / 512.f) + EPS) / rsqrtf(sf * (1.f / 512.f) + EPS);
#pragma unroll
            for (int bj = 0; bj < 2; ++bj)
#pragma unroll
                for (int n = 0; n < 2; ++n) acc[ai][bj][m][n] *= ratio;
            asm volatile("" ::: "memory"); }
    }
    __device__ __forceinline__ void operator()(f32x4 (&acc)[2][2][4][2], const pg8::Unit& u, int wr, int wc, int fr, int fq) const {
        asm volatile("" : "+v"(fr), "+v"(fq));
        const int rbase = u.row0 + wr * 64 + fr; const int cs = u.col0 + wc * 32 + cofs8(fq);
        u32x4 xc[2], xn[2]; f32x4 sf4[8]; float ssg[8], rmx[8]; unsigned w8p[2][2]; f32x4 ig[2][2];
#pragma unroll
        for (int g = 0; g < 8; ++g) { const int rr_ = rbase + (g >> 2) * 128 + (g & 3) * 16; sf4[g] = *((const f32x4*)(sso + (size_t)rr_ * 16) + 2 + (fq & 1)); rmx[g] = rmsx[rr_]; }
#pragma unroll
        for (int bj = 0; bj < 2; ++bj) { xc[bj] = *(const u32x4*)(hb + (size_t)rbase * DM + cs + bj * 128);
#pragma unroll
            for (int n = 0; n < 2; ++n) { const f32x4 gg = *(const f32x4*)(gmix + cs + bj * 128 + 4 * n); ig[bj][n] = (f32x4){__builtin_amdgcn_rcpf(gg[0]), __builtin_amdgcn_rcpf(gg[1]), __builtin_amdgcn_rcpf(gg[2]), __builtin_amdgcn_rcpf(gg[3])}; } }
#pragma unroll
        for (int g = 0; g < 8; ++g) { const int ai = g >> 2, m = g & 3; const int row = rbase + ai * 128 + m * 16;
            if (g + 1 < 8) { const int rn = rbase + ((g + 1) >> 2) * 128 + ((g + 1) & 3) * 16;
#pragma unroll
                for (int bj = 0; bj < 2; ++bj) xn[bj] = *(const u32x4*)(hb + (size_t)rn * DM + cs + bj * 128); }
            float tf = (sf4[g][0] + sf4[g][1]) + (sf4[g][2] + sf4[g][3]); tf += __shfl_xor(tf, 16);
            const float rf = rsqrtf(tf * (1.f / 512.f) + EPS), rx = rmx[g];
            const size_t off = (size_t)row * DM + cs; float ss = 0.f;
#pragma unroll
            for (int bj = 0; bj < 2; ++bj) { const u32x4 w = xc[bj];
                f32x4 a0, a1;
#pragma unroll
                for (int e = 0; e < 4; ++e) { const auto r = __builtin_amdgcn_permlane16_swap(__float_as_uint(acc[ai][bj][m][0][e]), __float_as_uint(acc[ai][bj][m][1][e]), false, false); a0[e] = __uint_as_float(r[0]) * rf; a1[e] = __uint_as_float(r[1]) * rf; }
                a0 += (f32x4){__uint_as_float(w.x << 16), __uint_as_float(w.x & 0xffff0000u), __uint_as_float(w.y << 16), __uint_as_float(w.y & 0xffff0000u)} * ig[bj][0] * rx;
                a1 += (f32x4){__uint_as_float(w.z << 16), __uint_as_float(w.z & 0xffff0000u), __uint_as_float(w.w << 16), __uint_as_float(w.w & 0xffff0000u)} * ig[bj][1] * rx;
                ss += sum4sq(a0) + sum4sq(a1);
                *(u32x4*)(hb + off + bj * 128) = (u32x4){cvtpk(a0[0], a0[1]), cvtpk(a0[2], a0[3]), cvtpk(a1[0], a1[1]), cvtpk(a1[2], a1[3])};
                int w0 = 0, w1 = 0; w0 = __builtin_amdgcn_cvt_pk_fp8_f32(a0[0] * H8_SCALE, a0[1] * H8_SCALE, w0, false); w0 = __builtin_amdgcn_cvt_pk_fp8_f32(a0[2] * H8_SCALE, a0[3] * H8_SCALE, w0, true);
                w1 = __builtin_amdgcn_cvt_pk_fp8_f32(a1[0] * H8_SCALE, a1[1] * H8_SCALE, w1, false); w1 = __builtin_amdgcn_cvt_pk_fp8_f32(a1[2] * H8_SCALE, a1[3] * H8_SCALE, w1, true);
                if ((g & 1) == 0) { w8p[bj][0] = (unsigned)w0; w8p[bj][1] = (unsigned)w1; }
                else {
                    const auto r0 = __builtin_amdgcn_permlane32_swap(w8p[bj][0], (unsigned)w0, false, false), r1 = __builtin_amdgcn_permlane32_swap(w8p[bj][1], (unsigned)w1, false, false);
                    const int rw = row - ((fq < 2) ? 16 : 0);
                    *(u32x4*)(h8 + (size_t)rw * DM + u.col0 + wc * 32 + (fq & 1) * 16 + bj * 128) = (u32x4){r0[0], r1[0], r0[1], r1[1]}; } }
            ss += __shfl_xor(ss, 16); ss += __shfl_xor(ss, 32); ssg[g] = ss;
            asm volatile("" ::: "memory");
#pragma unroll
            for (int bj = 0; bj < 2; ++bj) xc[bj] = xn[bj]; }
        { const float s0 = fq == 0 ? ssg[0] : fq == 1 ? ssg[1] : fq == 2 ? ssg[2] : ssg[3], s1 = fq == 0 ? ssg[4] : fq == 1 ? ssg[5] : fq == 2 ? ssg[6] : ssg[7];
          float* sp = ssq1 + (size_t)(rbase + fq * 16) * 16 + u.pn * 4 + wc; sp[0] = s0; sp[128 * 16] = s1; }
    }
};
struct EpiAddOut {
    static constexpr bool PERM = false, MID = false;
    bf16* hb; float osc;
    __device__ __forceinline__ void operator()(f32x4 (&acc)[2][2][4][2], const pg8::Unit& u, int wr, int wc, int fr, int fq) const {
        asm volatile("" : "+v"(fr), "+v"(fq));
        const int rbase = u.row0 + wr * 64 + fr; const int cb = u.col0 + wc * 32 + cofs8(fq);
        u32x4 xc[2], xn[2];
#pragma unroll
        for (int bj = 0; bj < 2; ++bj) xc[bj] = *(const u32x4*)(hb + (size_t)rbase * DM + cb + bj * 128);
#pragma unroll
        for (int g = 0; g < 8; ++g) { const int ai = g >> 2, m = g & 3; const int row = rbase + ai * 128 + m * 16;
            if (g + 1 < 8) { const int rn = rbase + ((g + 1) >> 2) * 128 + ((g + 1) & 3) * 16;
#pragma unroll
                for (int bj = 0; bj < 2; ++bj) xn[bj] = *(const u32x4*)(hb + (size_t)rn * DM + cb + bj * 128); }
#pragma unroll
            for (int bj = 0; bj < 2; ++bj) { const u32x4 w = xc[bj]; f32x4 a0, a1;
#pragma unroll
                for (int e = 0; e < 4; ++e) { const auto r = __builtin_amdgcn_permlane16_swap(__float_as_uint(acc[ai][bj][m][0][e]), __float_as_uint(acc[ai][bj][m][1][e]), false, false); a0[e] = __uint_as_float(r[0]) * osc; a1[e] = __uint_as_float(r[1]) * osc; }
                const f32x4 h0 = (f32x4){__uint_as_float(w.x << 16), __uint_as_float(w.x & 0xffff0000u), __uint_as_float(w.y << 16), __uint_as_float(w.y & 0xffff0000u)} + a0;
                const f32x4 h1 = (f32x4){__uint_as_float(w.z << 16), __uint_as_float(w.z & 0xffff0000u), __uint_as_float(w.w << 16), __uint_as_float(w.w & 0xffff0000u)} + a1;
                *(u32x4*)(hb + (size_t)row * DM + cb + bj * 128) = (u32x4){cvtpk(h0[0], h0[1]), cvtpk(h0[2], h0[3]), cvtpk(h1[0], h1[1]), cvtpk(h1[2], h1[3])}; }
            asm volatile("" ::: "memory");
#pragma unroll
            for (int bj = 0; bj < 2; ++bj) xc[bj] = xn[bj]; }
    }
};

namespace att {
__device__ __forceinline__ int crow(int r, int hi) { return (r & 3) + 8 * (r >> 2) + 4 * hi; }
struct Src { const bf16* q; int ldq; const bf16* k1; int ldk1; const bf16* k2; int ldk2; const bf16* v; int ldv; bf16* o; int ldo; float* sso; int nt; int q0; const float* kn; const float* cum; };
typedef short v4i16_t __attribute__((ext_vector_type(4)));
__device__ __forceinline__ s16x4 vtr(const LAS unsigned char* p) { return __builtin_bit_cast(s16x4, __builtin_amdgcn_ds_read_tr16_b64_v4i16((LAS v4i16_t*)p)); }
__device__ __forceinline__ float rowmax32(const f32x16& p0, const f32x16& p1) {
    float a = fmaxf(fmaxf(p0[0], p0[1]), p1[0]), b = fmaxf(fmaxf(p0[2], p0[3]), p1[1]); a = fmaxf(fmaxf(a, p1[2]), p1[3]);
#pragma unroll
    for (int r = 4; r < 16; r += 4) { a = fmaxf(fmaxf(a, p0[r]), p0[r + 1]); b = fmaxf(fmaxf(b, p0[r + 2]), p0[r + 3]); a = fmaxf(fmaxf(a, p1[r]), p1[r + 1]); b = fmaxf(fmaxf(b, p1[r + 2]), p1[r + 3]); }
    const float m = fmaxf(a, b);
    auto rr = __builtin_amdgcn_permlane32_swap(__float_as_uint(m), __float_as_uint(m), false, false);
    return fmaxf(__uint_as_float(rr[0]), __uint_as_float(rr[1]));
}
template <int I, int N, class F> __device__ __forceinline__ void cfor(F&& f) { if constexpr (I < N) { f(std::integral_constant<int, I>{}); cfor<I + 1, N>(f); } }
template <int D0, int NKS, bool AUG> __device__ __forceinline__ void kread(bf16x8& f0, bf16x8& f1, unsigned base, unsigned abase) {
    if constexpr (AUG && D0 == NKS - 1) { asm volatile("ds_read_b128 %0, %1 offset:8192" : "=v"(f0) : "v"(abase)); asm volatile("ds_read_b128 %0, %1 offset:8704" : "=v"(f1) : "v"(abase)); }
    else { asm volatile("ds_read_b128 %0, %1 offset:%2" : "=v"(f0) : "v"(base), "n"(D0 * 2048)); asm volatile("ds_read_b128 %0, %1 offset:%2" : "=v"(f1) : "v"(base), "n"(D0 * 2048 + 512)); }
}
template <int NKS, int NC1, int NCH, int ND0, bool CAUSAL, bool AUG, bool REV, bool WSSO, bool EARLY = false, bool ASMK = true>
__device__ __forceinline__ void unit(const Src& s, LAS unsigned char* lds, const int wave) {
    int tid_ = (wave << 6) | lane_id(); asm volatile("" : "+v"(tid_));
    const int tid = tid_, lane = tid & 63, r32 = lane & 31, hi = lane >> 5, wid = __builtin_amdgcn_readfirstlane(tid >> 6);
    constexpr int KSL = NCH * 1024, VSL = ND0 * 4096, KPW = (NCH + 7) / 8, VPW = ND0 / 2;
    constexpr int VOFF = 2 * KSL, WSF = VOFF + 2 * VSL;
    constexpr float THR = 8.f;
    LAS float* wsf = (LAS float*)(lds + WSF) + wid * 64;
    bf16x8 qr[NKS];
    { const bf16* qw = s.q + (size_t)(wid * 32 + r32) * s.ldq + hi * 8;
#pragma unroll
      for (int d0 = 0; d0 < NKS; ++d0) { if (AUG && d0 == NKS - 1) { const short one = hi ? (short)0 : (short)0x3F80; qr[d0] = (bf16x8){one, one, one, 0, 0, 0, 0, 0}; } else qr[d0] = *(const bf16x8*)(qw + d0 * 16); } }
    LAS float* shf = (LAS float*)(lds + WSF + 2048);
    float thr = 0.f;
    if constexpr (EARLY) {
        float q2 = 0.f;
#pragma unroll
        for (int d0 = 0; d0 < NKS - 1; ++d0)
#pragma unroll
            for (int j = 0; j < 8; ++j) { const float f = __uint_as_float(((unsigned)(unsigned short)qr[d0][j]) << 16); q2 += f * f; }
        { auto rr = __builtin_amdgcn_permlane32_swap(__float_as_uint(q2), __float_as_uint(q2), false, false); q2 = __uint_as_float(rr[0]) + __uint_as_float(rr[1]); }
#pragma unroll
        for (int o_ = 1; o_ < 32; o_ <<= 1) q2 = fmaxf(q2, __shfl_xor(q2, o_));
        if (lane == 0) shf[wid] = q2;
        float kn = s.kn[lane];
#pragma unroll
        for (int o_ = 1; o_ < 64; o_ <<= 1) { const float up = __shfl_up(kn, o_); if (lane >= o_) kn = fmaxf(kn, up); }
        thr = kn;
    }
    u32x4 kreg[2][KPW], vreg[2][VPW];
#define ATT_LOAD(t, S_) do { \
    _Pragma("unroll") for (int i_ = 0; i_ < KPW; ++i_) { const int c_ = (wid + 8 * i_ < NCH) ? wid + 8 * i_ : wid; const size_t row_ = (size_t)(t) * 64 + lane;     \
        const bf16* g_ = (c_ < NC1) ? s.k1 + row_ * s.ldk1 + c_ * 8 : s.k2 + row_ * s.ldk2 + (c_ - NC1) * 8; kreg[S_][i_] = *(const u32x4*)g_; } \
    _Pragma("unroll") for (int i_ = 0; i_ < VPW; ++i_) { const int p_ = wid + 8 * i_; const int dh_ = p_ >> 2, rg_ = p_ & 3; \
        vreg[S_][i_] = *(const u32x4*)(s.v + ((size_t)(t) * 64 + 16 * rg_ + (lane >> 2)) * s.ldv + dh_ * 32 + (lane & 3) * 8); } } while (0)
#define ATT_WRITE(slot, S_) do { \
    _Pragma("unroll") for (int i_ = 0; i_ < KPW; ++i_) { const int c_ = (wid + 8 * i_ < NCH) ? wid + 8 * i_ : wid; *(LAS u32x4*)(lds + (slot) * KSL + c_ * 1024 + lane * 16) = kreg[S_][i_]; } \
    _Pragma("unroll") for (int i_ = 0; i_ < VPW; ++i_) { const int p_ = wid + 8 * i_; *(LAS u32x4*)(lds + VOFF + (slot) * VSL + p_ * 1024 + lane * 16) = vreg[S_][i_]; } } while (0)
    const int nt = s.nt;
    ATT_LOAD(REV ? nt - 1 : 0, 0); ATT_LOAD(REV ? nt - 2 : 1, 1); ATT_WRITE(0, 0);
    __syncthreads();
    if constexpr (EARLY) { float qm = shf[0];
#pragma unroll
        for (int w = 1; w < 8; ++w) qm = fmaxf(qm, shf[w]);
        thr = sqrtf(qm) * thr * 1.001f - s.cum[64 * lane + 63] * LOG2E; }
    float m = 0.f, l = 0.f; f32x16 o[ND0]; bool have = false;
    f32x16 negm = f32x16{};
#pragma unroll
    for (int d = 0; d < ND0; ++d) o[d] = f32x16{};
    const int qmin = s.q0 + wid * 32;
    auto body = [&](auto parc, const int i) -> bool { constexpr int PAR = decltype(parc)::value;
        const int t = REV ? nt - 1 - i : i; constexpr int cur = PAR;
        if constexpr (EARLY) { if (i > 0) { float mmin = shf[8 + (PAR ^ 1) * 8];
#pragma unroll
            for (int w = 1; w < 8; ++w) mmin = fminf(mmin, shf[8 + (PAR ^ 1) * 8 + w]);
            const float bound = __uint_as_float(__builtin_amdgcn_readlane(__float_as_uint(thr), t));
            if (bound - mmin < -40.f) return false; } }
        { const int t2 = REV ? (t >= 2 ? t - 2 : 0) : (t + 2 < nt ? t + 2 : nt - 1); ATT_LOAD(t2, PAR); }
        const bool skip = CAUSAL && (64 * t > qmin + 31);
        if (!skip) {
            const LAS unsigned char* kb = lds + cur * KSL + r32 * 16;
            f32x16 p0 = negm, p1 = negm;
            if constexpr (!ASMK) {
                const LAS unsigned char* kq = kb + hi * 1024; bf16x8 ka[8], kc[8];
#pragma unroll
                for (int d = 0; d < 4; ++d) { ka[2 * d] = *(const LAS bf16x8*)(kq + d * 2048); ka[2 * d + 1] = *(const LAS bf16x8*)(kq + d * 2048 + 512); }
#pragma unroll
                for (int g0 = 0; g0 < NKS; g0 += 4) {
                    if (g0 + 4 < NKS) {
#pragma unroll
                        for (int d = 0; d < 4; ++d) { kc[2 * d] = *(const LAS bf16x8*)(kq + (g0 + 4 + d) * 2048); kc[2 * d + 1] = *(const LAS bf16x8*)(kq + (g0 + 4 + d) * 2048 + 512); } }
                    __builtin_amdgcn_sched_group_barrier(0x100, 8, 0);
#pragma unroll
                    for (int d = 0; d < 4; ++d) { p0 = __builtin_amdgcn_mfma_f32_32x32x16_bf16(ka[2 * d], qr[g0 + d], p0, 0, 0, 0); p1 = __builtin_amdgcn_mfma_f32_32x32x16_bf16(ka[2 * d + 1], qr[g0 + d], p1, 0, 0, 0); }
                    __builtin_amdgcn_sched_group_barrier(0x008, 8, 0);
#pragma unroll
                    for (int z = 0; z < 8; ++z) ka[z] = kc[z];
                }
            } else {
            constexpr int KB = (NKS % 3 == 0 || NKS == 5) ? 3 : 4, NB = (NKS + KB - 1) / KB;
            const unsigned kbase = (unsigned)(size_t)(kb + hi * 1024), abase = (unsigned)(size_t)kb;
            bf16x8 kfa[2 * KB], kfb[2 * KB];
#pragma unroll
            for (int z_ = 0; z_ < 2 * KB; ++z_) { kfa[z_] = bf16x8{}; kfb[z_] = bf16x8{}; }
            cfor<0, KB>([&](auto ic) { constexpr int D = decltype(ic)::value; if constexpr (D < NKS) kread<D, NKS, AUG>(kfa[2 * D], kfa[2 * D + 1], kbase, abase); });
            cfor<0, NB>([&](auto bc) { constexpr int B = decltype(bc)::value;
                if constexpr (B % 2 == 0) { if constexpr (KB == 3) asm volatile("s_waitcnt lgkmcnt(0)" : "+v"(kfa[0]), "+v"(kfa[1]), "+v"(kfa[2]), "+v"(kfa[3]), "+v"(kfa[4]), "+v"(kfa[5]) :: "memory");
                                            else asm volatile("s_waitcnt lgkmcnt(0)" : "+v"(kfa[0]), "+v"(kfa[1]), "+v"(kfa[2]), "+v"(kfa[3]), "+v"(kfa[4]), "+v"(kfa[5]), "+v"(kfa[6]), "+v"(kfa[7]) :: "memory"); }
                else { if constexpr (KB == 3) asm volatile("s_waitcnt lgkmcnt(0)" : "+v"(kfb[0]), "+v"(kfb[1]), "+v"(kfb[2]), "+v"(kfb[3]), "+v"(kfb[4]), "+v"(kfb[5]) :: "memory");
                       else asm volatile("s_waitcnt lgkmcnt(0)" : "+v"(kfb[0]), "+v"(kfb[1]), "+v"(kfb[2]), "+v"(kfb[3]), "+v"(kfb[4]), "+v"(kfb[5]), "+v"(kfb[6]), "+v"(kfb[7]) :: "memory"); }
                __builtin_amdgcn_sched_barrier(0);
                if constexpr (B % 2 == 0) {
                    cfor<0, KB>([&](auto ic) { constexpr int D = (B + 1) * KB + decltype(ic)::value; if constexpr (D < NKS) kread<D, NKS, AUG>(kfb[2 * decltype(ic)::value], kfb[2 * decltype(ic)::value + 1], kbase, abase); });
                    __builtin_amdgcn_sched_barrier(0);
                    cfor<0, KB>([&](auto ic) { constexpr int D = B * KB + decltype(ic)::value; if constexpr (D < NKS) { p0 = __builtin_amdgcn_mfma_f32_32x32x16_bf16(kfa[2 * decltype(ic)::value], qr[D], p0, 0, 0, 0); p1 = __builtin_amdgcn_mfma_f32_32x32x16_bf16(kfa[2 * decltype(ic)::value + 1], qr[D], p1, 0, 0, 0); } });
                } else {
                    cfor<0, KB>([&](auto ic) { constexpr int D = (B + 1) * KB + decltype(ic)::value; if constexpr (D < NKS) kread<D, NKS, AUG>(kfa[2 * decltype(ic)::value], kfa[2 * decltype(ic)::value + 1], kbase, abase); });
                    __builtin_amdgcn_sched_barrier(0);
                    cfor<0, KB>([&](auto ic) { constexpr int D = B * KB + decltype(ic)::value; if constexpr (D < NKS) { p0 = __builtin_amdgcn_mfma_f32_32x32x16_bf16(kfb[2 * decltype(ic)::value], qr[D], p0, 0, 0, 0); p1 = __builtin_amdgcn_mfma_f32_32x32x16_bf16(kfb[2 * decltype(ic)::value + 1], qr[D], p1, 0, 0, 0); } });
                }
            });
            }
            const LAS unsigned char* vb = lds + VOFF + cur * VSL + ((lane >> 4) & 1) * 32 + (lane & 3) * 8 + (4 * hi + ((lane & 15) >> 2)) * 64;
            s16x4 vlo[2][4], vhi[2][4];
#pragma unroll
            for (int d = 0; d < 2; ++d)
#pragma unroll
                for (int ks = 0; ks < 4; ++ks) { vlo[d][ks] = vtr(vb + d * 4096 + ks * 1024); vhi[d][ks] = vtr(vb + d * 4096 + ks * 1024 + 512); }
            __builtin_amdgcn_sched_group_barrier(0x100, 16, 0);
            if (CAUSAL && (64 * t + 63 > qmin)) { const int q = qmin + r32, kv0 = 64 * t + 4 * hi;
#pragma unroll
                for (int r = 0; r < 16; ++r) { const int kv = kv0 + (r & 3) + 8 * (r >> 2); if (kv > q) p0[r] = -INFINITY; if (kv + 32 > q) p1[r] = -INFINITY; } }
            const float rmd = rowmax32(p0, p1);
            if (!have || __any(rmd > THR)) {
                const float dd = have ? fmaxf(rmd, 0.f) : rmd, alpha = have ? __builtin_amdgcn_exp2f(-dd) : 1.f; l *= alpha; m += dd;
#pragma unroll
                for (int r = 0; r < 16; ++r) { p0[r] -= dd; p1[r] -= dd; negm[r] = -m; }
                if (have) {
                    if (hi == 0) wsf[r32] = alpha;
                    asm volatile("s_waitcnt lgkmcnt(0)" ::: "memory");
#pragma unroll
                    for (int r = 0; r < 16; ++r) { const float a = wsf[crow(r, hi)];
#pragma unroll
                        for (int d = 0; d < ND0; ++d) o[d][r] *= a; } }
                have = true;
            }
            float sacc = 0.f;
#pragma unroll
            for (int r = 0; r < 16; ++r) { p0[r] = __builtin_amdgcn_exp2f(p0[r]); p1[r] = __builtin_amdgcn_exp2f(p1[r]); sacc += p0[r] + p1[r]; }
            l += sacc;
            u32x4 pw[4];
#pragma unroll
            for (int j = 0; j < 4; ++j) { pw[0][j] = cvtpk(p0[2 * j], p0[2 * j + 1]); pw[1][j] = cvtpk(p0[8 + 2 * j], p0[8 + 2 * j + 1]); pw[2][j] = cvtpk(p1[2 * j], p1[2 * j + 1]); pw[3][j] = cvtpk(p1[8 + 2 * j], p1[8 + 2 * j + 1]); }
#pragma unroll
            for (int d = 0; d < 2; ++d)
#pragma unroll
                for (int ks = 0; ks < 4; ++ks) { const bf16x8 vf = (bf16x8){vlo[d][ks][0], vlo[d][ks][1], vlo[d][ks][2], vlo[d][ks][3], vhi[d][ks][0], vhi[d][ks][1], vhi[d][ks][2], vhi[d][ks][3]};
                    o[d] = __builtin_amdgcn_mfma_f32_32x32x16_bf16(__builtin_bit_cast(bf16x8, pw[ks]), vf, o[d], 0, 0, 0); }
            if constexpr (ND0 > 2) {
#pragma unroll
                for (int d = 2; d < ND0; d += 2) { s16x4 wlo[2][4], whi[2][4];
#pragma unroll
                    for (int e = 0; e < 2; ++e)
#pragma unroll
                        for (int ks = 0; ks < 4; ++ks) { wlo[e][ks] = vtr(vb + (d + e) * 4096 + ks * 1024); whi[e][ks] = vtr(vb + (d + e) * 4096 + ks * 1024 + 512); }
#pragma unroll
                    for (int e = 0; e < 2; ++e)
#pragma unroll
                        for (int ks = 0; ks < 4; ++ks) { const bf16x8 vf = (bf16x8){wlo[e][ks][0], wlo[e][ks][1], wlo[e][ks][2], wlo[e][ks][3], whi[e][ks][0], whi[e][ks][1], whi[e][ks][2], whi[e][ks][3]};
                            o[d + e] = __builtin_amdgcn_mfma_f32_32x32x16_bf16(__builtin_bit_cast(bf16x8, pw[ks]), vf, o[d + e], 0, 0, 0); }
                    __builtin_amdgcn_sched_group_barrier(0x100, 16, 1); __builtin_amdgcn_sched_group_barrier(0x008, 8, 1); } }
        }
        ATT_WRITE(cur ^ 1, PAR ^ 1);
        if constexpr (EARLY) { float mw = have ? m : -1e30f;
#pragma unroll
            for (int o_ = 1; o_ < 32; o_ <<= 1) mw = fminf(mw, __shfl_xor(mw, o_));
            if (lane == 0) shf[8 + PAR * 8 + wid] = mw; }
        __syncthreads();
        return true;
    };
    for (int i = 0; i < nt; i += 2) { if (!body(std::integral_constant<int, 0>{}, i)) break; if (!body(std::integral_constant<int, 1>{}, i + 1)) break; }
    { auto rr = __builtin_amdgcn_permlane32_swap(__float_as_uint(l), __float_as_uint(l), false, false); l = __uint_as_float(rr[0]) + __uint_as_float(rr[1]); }
    if (hi == 0) wsf[32 + r32] = 1.f / l;
    asm volatile("s_waitcnt lgkmcnt(0)" ::: "memory");
    LAS bf16* stg = (LAS bf16*)(lds + wid * (ND0 * 2048));
#pragma unroll
    for (int r = 0; r < 16; ++r) { const float rl = wsf[32 + crow(r, hi)]; const int orow = crow(r, hi);
#pragma unroll
        for (int d = 0; d < ND0; ++d) stg[orow * (ND0 * 32) + d * 32 + r32] = f2bf(o[d][r] * rl); }
    asm volatile("s_waitcnt lgkmcnt(0)" ::: "memory");
    constexpr int CPR = ND0 * 4, RPI = 64 / CPR;
    bf16* ow = s.o + (size_t)(wid * 32) * s.ldo;
#pragma unroll
    for (int it = 0; it < 32 / RPI; ++it) { const int row = it * RPI + lane / CPR, ch = lane % CPR; const u32x4 v = *(const LAS u32x4*)(stg + row * (ND0 * 32) + ch * 8);
        *(u32x4*)(ow + (size_t)row * s.ldo + ch * 8) = v;
        if (WSSO) { float ss = 0.f;
#pragma unroll
            for (int j = 0; j < 4; ++j) { const float a = __uint_as_float(v[j] << 16), b = __uint_as_float(v[j] & 0xffff0000u); ss += a * a + b * b; }
#pragma unroll
            for (int sh = 1; sh < CPR; sh <<= 1) ss += __shfl_xor(ss, sh);
            if (ch == 0) s.sso[(size_t)(wid * 32 + row) * 16] = ss; } }
    __syncthreads();
#undef ATT_LOAD
#undef ATT_WRITE
}
__device__ __forceinline__ void xunit(const Src& s, LAS unsigned char* lds, const int wave) {
    int tid_ = (wave << 6) | lane_id(); asm volatile("" : "+v"(tid_));
    const int tid = tid_, lane = tid & 63, r32 = lane & 31, hi = lane >> 5, wid = __builtin_amdgcn_readfirstlane(tid >> 6);
    constexpr int KSL = 16384, VSL = 16384, VOFF = 2 * KSL, STG = VOFF + 2 * VSL;
    LAS float* wsf = (LAS float*)(lds + 131072) + wid * 64;
    f32x16 p[4][2];
#pragma unroll
    for (int t = 0; t < 4; ++t) { p[t][0] = f32x16{}; p[t][1] = f32x16{}; }
    typedef int xi4 __attribute__((ext_vector_type(4))); typedef int xi8 __attribute__((ext_vector_type(8)));
    u32x4 sreg[2][2];
#define X_LOAD(J) do { if constexpr ((J) < 4) { _Pragma("unroll") for (int i_ = 0; i_ < 2; ++i_) sreg[(J) & 1][i_] = *(const u32x4*)((const unsigned char*)s.k1 + (size_t)((J) * 64 + lane) * s.ldk1 + (wid + 8 * i_) * 16); } \
        else if constexpr ((J) < 12) { _Pragma("unroll") for (int i_ = 0; i_ < 2; ++i_) { const int p_ = wid + 8 * i_, dh_ = p_ >> 2, rg_ = p_ & 3; \
            sreg[(J) & 1][i_] = *(const u32x4*)(s.v + (size_t)(((J) & 3) * 64 + 16 * rg_ + (lane >> 2)) * s.ldv + (((J) - 4) >> 2) * 128 + dh_ * 32 + (lane & 3) * 8); } } } while (0)
#define X_WRITE(J) do { if constexpr ((J) < 12) { _Pragma("unroll") for (int i_ = 0; i_ < 2; ++i_) *(LAS u32x4*)(lds + ((J) < 4 ? 0 : VOFF) + ((J) & 1) * KSL + (wid + 8 * i_) * 1024 + lane * 16) = sreg[(J) & 1][i_]; } } while (0)
    X_LOAD(0); X_LOAD(1);
    xi8 q8[4];
    { const unsigned char* qw8 = (const unsigned char*)s.q + (size_t)(wid * 32 + r32) * s.ldq + hi * 32;
#pragma unroll
      for (int s_ = 0; s_ < 4; ++s_) { const xi4 lo_ = *(const xi4*)(qw8 + 64 * s_), hi_ = *(const xi4*)(qw8 + 64 * s_ + 16); q8[s_] = __builtin_shufflevector(lo_, hi_, 0, 1, 2, 3, 4, 5, 6, 7); } }
    X_WRITE(0);
    __syncthreads();
    cfor<0, 4>([&](auto ic) { constexpr int I = decltype(ic)::value;
        X_LOAD(I + 2);
        const LAS unsigned char* kq = lds + (I & 1) * KSL + r32 * 16 + hi * 2048; xi8 kf[8];
#pragma unroll
        for (int s_ = 0; s_ < 4; ++s_)
#pragma unroll
            for (int kb = 0; kb < 2; ++kb) { const xi4 lo_ = *(const LAS xi4*)(kq + s_ * 4096 + kb * 512), hi_ = *(const LAS xi4*)(kq + s_ * 4096 + 1024 + kb * 512); kf[2 * s_ + kb] = __builtin_shufflevector(lo_, hi_, 0, 1, 2, 3, 4, 5, 6, 7); }
#pragma unroll
        for (int s_ = 0; s_ < 4; ++s_) { p[I][0] = __builtin_amdgcn_mfma_scale_f32_32x32x64_f8f6f4(kf[2 * s_], q8[s_], p[I][0], 0, 0, 0, 0x7F7F7F7F, 0, 0x7F7F7F7F);
                                       p[I][1] = __builtin_amdgcn_mfma_scale_f32_32x32x64_f8f6f4(kf[2 * s_ + 1], q8[s_], p[I][1], 0, 0, 0, 0x7F7F7F7F, 0, 0x7F7F7F7F); }
        X_WRITE(I + 1);
        __syncthreads();
    });
    float m = rowmax32(p[0][0], p[0][1]);
#pragma unroll
    for (int t = 1; t < 4; ++t) m = fmaxf(m, rowmax32(p[t][0], p[t][1]));
    float l = 0.f; u32x4 pw[4][4];
#pragma unroll
    for (int t = 0; t < 4; ++t) { float sacc = 0.f;
#pragma unroll
        for (int r = 0; r < 16; ++r) { p[t][0][r] = __builtin_amdgcn_exp2f((p[t][0][r] - m) * (1.f / XQ8_SCALE)); p[t][1][r] = __builtin_amdgcn_exp2f((p[t][1][r] - m) * (1.f / XQ8_SCALE)); sacc += p[t][0][r] + p[t][1][r]; }
        l += sacc;
#pragma unroll
        for (int j = 0; j < 4; ++j) { pw[t][0][j] = cvtpk(p[t][0][2 * j], p[t][0][2 * j + 1]); pw[t][1][j] = cvtpk(p[t][0][8 + 2 * j], p[t][0][8 + 2 * j + 1]); pw[t][2][j] = cvtpk(p[t][1][2 * j], p[t][1][2 * j + 1]); pw[t][3][j] = cvtpk(p[t][1][8 + 2 * j], p[t][1][8 + 2 * j + 1]); } }
    { auto rr = __builtin_amdgcn_permlane32_swap(__float_as_uint(l), __float_as_uint(l), false, false); l = __uint_as_float(rr[0]) + __uint_as_float(rr[1]); }
    if (hi == 0) wsf[32 + r32] = 1.f / l;
    asm volatile("s_waitcnt lgkmcnt(0)" ::: "memory");
    f32x16 o[4];
    cfor<0, 8>([&](auto ic) { constexpr int I = decltype(ic)::value, TT = I & 3, DVH = I >> 2;
        X_LOAD(I + 6);
        if constexpr (TT == 0) {
#pragma unroll
            for (int d = 0; d < 4; ++d) o[d] = f32x16{}; }
        const LAS unsigned char* vb = lds + VOFF + (I & 1) * VSL + ((lane >> 4) & 1) * 32 + (lane & 3) * 8 + (4 * hi + ((lane & 15) >> 2)) * 64;
#pragma unroll
        for (int d = 0; d < 4; d += 2) { s16x4 vlo[2][4], vhi[2][4];
#pragma unroll
            for (int e = 0; e < 2; ++e)
#pragma unroll
                for (int ks = 0; ks < 4; ++ks) { vlo[e][ks] = vtr(vb + (d + e) * 4096 + ks * 1024); vhi[e][ks] = vtr(vb + (d + e) * 4096 + ks * 1024 + 512); }
#pragma unroll
            for (int e = 0; e < 2; ++e)
#pragma unroll
                for (int ks = 0; ks < 4; ++ks) { const bf16x8 vf = (bf16x8){vlo[e][ks][0], vlo[e][ks][1], vlo[e][ks][2], vlo[e][ks][3], vhi[e][ks][0], vhi[e][ks][1], vhi[e][ks][2], vhi[e][ks][3]};
                    o[d + e] = __builtin_amdgcn_mfma_f32_32x32x16_bf16(__builtin_bit_cast(bf16x8, pw[TT][ks]), vf, o[d + e], 0, 0, 0); } }
        X_WRITE(I + 5);
        if constexpr (TT == 3) {
            LAS bf16* stg = (LAS bf16*)(lds + STG + wid * 8192);
#pragma unroll
            for (int r = 0; r < 16; ++r) { const float rl = wsf[32 + crow(r, hi)]; const int orow = crow(r, hi);
#pragma unroll
                for (int d = 0; d < 4; ++d) stg[orow * 128 + d * 32 + r32] = f2bf(o[d][r] * rl); }
            asm volatile("s_waitcnt lgkmcnt(0)" ::: "memory");
            unsigned char* ow = (unsigned char*)s.o + (size_t)(wid * 32) * s.ldo + DVH * 128;
#pragma unroll
            for (int it = 0; it < 4; ++it) { const int row = it * 8 + (lane >> 3), ch = lane & 7; const u32x4 v0 = *(const LAS u32x4*)(stg + row * 128 + ch * 16), v1 = *(const LAS u32x4*)(stg + row * 128 + ch * 16 + 8); u32x4 f;
#pragma unroll
                for (int j = 0; j < 4; ++j) { const unsigned q_ = j < 2 ? v0[2 * j] : v1[2 * j - 4], r_ = j < 2 ? v0[2 * j + 1] : v1[2 * j - 3]; int w = 0;
                    w = __builtin_amdgcn_cvt_pk_fp8_f32(__uint_as_float(q_ << 16) * XO8_SCALE, __uint_as_float(q_ & 0xffff0000u) * XO8_SCALE, w, false);
                    w = __builtin_amdgcn_cvt_pk_fp8_f32(__uint_as_float(r_ << 16) * XO8_SCALE, __uint_as_float(r_ & 0xffff0000u) * XO8_SCALE, w, true); f[j] = (unsigned)w; }
                *(u32x4*)(ow + (size_t)row * s.ldo + ch * 16) = f; }
            asm volatile("s_waitcnt lgkmcnt(0)" ::: "memory"); }
        __syncthreads();
    });
#undef X_LOAD
#undef X_WRITE
}
}

#define XB_TMO      128
#define XB_XCNT(j)  (256  + 64 * (j))
#define XB_XSUB(j)  (1280 + 64 * (j))
#define XB_XGEN(j)  (2304 + 64 * (j))
#define XB_TOP      3328
#define XB_TOPGEN   3392
#define XCD_BAR_WORDS 3456
#define XB_SPIN_CAP (1u << 18)
__device__ __forceinline__ unsigned xb_ld(unsigned* p)              { return __hip_atomic_load(p, __ATOMIC_RELAXED, __HIP_MEMORY_SCOPE_AGENT); }
__device__ __forceinline__ unsigned xb_add(unsigned* p, unsigned v) { return __hip_atomic_fetch_add(p, v, __ATOMIC_RELAXED, __HIP_MEMORY_SCOPE_AGENT); }
__device__ __forceinline__ unsigned xb_xcc_id() { return (unsigned)__builtin_amdgcn_s_getreg((3 << 11) | 20) & 0xFu; }
#define XB_SPIN(cond, bar) do { unsigned _sp = 0; while (cond) { __builtin_amdgcn_s_sleep(1); \
    if ((++_sp & 255u) == 0u) { if (xb_ld(&(bar)[XB_TMO])) break; if (_sp > XB_SPIN_CAP) { atomicAdd(&(bar)[XB_TMO], 1u); break; } } } } while (0)
struct XcdBarrier { unsigned* bar; unsigned x; volatile LAS unsigned* st; bool wave0; };
__device__ __forceinline__ XcdBarrier xcd_barrier_post(unsigned* bar, volatile LAS unsigned* st, int wave) {
    XcdBarrier b; b.bar = bar; b.x = xb_xcc_id(); b.st = st; b.wave0 = (wave == 0);
    if (b.wave0 && lane_id() == 0) (void)xb_add(&bar[XB_XCNT(b.x)], 1u);
    return b;
}
__device__ __forceinline__ void xcd_barrier_complete(unsigned* bar, unsigned x, unsigned& nloc, unsigned& nx) {
    const unsigned G = gridDim.x * gridDim.y * gridDim.z;
    unsigned sum, cnt, mine, sp = 0u;
    for (;;) {
        sum = 0u; cnt = 0u; mine = 0u;
#pragma unroll
        for (unsigned j = 0; j < 16; ++j) { const unsigned c = xb_ld(&bar[XB_XCNT(j)]); sum += c; cnt += (c > 0u) ? 1u : 0u; mine = (j == x) ? c : mine; }
        if (sum == G) break;
        __builtin_amdgcn_s_sleep(1);
        if ((++sp & 255u) == 0u) { if (xb_ld(&bar[XB_TMO])) break; if (sp > XB_SPIN_CAP) { atomicAdd(&bar[XB_TMO], 1u); break; } }
    }
    nloc = mine > 0u ? mine : 1u; nx = cnt > 0u ? cnt : 1u;
}
__device__ __forceinline__ void xcd_barrier(const XcdBarrier& b) {
    asm volatile("s_waitcnt vmcnt(0)" ::: "memory");
    __syncthreads();
    if (b.wave0 && lane_id() == 0) {
        unsigned* bar = b.bar;
        __builtin_amdgcn_s_waitcnt(0);
        unsigned nloc = b.st[0], nx = b.st[1];
        if (nloc == 0u) { xcd_barrier_complete(bar, b.x, nloc, nx); b.st[0] = nloc; b.st[1] = nx; }
        const unsigned old = xb_add(&bar[XB_XSUB(b.x)], 1u);
        const unsigned gen = old / nloc;
        if (old + 1u == (gen + 1u) * nloc) {
            __builtin_amdgcn_fence(__ATOMIC_RELEASE, "agent");
            asm volatile("s_waitcnt vmcnt(0)" ::: "memory");
            const unsigned og = xb_add(&bar[XB_TOP], 1u);
            const unsigned tg = og / nx;
            if (og + 1u == (tg + 1u) * nx) xb_add(&bar[XB_TOPGEN], 1u);
            else XB_SPIN(xb_ld(&bar[XB_TOPGEN]) == tg, bar);
            __builtin_amdgcn_fence(__ATOMIC_ACQUIRE, "agent");
            xb_add(&bar[XB_XGEN(b.x)], 1u);
            asm volatile("s_waitcnt vmcnt(0)" ::: "memory");
        } else {
            XB_SPIN(xb_ld(&bar[XB_XGEN(b.x)]) == gen, bar);
            __builtin_amdgcn_fence(__ATOMIC_ACQUIRE, "agent");
            asm volatile("s_waitcnt vmcnt(0)" ::: "memory");
        }
    }
    __syncthreads();
}

constexpr int NWAVES = 8;
constexpr int RING_BYTES = 131072, TABS_OFF = RING_BYTES, MISC_OFF = TABS_OFF + 2048, LDS_BYTES = 147456;
constexpr int CW_FOXQ = 256;
constexpr int CW_BAR = 4096;
constexpr int N_PHASES = 11;
constexpr float W8_SCALE = 32.f, ACT8_SCALE = 4.f, Y8_SCALE = 16.f;
#ifndef PROBE_REP
#define PROBE_REP -1
#endif
#define REPS(k) for (int rep_ = 0; rep_ < ((PROBE_REP) == (k) ? 2 : 1); ++rep_)
struct MegaArgs {
    const float* in[25]; float* out; unsigned char* ws; int ph_lo, ph_hi; int coop; int pad;
};
struct Frame {
    LAS unsigned char* lds; volatile LAS unsigned* MISC; LAS unsigned* tabs;
    int wave, vcu, G;
};
struct P0Item { const float* W; bf16* WT; const float* kscale; const float* kscale2; int K, N, NT, c_lo, c_hi, item; float cscale; bool f8; };
__device__ __forceinline__ void p0_load(const P0Item& d, f32x4 (&v)[8], int lane) {
    const int nblk = d.NT / 32, kb = d.item / nblk, nb = d.item % nblk, k0 = 64 * kb, n0 = 32 * nb; const int r8 = lane >> 3, c4 = lane & 7, nn = n0 + 4 * c4;
#pragma unroll
    for (int i = 0; i < 8; ++i) { const int kk = i * 8 + r8; v[i] = (f32x4){0.f, 0.f, 0.f, 0.f}; if (nn < d.N) v[i] = __builtin_nontemporal_load((const f32x4*)(d.W + (size_t)(k0 + kk) * d.N + nn)); }
}
__device__ __forceinline__ void p0_finish(const P0Item& d, const f32x4 (&v)[8], LAS float* scr, int lane) {
    const int nblk = d.NT / 32, kb = d.item / nblk, nb = d.item % nblk, k0 = 64 * kb, n0 = 32 * nb; const int r8 = lane >> 3, c4 = lane & 7, nn = n0 + 4 * c4;
    const float cs = (nn >= d.c_lo && nn < d.c_hi) ? d.cscale : 1.f;
#pragma unroll
    for (int i = 0; i < 8; ++i) { const int kk = i * 8 + r8; float ks = cs; if (d.kscale) ks *= (d.kscale2 && k0 >= 512) ? d.kscale2[k0 + kk - 512] : d.kscale[k0 + kk];
        LAS float* p = scr + kk * 33 + 4 * c4; p[0] = v[i][0] * ks; p[1] = v[i][1] * ks; p[2] = v[i][2] * ks; p[3] = v[i][3] * ks; }
    asm volatile("s_waitcnt lgkmcnt(0)" ::: "memory");
    const int c = lane & 7;
#pragma unroll
    for (int j = 0; j < 4; ++j) { const int n = (lane >> 3) + 8 * j; const LAS float* s = scr + (8 * c) * 33 + n;
        if (d.f8) { int w0 = 0, w1 = 0; w0 = __builtin_amdgcn_cvt_pk_fp8_f32(s[0 * 33], s[1 * 33], w0, false); w0 = __builtin_amdgcn_cvt_pk_fp8_f32(s[2 * 33], s[3 * 33], w0, true);
            w1 = __builtin_amdgcn_cvt_pk_fp8_f32(s[4 * 33], s[5 * 33], w1, false); w1 = __builtin_amdgcn_cvt_pk_fp8_f32(s[6 * 33], s[7 * 33], w1, true);
            *(u32x2*)((unsigned char*)d.WT + (size_t)(n0 + n) * d.K + k0 + 8 * c) = (u32x2){(unsigned)w0, (unsigned)w1}; }
        else { u32x4 o; o.x = cvtpk(s[0 * 33], s[1 * 33]); o.y = cvtpk(s[2 * 33], s[3 * 33]); o.z = cvtpk(s[4 * 33], s[5 * 33]); o.w = cvtpk(s[6 * 33], s[7 * 33]);
            *(u32x4*)(d.WT + (size_t)(n0 + n) * d.K + k0 + 8 * c) = o; } }
    asm volatile("s_waitcnt lgkmcnt(0)" ::: "memory");
}
__device__ __forceinline__ void rms_row_to_bf16(const float* xrow, const float* g, bf16* orow, int lane) {
    const f32x4* xr = (const f32x4*)xrow + lane; const f32x4* gr = (const f32x4*)g + lane;
    f32x4 v[4]; float s = 0.f;
#pragma unroll
    for (int j = 0; j < 4; ++j) { v[j] = xr[64 * j]; s += sum4sq(v[j]); }
    const float r = rsqrtf(wave_sum(s) * (1.f / DM) + EPS);
#pragma unroll
    for (int j = 0; j < 4; ++j) { const f32x4 o = v[j] * r * gr[64 * j]; st_bf4(orow + 4 * lane + 256 * j, o); }
}
constexpr size_t WS_WRG = 31 * MiB;
constexpr size_t WS_KN = 1 * MiB + 512 * 1024;
constexpr size_t WS_XF8 = 416 * MiB;
constexpr size_t WS_H1F8 = 880 * MiB;
constexpr size_t WS_XOF8 = 912 * MiB;
constexpr size_t WS_KM8 = 944 * MiB;
constexpr size_t WS_RMSX = 866 * MiB;
constexpr size_t WS_GSORT = 868 * MiB;
constexpr size_t WS_LF = 996 * MiB;

__device__ __forceinline__ P0Item p0_decode(const MegaArgs& a, int it) {
    unsigned char* ws = a.ws;
    constexpr int I_IN = 16 * 64, I_Q = 4 * 24, I_KV = 2 * 32, I_SQ = 16 * 32, I_MKV = 16 * 64, I_GU = 16 * 64, I_D = 16 * 32;
    P0Item d; d.kscale = nullptr; d.kscale2 = nullptr; d.cscale = 1.f; d.c_lo = 0; d.c_hi = 0; d.f8 = false; int r = it;
    if (r < NEXP * I_GU) { const int e = r / I_GU; d.W = a.in[20] + (size_t)e * DM * 2048; d.K = DM; d.N = 2048; d.NT = 2048; d.WT = (bf16*)(ws + WS_WGU + (size_t)e * 2048 * DM); d.f8 = true; d.cscale = W8_SCALE; d.c_hi = 2048; d.item = r % I_GU; return d; } r -= NEXP * I_GU;
    if (r < NEXP * I_D) { const int e = r / I_D; d.W = a.in[22] + (size_t)e * DEXP * DM; d.K = DEXP; d.N = DM; d.NT = DM; d.WT = (bf16*)(ws + WS_WD + (size_t)e * DM * DEXP); d.f8 = true; d.cscale = W8_SCALE; d.c_hi = DM; d.item = r % I_D; return d; } r -= NEXP * I_D;
    if (r < I_IN) { d.W = a.in[3]; d.K = DM; d.N = IN_COLS; d.NT = NPROJ; d.WT = (bf16*)(ws + WS_WIN); d.cscale = C2F; d.c_lo = C_FQ; d.c_hi = C_FK; d.item = r; return d; } r -= I_IN;
    if (r < I_Q) { d.W = a.in[5]; d.K = 256; d.N = 768; d.NT = 768; d.WT = (bf16*)(ws + WS_WQ); d.kscale = a.in[4]; d.cscale = C2M; d.c_lo = 0; d.c_hi = 768; d.item = r; return d; } r -= I_Q;
    if (r < I_KV) { d.W = a.in[7]; d.K = 128; d.N = 1024; d.NT = 1024; d.WT = (bf16*)(ws + WS_WKV); d.kscale = a.in[6]; d.item = r; return d; } r -= I_KV;
    if (r < I_SQ) { d.W = a.in[11]; d.K = DM; d.N = DM; d.NT = DM; d.WT = (bf16*)(ws + WS_WO); d.kscale = a.in[9]; d.kscale2 = a.in[10]; d.item = r; return d; } r -= I_SQ;
    if (r < I_SQ) { d.W = a.in[14]; d.K = DM; d.N = DM; d.NT = DM; d.WT = (bf16*)(ws + WS_WXQ); d.kscale = a.in[12]; d.cscale = C2X * WXQ8_SCALE; d.c_lo = 0; d.c_hi = DM; d.f8 = true; d.item = r; return d; } r -= I_SQ;
    if (r < I_SQ) { d.W = a.in[16]; d.K = DM; d.N = DM; d.NT = DM; d.WT = (bf16*)(ws + WS_WXO); d.cscale = WXO8_SCALE; d.c_lo = 0; d.c_hi = DM; d.f8 = true; d.item = r; return d; } r -= I_SQ;
    d.W = a.in[15]; d.K = DM; d.N = 2048; d.NT = 2048; d.WT = (bf16*)(ws + WS_WMKV); d.item = r; return d;
}
constexpr int P0_NITEMS = 16 * 64 + 4 * 24 + 2 * 32 + 3 * 16 * 32 + 16 * 64 + NEXP * 16 * 64 + NEXP * 16 * 32;
constexpr int MOE_ITEMS = NEXP * 16 * 64 + NEXP * 16 * 32;
constexpr int WCHUNKS = 256, WCH_ITEMS = MOE_ITEMS / WCHUNKS;
__device__ __forceinline__ void rms_rows2_to_bf16(const float* x0, const float* x1, const float* g, bf16* o0, bf16* o1, int lane, float* rms = nullptr) {
    const f32x4* xa = (const f32x4*)x0 + lane; const f32x4* xb = (const f32x4*)x1 + lane; const f32x4* gr = (const f32x4*)g + lane;
    f32x4 va[4], vb[4]; float sa = 0.f, sb = 0.f;
#pragma unroll
    for (int j = 0; j < 4; ++j) { va[j] = __builtin_nontemporal_load(xa + 64 * j); vb[j] = __builtin_nontemporal_load(xb + 64 * j); }
#pragma unroll
    for (int j = 0; j < 4; ++j) { sa += sum4sq(va[j]); sb += sum4sq(vb[j]); }
    const float ra = rsqrtf(wave_sum(sa) * (1.f / DM) + EPS), rb = rsqrtf(wave_sum(sb) * (1.f / DM) + EPS);
    if (rms && lane == 0) { rms[0] = 1.f / ra; rms[1] = 1.f / rb; }
#pragma unroll
    for (int j = 0; j < 4; ++j) { const f32x4 gg = gr[64 * j]; st_bf4(o0 + 4 * lane + 256 * j, va[j] * ra * gg); st_bf4(o1 + 4 * lane + 256 * j, vb[j] * rb * gg); }
}
__device__ __forceinline__ void p0_items(const MegaArgs& a, LAS float* scr, int lane, int first, const int end, const int step) {
    f32x4 va[8], vb[8]; int it = first;
    if (it < end) { P0Item da = p0_decode(a, it); p0_load(da, va, lane);
        for (;;) {
            const int itb = it + step; P0Item db; const bool hb = itb < end; if (hb) { db = p0_decode(a, itb); p0_load(db, vb, lane); }
            p0_finish(da, va, scr, lane);
            if (!hb) break;
            const int ita = itb + step; const bool ha = ita < end; if (ha) { da = p0_decode(a, ita); p0_load(da, va, lane); }
            p0_finish(db, vb, scr, lane);
            if (!ha) break;
            it = ita;
        } }
}
__device__ __forceinline__ void p0_items4(const MegaArgs& a, LAS float* scr, int lane, int first, const int end, const int step) {
    f32x4 v0[8], v1[8], v2[8], v3[8]; P0Item d0, d1, d2, d3; int it = first;
    if (it < end) { d0 = p0_decode(a, it); p0_load(d0, v0, lane); }
    if (it + step < end) { d1 = p0_decode(a, it + step); p0_load(d1, v1, lane); }
    if (it + 2 * step < end) { d2 = p0_decode(a, it + 2 * step); p0_load(d2, v2, lane); }
    if (it + 3 * step < end) { d3 = p0_decode(a, it + 3 * step); p0_load(d3, v3, lane); }
    for (;;) {
        if (!(it < end)) break; p0_finish(d0, v0, scr, lane); if (it + 4 * step < end) { d0 = p0_decode(a, it + 4 * step); p0_load(d0, v0, lane); }
        if (!(it + step < end)) break; p0_finish(d1, v1, scr, lane); if (it + 5 * step < end) { d1 = p0_decode(a, it + 5 * step); p0_load(d1, v1, lane); }
        if (!(it + 2 * step < end)) break; p0_finish(d2, v2, scr, lane); if (it + 6 * step < end) { d2 = p0_decode(a, it + 6 * step); p0_load(d2, v2, lane); }
        if (!(it + 3 * step < end)) break; p0_finish(d3, v3, scr, lane); if (it + 7 * step < end) { d3 = p0_decode(a, it + 7 * step); p0_load(d3, v3, lane); }
        it += 4 * step;
    }
}
__device__ __forceinline__ void p0_chunk(const Frame& F, const MegaArgs& a, int chunk) {
    LAS float* scr = (LAS float*)(F.lds + F.wave * 16384); int lane = lane_id(); asm volatile("" : "+v"(lane));
    p0_items4(a, scr, lane, chunk * WCH_ITEMS + F.wave, (chunk + 1) * WCH_ITEMS, NWAVES);
    __syncthreads();
}
__device__ __forceinline__ void p0_prologue(const Frame& F, const MegaArgs& a) {
    LAS float* scr = (LAS float*)(F.lds + F.wave * 16384);
    int lane = lane_id(); asm volatile("" : "+v"(lane)); const int gw = F.vcu * NWAVES + F.wave, NGW = F.G * NWAVES;
    unsigned char* ws = a.ws;
    p0_items(a, scr, lane, MOE_ITEMS + gw, P0_NITEMS, NGW);
    for (int m = 2 * gw; m < T; m += 2 * NGW) rms_rows2_to_bf16(a.in[0] + (size_t)m * DM, a.in[0] + (size_t)(m + 1) * DM, a.in[2], (bf16*)(ws + WS_XN) + (size_t)m * DM, (bf16*)(ws + WS_XN) + (size_t)(m + 1) * DM, lane, (float*)(ws + WS_RMSX) + m);
    for (int m = 2 * gw; m < TM; m += 2 * NGW) rms_rows2_to_bf16(a.in[1] + (size_t)m * DM, a.in[1] + (size_t)(m + 1) * DM, a.in[13], (bf16*)(ws + WS_MEMN) + (size_t)m * DM, (bf16*)(ws + WS_MEMN) + (size_t)(m + 1) * DM, lane);
    { float* tab = (float*)(ws + WS_ROPE); for (int i = gw * 64 + lane; i < 4096 * 16; i += NGW * 64) { const int pos = i >> 4, j = i & 15; const float inv = powf(10000.f, -(float)j / 16.f); const float ang = (float)pos * inv; tab[2 * i] = cosf(ang); tab[2 * i + 1] = sinf(ang); } }
    { bf16* wh = (bf16*)(ws + WS_WRG); bf16* wl = wh + DM * NEXP;
      for (int i = gw * 64 + lane; i < DM * NEXP; i += NGW * 64) { const float w = a.in[18][i] * a.in[17][i >> 5]; const bf16 h = f2bf(w); const int o_ = (i & 31) * DM + (i >> 5); wh[o_] = h; wl[o_] = f2bf(w - bf2f(h)); } }
}
__device__ __forceinline__ void p2_scan_item(const float* LF, float* cum, bf16* kaug, int item, int lane) {
    const int b = item >> 3, ck = item & 7; const float* base = LF + (size_t)b * SEQ * 8;
    float carry[8];
#pragma unroll
    for (int h = 0; h < 8; ++h) carry[h] = 0.f;
    for (int p = lane; p < ck * 512; p += 64) { const f32x4 x0 = *(const f32x4*)(base + (size_t)p * 8), x1 = *(const f32x4*)(base + (size_t)p * 8 + 4);
#pragma unroll
        for (int e = 0; e < 4; ++e) { carry[e] += x0[e]; carry[4 + e] += x1[e]; } }
#pragma unroll
    for (int h = 0; h < 8; ++h) carry[h] = wave_sum(carry[h]);
    const int s0 = ck * 512 + lane * 8;
    float v[8][8];
#pragma unroll
    for (int i = 0; i < 8; ++i) { const f32x4 x0 = *(const f32x4*)(base + (size_t)(s0 + i) * 8), x1 = *(const f32x4*)(base + (size_t)(s0 + i) * 8 + 4);
#pragma unroll
        for (int e = 0; e < 4; ++e) { v[i][e] = x0[e]; v[i][4 + e] = x1[e]; } }
#pragma unroll
    for (int h = 0; h < 8; ++h) {
#pragma unroll
        for (int i = 1; i < 8; ++i) v[i][h] += v[i - 1][h];
        float tot = v[7][h], inc = tot;
#pragma unroll
        for (int o = 1; o < 64; o <<= 1) { const float up = __shfl_up(inc, o); if (lane >= o) inc += up; }
        const float off = carry[h] + (inc - tot);
#pragma unroll
        for (int i = 0; i < 8; ++i) v[i][h] += off;
    }
#pragma unroll
    for (int h = 0; h < 8; ++h) {
        float* cr = cum + (size_t)(b * 8 + h) * SEQ + s0; *(f32x4*)cr = (f32x4){v[0][h], v[1][h], v[2][h], v[3][h]}; *(f32x4*)(cr + 4) = (f32x4){v[4][h], v[5][h], v[6][h], v[7][h]};
        bf16* kr = kaug + ((size_t)(b * 8 + h) * SEQ + s0) * 8;
#pragma unroll
        for (int i = 0; i < 8; ++i) { const float x = -v[i][h] * LOG2E; const unsigned hi = cvtpk(x, 0.f) & 0xffffu; const float r1 = x - __uint_as_float(hi << 16); const unsigned mid = cvtpk(r1, 0.f) & 0xffffu;
            const float r2 = r1 - __uint_as_float(mid << 16); const unsigned lo = cvtpk(r2, 0.f) & 0xffffu; *(u32x4*)(kr + i * 8) = (u32x4){hi | (mid << 16), lo, 0u, 0u}; }
    }
}

struct EpiGateUp {
    static constexpr bool PERM = true, MID = false;
    const float* bias; unsigned char* ACT8;
    __device__ __forceinline__ void act(const f32x4 (&a4)[2][2], const f32x4 (&bv)[2][2], unsigned (&w)[2]) const {
        const f32x4 sv = (f32x4){1.f / W8_SCALE, ACT8_SCALE / W8_SCALE, 1.f / W8_SCALE, ACT8_SCALE / W8_SCALE};
#pragma unroll
        for (int bj = 0; bj < 2; ++bj) { const f32x4 v0 = a4[bj][0] * sv + bv[bj][0], v1 = a4[bj][1] * sv + bv[bj][1];
            const f32x4 G = (f32x4){fminf(v0[0], 7.f), fminf(v0[2], 7.f), fminf(v1[0], 7.f), fminf(v1[2], 7.f)};
            const f32x4 L = (f32x4){__builtin_amdgcn_fmed3f(v0[1], -6.f * ACT8_SCALE, 8.f * ACT8_SCALE), __builtin_amdgcn_fmed3f(v0[3], -6.f * ACT8_SCALE, 8.f * ACT8_SCALE),
                                    __builtin_amdgcn_fmed3f(v1[1], -6.f * ACT8_SCALE, 8.f * ACT8_SCALE), __builtin_amdgcn_fmed3f(v1[3], -6.f * ACT8_SCALE, 8.f * ACT8_SCALE)};
            const f32x4 tt = G * (-1.702f * LOG2E);
            const f32x4 dd = (f32x4){__builtin_amdgcn_exp2f(tt[0]), __builtin_amdgcn_exp2f(tt[1]), __builtin_amdgcn_exp2f(tt[2]), __builtin_amdgcn_exp2f(tt[3])} + 1.f;
            const f32x4 rr = (f32x4){__builtin_amdgcn_rcpf(dd[0]), __builtin_amdgcn_rcpf(dd[1]), __builtin_amdgcn_rcpf(dd[2]), __builtin_amdgcn_rcpf(dd[3])};
            const f32x4 a = (G * rr) * L;
            int x = 0; x = __builtin_amdgcn_cvt_pk_fp8_f32(a[0], a[1], x, false); x = __builtin_amdgcn_cvt_pk_fp8_f32(a[2], a[3], x, true); w[bj] = (unsigned)x; }
    }
    __device__ __forceinline__ void operator()(f32x4 (&acc)[2][2][4][2], const pg8::Unit& u, int wr, int wc, int fr, int fq) const {
        asm volatile("" : "+v"(fr), "+v"(fq));
        const int c0 = u.col0 + wc * 32 + fq * 8; const float* bp = bias + (size_t)u.e * 2048 + c0;
        const f32x4 bm = (f32x4){1.f, ACT8_SCALE, 1.f, ACT8_SCALE}, ba = (f32x4){0.f, ACT8_SCALE, 0.f, ACT8_SCALE};
        f32x4 bv[2][2];
#pragma unroll
        for (int bj = 0; bj < 2; ++bj) { bv[bj][0] = *(const f32x4*)(bp + bj * 128) * bm + ba; bv[bj][1] = *(const f32x4*)(bp + bj * 128 + 4) * bm + ba; }
#pragma unroll
        for (int ai = 0; ai < 2; ++ai)
#pragma unroll
            for (int mp = 0; mp < 2; ++mp) {
                asm volatile("" : "+v"(acc[ai][0][2 * mp][0]), "+v"(acc[ai][0][2 * mp][1]), "+v"(acc[ai][1][2 * mp][0]), "+v"(acc[ai][1][2 * mp][1]));
                unsigned d[2][2];
#pragma unroll
                for (int q = 0; q < 2; ++q) { const int m = 2 * mp + q; unsigned w[2]; const f32x4 a4[2][2] = {{acc[ai][0][m][0], acc[ai][0][m][1]}, {acc[ai][1][m][0], acc[ai][1][m][1]}}; act(a4, bv, w);
                    const auto r = __builtin_amdgcn_permlane16_swap(w[0], w[1], false, false); d[q][0] = r[0]; d[q][1] = r[1]; }
                const auto r0 = __builtin_amdgcn_permlane32_swap(d[0][0], d[1][0], false, false), r1 = __builtin_amdgcn_permlane32_swap(d[0][1], d[1][1], false, false);
                int f2 = fr, q2 = fq; asm volatile("" : "+v"(f2), "+v"(q2));
                const int rl = ai * 128 + wr * 64 + (2 * mp + (q2 >> 1)) * 16 + f2; const unsigned rowi = rl < u.rows ? (unsigned)(u.row0 + rl) : (unsigned)(T * 4 + rl);
                *(u32x4*)(ACT8 + (rowi * (unsigned)DEXP + (unsigned)((u.col0 >> 1) + wc * 16 + (q2 & 1) * 64))) = (u32x4){r0[0], r1[0], r0[1], r1[1]};
                asm volatile("" ::: "memory"); }
    }
};
struct EpiDown {
    static constexpr bool PERM = true, MID = false;
    const float* bias; const float* gsort; const int* list0; unsigned char* Y8;
    __device__ __forceinline__ void operator()(f32x4 (&acc)[2][2][4][2], const pg8::Unit& u, int wr, int wc, int fr, int fq) const {
        asm volatile("" : "+v"(fr), "+v"(fq));
        const int c0 = u.col0 + wc * 32 + fq * 8; const float* bp = bias + (size_t)u.e * DM + c0;
        const float* gp = gsort + (u.list - list0) + wr * 64 + fq * 16 + fr;
        const float g0 = gp[0] * Y8_SCALE, g1 = gp[128] * Y8_SCALE;
        f32x4 bv[2][2];
#pragma unroll
        for (int bj = 0; bj < 2; ++bj) { bv[bj][0] = *(const f32x4*)(bp + bj * 128); bv[bj][1] = *(const f32x4*)(bp + bj * 128 + 4); }
#pragma unroll
        for (int g = 0; g < 8; ++g) { const int ai = g >> 2, m = g & 3;
                int f2 = fr, q2 = fq; asm volatile("" : "+v"(f2), "+v"(q2));
                const float gg = __int_as_float(__builtin_amdgcn_ds_bpermute(4 * (m * 16 + f2), __float_as_int(ai ? g1 : g0)));
                const int rl = ai * 128 + wr * 64 + m * 16 + f2; const unsigned rowi = rl < u.rows ? (unsigned)(u.row0 + rl) : (unsigned)(T * 4 + rl);
                unsigned w[2][2];
#pragma unroll
                for (int bj = 0; bj < 2; ++bj) { const f32x4 v0 = (acc[ai][bj][m][0] * (1.f / (W8_SCALE * ACT8_SCALE)) + bv[bj][0]) * gg, v1 = (acc[ai][bj][m][1] * (1.f / (W8_SCALE * ACT8_SCALE)) + bv[bj][1]) * gg;
                    int w0 = 0, w1 = 0; w0 = __builtin_amdgcn_cvt_pk_fp8_f32(v0[0], v0[1], w0, false); w0 = __builtin_amdgcn_cvt_pk_fp8_f32(v0[2], v0[3], w0, true);
                    w1 = __builtin_amdgcn_cvt_pk_fp8_f32(v1[0], v1[1], w1, false); w1 = __builtin_amdgcn_cvt_pk_fp8_f32(v1[2], v1[3], w1, true); w[bj][0] = (unsigned)w0; w[bj][1] = (unsigned)w1; }
                const auto r0 = __builtin_amdgcn_permlane16_swap(w[0][0], w[1][0], false, false), r1 = __builtin_amdgcn_permlane16_swap(w[0][1], w[1][1], false, false);
                *(u32x4*)(Y8 + (rowi * (unsigned)DM + (unsigned)(u.col0 + wc * 32 + ((q2 & 1) ? 128 + 8 * (q2 - 1) : 8 * q2)))) = (u32x4){r0[0], r1[0], r0[1], r1[1]};
                asm volatile("" ::: "memory");
            }
    }
};
struct MoeSched {
    pg8::TileOrder o; const volatile LAS int* tpre; const volatile LAS int* roff;
    const char* A; size_t a_row_bytes; const char* Wt; size_t w_exp_bytes; int brow; const int* list; bool gather;
    __device__ __forceinline__ void tables(const volatile LAS int* tp, const volatile LAS int* ro) { tpre = tp; roff = ro; }
    __device__ __forceinline__ bool next(int i, pg8::Unit& u) const { int pm, pn; if (!o.tile(i, pm, pn)) return false;
        int l = lane_id(); const int j = l < 32 ? l : 32; const int tv = tpre[j], rv = roff[j];
        const unsigned long long mk = __ballot(l >= 1 && l < NEXP && tv <= pm); const int e = __builtin_popcountll(mk);
        const int tp = __builtin_amdgcn_readlane(tv, e), r0 = __builtin_amdgcn_readlane(rv, e), r1 = __builtin_amdgcn_readlane(rv, e + 1);
        const int mt = pm - tp, cnt = r1 - r0; u.row0 = r0 + mt * 256; u.rows = (cnt - mt * 256) < 256 ? (cnt - mt * 256) : 256; u.col0 = pn * 256; u.pn = pn; u.e = e;
        u.a = gather ? A : A + (size_t)u.row0 * a_row_bytes; u.b = Wt + (size_t)e * w_exp_bytes + (size_t)pn * 256 * brow; u.list = list + (size_t)e * T + mt * 256; return true; }
};
__device__ __forceinline__ int moe_tables(const Frame& F, const int* cnt) {
    volatile LAS int* tp = (volatile LAS int*)(F.MISC + 64); volatile LAS int* ro = (volatile LAS int*)(F.MISC + 128);
    __syncthreads();
    if (F.wave == 0 && lane_id() == 0) { int t = 0, r = 0; for (int e = 0; e < NEXP; ++e) { const int c = __hip_atomic_load(cnt + e, __ATOMIC_RELAXED, __HIP_MEMORY_SCOPE_AGENT); tp[e] = t; ro[e] = r; t += (c + 255) >> 8; r += c; } tp[NEXP] = t; ro[NEXP] = r; }
    __syncthreads();
    return __builtin_amdgcn_readfirstlane(tp[NEXP]);
}
__device__ __forceinline__ void p7_route(const Frame& F, const MegaArgs& a, const size_t dummy) {
    unsigned char* ws = a.ws; const float* wrg = (const float*)(ws + WS_WRG); const bf16* h2 = (const bf16*)(ws + WS_XN); const float* gln = a.in[17]; const float* br = a.in[19];
    unsigned char* XF8 = ws + WS_XF8 + dummy; int* cnt = (int*)(ws + WS_CTL) + CW_CNT + (dummy ? 64 : 0);   const size_t d2 = dummy ? (WS_QM - WS_TOPI) : 0; int* topi = (int*)(ws + WS_TOPI + d2); float* gate = (float*)(ws + WS_GATE + d2); int* slot = (int*)(ws + WS_SLOT + d2); int* list = (int*)(ws + WS_LIST + d2); float* gsort = (float*)(ws + WS_GSORT + (dummy ? 8 * MiB : 0));
    LAS float* W = (LAS float*)F.lds; int tid = (F.wave << 6) | lane_id(); asm volatile("" : "+v"(tid)); const int lane = tid & 63;
    volatile LAS int* lcnt = (volatile LAS int*)(F.MISC + 16); volatile LAS int* lbase = (volatile LAS int*)(F.MISC + 192); LAS int* rec = (LAS int*)(F.MISC + 256);
    { const bf16* wh = (const bf16*)wrg; LAS unsigned char* Wb = F.lds;
      for (int idx = tid; idx < 8192; idx += NWAVES * 64) { const int pc = idx >> 12, R = (idx >> 5) & 127, c = idx & 31, kq_ = R >> 5, e = R & 31;
          *(LAS u32x4*)(Wb + pc * 65536 + R * 512 + ((c ^ (R & 15)) << 4)) = *(const u32x4*)(wh + (size_t)pc * DM * NEXP + e * DM + 32 * c + 8 * kq_); } }
    if (tid < NEXP) lcnt[tid] = 0;
    __syncthreads();
    const int TPB = T / F.G, t0 = F.vcu * TPB, TPW = TPB / NWAVES;
    const int li = lane & 15, kq = lane >> 4, tw0 = t0 + F.wave * TPW;
    float rs;
    f32x4 d0 = (f32x4){0.f, 0.f, 0.f, 0.f}, d1 = (f32x4){0.f, 0.f, 0.f, 0.f};
    { const bf16* xrow = h2 + (size_t)(tw0 + li) * DM + 8 * kq; const LAS unsigned char* w0 = F.lds + (kq * 32 + li) * 512;
      float ssq = 0.f;
#pragma unroll
      for (int c = 0; c < 4; ++c) { u32x4 xr[8];
#pragma unroll
          for (int u = 0; u < 8; ++u) xr[u] = *(const u32x4*)(xrow + 32 * (8 * c + u));
#pragma unroll
          for (int u = 0; u < 8; ++u) { const int sw = ((8 * c + u) ^ li) << 4; const bf16x8 av = __builtin_bit_cast(bf16x8, xr[u]);
              const bf16x8 bh0 = *(const LAS bf16x8*)(w0 + sw), bl0 = *(const LAS bf16x8*)(w0 + 65536 + sw), bh1 = *(const LAS bf16x8*)(w0 + 8192 + sw), bl1 = *(const LAS bf16x8*)(w0 + 65536 + 8192 + sw);
              d0 = __builtin_amdgcn_mfma_f32_16x16x32_bf16(av, bh0, d0, 0, 0, 0); d1 = __builtin_amdgcn_mfma_f32_16x16x32_bf16(av, bh1, d1, 0, 0, 0);
              d0 = __builtin_amdgcn_mfma_f32_16x16x32_bf16(av, bl0, d0, 0, 0, 0); d1 = __builtin_amdgcn_mfma_f32_16x16x32_bf16(av, bl1, d1, 0, 0, 0);
#pragma unroll
              for (int j = 0; j < 4; ++j) { const float xl = __uint_as_float(xr[u][j] << 16), xh = __uint_as_float(xr[u][j] & 0xffff0000u); ssq += xl * xl + xh * xh; } } }
      ssq += __shfl_xor(ssq, 16); ssq += __shfl_xor(ssq, 32); rs = rsqrtf(ssq * (1.f / DM) + EPS); }
    { const float b0 = br[li], b1 = br[li + 16];
#pragma unroll
      for (int r = 0; r < 4; ++r) { const float rt = __shfl(rs, 4 * kq + r); float c0 = d0[r] * rt + b0, c1 = d1[r] * rt + b1;
        float tv[4]; int ti[4];
#pragma unroll
        for (int k = 0; k < 4; ++k) { float bv = c0; int bi = li; if (c1 > c0) { bv = c1; bi = li + 16; }
#pragma unroll
            for (int o = 1; o < 16; o <<= 1) { const float ov = __shfl_xor(bv, o); const int oi = __shfl_xor(bi, o); if (ov > bv || (ov == bv && oi < bi)) { bv = ov; bi = oi; } }
            tv[k] = bv; ti[k] = bi; if (bi == li) c0 = -INFINITY; if (bi == li + 16) c1 = -INFINITY; }
        const float e1 = __expf(tv[1] - tv[0]), e2 = __expf(tv[2] - tv[0]), e3 = __expf(tv[3] - tv[0]); const float inv = 1.f / (1.f + e1 + e2 + e3);
        const float gs[4] = {inv, e1 * inv, e2 * inv, e3 * inv};
        const int tok = F.wave * TPW + 4 * kq + r;
#pragma unroll
        for (int k = 0; k < 4; ++k) if ((ti[k] & 15) == li) { const int ex = ti[k]; const int ls = __hip_atomic_fetch_add((LAS int*)(lcnt + ex), 1, __ATOMIC_RELAXED, __HIP_MEMORY_SCOPE_WORKGROUP); LAS int* rr = rec + (tok * 4 + k) * 3; rr[0] = ex; rr[1] = __float_as_int(gs[k]); rr[2] = ls; } } }
    { f32x4 gv[4];
#pragma unroll
      for (int j = 0; j < 4; ++j) gv[j] = *(const f32x4*)(gln + 16 * lane + 4 * j);
#pragma unroll
      for (int tb = 0; tb < 16; tb += 8) { u32x4 xw[8][2];
#pragma unroll
          for (int tt = 0; tt < 8; ++tt)
#pragma unroll
              for (int j = 0; j < 2; ++j) xw[tt][j] = *(const u32x4*)(h2 + (size_t)(tw0 + tb + tt) * DM + 16 * lane + 8 * j);
#pragma unroll
          for (int tt = 0; tt < 8; ++tt) { const float rt = __shfl(rs, tb + tt); u32x4 f;
#pragma unroll
              for (int j = 0; j < 4; ++j) { const unsigned a0 = xw[tt][j >> 1][(j & 1) * 2], a1 = xw[tt][j >> 1][(j & 1) * 2 + 1];
                  const f32x4 y = (f32x4){__uint_as_float(a0 << 16), __uint_as_float(a0 & 0xffff0000u), __uint_as_float(a1 << 16), __uint_as_float(a1 & 0xffff0000u)} * rt * gv[j];
                  int w = 0; w = __builtin_amdgcn_cvt_pk_fp8_f32(y[0], y[1], w, false); w = __builtin_amdgcn_cvt_pk_fp8_f32(y[2], y[3], w, true); f[j] = (unsigned)w; }
              *(u32x4*)(XF8 + (size_t)(tw0 + tb + tt) * DM + 16 * lane) = f; } } }
    __syncthreads();
    if (tid < NEXP) lbase[tid] = atomicAdd(cnt + tid, (int)lcnt[tid]);
    __syncthreads();
    for (int idx = tid; idx < TPB * 4; idx += NWAVES * 64) { const LAS int* r = rec + idx * 3; const int e = r[0], sl = lbase[e] + r[2]; const int gi = t0 * 4 + idx;
        topi[gi] = e; gate[gi] = __int_as_float(r[1]); slot[gi] = sl; list[(size_t)e * T + sl] = gi; gsort[(size_t)e * T + sl] = __int_as_float(r[1]); }
}
__device__ __forceinline__ void p10_combine(const Frame& F, const MegaArgs& a, float* dst) {
    unsigned char* ws = a.ws; const unsigned char* Y8 = ws + WS_Y; const bf16* h2 = (const bf16*)(ws + WS_XN); const int* topi = (const int*)(ws + WS_TOPI); const int* slot = (const int*)(ws + WS_SLOT); const float* g = a.in[24];
    const volatile LAS int* ro = (const volatile LAS int*)(F.MISC + 128); int lane = lane_id(); asm volatile("" : "+v"(lane));
    const int t0 = F.vcu * NWAVES + F.wave, ts = F.G * NWAVES;
    f32x4 gv[4];
#pragma unroll
    for (int j = 0; j < 4; ++j) gv[j] = *(const f32x4*)(g + 16 * lane + 4 * j);
    constexpr int NB = 3;
    u32x4 yn[NB][4], hn[NB][2]; int en[NB], sn[NB];
#define P10_IDX(bt) do { _Pragma("unroll") for (int q_ = 0; q_ < NB; ++q_) { const int tt_ = (bt) + q_ * ts; en[q_] = 0; sn[q_] = 0; if (tt_ < T && lane < 4) { en[q_] = topi[tt_ * 4 + lane]; sn[q_] = slot[tt_ * 4 + lane]; } } } while (0)
#define P10_LOAD(bt) do { _Pragma("unroll") for (int q_ = 0; q_ < NB; ++q_) { const int tt_ = (bt) + q_ * ts; if (tt_ < T) { \
        const int pl_ = (lane < 4 ? ro[en[q_]] : 0) + sn[q_]; \
        _Pragma("unroll") for (int k = 0; k < 4; ++k) { const size_t pos = (size_t)__builtin_amdgcn_readlane(pl_, k); yn[q_][k] = *(const u32x4*)(Y8 + pos * DM + 16 * lane); } \
        _Pragma("unroll") for (int j = 0; j < 2; ++j) hn[q_][j] = *(const u32x4*)(h2 + (size_t)tt_ * DM + 16 * lane + 8 * j); } } } while (0)
    P10_IDX(t0); P10_LOAD(t0); P10_IDX(t0 + NB * ts);
    for (int tb = t0; tb < T; tb += NB * ts) {
        u32x4 y[NB][4], hw[NB][2];
#pragma unroll
        for (int q = 0; q < NB; ++q) {
#pragma unroll
            for (int k = 0; k < 4; ++k) y[q][k] = yn[q][k];
#pragma unroll
            for (int j = 0; j < 2; ++j) hw[q][j] = hn[q][j]; }
        if (tb + NB * ts < T) { P10_LOAD(tb + NB * ts); P10_IDX(tb + 2 * NB * ts); }
#pragma unroll
        for (int q = 0; q < NB; ++q) { const int t = tb + q * ts; if (t < T) {
            f32x4 v[4];
#pragma unroll
            for (int j = 0; j < 4; ++j) { f32x4 ys = (f32x4){0.f, 0.f, 0.f, 0.f};
#pragma unroll
                for (int k = 0; k < 4; ++k) { const f32x2 lo = __builtin_amdgcn_cvt_pk_f32_fp8((int)y[q][k][j], false), hi = __builtin_amdgcn_cvt_pk_f32_fp8((int)y[q][k][j], true); ys[0] += lo.x; ys[1] += lo.y; ys[2] += hi.x; ys[3] += hi.y; }
                const unsigned w0 = hw[q][j >> 1][(j & 1) * 2], w1 = hw[q][j >> 1][(j & 1) * 2 + 1];
                v[j] = (f32x4){__uint_as_float(w0 << 16), __uint_as_float(w0 & 0xffff0000u), __uint_as_float(w1 << 16), __uint_as_float(w1 & 0xffff0000u)} + ys * (1.f / Y8_SCALE); }
            float sq = 0.f;
#pragma unroll
            for (int j = 0; j < 4; ++j) sq += sum4sq(v[j]);
            const float r = rsqrtf(wave_sum(sq) * (1.f / DM) + EPS);
#pragma unroll
            for (int j = 0; j < 4; ++j) *(f32x4*)(dst + (size_t)t * DM + 16 * lane + 4 * j) = v[j] * r * gv[j]; } }
    }
#undef P10_LOAD
#undef P10_IDX
}
__global__ void __launch_bounds__(NWAVES * 64, 2) mega_fwd(MegaArgs args) {
    extern __shared__ __attribute__((aligned(16))) unsigned char lds_raw[];
    Frame F;
    F.lds = (LAS unsigned char*)lds_raw; F.MISC = (volatile LAS unsigned*)(F.lds + MISC_OFF); F.tabs = (LAS unsigned*)(F.lds + TABS_OFF);
    F.wave = __builtin_amdgcn_readfirstlane((int)threadIdx.x >> 6);
    F.G = gridDim.x; { const int bx = blockIdx.x; F.vcu = (F.G % 8 == 0) ? (bx % 8) * (F.G / 8) + bx / 8 : bx; }
    unsigned char* ws = args.ws;
    unsigned* ctl = (unsigned*)(ws + WS_CTL);
    for (int u = (F.wave << 6) | lane_id(); u < (LDS_BYTES - MISC_OFF) / 4; u += NWAVES * 64) ((LAS unsigned*)(F.lds + MISC_OFF))[u] = 0u;
    __syncthreads();
    XcdBarrier bar; bar.bar = ctl + CW_BAR; bar.x = 0; bar.st = nullptr; bar.wave0 = false;
    if (args.coop) bar = xcd_barrier_post(ctl + CW_BAR, F.MISC + 8, F.wave);
    const int lo = args.ph_lo, hi = args.ph_hi;
#define IN(k) (lo <= (k) && (k) < hi)
#define SEAM(k) do { if (args.coop && IN(k) && IN((k) + 1)) { xcd_barrier(bar); if ((PROBE_REP) == 100) xcd_barrier(bar); } } while (0)
    bf16 *WinT = (bf16*)(ws + WS_WIN), *WqT = (bf16*)(ws + WS_WQ), *WkvT = (bf16*)(ws + WS_WKV), *WmkvT = (bf16*)(ws + WS_WMKV);
    bf16 *XN = (bf16*)(ws + WS_XN), *PROJ = (bf16*)(ws + WS_PROJ), *QM = (bf16*)(ws + WS_QM), *KVM = (bf16*)(ws + WS_KVM), *MEMN = (bf16*)(ws + WS_MEMN), *KVMEM = (bf16*)(ws + WS_KVMEM);
    float *rope = (float*)(ws + WS_ROPE), *ssqq = (float*)(ws + WS_SSQQ), *ssqkv = (float*)(ws + WS_SSQKV), *LF = (float*)(ws + WS_LF);

    if (IN(0)) { REPS(0) p0_prologue(F, args); }
    if (args.coop == 2) cg::this_grid().sync();
    SEAM(0);
    if (IN(1)) REPS(1) {
        pg8::DenseSched S; S.init(XN, DM, WinT, T, NPROJ, DM, F.G, (int)blockIdx.x);
        EpiProj E{PROJ, ssqq, ssqkv, rope, LF, args.in[8]};
        pg8::gemm_phase<EpiProj, pg8::DenseSched, false>(F.lds, F.tabs, DM, DM, S, E, F.wave);
    }
    SEAM(1);
    if (IN(2)) REPS(2) {
        const int GA = (F.G * 3) / 4, bx = (int)blockIdx.x;
        if (bx >= GA) { const int sid = bx - GA, ns = F.G - GA;
          if (F.wave == 0) for (int it = sid; it < 64; it += ns) { int ln = lane_id(); asm volatile("" : "+v"(ln)); p2_scan_item(LF, (float*)(ws + WS_CUM), (bf16*)(ws + WS_KAUG), it, ln); }
          for (int item = sid * NWAVES + F.wave; item < BATCH * 64; item += ns * NWAVES) {
          { int ln = lane_id(); asm volatile("" : "+v"(ln)); const int b = item >> 6, t = item & 63; const bf16* kr = PROJ + ((size_t)b * SEQ + t * 64 + ln) * NPROJ + C_FK; float* KN = (float*)(ws + WS_KN);
            for (int h = 0; h < 8; ++h) { float s2 = 0.f;
#pragma unroll
                for (int c = 0; c < 8; ++c) { const u32x4 w = *(const u32x4*)(kr + h * 64 + c * 8);
#pragma unroll
                    for (int j = 0; j < 4; ++j) { const float a_ = __uint_as_float(w[j] << 16), b_ = __uint_as_float(w[j] & 0xffff0000u); s2 += a_ * a_ + b_ * b_; } }
#pragma unroll
                for (int o_ = 1; o_ < 64; o_ <<= 1) s2 = fmaxf(s2, __shfl_xor(s2, o_));
                if (ln == 0) KN[(size_t)(b * 8 + h) * 64 + t] = sqrtf(s2); } } } }
        __syncthreads();
        if (F.G >= 8 && (F.G % 32) == 0) {
            if (bx < GA) {
                { pg8::DenseSched S; S.init(PROJ + C_QLAT, NPROJ, WqT, T, 768, 256, GA, bx); EpiScale<4, true> E{QM, 768, ssqq, 1.f / 256.f, rope}; pg8::gemm_phase<EpiScale<4, true>, pg8::DenseSched, false>(F.lds, F.tabs, 256, NPROJ, S, E, F.wave); }
                { pg8::DenseSched S; S.init(PROJ + C_KVLAT, NPROJ, WkvT, T, 1024, 128, GA, bx); EpiScale<4, false> E{KVM, 1024, ssqkv, 1.f / 128.f, nullptr}; pg8::gemm_phase<EpiScale<4, false>, pg8::DenseSched, false>(F.lds, F.tabs, 128, NPROJ, S, E, F.wave); }
            } else {
                pg8::DenseSched S; S.init(MEMN, DM, WmkvT, TM, 2048, DM, F.G - GA, bx - GA); EpiMemKV E{KVMEM, ws + WS_KM8}; pg8::gemm_phase<EpiMemKV, pg8::DenseSched, false>(F.lds, F.tabs, DM, DM, S, E, F.wave);
            }
        }
    }
    SEAM(2);
    if (IN(3)) REPS(3) {
        bf16* O = (bf16*)(ws + WS_O); float* SSO = (float*)(ws + WS_SSO); const bf16* KAUG = (const bf16*)(ws + WS_KAUG);
        int upos = 0; unsigned chdone = 0u;
        for (int P = F.vcu; P < 512; P += F.G) {
            const int bh = P >> 3, pair = P & 7, b = bh >> 3, h = bh & 7;
            for (int j = 0; j < 2; ++j) {
                { const int q_ = upos & 3;
                  for (int i_ = 0; i_ < 2; ++i_) { const int ch = F.vcu + F.G * i_; if (ch < WCHUNKS && (((F.vcu & 3) + 2 * i_) & 3) == q_ && upos < 4) { p0_chunk(F, args, ch); chdone |= 1u << i_; } }
                  ++upos; }
                const int qb = j ? 15 - pair : pair; const size_t r0 = (size_t)b * SEQ, rq = r0 + (size_t)qb * 256;
                att::Src s; s.nt = 4 * (qb + 1); s.q0 = qb * 256; s.ldo = DM; s.kn = nullptr; s.cum = nullptr;
                s.q = QM + rq * 768 + h * 96; s.ldq = 768; s.k1 = KVM + r0 * 1024 + h * 128; s.ldk1 = 1024; s.k2 = PROJ + r0 * NPROJ + C_KPE; s.ldk2 = NPROJ; s.v = KVM + r0 * 1024 + h * 128 + 64; s.ldv = 1024;
                s.o = O + rq * DM + h * 64; s.sso = SSO + rq * 16 + h;
                att::unit<6, 8, 12, 2, true, false, false, true>(s, F.lds, F.wave); }
        }
        for (int i_ = 0; F.vcu + F.G * i_ < WCHUNKS; ++i_) if (i_ >= 2 || !((chdone >> i_) & 1u)) p0_chunk(F, args, F.vcu + F.G * i_);
        if (args.coop) {
            unsigned* fq = ctl + CW_FOXQ; volatile LAS unsigned* tk = F.MISC + 48; const bool lead = F.wave == 0 && lane_id() == 0;
            if (lead) tk[0] = __hip_atomic_fetch_add(fq, 1u, __ATOMIC_RELAXED, __HIP_MEMORY_SCOPE_AGENT);
            __syncthreads();
            unsigned cur = __builtin_amdgcn_readfirstlane(tk[0]);
            while (cur < 1024u) {
                unsigned nx = 0; if (lead) nx = __hip_atomic_fetch_add(fq, 1u, __ATOMIC_RELAXED, __HIP_MEMORY_SCOPE_AGENT);
                const int r = (int)(cur >> 7), qb = 15 - (int)((cur >> 3) & 15), b = (int)(cur & 7);
                const float* bfg = args.in[8]; int h = 0;
                for (int c = 0; c < 8; ++c) { int rk = 0; for (int j = 0; j < 8; ++j) rk += (bfg[j] > bfg[c] || (bfg[j] == bfg[c] && j < c)) ? 1 : 0; if (rk == r) h = c; }
                const size_t r0 = (size_t)b * SEQ, rq = r0 + (size_t)qb * 256;
                att::Src s; s.nt = 4 * (qb + 1); s.q0 = qb * 256; s.ldo = DM;
                s.q = PROJ + rq * NPROJ + C_FQ + h * 64; s.ldq = NPROJ; s.k1 = PROJ + r0 * NPROJ + C_FK + h * 64; s.ldk1 = NPROJ; s.k2 = KAUG + (size_t)(b * 8 + h) * SEQ * 8; s.ldk2 = 8; s.v = PROJ + r0 * NPROJ + C_FV + h * 64; s.ldv = NPROJ;
                s.o = O + rq * DM + 512 + h * 64; s.sso = SSO + rq * 16 + 8 + h; s.kn = (const float*)(ws + WS_KN) + (size_t)(b * 8 + h) * 64; s.cum = (const float*)(ws + WS_CUM) + (size_t)(b * 8 + h) * SEQ;
                att::unit<5, 8, 9, 2, true, true, true, true, true>(s, F.lds, F.wave);
                if (lead) tk[0] = nx;
                __syncthreads();
                cur = __builtin_amdgcn_readfirstlane(tk[0]);
            }
        }
    }
    SEAM(3);
    bf16 *WoT = (bf16*)(ws + WS_WO), *WxqT = (bf16*)(ws + WS_WXQ), *WxoT = (bf16*)(ws + WS_WXO), *XQ = (bf16*)(ws + WS_XQ), *XO = (bf16*)(ws + WS_XO);
    float* ssq1 = (float*)(ws + WS_SSQ1);
    if (IN(4)) REPS(4) {
        pg8::DenseSched S; S.init((const bf16*)(ws + WS_O), DM, WoT, T, DM, DM, F.G, (int)blockIdx.x);
        EpiWo E{(const float*)(ws + WS_SSO), (const float*)(ws + WS_RMSX), args.in[2], XN, ssq1, ws + WS_H1F8};
        pg8::gemm_phase<EpiWo, pg8::DenseSched, false>(F.lds, F.tabs, DM, DM, S, E, F.wave);
    }
    SEAM(4);
    if (IN(5)) REPS(5) {
        pg8::DenseSched S; S.init((const bf16*)(ws + WS_H1F8), DM / 2, WxqT, T, DM, DM / 2, F.G, (int)blockIdx.x);
        { EpiXQ8 E{ws + WS_XQ, ssq1, XQ8_SCALE / (H8_SCALE * WXQ8_SCALE)}; pg8::gemm_phase<EpiXQ8, pg8::DenseSched, false, true>(F.lds, F.tabs, DM, DM, S, E, F.wave); }
        asm volatile("s_waitcnt vmcnt(0)" ::: "memory"); __syncthreads();
        __builtin_amdgcn_fence(__ATOMIC_ACQUIRE, "agent"); asm volatile("s_waitcnt vmcnt(0)" ::: "memory"); __syncthreads();
        pg8::Unit u; pg8::DenseSched S2; S2.init(XN, DM, WxqT, T, DM, DM, F.G, (int)blockIdx.x);
        for (int i = 0; S2.next(i, u); ++i) {
            const int b = u.row0 / SEQ, h = u.pn;
            { att::Src s; s.kn = nullptr; s.cum = nullptr; s.nt = MEMLEN / 64; s.q0 = 0; s.q = (const bf16*)(ws + WS_XQ + (size_t)u.row0 * DM + h * 256); s.ldq = DM; s.k1 = (const bf16*)(ws + WS_KM8 + (size_t)b * MEMLEN * 1024 + h * 256); s.ldk1 = 1024; s.k2 = s.k1; s.ldk2 = 1024;
              s.v = KVMEM + (size_t)b * MEMLEN * 2048 + 1024 + h * 256; s.ldv = 2048; s.o = (bf16*)(ws + WS_XOF8 + (size_t)u.row0 * DM + h * 256); s.ldo = DM; s.sso = nullptr;
              att::xunit(s, F.lds, F.wave); }
        }
    }
    SEAM(5);
    if (IN(6)) {
        pg8::DenseSched S; S.init((const bf16*)(ws + WS_XOF8), DM / 2, WxoT, T, DM, DM / 2, F.G, (int)blockIdx.x);
        EpiAddOut E{XN, 1.f / (XO8_SCALE * WXO8_SCALE)};
        pg8::gemm_phase<EpiAddOut, pg8::DenseSched, false, true>(F.lds, F.tabs, DM, DM, S, E, F.wave);
    }
    SEAM(6);
    int* cnt = (int*)(ws + WS_CTL) + CW_CNT; const int* list = (const int*)(ws + WS_LIST);
    if (IN(7)) { if ((PROBE_REP) == 7) p7_route(F, args, (size_t)(WS_KVM - WS_XF8)); p7_route(F, args, 0); }
    SEAM(7);
    if (IN(8)) REPS(8) {
        const int nMt = moe_tables(F, cnt);
        MoeSched S; S.o.init(nMt, 2048 / 256, F.G, (int)blockIdx.x); S.tables((const volatile LAS int*)(F.MISC + 64), (const volatile LAS int*)(F.MISC + 128));
        S.A = (const char*)(ws + WS_XF8); S.a_row_bytes = 0; S.Wt = (const char*)(ws + WS_WGU); S.w_exp_bytes = (size_t)2048 * DM; S.brow = DM; S.list = list; S.gather = true;
        EpiGateUp E{args.in[21], ws + WS_ACT};
        pg8::gemm_phase<EpiGateUp, MoeSched, true, true>(F.lds, F.tabs, DM, DM, S, E, F.wave);
    }
    SEAM(8);
    if (IN(9)) REPS(9) {
        const int nMt = __builtin_amdgcn_readfirstlane(((const volatile LAS int*)(F.MISC + 64))[NEXP]);
        MoeSched S; S.o.init(nMt, DM / 256, F.G, (int)blockIdx.x); S.tables((const volatile LAS int*)(F.MISC + 64), (const volatile LAS int*)(F.MISC + 128));
        S.A = (const char*)(ws + WS_ACT); S.a_row_bytes = (size_t)DEXP; S.Wt = (const char*)(ws + WS_WD); S.w_exp_bytes = (size_t)DM * DEXP; S.brow = DEXP; S.list = list; S.gather = false;
        EpiDown E{args.in[23], (const float*)(ws + WS_GSORT), list, ws + WS_Y};
        pg8::gemm_phase<EpiDown, MoeSched, false, true>(F.lds, F.tabs, DEXP, DEXP, S, E, F.wave);
    }
    SEAM(9);
    if (IN(10)) { if ((PROBE_REP) == 10) p10_combine(F, args, (float*)(ws + WS_XQ)); p10_combine(F, args, args.out); }
#undef IN
#undef SEAM
}
extern "C" void kernel_launch(void* const* d_in, const int* in_sizes, int n_in, void* d_out, int out_size, void* d_ws, size_t ws_size, hipStream_t stream) {
    if (n_in != 25 || ws_size < WS_END || out_size != T * DM) { fprintf(stderr, "kernel_launch: unexpected shapes n_in %d ws %zu out %d\n", n_in, ws_size, out_size); return; }
    static int grid = 0;
    if (grid == 0) {
        int dev = 0, cus = 0, per_cu = 0;
        if (hipGetDevice(&dev) != hipSuccess || hipDeviceGetAttribute(&cus, hipDeviceAttributeMultiprocessorCount, dev) != hipSuccess) { fprintf(stderr, "kernel_launch: device query failed\n"); grid = -1; return; }
        if (hipFuncSetAttribute((const void*)mega_fwd, hipFuncAttributeMaxDynamicSharedMemorySize, LDS_BYTES) != hipSuccess) { fprintf(stderr, "kernel_launch: hipFuncSetAttribute failed\n"); grid = -1; return; }
        if (hipOccupancyMaxActiveBlocksPerMultiprocessor(&per_cu, (const void*)mega_fwd, NWAVES * 64, LDS_BYTES) != hipSuccess || per_cu < 1) { fprintf(stderr, "kernel_launch: occupancy query says %d blocks per CU\n", per_cu); (void)hipGetLastError(); grid = -1; return; }
        grid = cus;
    }
    if (grid < 0) return;
    (void)hipMemsetAsync((char*)d_ws + WS_CTL, 0, 1 * MiB, stream);
    MegaArgs a{}; for (int i = 0; i < 25; ++i) a.in[i] = (const float*)d_in[i]; a.out = (float*)d_out; a.ws = (unsigned char*)d_ws; a.ph_lo = 0; a.ph_hi = N_PHASES; a.coop = 1;
    void* params[] = {&a};
    const hipError_t e = hipLaunchCooperativeKernel((const void*)mega_fwd, dim3(grid), dim3(NWAVES * 64), params, LDS_BYTES, stream);
    if (e != hipSuccess) fprintf(stderr, "cooperative launch failed: %s (grid %d)\n", hipGetErrorString(e), grid);
}
```

```cpp
#include <hip/hip_runtime.h>
#include <cstdio>
#include <cstdint>

constexpr int DM = 1024, BATCH = 8, SEQ = 4096, T = BATCH * SEQ, MEMLEN = 256, TM = BATCH * MEMLEN;
constexpr int NPROJ = 2048;
constexpr int C_QLAT = 0, C_KVLAT = 256, C_KPE = 384, C_FQ = 416, C_FK = 928, C_FV = 1440, C_FL = 1952, IN_COLS = 1960;
constexpr int NEXP = 32, TOPK = 4, DEXP = 1024;
constexpr float EPS = 1e-6f, LOG2E = 1.4426950408889634f;
constexpr float C2M = 0.10206207261596577f * LOG2E;
constexpr float C2F = 0.125f * LOG2E;
constexpr float C2X = 0.0625f * LOG2E;

typedef unsigned short bf16;
__device__ __forceinline__ float bf2f(bf16 v) { return __uint_as_float(((unsigned)v) << 16); }
__device__ __forceinline__ bf16 f2bf(float f) { unsigned u = __float_as_uint(f); return (bf16)((u + 0x7fffu + ((u >> 16) & 1u)) >> 16); }

constexpr size_t MiB = 1u << 20;
constexpr size_t WS_CTL = 0;
constexpr size_t WS_ROPE = 1 * MiB;
constexpr size_t WS_CUM = 2 * MiB;
constexpr size_t WS_KAUG = 3 * MiB;
constexpr size_t WS_SSQQ = 7 * MiB;
constexpr size_t WS_SSQKV = 7 * MiB + 512 * 1024;
constexpr size_t WS_SSO = 8 * MiB;
constexpr size_t WS_SSQ1 = 994 * MiB;
constexpr size_t WS_TOPI = 10 * MiB + 512 * 1024;
constexpr size_t WS_GATE = 11 * MiB;
constexpr size_t WS_SLOT = 11 * MiB + 512 * 1024;
constexpr size_t WS_LIST = 12 * MiB;
constexpr size_t WS_WIN = 16 * MiB;
constexpr size_t WS_WQ = 20 * MiB;
constexpr size_t WS_WKV = 20 * MiB + 512 * 1024;
constexpr size_t WS_WO = 21 * MiB;
constexpr size_t WS_WXQ = 23 * MiB;
constexpr size_t WS_WMKV = 25 * MiB;
constexpr size_t WS_WXO = 29 * MiB;
constexpr size_t WS_WGU = 32 * MiB;
constexpr size_t WS_WD = 160 * MiB;
constexpr size_t WS_XN = 224 * MiB;
constexpr size_t WS_PROJ = 288 * MiB;
constexpr size_t WS_QM = 416 * MiB;
constexpr size_t WS_KVM = 464 * MiB;
constexpr size_t WS_O = 528 * MiB;
constexpr size_t WS_XQ = 592 * MiB;
constexpr size_t WS_XO = 656 * MiB;
constexpr size_t WS_MEMN = 720 * MiB;
constexpr size_t WS_KVMEM = 724 * MiB;
constexpr size_t WS_ACT = 736 * MiB;
constexpr size_t WS_SC = 736 * MiB;
constexpr size_t WS_Y = 288 * MiB;
constexpr size_t WS_END = 1000 * MiB;
constexpr int CW_CNT = 64;

#include <hip/hip_cooperative_groups.h>
#include <type_traits>
namespace cg = cooperative_groups;
#define LAS __attribute__((address_space(3)))
#define GAS __attribute__((address_space(1)))
typedef short bf16x8 __attribute__((ext_vector_type(8)));
typedef short s16x4 __attribute__((ext_vector_type(4)));
typedef float f32x4 __attribute__((ext_vector_type(4)));
typedef float f32x2 __attribute__((ext_vector_type(2)));
typedef float f32x16 __attribute__((ext_vector_type(16)));
typedef unsigned u32x4 __attribute__((ext_vector_type(4)));
typedef unsigned u32x2 __attribute__((ext_vector_type(2)));
typedef __bf16 bf16x2_t __attribute__((ext_vector_type(2)));
__device__ __forceinline__ unsigned cvtpk(float lo, float hi) { f32x2 v = {lo, hi}; bf16x2_t b = __builtin_convertvector(v, bf16x2_t); return __builtin_bit_cast(unsigned, b); }
__device__ __forceinline__ int lane_id() { int l; asm volatile("v_mbcnt_lo_u32_b32 %0, -1, 0\n\tv_mbcnt_hi_u32_b32 %0, -1, %0" : "=v"(l)); return l; }
__device__ __forceinline__ float wave_sum(float v) {
#pragma unroll
    for (int o = 1; o < 64; o <<= 1) v += __shfl_xor(v, o);
    return v;
}

constexpr float XQ8_SCALE = 32.f;
constexpr float WXQ8_SCALE = 256.f, WXO8_SCALE = 32.f, H8_SCALE = 4.f, XO8_SCALE = 64.f;
namespace pg8 {
constexpr int BM = 256, BK = 64, HALF = 128, HTB = HALF * BK * 2  , STAGE_BYTES = 8 * HTB, NXCD = 8, WGM = 8;
__host__ __device__ __forceinline__ int lds_byte(int r, int c) { const int st = (r >> 4) * 2 + (c >> 5), rr = r & 15, cc = c & 31, ob = rr * 64 + cc * 2; return st * 1024 + (ob ^ (((ob >> 9) & 1) << 5)); }
__host__ __device__ __forceinline__ void stage_rc(int b, int& R, int& C) { const int st = b / 1024, sb = b % 1024, swz = sb ^ (((sb >> 9) & 1) << 5); R = (st >> 1) * 16 + swz / 64; C = (st & 1) * 32 + (swz % 64) / 2; }
__host__ __device__ __forceinline__ int perm32(int rho) { const int n = rho >> 4, i = rho & 15; return 8 * (i >> 2) + 4 * n + (i & 3); }

struct Unit { int row0, col0, rows, pn, e; const char* a; const char* b; const int* list; };

typedef int i32x8 __attribute__((ext_vector_type(8)));
typedef int i32x4 __attribute__((ext_vector_type(4)));
template <class Epi, class Sched, bool GATHER, bool F8 = false>
__device__ __forceinline__ void gemm_phase(LAS unsigned char* lds, LAS unsigned* tabs, const int K, const int lda, const Sched& S, const Epi& E, const int wave) {
    int tid_ = (wave << 6) | lane_id(); asm volatile("" : "+v"(tid_));
    const int tid = tid_, wid = __builtin_amdgcn_readfirstlane(tid >> 6), lane = tid & 63, wr = wid >> 2, wc = wid & 3, fr = lane & 15, fq = lane >> 4;
    const int nt = K / (F8 ? 128 : BK);
    const int rowA = F8 ? lda : 2 * lda, rowB = F8 ? K : 2 * K;
    unsigned vB[2], vA[2], vcu[2][2];
#pragma unroll
    for (int i = 0; i < 2; ++i) { int R, C; stage_rc(tid * 16 + i * 8192, R, C); const int Rb = Epi::PERM ? ((R & ~31) + perm32(R & 31)) : R;
        vB[i] = (unsigned)(Rb * rowB + 2 * C); vA[i] = (unsigned)(R * rowA + 2 * C);
#pragma unroll
        for (int h = 0; h < 2; ++h) vcu[h][i] = 0u; }
    const size_t hstepA = (size_t)HALF * rowA;
    const size_t kstep = (size_t)(BK * 2);
    const size_t hstepB = (size_t)HALF * rowB;
    const unsigned ldsw = (unsigned)wid * 1024u;
    const unsigned lds_u32 = (unsigned)__builtin_amdgcn_readfirstlane((int)(unsigned)(size_t)lds);
    const int aoff = lds_byte(wr * 64 + fr, F8 ? fq * 16 : fq * 8); int boff = lds_byte(wc * 32 + fr, F8 ? fq * 16 : fq * 8) + 4 * HTB;
    asm volatile("" : "+v"(boff));
#define PG8_SA(b, h) (((b) * 2 + (h)) * HTB)
#define PG8_SB(b, h) ((4 + (b) * 2 + (h)) * HTB)
#define PG8_STAGE(bufoff, gbase, voff) do { const unsigned long long _gb = (unsigned long long)(gbase); \
        const unsigned _glo = __builtin_amdgcn_readfirstlane((unsigned)_gb), _ghi = __builtin_amdgcn_readfirstlane((unsigned)(_gb >> 32)); const unsigned long long _sb = ((unsigned long long)_ghi << 32) | _glo; \
        _Pragma("unroll") for (int _i = 0; _i < 2; ++_i) { unsigned _keep; const unsigned _dst = lds_u32 + (unsigned)(bufoff) + ldsw + _i * 8192u; \
        asm volatile("s_mov_b32 %0, m0\n\ts_mov_b32 m0, %3\n\ts_nop 0\n\tglobal_load_lds_dwordx4 %1, %2\n\ts_mov_b32 m0, %0" : "=&s"(_keep) : "v"((voff)[_i]), "s"(_sb), "s"(_dst) : "memory"); } } while (0)
#define PG8_STAGE_A(bufoff, gbase, h, vsel) do { if constexpr (GATHER) { PG8_STAGE(bufoff, gbase, (vsel)[h]); } else { PG8_STAGE(bufoff, (gbase) + (h) * hstepA, vA); } } while (0)
#define PG8_RD8(dst, off) do { const i32x4 _l = *(const LAS i32x4*)(lds + (off)), _h = *(const LAS i32x4*)(lds + (off) + 16); dst = __builtin_shufflevector(_l, _h, 0, 1, 2, 3, 4, 5, 6, 7); } while (0)
#define PG8_LDA(dst, dst8, b, h) do { if constexpr (F8) { _Pragma("unroll") for (int m = 0; m < 4; ++m) PG8_RD8(dst8[m], PG8_SA(b, h) + aoff + m * 2048); } \
        else { _Pragma("unroll") for (int m = 0; m < 4; ++m) _Pragma("unroll") for (int k = 0; k < 2; ++k) dst[m][k] = *(const LAS bf16x8*)(lds + PG8_SA(b, h) + aoff + m * 2048 + k * 1024); } } while (0)
#define PG8_LDB(dst, dst8, b, h) do { if constexpr (F8) { _Pragma("unroll") for (int n = 0; n < 2; ++n) PG8_RD8(dst8[n], ((b) * 2 + (h)) * HTB + boff + n * 2048); } \
        else { _Pragma("unroll") for (int n = 0; n < 2; ++n) _Pragma("unroll") for (int k = 0; k < 2; ++k) dst[n][k] = *(const LAS bf16x8*)(lds + ((b) * 2 + (h)) * HTB + boff + n * 2048 + k * 1024); } } while (0)
#define PG8_MMA(ai, bj, At, At8, Bt, Bt8) do { __builtin_amdgcn_s_setprio(1); _Pragma("unroll") for (int m = 0; m < 4; ++m) _Pragma("unroll") for (int n = 0; n < 2; ++n) { \
        if constexpr (F8) acc[ai][bj][m][n] = __builtin_amdgcn_mfma_scale_f32_16x16x128_f8f6f4(Bt8[n], At8[m], acc[ai][bj][m][n], 0, 0, 0, 0x7F7F7F7F, 0, 0x7F7F7F7F); \
        else { _Pragma("unroll") for (int k = 0; k < 2; ++k) acc[ai][bj][m][n] = __builtin_amdgcn_mfma_f32_16x16x32_bf16(Bt[n][k], At[m][k], acc[ai][bj][m][n], 0, 0, 0); } } \
        __builtin_amdgcn_s_setprio(0); } while (0)
#define PG8_WAIT_V(n) asm volatile("s_waitcnt vmcnt(" #n ")" ::: "memory")
#define PG8_WAIT_L(n) asm volatile("s_waitcnt lgkmcnt(" #n ")" ::: "memory")
#define PG8_BAR __builtin_amdgcn_s_barrier()
#define PG8_SCHED __builtin_amdgcn_sched_barrier(0)
#define PG8_TABDMA(u, slot) __builtin_amdgcn_global_load_lds((const unsigned*)((u).list + lane_id() * 4), (LAS unsigned*)(tabs + (slot) * 256), 16, 0, 0)
#define PG8_TABOFF(dst, slot) do { const int _tid = (wid << 6) | lane_id(); _Pragma("unroll") for (int _i = 0; _i < 2; ++_i) { int _R, _C; stage_rc(_tid * 16 + _i * 8192, _R, _C); \
        _Pragma("unroll") for (int _h = 0; _h < 2; ++_h) { unsigned _t = tabs[(slot) * 256 + _h * HALF + _R] >> 2; _t = _t < (unsigned)(T - 1) ? _t : (unsigned)(T - 1); \
        dst[_h][_i] = _t * (unsigned)rowA + 2u * (unsigned)_C; } } } while (0)
    __builtin_amdgcn_s_waitcnt(0x0F70);
    Unit cur, nxt; int ui = 0;
    if (!S.next(0, cur)) return;
    if constexpr (GATHER) { PG8_TABDMA(cur, 0); PG8_WAIT_V(0); PG8_BAR; PG8_TABOFF(vcu, 0); PG8_WAIT_L(0); }
    f32x4 acc[2][2][4][2];
    bf16x8 At[4][2], B0[2][2], B1[2][2]; i32x8 At8[4], B08[2], B18[2];
    const char* cA = cur.a; const char* cB = cur.b;
    PG8_STAGE(PG8_SB(0, 0), cB, vB); PG8_STAGE(PG8_SB(0, 1), cB + hstepB, vB); PG8_STAGE_A(PG8_SA(0, 0), cA, 0, vcu); PG8_STAGE_A(PG8_SA(0, 1), cA, 1, vcu);
    if (wr == 1) PG8_BAR;
    PG8_WAIT_V(2); PG8_BAR;
    PG8_STAGE(PG8_SB(1, 0), cB + kstep, vB); PG8_STAGE_A(PG8_SA(1, 0), cA + kstep, 0, vcu); PG8_STAGE(PG8_SB(1, 1), cB + hstepB + kstep, vB);
    PG8_WAIT_V(6); PG8_BAR;
    asm volatile("" ::: "memory");
#pragma unroll
    for (int a = 0; a < 2; ++a)
#pragma unroll
        for (int b = 0; b < 2; ++b)
#pragma unroll
            for (int m = 0; m < 4; ++m)
#pragma unroll
                for (int n = 0; n < 2; ++n) acc[a][b][m][n] = (f32x4){0.f, 0.f, 0.f, 0.f};
    for (;;) {
        const bool has_next = S.next(ui + 1, nxt);
        if constexpr (GATHER) { if (has_next) PG8_TABDMA(nxt, (ui + 1) & 1); }
        const char* nA = has_next ? nxt.a : cA; const char* nB = has_next ? nxt.b : cB;
#pragma nounroll
        for (int t = 0; t < nt; t += 2) {
            const bool last = (t == nt - 2);
            if constexpr (Epi::MID) { if (t == nt / 2) { const int l2_ = lane_id(); E.mid(acc, cur, wr, l2_ & 15); } }
            unsigned v2[2][2];
#pragma unroll
            for (int h = 0; h < 2; ++h)
#pragma unroll
                for (int i = 0; i < 2; ++i) v2[h][i] = vcu[h][i];
            if constexpr (GATHER) { if (last && has_next) { PG8_TABOFF(v2, (ui + 1) & 1); PG8_WAIT_L(0); } }
            const char* a1 = cA + (size_t)(t + 1) * kstep;
            const char* a2 = last ? nA : cA + (size_t)(t + 2) * kstep; const char* b2 = last ? nB : cB + (size_t)(t + 2) * kstep;
            const char* a3 = a2 + kstep; const char* b3 = b2 + kstep;
            PG8_LDB(B0, B08, 0, 0); PG8_LDB(B1, B18, 0, 1); PG8_SCHED; PG8_LDA(At, At8, 0, 0); PG8_STAGE_A(PG8_SA(1, 1), a1, 1, vcu);
            PG8_WAIT_V(8); PG8_WAIT_L(0); PG8_BAR; PG8_MMA(0, 0, At, At8, B0, B08); PG8_MMA(0, 1, At, At8, B1, B18); PG8_BAR; PG8_SCHED;
            PG8_LDA(At, At8, 0, 1); PG8_STAGE(PG8_SB(0, 0), b2, vB); PG8_STAGE(PG8_SB(0, 1), b2 + hstepB, vB); PG8_STAGE_A(PG8_SA(0, 0), a2, 0, v2);
            PG8_WAIT_V(8); PG8_WAIT_L(0); PG8_BAR; PG8_MMA(1, 0, At, At8, B0, B08); PG8_MMA(1, 1, At, At8, B1, B18); PG8_BAR; PG8_SCHED;
            PG8_LDB(B0, B08, 1, 0); PG8_LDB(B1, B18, 1, 1); PG8_SCHED; PG8_LDA(At, At8, 1, 0); PG8_STAGE_A(PG8_SA(0, 1), a2, 1, v2);
            PG8_WAIT_V(8); PG8_WAIT_L(0); PG8_BAR; PG8_MMA(0, 0, At, At8, B0, B08); PG8_MMA(0, 1, At, At8, B1, B18); PG8_BAR; PG8_SCHED;
            PG8_LDA(At, At8, 1, 1); PG8_STAGE(PG8_SB(1, 0), b3, vB); PG8_STAGE(PG8_SB(1, 1), b3 + hstepB, vB); PG8_STAGE_A(PG8_SA(1, 0), a3, 0, v2);
            PG8_WAIT_V(8); PG8_WAIT_L(0); PG8_BAR; PG8_MMA(1, 0, At, At8, B0, B08); PG8_MMA(1, 1, At, At8, B1, B18); PG8_BAR; PG8_SCHED;
        }
        if (wr == 0) PG8_BAR;
        { const int l2_ = lane_id(); E(acc, cur, wr, wc, l2_ & 15, l2_ >> 4); }
        if (!has_next) break;
#pragma unroll
        for (int a = 0; a < 2; ++a)
#pragma unroll
            for (int b = 0; b < 2; ++b)
#pragma unroll
                for (int m = 0; m < 4; ++m)
#pragma unroll
                    for (int n = 0; n < 2; ++n) acc[a][b][m][n] = (f32x4){0.f, 0.f, 0.f, 0.f};
        cur = nxt; cA = nA; cB = nB; ++ui;
        if constexpr (GATHER) { PG8_TABOFF(vcu, ui & 1); PG8_WAIT_L(0); }
        if (wr == 1) PG8_BAR;
    }
    PG8_WAIT_V(0);
    PG8_BAR;
#undef PG8_SA
#undef PG8_SB
#undef PG8_STAGE
#undef PG8_STAGE_A
#undef PG8_RD8
#undef PG8_LDA
#undef PG8_LDB
#undef PG8_MMA
#undef PG8_TABDMA
#undef PG8_TABOFF
}
struct TileOrder {
    int nM, nN, nwg, G, c;
    __device__ __forceinline__ void init(int nM_, int nN_, int G_, int c_) { nM = nM_; nN = nN_; nwg = nM * nN; G = G_; c = c_; }
    __device__ __forceinline__ bool tile(int i, int& pm, int& pn) const {
        const int L = i * G + c; if (L >= nwg) return false;
        int wgid = L; { const int q = nwg / NXCD, r = nwg % NXCD, xcd = wgid % NXCD, off = wgid / NXCD; wgid = (xcd < r ? xcd * (q + 1) : r * (q + 1) + (xcd - r) * q) + off; }
        const int nig = WGM * nN, gid = wgid / nig, fm = gid * WGM, gsz = (nM - fm) < WGM ? (nM - fm) : WGM;
        pm = fm + ((wgid % nig) % gsz); pn = (wgid % nig) / gsz; return true;
    }
};
struct DenseSched {
    TileOrder o; const char* A; const char* Bt; int lda, K;
    __device__ __forceinline__ void init(const bf16* A_, int lda_, const bf16* Bt_, int M, int N, int K_, int G, int c) { o.init(M / BM, N / BM, G, c); A = (const char*)A_; Bt = (const char*)Bt_; lda = lda_; K = K_; }
    __device__ __forceinline__ bool next(int i, Unit& u) const { int pm, pn; if (!o.tile(i, pm, pn)) return false; u.row0 = pm * BM; u.col0 = pn * BM; u.rows = BM; u.pn = pn; u.e = 0;
        u.a = A + (size_t)pm * BM * lda * 2; u.b = Bt + (size_t)pn * BM * K * 2; u.list = nullptr; return true; }
};
}

__device__ __forceinline__ float sum4sq(const f32x4& v) { return (v[0] * v[0] + v[1] * v[1]) + (v[2] * v[2] + v[3] * v[3]); }
__device__ __forceinline__ void st_bf4(bf16* p, const f32x4& v) { u32x2 w; w.x = cvtpk(v[0], v[1]); w.y = cvtpk(v[2], v[3]); *(u32x2*)p = w; }
__device__ __forceinline__ int cofs8(int fq) { return 4 * fq + (fq & 1) * 12; }
__device__ __forceinline__ void st_bf8(bf16* p, const f32x4& v0, const f32x4& v1) {
    const unsigned a0 = cvtpk(v0[0], v0[1]), a1 = cvtpk(v0[2], v0[3]), b0 = cvtpk(v1[0], v1[1]), b1 = cvtpk(v1[2], v1[3]);
    const auto r0 = __builtin_amdgcn_permlane16_swap(a0, b0, false, false), r1 = __builtin_amdgcn_permlane16_swap(a1, b1, false, false);
    *(u32x4*)p = (u32x4){r0[0], r1[0], r0[1], r1[1]}; }
struct EpiProj {
    static constexpr bool PERM = false, MID = false;
    bf16* PROJ; float* ssqq; float* ssqkv; const float* rope; float* LF; const float* bfor;
    __device__ __forceinline__ void operator()(f32x4 (&acc)[2][2][4][2], const pg8::Unit& u, int wr, int wc, int fr, int fq) const {
        asm volatile("" : "+v"(fr), "+v"(fq));
        const bool rp1 = (u.pn == 1) && (wc == 0);
        f32x4 ca[8], cb[8];
        if (rp1) {
#pragma unroll
            for (int g = 0; g < 8; ++g) { const int pos = (u.row0 + (g >> 2) * 128 + wr * 64 + (g & 3) * 16 + fr) & (SEQ - 1); const float* q = rope + 2 * (pos * 16 + fq * 4); ca[g] = *(const f32x4*)q; cb[g] = *(const f32x4*)(q + 4); } }
#pragma unroll
        for (int ai = 0; ai < 2; ++ai)
#pragma unroll
            for (int m = 0; m < 4; ++m) {
                const int row = u.row0 + ai * 128 + wr * 64 + m * 16 + fr;
                if (u.pn == 0) { float s = (sum4sq(acc[ai][0][m][0]) + sum4sq(acc[ai][0][m][1])) + (sum4sq(acc[ai][1][m][0]) + sum4sq(acc[ai][1][m][1]));
                    s += __shfl_xor(s, 16); s += __shfl_xor(s, 32); if (fq == 0) ssqq[(size_t)row * 4 + wc] = s; }
                if (u.pn == 1) { float s = sum4sq(acc[ai][0][m][0]) + sum4sq(acc[ai][0][m][1]);
                    s += __shfl_xor(s, 16); s += __shfl_xor(s, 32); if (fq == 0) ssqkv[(size_t)row * 4 + wc] = s;
                    if (wc == 0) { const f32x4 x1 = acc[ai][1][m][0], x2 = acc[ai][1][m][1]; f32x4 y1, y2; const f32x4 c0 = ca[ai * 4 + m], c1 = cb[ai * 4 + m];
#pragma unroll
                        for (int e = 0; e < 4; ++e) { const float cx = e < 2 ? c0[2 * e] : c1[2 * e - 4], sx = e < 2 ? c0[2 * e + 1] : c1[2 * e - 3]; y1[e] = x1[e] * cx - x2[e] * sx; y2[e] = x2[e] * cx + x1[e] * sx; }
                        acc[ai][1][m][0] = y1; acc[ai][1][m][1] = y2; } }
                if (u.pn == 7 && wc == 1 && fq < 2) { const f32x4 z4 = acc[ai][1][m][0]; f32x4 lf;
#pragma unroll
                    for (int e = 0; e < 4; ++e) { const float z = z4[e] + bfor[fq * 4 + e]; lf[e] = fminf(z, 0.f) - 0.6931471805599453f * __builtin_amdgcn_logf(1.f + __builtin_amdgcn_exp2f(-LOG2E * fabsf(z))); }
                    *(f32x4*)(LF + (size_t)row * 8 + fq * 4) = lf; }
                bf16* rp = PROJ + (size_t)row * NPROJ + u.col0 + wc * 32 + cofs8(fq);
#pragma unroll
                for (int bj = 0; bj < 2; ++bj) st_bf8(rp + bj * 128, acc[ai][bj][m][0], acc[ai][bj][m][1]);
                asm volatile("" ::: "memory");
            }
    }
};
template <int NS, bool ROPE> struct EpiScale {
    static constexpr bool PERM = false, MID = false;
    bf16* C; int ldc; const float* ss; float inv_n; const float* rope; float osc = 1.f;
    __device__ __forceinline__ void operator()(f32x4 (&acc)[2][2][4][2], const pg8::Unit& u, int wr, int wc, int fr, int fq) const {
        asm volatile("" : "+v"(fr), "+v"(fq));
        const int rbase = u.row0 + wr * 64 + fr;
        f32x4 q[8], ca[8], cb[8]; int bjr = -1;
        if constexpr (ROPE) { const int g0 = (u.col0 >> 5) + wc; bjr = (g0 % 3 == 2) ? 0 : (((g0 + 4) % 3 == 2) ? 1 : -1);
            if (bjr >= 0) {
#pragma unroll
                for (int g = 0; g < 8; ++g) { const int pos = (rbase + (g >> 2) * 128 + (g & 3) * 16) & (SEQ - 1); const float* qq = rope + 2 * (pos * 16 + fq * 4); ca[g] = *(const f32x4*)qq; cb[g] = *(const f32x4*)(qq + 4); } } }
        float q1[8];
        if constexpr (NS == 16) {
#pragma unroll
            for (int g = 0; g < 8; ++g) q[g] = *(const f32x4*)(ss + (size_t)(rbase + (g >> 2) * 128 + (g & 3) * 16) * NS + 4 * fq); }
        if constexpr (NS == 4) {
#pragma unroll
            for (int g = 0; g < 8; ++g) q1[g] = ss[(size_t)(rbase + (g >> 2) * 128 + (g & 3) * 16) * 4 + fq]; }
#pragma unroll
        for (int g = 0; g < 8; ++g) { const int ai = g >> 2, m = g & 3;
                const int row = rbase + ai * 128 + m * 16; float sc = 1.f;
                if constexpr (NS > 0) { float t = NS == 16 ? (q[g][0] + q[g][1]) + (q[g][2] + q[g][3]) : q1[g];
                    t += __shfl_xor(t, 16); t += __shfl_xor(t, 32);
                    sc = rsqrtf(t * inv_n + EPS) * osc; }
                bf16* rp = C + (size_t)row * ldc + u.col0 + wc * 32 + cofs8(fq);
#pragma unroll
                for (int bj = 0; bj < 2; ++bj) {
                    f32x4 v0 = acc[ai][bj][m][0] * sc, v1 = acc[ai][bj][m][1] * sc;
                    if constexpr (ROPE) { if (bj == bjr) { f32x4 y1, y2; const f32x4 c0 = ca[g], c1 = cb[g];
#pragma unroll
                        for (int e = 0; e < 4; ++e) { const float cx = e < 2 ? c0[2 * e] : c1[2 * e - 4], sx = e < 2 ? c0[2 * e + 1] : c1[2 * e - 3]; y1[e] = v0[e] * cx - v1[e] * sx; y2[e] = v1[e] * cx + v0[e] * sx; }
                        v0 = y1; v1 = y2; } }
                    st_bf8(rp + bj * 128, v0, v1);
                }
                asm volatile("" ::: "memory");
            }
    }
};

__device__ __forceinline__ u32x2 pack8_f8(const f32x4& v0, const f32x4& v1, float sc) {
    f32x4 a0, a1;
#pragma unroll
    for (int e = 0; e < 4; ++e) { const auto r = __builtin_amdgcn_permlane16_swap(__float_as_uint(v0[e]), __float_as_uint(v1[e]), false, false); a0[e] = __uint_as_float(r[0]) * sc; a1[e] = __uint_as_float(r[1]) * sc; }
    int w0 = 0, w1 = 0; w0 = __builtin_amdgcn_cvt_pk_fp8_f32(a0[0], a0[1], w0, false); w0 = __builtin_amdgcn_cvt_pk_fp8_f32(a0[2], a0[3], w0, true);
    w1 = __builtin_amdgcn_cvt_pk_fp8_f32(a1[0], a1[1], w1, false); w1 = __builtin_amdgcn_cvt_pk_fp8_f32(a1[2], a1[3], w1, true); return (u32x2){(unsigned)w0, (unsigned)w1}; }
struct EpiMemKV {
    static constexpr bool PERM = false, MID = false;   static constexpr int NST = 16;
    bf16* C; unsigned char* k8;
    __device__ __forceinline__ void operator()(f32x4 (&acc)[2][2][4][2], const pg8::Unit& u, int wr, int wc, int fr, int fq) const {
        asm volatile("" : "+v"(fr), "+v"(fq));
        const int rbase = u.row0 + wr * 64 + fr;
#pragma unroll
        for (int g = 0; g < 8; ++g) { const int ai = g >> 2, m = g & 3; const int row = rbase + ai * 128 + m * 16; const int cc = u.col0 + wc * 32 + cofs8(fq);
#pragma unroll
            for (int bj = 0; bj < 2; ++bj) {
                if (u.pn < 4) *(u32x2*)(k8 + (size_t)row * 1024 + cc + bj * 128) = pack8_f8(acc[ai][bj][m][0], acc[ai][bj][m][1], 1.f);
                else st_bf8(C + (size_t)row * 2048 + cc + bj * 128, acc[ai][bj][m][0], acc[ai][bj][m][1]); }
            asm volatile("" ::: "memory"); }
    }
};
struct EpiXQ8 {
    static constexpr bool PERM = false, MID = false;   static constexpr int NST = 16;
    unsigned char* C8; const float* ss; float osc;
    __device__ __forceinline__ void operator()(f32x4 (&acc)[2][2][4][2], const pg8::Unit& u, int wr, int wc, int fr, int fq) const {
        asm volatile("" : "+v"(fr), "+v"(fq));
        const int rbase = u.row0 + wr * 64 + fr; f32x4 q[8];
#pragma unroll
        for (int g = 0; g < 8; ++g) q[g] = *(const f32x4*)(ss + (size_t)(rbase + (g >> 2) * 128 + (g & 3) * 16) * 16 + 4 * fq);
#pragma unroll
        for (int g = 0; g < 8; ++g) { const int ai = g >> 2, m = g & 3; const int row = rbase + ai * 128 + m * 16;
            float t = (q[g][0] + q[g][1]) + (q[g][2] + q[g][3]); t += __shfl_xor(t, 16); t += __shfl_xor(t, 32);
            const float sc = rsqrtf(t * (1.f / 1024.f) + EPS) * osc;
#pragma unroll
            for (int bj = 0; bj < 2; ++bj) *(u32x2*)(C8 + (size_t)row * DM + u.col0 + wc * 32 + cofs8(fq) + bj * 128) = pack8_f8(acc[ai][bj][m][0], acc[ai][bj][m][1], sc);
            asm volatile("" ::: "memory"); }
    }
};

struct EpiWo {
    static constexpr bool PERM = false, MID = true;
    const float* sso; const float* rmsx; const float* gmix; bf16* hb; float* ssq1; unsigned char* h8;
    __device__ __forceinline__ void mid(f32x4 (&acc)[2][2][4][2], const pg8::Unit& u, int wr, int fr) const {
        asm volatile("" : "+v"(fr));
        int fq = lane_id() >> 4; asm volatile("" : "+v"(fq));
        const int rbase = u.row0 + wr * 64 + fr; f32x4 p[8];
#pragma unroll
        for (int g = 0; g < 8; ++g) p[g] = *((const f32x4*)(sso + (size_t)(rbase + (g >> 2) * 128 + (g & 3) * 16) * 16) + fq);
#pragma unroll
        for (int g = 0; g < 8; ++g) { const int ai = g >> 2, m = g & 3;
            float t = (p[g][0] + p[g][1]) + (p[g][2] + p[g][3]); t += __shfl_xor(t, 16); const float o = __shfl_xor(t, 32);
            const float sm = fq < 2 ? t : o, sf = fq < 2 ? o : t;
            const float ratio = rsqrtf(sm * (1.f / 512.f) + EPS) / rsqrtf(sf * (1.f / 512.f) + EPS);
#pragma unroll
            for (int bj = 0; bj < 2; ++bj)
#pragma unroll
                for (int n = 0; n < 2; ++n) acc[ai][bj][m][n] *= ratio;
            asm volatile("" ::: "memory"); }
    }
    __device__ __forceinline__ void operator()(f32x4 (&acc)[2][2][4][2], const pg8::Unit& u, int wr, int wc, int fr, int fq) const {
        asm volatile("" : "+v"(fr), "+v"(fq));
        const int rbase = u.row0 + wr * 64 + fr; const int cs = u.col0 + wc * 32 + cofs8(fq);
        u32x4 xc[2], xn[2]; f32x4 sf4[8]; float ssg[8], rmx[8]; unsigned w8p[2][2]; f32x4 ig[2][2];
#pragma unroll
        for (int g = 0; g < 8; ++g) { const int rr_ = rbase + (g >> 2) * 128 + (g & 3) * 16; sf4[g] = *((const f32x4*)(sso + (size_t)rr_ * 16) + 2 + (fq & 1)); rmx[g] = rmsx[rr_]; }
#pragma unroll
        for (int bj = 0; bj < 2; ++bj) { xc[bj] = *(const u32x4*)(hb + (size_t)rbase * DM + cs + bj * 128);
#pragma unroll
            for (int n = 0; n < 2; ++n) { const f32x4 gg = *(const f32x4*)(gmix + cs + bj * 128 + 4 * n); ig[bj][n] = (f32x4){__builtin_amdgcn_rcpf(gg[0]), __builtin_amdgcn_rcpf(gg[1]), __builtin_amdgcn_rcpf(gg[2]), __builtin_amdgcn_rcpf(gg[3])}; } }
#pragma unroll
        for (int g = 0; g < 8; ++g) { const int ai = g >> 2, m = g & 3; const int row = rbase + ai * 128 + m * 16;
            if (g + 1 < 8) { const int rn = rbase + ((g + 1) >> 2) * 128 + ((g + 1) & 3) * 16;
#pragma unroll
                for (int bj = 0; bj < 2; ++bj) xn[bj] = *(const u32x4*)(hb + (size_t)rn * DM + cs + bj * 128); }
            float tf = (sf4[g][0] + sf4[g][1]) + (sf4[g][2] + sf4[g][3]); tf += __shfl_xor(tf, 16);
            const float rf = rsqrtf(tf * (1.f / 512.f) + EPS), rx = rmx[g];
            const size_t off = (size_t)row * DM + cs; float ss = 0.f;
#pragma unroll
            for (int bj = 0; bj < 2; ++bj) { const u32x4 w = xc[bj];
                f32x4 a0, a1;
#pragma unroll
                for (int e = 0; e < 4; ++e) { const auto r = __builtin_amdgcn_permlane16_swap(__float_as_uint(acc[ai][bj][m][0][e]), __float_as_uint(acc[ai][bj][m][1][e]), false, false); a0[e] = __uint_as_float(r[0]) * rf; a1[e] = __uint_as_float(r[1]) * rf; }
                a0 += (f32x4){__uint_as_float(w.x << 16), __uint_as_float(w.x & 0xffff0000u), __uint_as_float(w.y << 16), __uint_as_float(w.y & 0xffff0000u)} * ig[bj][0] * rx;
                a1 += (f32x4){__uint_as_float(w.z << 16), __uint_as_float(w.z & 0xffff0000u), __uint_as_float(w.w << 16), __uint_as_float(w.w & 0xffff0000u)} * ig[bj][1] * rx;
                ss += sum4sq(a0) + sum4sq(a1);
                *(u32x4*)(hb + off + bj * 128) = (u32x4){cvtpk(a0[0], a0[1]), cvtpk(a0[2], a0[3]), cvtpk(a1[0], a1[1]), cvtpk(a1[2], a1[3])};
                int w0 = 0, w1 = 0; w0 = __builtin_amdgcn_cvt_pk_fp8_f32(a0[0] * H8_SCALE, a0[1] * H8_SCALE, w0, false); w0 = __builtin_amdgcn_cvt_pk_fp8_f32(a0[2] * H8_SCALE, a0[3] * H8_SCALE, w0, true);
                w1 = __builtin_amdgcn_cvt_pk_fp8_f32(a1[0] * H8_SCALE, a1[1] * H8_SCALE, w1, false); w1 = __builtin_amdgcn_cvt_pk_fp8_f32(a1[2] * H8_SCALE, a1[3] * H8_SCALE, w1, true);
                if ((g & 1) == 0) { w8p[bj][0] = (unsigned)w0; w8p[bj][1] = (unsigned)w1; }
                else {
                    const auto r0 = __builtin_amdgcn_permlane32_swap(w8p[bj][0], (unsigned)w0, false, false), r1 = __builtin_amdgcn_permlane32_swap(w8p[bj][1], (unsigned)w1, false, false);
                    const int rw = row - ((fq < 2) ? 16 : 0);
                    *(u32x4*)(h8 + (size_t)rw * DM + u.col0 + wc * 32 + (fq & 1) * 16 + bj * 128) = (u32x4){r0[0], r1[0], r0[1], r1[1]}; } }
            ss += __shfl_xor(ss, 16); ss += __shfl_xor(ss, 32); ssg[g] = ss;
            asm volatile("" ::: "memory");
#pragma unroll
            for (int bj = 0; bj < 2; ++bj) xc[bj] = xn[bj]; }
        { const float s0 = fq == 0 ? ssg[0] : fq == 1 ? ssg[1] : fq == 2 ? ssg[2] : ssg[3], s1 = fq == 0 ? ssg[4] : fq == 1 ? ssg[5] : fq == 2 ? ssg[6] : ssg[7];
          float* sp = ssq1 + (size_t)(rbase + fq * 16) * 16 + u.pn * 4 + wc; sp[0] = s0; sp[128 * 16] = s1; }
    }
};
struct EpiAddOut {
    static constexpr bool PERM = false, MID = false;
    bf16* hb; float osc;
    __device__ __forceinline__ void operator()(f32x4 (&acc)[2][2][4][2], const pg8::Unit& u, int wr, int wc, int fr, int fq) const {
        asm volatile("" : "+v"(fr), "+v"(fq));
        const int rbase = u.row0 + wr * 64 + fr; const int cb = u.col0 + wc * 32 + cofs8(fq);
        u32x4 xc[2], xn[2];
#pragma unroll
        for (int bj = 0; bj < 2; ++bj) xc[bj] = *(const u32x4*)(hb + (size_t)rbase * DM + cb + bj * 128);
#pragma unroll
        for (int g = 0; g < 8; ++g) { const int ai = g >> 2, m = g & 3; const int row = rbase + ai * 128 + m * 16;
            if (g + 1 < 8) { const int rn = rbase + ((g + 1) >> 2) * 128 + ((g + 1) & 3) * 16;
#pragma unroll
                for (int bj = 0; bj < 2; ++bj) xn[bj] = *(const u32x4*)(hb + (size_t)rn * DM + cb + bj * 128); }
#pragma unroll
            for (int bj = 0; bj < 2; ++bj) { const u32x4 w = xc[bj]; f32x4 a0, a1;
#pragma unroll
                for (int e = 0; e < 4; ++e) { const auto r = __builtin_amdgcn_permlane16_swap(__float_as_uint(acc[ai][bj][m][0][e]), __float_as_uint(acc[ai][bj][m][1][e]), false, false); a0[e] = __uint_as_float(r[0]) * osc; a1[e] = __uint_as_float(r[1]) * osc; }
                const f32x4 h0 = (f32x4){__uint_as_float(w.x << 16), __uint_as_float(w.x & 0xffff0000u), __uint_as_float(w.y << 16), __uint_as_float(w.y & 0xffff0000u)} + a0;
                const f32x4 h1 = (f32x4){__uint_as_float(w.z << 16), __uint_as_float(w.z & 0xffff0000u), __uint_as_float(w.w << 16), __uint_as_float(w.w & 0xffff0000u)} + a1;
                *(u32x4*)(hb + (size_t)row * DM + cb + bj * 128) = (u32x4){cvtpk(h0[0], h0[1]), cvtpk(h0[2], h0[3]), cvtpk(h1[0], h1[1]), cvtpk(h1[2], h1[3])}; }
            asm volatile("" ::: "memory");
#pragma unroll
            for (int bj = 0; bj < 2; ++bj) xc[bj] = xn[bj]; }
    }
};

namespace att {
__device__ __forceinline__ int crow(int r, int hi) { return (r & 3) + 8 * (r >> 2) + 4 * hi; }
struct Src { const bf16* q; int ldq; const bf16* k1; int ldk1; const bf16* k2; int ldk2; const bf16* v; int ldv; bf16* o; int ldo; float* sso; int nt; int q0; const float* kn; const float* cum; };
typedef short v4i16_t __attribute__((ext_vector_type(4)));
__device__ __forceinline__ s16x4 vtr(const LAS unsigned char* p) { return __builtin_bit_cast(s16x4, __builtin_amdgcn_ds_read_tr16_b64_v4i16((LAS v4i16_t*)p)); }
__device__ __forceinline__ float rowmax32(const f32x16& p0, const f32x16& p1) {
    float a = fmaxf(fmaxf(p0[0], p0[1]), p1[0]), b = fmaxf(fmaxf(p0[2], p0[3]), p1[1]); a = fmaxf(fmaxf(a, p1[2]), p1[3]);
#pragma unroll
    for (int r = 4; r < 16; r += 4) { a = fmaxf(fmaxf(a, p0[r]), p0[r + 1]); b = fmaxf(fmaxf(b, p0[r + 2]), p0[r + 3]); a = fmaxf(fmaxf(a, p1[r]), p1[r + 1]); b = fmaxf(fmaxf(b, p1[r + 2]), p1[r + 3]); }
    const float m = fmaxf(a, b);
    auto rr = __builtin_amdgcn_permlane32_swap(__float_as_uint(m), __float_as_uint(m), false, false);
    return fmaxf(__uint_as_float(rr[0]), __uint_as_float(rr[1]));
}
template <int I, int N, class F> __device__ __forceinline__ void cfor(F&& f) { if constexpr (I < N) { f(std::integral_constant<int, I>{}); cfor<I + 1, N>(f); } }
template <int D0, int NKS, bool AUG> __device__ __forceinline__ void kread(bf16x8& f0, bf16x8& f1, unsigned base, unsigned abase) {
    if constexpr (AUG && D0 == NKS - 1) { asm volatile("ds_read_b128 %0, %1 offset:8192" : "=v"(f0) : "v"(abase)); asm volatile("ds_read_b128 %0, %1 offset:8704" : "=v"(f1) : "v"(abase)); }
    else { asm volatile("ds_read_b128 %0, %1 offset:%2" : "=v"(f0) : "v"(base), "n"(D0 * 2048)); asm volatile("ds_read_b128 %0, %1 offset:%2" : "=v"(f1) : "v"(base), "n"(D0 * 2048 + 512)); }
}
template <int NKS, int NC1, int NCH, int ND0, bool CAUSAL, bool AUG, bool REV, bool WSSO, bool EARLY = false, bool ASMK = true>
__device__ __forceinline__ void unit(const Src& s, LAS unsigned char* lds, const int wave) {
    int tid_ = (wave << 6) | lane_id(); asm volatile("" : "+v"(tid_));
    const int tid = tid_, lane = tid & 63, r32 = lane & 31, hi = lane >> 5, wid = __builtin_amdgcn_readfirstlane(tid >> 6);
    constexpr int KSL = NCH * 1024, VSL = ND0 * 4096, KPW = (NCH + 7) / 8, VPW = ND0 / 2;
    constexpr int VOFF = 2 * KSL, WSF = VOFF + 2 * VSL;
    constexpr float THR = 8.f;
    LAS float* wsf = (LAS float*)(lds + WSF) + wid * 64;
    bf16x8 qr[NKS];
    { const bf16* qw = s.q + (size_t)(wid * 32 + r32) * s.ldq + hi * 8;
#pragma unroll
      for (int d0 = 0; d0 < NKS; ++d0) { if (AUG && d0 == NKS - 1) { const short one = hi ? (short)0 : (short)0x3F80; qr[d0] = (bf16x8){one, one, one, 0, 0, 0, 0, 0}; } else qr[d0] = *(const bf16x8*)(qw + d0 * 16); } }
    LAS float* shf = (LAS float*)(lds + WSF + 2048);
    float thr = 0.f;
    if constexpr (EARLY) {
        float q2 = 0.f;
#pragma unroll
        for (int d0 = 0; d0 < NKS - 1; ++d0)
#pragma unroll
            for (int j = 0; j < 8; ++j) { const float f = __uint_as_float(((unsigned)(unsigned short)qr[d0][j]) << 16); q2 += f * f; }
        { auto rr = __builtin_amdgcn_permlane32_swap(__float_as_uint(q2), __float_as_uint(q2), false, false); q2 = __uint_as_float(rr[0]) + __uint_as_float(rr[1]); }
#pragma unroll
        for (int o_ = 1; o_ < 32; o_ <<= 1) q2 = fmaxf(q2, __shfl_xor(q2, o_));
        if (lane == 0) shf[wid] = q2;
        float kn = s.kn[lane];
#pragma unroll
        for (int o_ = 1; o_ < 64; o_ <<= 1) { const float up = __shfl_up(kn, o_); if (lane >= o_) kn = fmaxf(kn, up); }
        thr = kn;
    }
    u32x4 kreg[2][KPW], vreg[2][VPW];
#define ATT_LOAD(t, S_) do { \
    _Pragma("unroll") for (int i_ = 0; i_ < KPW; ++i_) { const int c_ = (wid + 8 * i_ < NCH) ? wid + 8 * i_ : wid; const size_t row_ = (size_t)(t) * 64 + lane;     \
        const bf16* g_ = (c_ < NC1) ? s.k1 + row_ * s.ldk1 + c_ * 8 : s.k2 + row_ * s.ldk2 + (c_ - NC1) * 8; kreg[S_][i_] = *(const u32x4*)g_; } \
    _Pragma("unroll") for (int i_ = 0; i_ < VPW; ++i_) { const int p_ = wid + 8 * i_; const int dh_ = p_ >> 2, rg_ = p_ & 3; \
        vreg[S_][i_] = *(const u32x4*)(s.v + ((size_t)(t) * 64 + 16 * rg_ + (lane >> 2)) * s.ldv + dh_ * 32 + (lane & 3) * 8); } } while (0)
#define ATT_WRITE(slot, S_) do { \
    _Pragma("unroll") for (int i_ = 0; i_ < KPW; ++i_) { const int c_ = (wid + 8 * i_ < NCH) ? wid + 8 * i_ : wid; *(LAS u32x4*)(lds + (slot) * KSL + c_ * 1024 + lane * 16) = kreg[S_][i_]; } \
    _Pragma("unroll") for (int i_ = 0; i_ < VPW; ++i_) { const int p_ = wid + 8 * i_; *(LAS u32x4*)(lds + VOFF + (slot) * VSL + p_ * 1024 + lane * 16) = vreg[S_][i_]; } } while (0)
    const int nt = s.nt;
    ATT_LOAD(REV ? nt - 1 : 0, 0); ATT_LOAD(REV ? nt - 2 : 1, 1); ATT_WRITE(0, 0);
    __syncthreads();
    if constexpr (EARLY) { float qm = shf[0];
#pragma unroll
        for (int w = 1; w < 8; ++w) qm = fmaxf(qm, shf[w]);
        thr = sqrtf(qm) * thr * 1.001f - s.cum[64 * lane + 63] * LOG2E; }
    float m = 0.f, l = 0.f; f32x16 o[ND0]; bool have = false;
    f32x16 negm = f32x16{};
#pragma unroll
    for (int d = 0; d < ND0; ++d) o[d] = f32x16{};
    const int qmin = s.q0 + wid * 32;
    auto body = [&](auto parc, const int i) -> bool { constexpr int PAR = decltype(parc)::value;
        const int t = REV ? nt - 1 - i : i; constexpr int cur = PAR;
        if constexpr (EARLY) { if (i > 0) { float mmin = shf[8 + (PAR ^ 1) * 8];
#pragma unroll
            for (int w = 1; w < 8; ++w) mmin = fminf(mmin, shf[8 + (PAR ^ 1) * 8 + w]);
            const float bound = __uint_as_float(__builtin_amdgcn_readlane(__float_as_uint(thr), t));
            if (bound - mmin < -40.f) return false; } }
        { const int t2 = REV ? (t >= 2 ? t - 2 : 0) : (t + 2 < nt ? t + 2 : nt - 1); ATT_LOAD(t2, PAR); }
        const bool skip = CAUSAL && (64 * t > qmin + 31);
        if (!skip) {
            const LAS unsigned char* kb = lds + cur * KSL + r32 * 16;
            f32x16 p0 = negm, p1 = negm;
            if constexpr (!ASMK) {
                const LAS unsigned char* kq = kb + hi * 1024; bf16x8 ka[8], kc[8];
#pragma unroll
                for (int d = 0; d < 4; ++d) { ka[2 * d] = *(const LAS bf16x8*)(kq + d * 2048); ka[2 * d + 1] = *(const LAS bf16x8*)(kq + d * 2048 + 512); }
#pragma unroll
                for (int g0 = 0; g0 < NKS; g0 += 4) {
                    if (g0 + 4 < NKS) {
#pragma unroll
                        for (int d = 0; d < 4; ++d) { kc[2 * d] = *(const LAS bf16x8*)(kq + (g0 + 4 + d) * 2048); kc[2 * d + 1] = *(const LAS bf16x8*)(kq + (g0 + 4 + d) * 2048 + 512); } }
                    __builtin_amdgcn_sched_group_barrier(0x100, 8, 0);
#pragma unroll
                    for (int d = 0; d < 4; ++d) { p0 = __builtin_amdgcn_mfma_f32_32x32x16_bf16(ka[2 * d], qr[g0 + d], p0, 0, 0, 0); p1 = __builtin_amdgcn_mfma_f32_32x32x16_bf16(ka[2 * d + 1], qr[g0 + d], p1, 0, 0, 0); }
                    __builtin_amdgcn_sched_group_barrier(0x008, 8, 0);
#pragma unroll
                    for (int z = 0; z < 8; ++z) ka[z] = kc[z];
                }
            } else {
            constexpr int KB = (NKS % 3 == 0 || NKS == 5) ? 3 : 4, NB = (NKS + KB - 1) / KB;
            const unsigned kbase = (unsigned)(size_t)(kb + hi * 1024), abase = (unsigned)(size_t)kb;
            bf16x8 kfa[2 * KB], kfb[2 * KB];
#pragma unroll
            for (int z_ = 0; z_ < 2 * KB; ++z_) { kfa[z_] = bf16x8{}; kfb[z_] = bf16x8{}; }
            cfor<0, KB>([&](auto ic) { constexpr int D = decltype(ic)::value; if constexpr (D < NKS) kread<D, NKS, AUG>(kfa[2 * D], kfa[2 * D + 1], kbase, abase); });
            cfor<0, NB>([&](auto bc) { constexpr int B = decltype(bc)::value;
                if constexpr (B % 2 == 0) { if constexpr (KB == 3) asm volatile("s_waitcnt lgkmcnt(0)" : "+v"(kfa[0]), "+v"(kfa[1]), "+v"(kfa[2]), "+v"(kfa[3]), "+v"(kfa[4]), "+v"(kfa[5]) :: "memory");
                                            else asm volatile("s_waitcnt lgkmcnt(0)" : "+v"(kfa[0]), "+v"(kfa[1]), "+v"(kfa[2]), "+v"(kfa[3]), "+v"(kfa[4]), "+v"(kfa[5]), "+v"(kfa[6]), "+v"(kfa[7]) :: "memory"); }
                else { if constexpr (KB == 3) asm volatile("s_waitcnt lgkmcnt(0)" : "+v"(kfb[0]), "+v"(kfb[1]), "+v"(kfb[2]), "+v"(kfb[3]), "+v"(kfb[4]), "+v"(kfb[5]) :: "memory");
                       else asm volatile("s_waitcnt lgkmcnt(0)" : "+v"(kfb[0]), "+v"(kfb[1]), "+v"(kfb[2]), "+v"(kfb[3]), "+v"(kfb[4]), "+v"(kfb[5]), "+v"(kfb[6]), "+v"(kfb[7]) :: "memory"); }
                __builtin_amdgcn_sched_barrier(0);
                if constexpr (B % 2 == 0) {
                    cfor<0, KB>([&](auto ic) { constexpr int D = (B + 1) * KB + decltype(ic)::value; if constexpr (D < NKS) kread<D, NKS, AUG>(kfb[2 * decltype(ic)::value], kfb[2 * decltype(ic)::value + 1], kbase, abase); });
                    __builtin_amdgcn_sched_barrier(0);
                    cfor<0, KB>([&](auto ic) { constexpr int D = B * KB + decltype(ic)::value; if constexpr (D < NKS) { p0 = __builtin_amdgcn_mfma_f32_32x32x16_bf16(kfa[2 * decltype(ic)::value], qr[D], p0, 0, 0, 0); p1 = __builtin_amdgcn_mfma_f32_32x32x16_bf16(kfa[2 * decltype(ic)::value + 1], qr[D], p1, 0, 0, 0); } });
                } else {
                    cfor<0, KB>([&](auto ic) { constexpr int D = (B + 1) * KB + decltype(ic)::value; if constexpr (D < NKS) kread<D, NKS, AUG>(kfa[2 * decltype(ic)::value], kfa[2 * decltype(ic)::value + 1], kbase, abase); });
                    __builtin_amdgcn_sched_barrier(0);
                    cfor<0, KB>([&](auto ic) { constexpr int D = B * KB + decltype(ic)::value; if constexpr (D < NKS) { p0 = __builtin_amdgcn_mfma_f32_32x32x16_bf16(kfb[2 * decltype(ic)::value], qr[D], p0, 0, 0, 0); p1 = __builtin_amdgcn_mfma_f32_32x32x16_bf16(kfb[2 * decltype(ic)::value + 1], qr[D], p1, 0, 0, 0); } });
                }
            });
            }
            const LAS unsigned char* vb = lds + VOFF + cur * VSL + ((lane >> 4) & 1) * 32 + (lane & 3) * 8 + (4 * hi + ((lane & 15) >> 2)) * 64;
            s16x4 vlo[2][4], vhi[2][4];
#pragma unroll
            for (int d = 0; d < 2; ++d)
#pragma unroll
                for (int ks = 0; ks < 4; ++ks) { vlo[d][ks] = vtr(vb + d * 4096 + ks * 1024); vhi[d][ks] = vtr(vb + d * 4096 + ks * 1024 + 512); }
            __builtin_amdgcn_sched_group_barrier(0x100, 16, 0);
            if (CAUSAL && (64 * t + 63 > qmin)) { const int q = qmin + r32, kv0 = 64 * t + 4 * hi;
#pragma unroll
                for (int r = 0; r < 16; ++r) { const int kv = kv0 + (r & 3) + 8 * (r >> 2); if (kv > q) p0[r] = -INFINITY; if (kv + 32 > q) p1[r] = -INFINITY; } }
            const float rmd = rowmax32(p0, p1);
            if (!have || __any(rmd > THR)) {
                const float dd = have ? fmaxf(rmd, 0.f) : rmd, alpha = have ? __builtin_amdgcn_exp2f(-dd) : 1.f; l *= alpha; m += dd;
#pragma unroll
                for (int r = 0; r < 16; ++r) { p0[r] -= dd; p1[r] -= dd; negm[r] = -m; }
                if (have) {
                    if (hi == 0) wsf[r32] = alpha;
                    asm volatile("s_waitcnt lgkmcnt(0)" ::: "memory");
#pragma unroll
                    for (int r = 0; r < 16; ++r) { const float a = wsf[crow(r, hi)];
#pragma unroll
                        for (int d = 0; d < ND0; ++d) o[d][r] *= a; } }
                have = true;
            }
            float sacc = 0.f;
#pragma unroll
            for (int r = 0; r < 16; ++r) { p0[r] = __builtin_amdgcn_exp2f(p0[r]); p1[r] = __builtin_amdgcn_exp2f(p1[r]); sacc += p0[r] + p1[r]; }
            l += sacc;
            u32x4 pw[4];
#pragma unroll
            for (int j = 0; j < 4; ++j) { pw[0][j] = cvtpk(p0[2 * j], p0[2 * j + 1]); pw[1][j] = cvtpk(p0[8 + 2 * j], p0[8 + 2 * j + 1]); pw[2][j] = cvtpk(p1[2 * j], p1[2 * j + 1]); pw[3][j] = cvtpk(p1[8 + 2 * j], p1[8 + 2 * j + 1]); }
#pragma unroll
            for (int d = 0; d < 2; ++d)
#pragma unroll
                for (int ks = 0; ks < 4; ++ks) { const bf16x8 vf = (bf16x8){vlo[d][ks][0], vlo[d][ks][1], vlo[d][ks][2], vlo[d][ks][3], vhi[d][ks][0], vhi[d][ks][1], vhi[d][ks][2], vhi[d][ks][3]};
                    o[d] = __builtin_amdgcn_mfma_f32_32x32x16_bf16(__builtin_bit_cast(bf16x8, pw[ks]), vf, o[d], 0, 0, 0); }
            if constexpr (ND0 > 2) {
#pragma unroll
                for (int d = 2; d < ND0; d += 2) { s16x4 wlo[2][4], whi[2][4];
#pragma unroll
                    for (int e = 0; e < 2; ++e)
#pragma unroll
                        for (int ks = 0; ks < 4; ++ks) { wlo[e][ks] = vtr(vb + (d + e) * 4096 + ks * 1024); whi[e][ks] = vtr(vb + (d + e) * 4096 + ks * 1024 + 512); }
#pragma unroll
                    for (int e = 0; e < 2; ++e)
#pragma unroll
                        for (int ks = 0; ks < 4; ++ks) { const bf16x8 vf = (bf16x8){wlo[e][ks][0], wlo[e][ks][1], wlo[e][ks][2], wlo[e][ks][3], whi[e][ks][0], whi[e][ks][1], whi[e][ks][2], whi[e][ks][3]};
                            o[d + e] = __builtin_amdgcn_mfma_f32_32x32x16_bf16(__builtin_bit_cast(bf16x8, pw[ks]), vf, o[d + e], 0, 0, 0); }
                    __builtin_amdgcn_sched_group_barrier(0x100, 16, 1); __builtin_amdgcn_sched_group_barrier(0x008, 8, 1); } }
        }
        ATT_WRITE(cur ^ 1, PAR ^ 1);
        if constexpr (EARLY) { float mw = have ? m : -1e30f;
#pragma unroll
            for (int o_ = 1; o_ < 32; o_ <<= 1) mw = fminf(mw, __shfl_xor(mw, o_));
            if (lane == 0) shf[8 + PAR * 8 + wid] = mw; }
        __syncthreads();
        return true;
    };
    for (int i = 0; i < nt; i += 2) { if (!body(std::integral_constant<int, 0>{}, i)) break; if (!body(std::integral_constant<int, 1>{}, i + 1)) break; }
    { auto rr = __builtin_amdgcn_permlane32_swap(__float_as_uint(l), __float_as_uint(l), false, false); l = __uint_as_float(rr[0]) + __uint_as_float(rr[1]); }
    if (hi == 0) wsf[32 + r32] = 1.f / l;
    asm volatile("s_waitcnt lgkmcnt(0)" ::: "memory");
    LAS bf16* stg = (LAS bf16*)(lds + wid * (ND0 * 2048));
#pragma unroll
    for (int r = 0; r < 16; ++r) { const float rl = wsf[32 + crow(r, hi)]; const int orow = crow(r, hi);
#pragma unroll
        for (int d = 0; d < ND0; ++d) stg[orow * (ND0 * 32) + d * 32 + r32] = f2bf(o[d][r] * rl); }
    asm volatile("s_waitcnt lgkmcnt(0)" ::: "memory");
    constexpr int CPR = ND0 * 4, RPI = 64 / CPR;
    bf16* ow = s.o + (size_t)(wid * 32) * s.ldo;
#pragma unroll
    for (int it = 0; it < 32 / RPI; ++it) { const int row = it * RPI + lane / CPR, ch = lane % CPR; const u32x4 v = *(const LAS u32x4*)(stg + row * (ND0 * 32) + ch * 8);
        *(u32x4*)(ow + (size_t)row * s.ldo + ch * 8) = v;
        if (WSSO) { float ss = 0.f;
#pragma unroll
            for (int j = 0; j < 4; ++j) { const float a = __uint_as_float(v[j] << 16), b = __uint_as_float(v[j] & 0xffff0000u); ss += a * a + b * b; }
#pragma unroll
            for (int sh = 1; sh < CPR; sh <<= 1) ss += __shfl_xor(ss, sh);
            if (ch == 0) s.sso[(size_t)(wid * 32 + row) * 16] = ss; } }
    __syncthreads();
#undef ATT_LOAD
#undef ATT_WRITE
}
__device__ __forceinline__ void xunit(const Src& s, LAS unsigned char* lds, const int wave) {
    int tid_ = (wave << 6) | lane_id(); asm volatile("" : "+v"(tid_));
    const int tid = tid_, lane = tid & 63, r32 = lane & 31, hi = lane >> 5, wid = __builtin_amdgcn_readfirstlane(tid >> 6);
    constexpr int KSL = 16384, VSL = 16384, VOFF = 2 * KSL, STG = VOFF + 2 * VSL;
    LAS float* wsf = (LAS float*)(lds + 131072) + wid * 64;
    f32x16 p[4][2];
#pragma unroll
    for (int t = 0; t < 4; ++t) { p[t][0] = f32x16{}; p[t][1] = f32x16{}; }
    typedef int xi4 __attribute__((ext_vector_type(4))); typedef int xi8 __attribute__((ext_vector_type(8)));
    u32x4 sreg[2][2];
#define X_LOAD(J) do { if constexpr ((J) < 4) { _Pragma("unroll") for (int i_ = 0; i_ < 2; ++i_) sreg[(J) & 1][i_] = *(const u32x4*)((const unsigned char*)s.k1 + (size_t)((J) * 64 + lane) * s.ldk1 + (wid + 8 * i_) * 16); } \
        else if constexpr ((J) < 12) { _Pragma("unroll") for (int i_ = 0; i_ < 2; ++i_) { const int p_ = wid + 8 * i_, dh_ = p_ >> 2, rg_ = p_ & 3; \
            sreg[(J) & 1][i_] = *(const u32x4*)(s.v + (size_t)(((J) & 3) * 64 + 16 * rg_ + (lane >> 2)) * s.ldv + (((J) - 4) >> 2) * 128 + dh_ * 32 + (lane & 3) * 8); } } } while (0)
#define X_WRITE(J) do { if constexpr ((J) < 12) { _Pragma("unroll") for (int i_ = 0; i_ < 2; ++i_) *(LAS u32x4*)(lds + ((J) < 4 ? 0 : VOFF) + ((J) & 1) * KSL + (wid + 8 * i_) * 1024 + lane * 16) = sreg[(J) & 1][i_]; } } while (0)
    X_LOAD(0); X_LOAD(1);
    xi8 q8[4];
    { const unsigned char* qw8 = (const unsigned char*)s.q + (size_t)(wid * 32 + r32) * s.ldq + hi * 32;
#pragma unroll
      for (int s_ = 0; s_ < 4; ++s_) { const xi4 lo_ = *(const xi4*)(qw8 + 64 * s_), hi_ = *(const xi4*)(qw8 + 64 * s_ + 16); q8[s_] = __builtin_shufflevector(lo_, hi_, 0, 1, 2, 3, 4, 5, 6, 7); } }
    X_WRITE(0);
    __syncthreads();
    cfor<0, 4>([&](auto ic) { constexpr int I = decltype(ic)::value;
        X_LOAD(I + 2);
        const LAS unsigned char* kq = lds + (I & 1) * KSL + r32 * 16 + hi * 2048; xi8 kf[8];
#pragma unroll
        for (int s_ = 0; s_ < 4; ++s_)
#pragma unroll
            for (int kb = 0; kb < 2; ++kb) { const xi4 lo_ = *(const LAS xi4*)(kq + s_ * 4096 + kb * 512), hi_ = *(const LAS xi4*)(kq + s_ * 4096 + 1024 + kb * 512); kf[2 * s_ + kb] = __builtin_shufflevector(lo_, hi_, 0, 1, 2, 3, 4, 5, 6, 7); }
#pragma unroll
        for (int s_ = 0; s_ < 4; ++s_) { p[I][0] = __builtin_amdgcn_mfma_scale_f32_32x32x64_f8f6f4(kf[2 * s_], q8[s_], p[I][0], 0, 0, 0, 0x7F7F7F7F, 0, 0x7F7F7F7F);
                                       p[I][1] = __builtin_amdgcn_mfma_scale_f32_32x32x64_f8f6f4(kf[2 * s_ + 1], q8[s_], p[I][1], 0, 0, 0, 0x7F7F7F7F, 0, 0x7F7F7F7F); }
        X_WRITE(I + 1);
        __syncthreads();
    });
    float m = rowmax32(p[0][0], p[0][1]);
#pragma unroll
    for (int t = 1; t < 4; ++t) m = fmaxf(m, rowmax32(p[t][0], p[t][1]));
    float l = 0.f; u32x4 pw[4][4];
#pragma unroll
    for (int t = 0; t < 4; ++t) { float sacc = 0.f;
#pragma unroll
        for (int r = 0; r < 16; ++r) { p[t][0][r] = __builtin_amdgcn_exp2f((p[t][0][r] - m) * (1.f / XQ8_SCALE)); p[t][1][r] = __builtin_amdgcn_exp2f((p[t][1][r] - m) * (1.f / XQ8_SCALE)); sacc += p[t][0][r] + p[t][1][r]; }
        l += sacc;
#pragma unroll
        for (int j = 0; j < 4; ++j) { pw[t][0][j] = cvtpk(p[t][0][2 * j], p[t][0][2 * j + 1]); pw[t][1][j] = cvtpk(p[t][0][8 + 2 * j], p[t][0][8 + 2 * j + 1]); pw[t][2][j] = cvtpk(p[t][1][2 * j], p[t][1][2 * j + 1]); pw[t][3][j] = cvtpk(p[t][1][8 + 2 * j], p[t][1][8 + 2 * j + 1]); } }
    { auto rr = __builtin_amdgcn_permlane32_swap(__float_as_uint(l), __float_as_uint(l), false, false); l = __uint_as_float(rr[0]) + __uint_as_float(rr[1]); }
    if (hi == 0) wsf[32 + r32] = 1.f / l;
    asm volatile("s_waitcnt lgkmcnt(0)" ::: "memory");
    f32x16 o[4];
    cfor<0, 8>([&](auto ic) { constexpr int I = decltype(ic)::value, TT = I & 3, DVH = I >> 2;
        X_LOAD(I + 6);
        if constexpr (TT == 0) {
#pragma unroll
            for (int d = 0; d < 4; ++d) o[d] = f32x16{}; }
        const LAS unsigned char* vb = lds + VOFF + (I & 1) * VSL + ((lane >> 4) & 1) * 32 + (lane & 3) * 8 + (4 * hi + ((lane & 15) >> 2)) * 64;
#pragma unroll
        for (int d = 0; d < 4; d += 2) { s16x4 vlo[2][4], vhi[2][4];
#pragma unroll
            for (int e = 0; e < 2; ++e)
#pragma unroll
                for (int ks = 0; ks < 4; ++ks) { vlo[e][ks] = vtr(vb + (d + e) * 4096 + ks * 1024); vhi[e][ks] = vtr(vb + (d + e) * 4096 + ks * 1024 + 512); }
#pragma unroll
            for (int e = 0; e < 2; ++e)
#pragma unroll
                for (int ks = 0; ks < 4; ++ks) { const bf16x8 vf = (bf16x8){vlo[e][ks][0], vlo[e][ks][1], vlo[e][ks][2], vlo[e][ks][3], vhi[e][ks][0], vhi[e][ks][1], vhi[e][ks][2], vhi[e][ks][3]};
                    o[d + e] = __builtin_amdgcn_mfma_f32_32x32x16_bf16(__builtin_bit_cast(bf16x8, pw[TT][ks]), vf, o[d + e], 0, 0, 0); } }
        X_WRITE(I + 5);
        if constexpr (TT == 3) {
            LAS bf16* stg = (LAS bf16*)(lds + STG + wid * 8192);
#pragma unroll
            for (int r = 0; r < 16; ++r) { const float rl = wsf[32 + crow(r, hi)]; const int orow = crow(r, hi);
#pragma unroll
                for (int d = 0; d < 4; ++d) stg[orow * 128 + d * 32 + r32] = f2bf(o[d][r] * rl); }
            asm volatile("s_waitcnt lgkmcnt(0)" ::: "memory");
            unsigned char* ow = (unsigned char*)s.o + (size_t)(wid * 32) * s.ldo + DVH * 128;
#pragma unroll
            for (int it = 0; it < 4; ++it) { const int row = it * 8 + (lane >> 3), ch = lane & 7; const u32x4 v0 = *(const LAS u32x4*)(stg + row * 128 + ch * 16), v1 = *(const LAS u32x4*)(stg + row * 128 + ch * 16 + 8); u32x4 f;
#pragma unroll
                for (int j = 0; j < 4; ++j) { const unsigned q_ = j < 2 ? v0[2 * j] : v1[2 * j - 4], r_ = j < 2 ? v0[2 * j + 1] : v1[2 * j - 3]; int w = 0;
                    w = __builtin_amdgcn_cvt_pk_fp8_f32(__uint_as_float(q_ << 16) * XO8_SCALE, __uint_as_float(q_ & 0xffff0000u) * XO8_SCALE, w, false);
                    w = __builtin_amdgcn_cvt_pk_fp8_f32(__uint_as_float(r_ << 16) * XO8_SCALE, __uint_as_float(r_ & 0xffff0000u) * XO8_SCALE, w, true); f[j] = (unsigned)w; }
                *(u32x4*)(ow + (size_t)row * s.ldo + ch * 16) = f; }
            asm volatile("s_waitcnt lgkmcnt(0)" ::: "memory"); }
        __syncthreads();
    });
#undef X_LOAD
#undef X_WRITE
}
}

#define XB_TMO      128
#define XB_XCNT(j)  (256  + 64 * (j))
#define XB_XSUB(j)  (1280 + 64 * (j))
#define XB_XGEN(j)  (2304 + 64 * (j))
#define XB_TOP      3328
#define XB_TOPGEN   3392
#define XCD_BAR_WORDS 3456
#define XB_SPIN_CAP (1u << 18)
__device__ __forceinline__ unsigned xb_ld(unsigned* p)              { return __hip_atomic_load(p, __ATOMIC_RELAXED, __HIP_MEMORY_SCOPE_AGENT); }
__device__ __forceinline__ unsigned xb_add(unsigned* p, unsigned v) { return __hip_atomic_fetch_add(p, v, __ATOMIC_RELAXED, __HIP_MEMORY_SCOPE_AGENT); }
__device__ __forceinline__ unsigned xb_xcc_id() { return (unsigned)__builtin_amdgcn_s_getreg((3 << 11) | 20) & 0xFu; }
#define XB_SPIN(cond, bar) do { unsigned _sp = 0; while (cond) { __builtin_amdgcn_s_sleep(1); \
    if ((++_sp & 255u) == 0u) { if (xb_ld(&(bar)[XB_TMO])) break; if (_sp > XB_SPIN_CAP) { atomicAdd(&(bar)[XB_TMO], 1u); break; } } } } while (0)
struct XcdBarrier { unsigned* bar; unsigned x; volatile LAS unsigned* st; bool wave0; };
__device__ __forceinline__ XcdBarrier xcd_barrier_post(unsigned* bar, volatile LAS unsigned* st, int wave) {
    XcdBarrier b; b.bar = bar; b.x = xb_xcc_id(); b.st = st; b.wave0 = (wave == 0);
    if (b.wave0 && lane_id() == 0) (void)xb_add(&bar[XB_XCNT(b.x)], 1u);
    return b;
}
__device__ __forceinline__ void xcd_barrier_complete(unsigned* bar, unsigned x, unsigned& nloc, unsigned& nx) {
    const unsigned G = gridDim.x * gridDim.y * gridDim.z;
    unsigned sum, cnt, mine, sp = 0u;
    for (;;) {
        sum = 0u; cnt = 0u; mine = 0u;
#pragma unroll
        for (unsigned j = 0; j < 16; ++j) { const unsigned c = xb_ld(&bar[XB_XCNT(j)]); sum += c; cnt += (c > 0u) ? 1u : 0u; mine = (j == x) ? c : mine; }
        if (sum == G) break;
        __builtin_amdgcn_s_sleep(1);
        if ((++sp & 255u) == 0u) { if (xb_ld(&bar[XB_TMO])) break; if (sp > XB_SPIN_CAP) { atomicAdd(&bar[XB_TMO], 1u); break; } }
    }
    nloc = mine > 0u ? mine : 1u; nx = cnt > 0u ? cnt : 1u;
}
__device__ __forceinline__ void xcd_barrier(const XcdBarrier& b) {
    asm volatile("s_waitcnt vmcnt(0)" ::: "memory");
    __syncthreads();
    if (b.wave0 && lane_id() == 0) {
        unsigned* bar = b.bar;
        __builtin_amdgcn_s_waitcnt(0);
        unsigned nloc = b.st[0], nx = b.st[1];
        if (nloc == 0u) { xcd_barrier_complete(bar, b.x, nloc, nx); b.st[0] = nloc; b.st[1] = nx; }
        const unsigned old = xb_add(&bar[XB_XSUB(b.x)], 1u);
        const unsigned gen = old / nloc;
        if (old + 1u == (gen + 1u) * nloc) {
            __builtin_amdgcn_fence(__ATOMIC_RELEASE, "agent");
            asm volatile("s_waitcnt vmcnt(0)" ::: "memory");
            const unsigned og = xb_add(&bar[XB_TOP], 1u);
            const unsigned tg = og / nx;
            if (og + 1u == (tg + 1u) * nx) xb_add(&bar[XB_TOPGEN], 1u);
            else XB_SPIN(xb_ld(&bar[XB_TOPGEN]) == tg, bar);
            __builtin_amdgcn_fence(__ATOMIC_ACQUIRE, "agent");
            xb_add(&bar[XB_XGEN(b.x)], 1u);
            asm volatile("s_waitcnt vmcnt(0)" ::: "memory");
        } else {
            XB_SPIN(xb_ld(&bar[XB_XGEN(b.x)]) == gen, bar);
            __builtin_amdgcn_fence(__ATOMIC_ACQUIRE, "agent");
            asm volatile("s_waitcnt vmcnt(0)" ::: "memory");
        }
    }
    __syncthreads();
}

constexpr int NWAVES = 8;
constexpr int RING_BYTES = 131072, TABS_OFF = RING_BYTES, MISC_OFF = TABS_OFF + 2048, LDS_BYTES = 147456;
constexpr int CW_FOXQ = 256;
constexpr int CW_BAR = 4096;
constexpr int N_PHASES = 11;
constexpr float W8_SCALE = 32.f, ACT8_SCALE = 4.f, Y8_SCALE = 16.f;
#ifndef PROBE_REP
#define PROBE_REP -1
#endif
#define REPS(k) for (int rep_ = 0; rep_ < ((PROBE_REP) == (k) ? 2 : 1); ++rep_)
struct MegaArgs {
    const float* in[25]; float* out; unsigned char* ws; int ph_lo, ph_hi; int coop; int pad;
};
struct Frame {
    LAS unsigned char* lds; volatile LAS unsigned* MISC; LAS unsigned* tabs;
    int wave, vcu, G;
};
struct P0Item { const float* W; bf16* WT; const float* kscale; const float* kscale2; int K, N, NT, c_lo, c_hi, item; float cscale; bool f8; };
__device__ __forceinline__ void p0_load(const P0Item& d, f32x4 (&v)[8], int lane) {
    const int nblk = d.NT / 32, kb = d.item / nblk, nb = d.item % nblk, k0 = 64 * kb, n0 = 32 * nb; const int r8 = lane >> 3, c4 = lane & 7, nn = n0 + 4 * c4;
#pragma unroll
    for (int i = 0; i < 8; ++i) { const int kk = i * 8 + r8; v[i] = (f32x4){0.f, 0.f, 0.f, 0.f}; if (nn < d.N) v[i] = __builtin_nontemporal_load((const f32x4*)(d.W + (size_t)(k0 + kk) * d.N + nn)); }
}
__device__ __forceinline__ void p0_finish(const P0Item& d, const f32x4 (&v)[8], LAS float* scr, int lane) {
    const int nblk = d.NT / 32, kb = d.item / nblk, nb = d.item % nblk, k0 = 64 * kb, n0 = 32 * nb; const int r8 = lane >> 3, c4 = lane & 7, nn = n0 + 4 * c4;
    const float cs = (nn >= d.c_lo && nn < d.c_hi) ? d.cscale : 1.f;
#pragma unroll
    for (int i = 0; i < 8; ++i) { const int kk = i * 8 + r8; float ks = cs; if (d.kscale) ks *= (d.kscale2 && k0 >= 512) ? d.kscale2[k0 + kk - 512] : d.kscale[k0 + kk];
        LAS float* p = scr + kk * 33 + 4 * c4; p[0] = v[i][0] * ks; p[1] = v[i][1] * ks; p[2] = v[i][2] * ks; p[3] = v[i][3] * ks; }
    asm volatile("s_waitcnt lgkmcnt(0)" ::: "memory");
    const int c = lane & 7;
#pragma unroll
    for (int j = 0; j < 4; ++j) { const int n = (lane >> 3) + 8 * j; const LAS float* s = scr + (8 * c) * 33 + n;
        if (d.f8) { int w0 = 0, w1 = 0; w0 = __builtin_amdgcn_cvt_pk_fp8_f32(s[0 * 33], s[1 * 33], w0, false); w0 = __builtin_amdgcn_cvt_pk_fp8_f32(s[2 * 33], s[3 * 33], w0, true);
            w1 = __builtin_amdgcn_cvt_pk_fp8_f32(s[4 * 33], s[5 * 33], w1, false); w1 = __builtin_amdgcn_cvt_pk_fp8_f32(s[6 * 33], s[7 * 33], w1, true);
            *(u32x2*)((unsigned char*)d.WT + (size_t)(n0 + n) * d.K + k0 + 8 * c) = (u32x2){(unsigned)w0, (unsigned)w1}; }
        else { u32x4 o; o.x = cvtpk(s[0 * 33], s[1 * 33]); o.y = cvtpk(s[2 * 33], s[3 * 33]); o.z = cvtpk(s[4 * 33], s[5 * 33]); o.w = cvtpk(s[6 * 33], s[7 * 33]);
            *(u32x4*)(d.WT + (size_t)(n0 + n) * d.K + k0 + 8 * c) = o; } }
    asm volatile("s_waitcnt lgkmcnt(0)" ::: "memory");
}
__device__ __forceinline__ void rms_row_to_bf16(const float* xrow, const float* g, bf16* orow, int lane) {
    const f32x4* xr = (const f32x4*)xrow + lane; const f32x4* gr = (const f32x4*)g + lane;
    f32x4 v[4]; float s = 0.f;
#pragma unroll
    for (int j = 0; j < 4; ++j) { v[j] = xr[64 * j]; s += sum4sq(v[j]); }
    const float r = rsqrtf(wave_sum(s) * (1.f / DM) + EPS);
#pragma unroll
    for (int j = 0; j < 4; ++j) { const f32x4 o = v[j] * r * gr[64 * j]; st_bf4(orow + 4 * lane + 256 * j, o); }
}
constexpr size_t WS_WRG = 31 * MiB;
constexpr size_t WS_KN = 1 * MiB + 512 * 1024;
constexpr size_t WS_XF8 = 416 * MiB;
constexpr size_t WS_H1F8 = 880 * MiB;
constexpr size_t WS_XOF8 = 912 * MiB;
constexpr size_t WS_KM8 = 944 * MiB;
constexpr size_t WS_RMSX = 866 * MiB;
constexpr size_t WS_GSORT = 868 * MiB;
constexpr size_t WS_LF = 996 * MiB;

__device__ __forceinline__ P0Item p0_decode(const MegaArgs& a, int it) {
    unsigned char* ws = a.ws;
    constexpr int I_IN = 16 * 64, I_Q = 4 * 24, I_KV = 2 * 32, I_SQ = 16 * 32, I_MKV = 16 * 64, I_GU = 16 * 64, I_D = 16 * 32;
    P0Item d; d.kscale = nullptr; d.kscale2 = nullptr; d.cscale = 1.f; d.c_lo = 0; d.c_hi = 0; d.f8 = false; int r = it;
    if (r < NEXP * I_GU) { const int e = r / I_GU; d.W = a.in[20] + (size_t)e * DM * 2048; d.K = DM; d.N = 2048; d.NT = 2048; d.WT = (bf16*)(ws + WS_WGU + (size_t)e * 2048 * DM); d.f8 = true; d.cscale = W8_SCALE; d.c_hi = 2048; d.item = r % I_GU; return d; } r -= NEXP * I_GU;
    if (r < NEXP * I_D) { const int e = r / I_D; d.W = a.in[22] + (size_t)e * DEXP * DM; d.K = DEXP; d.N = DM; d.NT = DM; d.WT = (bf16*)(ws + WS_WD + (size_t)e * DM * DEXP); d.f8 = true; d.cscale = W8_SCALE; d.c_hi = DM; d.item = r % I_D; return d; } r -= NEXP * I_D;
    if (r < I_IN) { d.W = a.in[3]; d.K = DM; d.N = IN_COLS; d.NT = NPROJ; d.WT = (bf16*)(ws + WS_WIN); d.cscale = C2F; d.c_lo = C_FQ; d.c_hi = C_FK; d.item = r; return d; } r -= I_IN;
    if (r < I_Q) { d.W = a.in[5]; d.K = 256; d.N = 768; d.NT = 768; d.WT = (bf16*)(ws + WS_WQ); d.kscale = a.in[4]; d.cscale = C2M; d.c_lo = 0; d.c_hi = 768; d.item = r; return d; } r -= I_Q;
    if (r < I_KV) { d.W = a.in[7]; d.K = 128; d.N = 1024; d.NT = 1024; d.WT = (bf16*)(ws + WS_WKV); d.kscale = a.in[6]; d.item = r; return d; } r -= I_KV;
    if (r < I_SQ) { d.W = a.in[11]; d.K = DM; d.N = DM; d.NT = DM; d.WT = (bf16*)(ws + WS_WO); d.kscale = a.in[9]; d.kscale2 = a.in[10]; d.item = r; return d; } r -= I_SQ;
    if (r < I_SQ) { d.W = a.in[14]; d.K = DM; d.N = DM; d.NT = DM; d.WT = (bf16*)(ws + WS_WXQ); d.kscale = a.in[12]; d.cscale = C2X * WXQ8_SCALE; d.c_lo = 0; d.c_hi = DM; d.f8 = true; d.item = r; return d; } r -= I_SQ;
    if (r < I_SQ) { d.W = a.in[16]; d.K = DM; d.N = DM; d.NT = DM; d.WT = (bf16*)(ws + WS_WXO); d.cscale = WXO8_SCALE; d.c_lo = 0; d.c_hi = DM; d.f8 = true; d.item = r; return d; } r -= I_SQ;
    d.W = a.in[15]; d.K = DM; d.N = 2048; d.NT = 2048; d.WT = (bf16*)(ws + WS_WMKV); d.item = r; return d;
}
constexpr int P0_NITEMS = 16 * 64 + 4 * 24 + 2 * 32 + 3 * 16 * 32 + 16 * 64 + NEXP * 16 * 64 + NEXP * 16 * 32;
constexpr int MOE_ITEMS = NEXP * 16 * 64 + NEXP * 16 * 32;
constexpr int WCHUNKS = 256, WCH_ITEMS = MOE_ITEMS / WCHUNKS;
__device__ __forceinline__ void rms_rows2_to_bf16(const float* x0, const float* x1, const float* g, bf16* o0, bf16* o1, int lane, float* rms = nullptr) {
    const f32x4* xa = (const f32x4*)x0 + lane; const f32x4* xb = (const f32x4*)x1 + lane; const f32x4* gr = (const f32x4*)g + lane;
    f32x4 va[4], vb[4]; float sa = 0.f, sb = 0.f;
#pragma unroll
    for (int j = 0; j < 4; ++j) { va[j] = __builtin_nontemporal_load(xa + 64 * j); vb[j] = __builtin_nontemporal_load(xb + 64 * j); }
#pragma unroll
    for (int j = 0; j < 4; ++j) { sa += sum4sq(va[j]); sb += sum4sq(vb[j]); }
    const float ra = rsqrtf(wave_sum(sa) * (1.f / DM) + EPS), rb = rsqrtf(wave_sum(sb) * (1.f / DM) + EPS);
    if (rms && lane == 0) { rms[0] = 1.f / ra; rms[1] = 1.f / rb; }
#pragma unroll
    for (int j = 0; j < 4; ++j) { const f32x4 gg = gr[64 * j]; st_bf4(o0 + 4 * lane + 256 * j, va[j] * ra * gg); st_bf4(o1 + 4 * lane + 256 * j, vb[j] * rb * gg); }
}
__device__ __forceinline__ void p0_items(const MegaArgs& a, LAS float* scr, int lane, int first, const int end, const int step) {
    f32x4 va[8], vb[8]; int it = first;
    if (it < end) { P0Item da = p0_decode(a, it); p0_load(da, va, lane);
        for (;;) {
            const int itb = it + step; P0Item db; const bool hb = itb < end; if (hb) { db = p0_decode(a, itb); p0_load(db, vb, lane); }
            p0_finish(da, va, scr, lane);
            if (!hb) break;
            const int ita = itb + step; const bool ha = ita < end; if (ha) { da = p0_decode(a, ita); p0_load(da, va, lane); }
            p0_finish(db, vb, scr, lane);
            if (!ha) break;
            it = ita;
        } }
}
__device__ __forceinline__ void p0_items4(const MegaArgs& a, LAS float* scr, int lane, int first, const int end, const int step) {
    f32x4 v0[8], v1[8], v2[8], v3[8], v4[8], v5[8]; P0Item d0, d1, d2, d3, d4, d5; int it = first;
#define P0_PRE(k, D, V) if (it + (k) * step < end) { D = p0_decode(a, it + (k) * step); p0_load(D, V, lane); }
#define P0_STEP(k, D, V) if (!(it + (k) * step < end)) break; p0_finish(D, V, scr, lane); if (it + ((k) + 6) * step < end) { D = p0_decode(a, it + ((k) + 6) * step); p0_load(D, V, lane); }
    P0_PRE(0, d0, v0) P0_PRE(1, d1, v1) P0_PRE(2, d2, v2) P0_PRE(3, d3, v3) P0_PRE(4, d4, v4) P0_PRE(5, d5, v5)
    for (;;) { P0_STEP(0, d0, v0) P0_STEP(1, d1, v1) P0_STEP(2, d2, v2) P0_STEP(3, d3, v3) P0_STEP(4, d4, v4) P0_STEP(5, d5, v5) it += 6 * step; }
#undef P0_PRE
#undef P0_STEP
}
__device__ __forceinline__ void p0_chunk(const Frame& F, const MegaArgs& a, int chunk) {
    LAS float* scr = (LAS float*)(F.lds + F.wave * 16384); int lane = lane_id(); asm volatile("" : "+v"(lane));
    p0_items4(a, scr, lane, chunk * WCH_ITEMS + F.wave, (chunk + 1) * WCH_ITEMS, NWAVES);
    __syncthreads();
}
__device__ __forceinline__ void p0_prologue(const Frame& F, const MegaArgs& a) {
    LAS float* scr = (LAS float*)(F.lds + F.wave * 16384);
    int lane = lane_id(); asm volatile("" : "+v"(lane)); const int gw = F.vcu * NWAVES + F.wave, NGW = F.G * NWAVES;
    unsigned char* ws = a.ws;
    p0_items(a, scr, lane, MOE_ITEMS + gw, P0_NITEMS, NGW);
    for (int m = 2 * gw; m < T; m += 2 * NGW) rms_rows2_to_bf16(a.in[0] + (size_t)m * DM, a.in[0] + (size_t)(m + 1) * DM, a.in[2], (bf16*)(ws + WS_XN) + (size_t)m * DM, (bf16*)(ws + WS_XN) + (size_t)(m + 1) * DM, lane, (float*)(ws + WS_RMSX) + m);
    for (int m = 2 * gw; m < TM; m += 2 * NGW) rms_rows2_to_bf16(a.in[1] + (size_t)m * DM, a.in[1] + (size_t)(m + 1) * DM, a.in[13], (bf16*)(ws + WS_MEMN) + (size_t)m * DM, (bf16*)(ws + WS_MEMN) + (size_t)(m + 1) * DM, lane);
    { float* tab = (float*)(ws + WS_ROPE); for (int i = gw * 64 + lane; i < 4096 * 16; i += NGW * 64) { const int pos = i >> 4, j = i & 15; const float inv = powf(10000.f, -(float)j / 16.f); const float ang = (float)pos * inv; tab[2 * i] = cosf(ang); tab[2 * i + 1] = sinf(ang); } }
    { bf16* wh = (bf16*)(ws + WS_WRG); bf16* wl = wh + DM * NEXP;
      for (int i = gw * 64 + lane; i < DM * NEXP; i += NGW * 64) { const float w = a.in[18][i] * a.in[17][i >> 5]; const bf16 h = f2bf(w); const int o_ = (i & 31) * DM + (i >> 5); wh[o_] = h; wl[o_] = f2bf(w - bf2f(h)); } }
}
__device__ __forceinline__ void p2_scan_item(const float* LF, float* cum, bf16* kaug, int item, int lane) {
    const int b = item >> 3, ck = item & 7; const float* base = LF + (size_t)b * SEQ * 8;
    float carry[8];
#pragma unroll
    for (int h = 0; h < 8; ++h) carry[h] = 0.f;
    for (int p = lane; p < ck * 512; p += 64) { const f32x4 x0 = *(const f32x4*)(base + (size_t)p * 8), x1 = *(const f32x4*)(base + (size_t)p * 8 + 4);
#pragma unroll
        for (int e = 0; e < 4; ++e) { carry[e] += x0[e]; carry[4 + e] += x1[e]; } }
#pragma unroll
    for (int h = 0; h < 8; ++h) carry[h] = wave_sum(carry[h]);
    const int s0 = ck * 512 + lane * 8;
    float v[8][8];
#pragma unroll
    for (int i = 0; i < 8; ++i) { const f32x4 x0 = *(const f32x4*)(base + (size_t)(s0 + i) * 8), x1 = *(const f32x4*)(base + (size_t)(s0 + i) * 8 + 4);
#pragma unroll
        for (int e = 0; e < 4; ++e) { v[i][e] = x0[e]; v[i][4 + e] = x1[e]; } }
#pragma unroll
    for (int h = 0; h < 8; ++h) {
#pragma unroll
        for (int i = 1; i < 8; ++i) v[i][h] += v[i - 1][h];
        float tot = v[7][h], inc = tot;
#pragma unroll
        for (int o = 1; o < 64; o <<= 1) { const float up = __shfl_up(inc, o); if (lane >= o) inc += up; }
        const float off = carry[h] + (inc - tot);
#pragma unroll
        for (int i = 0; i < 8; ++i) v[i][h] += off;
    }
#pragma unroll
    for (int h = 0; h < 8; ++h) {
        float* cr = cum + (size_t)(b * 8 + h) * SEQ + s0; *(f32x4*)cr = (f32x4){v[0][h], v[1][h], v[2][h], v[3][h]}; *(f32x4*)(cr + 4) = (f32x4){v[4][h], v[5][h], v[6][h], v[7][h]};
        bf16* kr = kaug + ((size_t)(b * 8 + h) * SEQ + s0) * 8;
#pragma unroll
        for (int i = 0; i < 8; ++i) { const float x = -v[i][h] * LOG2E; const unsigned hi = cvtpk(x, 0.f) & 0xffffu; const float r1 = x - __uint_as_float(hi << 16); const unsigned mid = cvtpk(r1, 0.f) & 0xffffu;
            const float r2 = r1 - __uint_as_float(mid << 16); const unsigned lo = cvtpk(r2, 0.f) & 0xffffu; *(u32x4*)(kr + i * 8) = (u32x4){hi | (mid << 16), lo, 0u, 0u}; }
    }
}

struct EpiGateUp {
    static constexpr bool PERM = true, MID = false;
    const float* bias; unsigned char* ACT8;
    __device__ __forceinline__ void act(const f32x4 (&a4)[2][2], const f32x4 (&bv)[2][2], unsigned (&w)[2]) const {
        const f32x4 sv = (f32x4){1.f / W8_SCALE, ACT8_SCALE / W8_SCALE, 1.f / W8_SCALE, ACT8_SCALE / W8_SCALE};
#pragma unroll
        for (int bj = 0; bj < 2; ++bj) { const f32x4 v0 = a4[bj][0] * sv + bv[bj][0], v1 = a4[bj][1] * sv + bv[bj][1];
            const f32x4 G = (f32x4){fminf(v0[0], 7.f), fminf(v0[2], 7.f), fminf(v1[0], 7.f), fminf(v1[2], 7.f)};
            const f32x4 L = (f32x4){__builtin_amdgcn_fmed3f(v0[1], -6.f * ACT8_SCALE, 8.f * ACT8_SCALE), __builtin_amdgcn_fmed3f(v0[3], -6.f * ACT8_SCALE, 8.f * ACT8_SCALE),
                                    __builtin_amdgcn_fmed3f(v1[1], -6.f * ACT8_SCALE, 8.f * ACT8_SCALE), __builtin_amdgcn_fmed3f(v1[3], -6.f * ACT8_SCALE, 8.f * ACT8_SCALE)};
            const f32x4 tt = G * (-1.702f * LOG2E);
            const f32x4 dd = (f32x4){__builtin_amdgcn_exp2f(tt[0]), __builtin_amdgcn_exp2f(tt[1]), __builtin_amdgcn_exp2f(tt[2]), __builtin_amdgcn_exp2f(tt[3])} + 1.f;
            const f32x4 rr = (f32x4){__builtin_amdgcn_rcpf(dd[0]), __builtin_amdgcn_rcpf(dd[1]), __builtin_amdgcn_rcpf(dd[2]), __builtin_amdgcn_rcpf(dd[3])};
            const f32x4 a = (G * rr) * L;
            int x = 0; x = __builtin_amdgcn_cvt_pk_fp8_f32(a[0], a[1], x, false); x = __builtin_amdgcn_cvt_pk_fp8_f32(a[2], a[3], x, true); w[bj] = (unsigned)x; }
    }
    __device__ __forceinline__ void operator()(f32x4 (&acc)[2][2][4][2], const pg8::Unit& u, int wr, int wc, int fr, int fq) const {
        asm volatile("" : "+v"(fr), "+v"(fq));
        const int c0 = u.col0 + wc * 32 + fq * 8; const float* bp = bias + (size_t)u.e * 2048 + c0;
        const f32x4 bm = (f32x4){1.f, ACT8_SCALE, 1.f, ACT8_SCALE}, ba = (f32x4){0.f, ACT8_SCALE, 0.f, ACT8_SCALE};
        f32x4 bv[2][2];
#pragma unroll
        for (int bj = 0; bj < 2; ++bj) { bv[bj][0] = *(const f32x4*)(bp + bj * 128) * bm + ba; bv[bj][1] = *(const f32x4*)(bp + bj * 128 + 4) * bm + ba; }
#pragma unroll
        for (int ai = 0; ai < 2; ++ai)
#pragma unroll
            for (int mp = 0; mp < 2; ++mp) {
                asm volatile("" : "+v"(acc[ai][0][2 * mp][0]), "+v"(acc[ai][0][2 * mp][1]), "+v"(acc[ai][1][2 * mp][0]), "+v"(acc[ai][1][2 * mp][1]));
                unsigned d[2][2];
#pragma unroll
                for (int q = 0; q < 2; ++q) { const int m = 2 * mp + q; unsigned w[2]; const f32x4 a4[2][2] = {{acc[ai][0][m][0], acc[ai][0][m][1]}, {acc[ai][1][m][0], acc[ai][1][m][1]}}; act(a4, bv, w);
                    const auto r = __builtin_amdgcn_permlane16_swap(w[0], w[1], false, false); d[q][0] = r[0]; d[q][1] = r[1]; }
                const auto r0 = __builtin_amdgcn_permlane32_swap(d[0][0], d[1][0], false, false), r1 = __builtin_amdgcn_permlane32_swap(d[0][1], d[1][1], false, false);
                int f2 = fr, q2 = fq; asm volatile("" : "+v"(f2), "+v"(q2));
                const int rl = ai * 128 + wr * 64 + (2 * mp + (q2 >> 1)) * 16 + f2; const unsigned rowi = rl < u.rows ? (unsigned)(u.row0 + rl) : (unsigned)(T * 4 + rl);
                *(u32x4*)(ACT8 + (rowi * (unsigned)DEXP + (unsigned)((u.col0 >> 1) + wc * 16 + (q2 & 1) * 64))) = (u32x4){r0[0], r1[0], r0[1], r1[1]};
                asm volatile("" ::: "memory"); }
    }
};
struct EpiDown {
    static constexpr bool PERM = true, MID = false;
    const float* bias; const float* gsort; const int* list0; unsigned char* Y8;
    __device__ __forceinline__ void operator()(f32x4 (&acc)[2][2][4][2], const pg8::Unit& u, int wr, int wc, int fr, int fq) const {
        asm volatile("" : "+v"(fr), "+v"(fq));
        const int c0 = u.col0 + wc * 32 + fq * 8; const float* bp = bias + (size_t)u.e * DM + c0;
        const float* gp = gsort + (u.list - list0) + wr * 64 + fq * 16 + fr;
        const float g0 = gp[0] * Y8_SCALE, g1 = gp[128] * Y8_SCALE;
        f32x4 bv[2][2];
#pragma unroll
        for (int bj = 0; bj < 2; ++bj) { bv[bj][0] = *(const f32x4*)(bp + bj * 128); bv[bj][1] = *(const f32x4*)(bp + bj * 128 + 4); }
#pragma unroll
        for (int g = 0; g < 8; ++g) { const int ai = g >> 2, m = g & 3;
                int f2 = fr, q2 = fq; asm volatile("" : "+v"(f2), "+v"(q2));
                const float gg = __int_as_float(__builtin_amdgcn_ds_bpermute(4 * (m * 16 + f2), __float_as_int(ai ? g1 : g0)));
                const int rl = ai * 128 + wr * 64 + m * 16 + f2; const unsigned rowi = rl < u.rows ? (unsigned)(u.row0 + rl) : (unsigned)(T * 4 + rl);
                unsigned w[2][2];
#pragma unroll
                for (int bj = 0; bj < 2; ++bj) { const f32x4 v0 = (acc[ai][bj][m][0] * (1.f / (W8_SCALE * ACT8_SCALE)) + bv[bj][0]) * gg, v1 = (acc[ai][bj][m][1] * (1.f / (W8_SCALE * ACT8_SCALE)) + bv[bj][1]) * gg;
                    int w0 = 0, w1 = 0; w0 = __builtin_amdgcn_cvt_pk_fp8_f32(v0[0], v0[1], w0, false); w0 = __builtin_amdgcn_cvt_pk_fp8_f32(v0[2], v0[3], w0, true);
                    w1 = __builtin_amdgcn_cvt_pk_fp8_f32(v1[0], v1[1], w1, false); w1 = __builtin_amdgcn_cvt_pk_fp8_f32(v1[2], v1[3], w1, true); w[bj][0] = (unsigned)w0; w[bj][1] = (unsigned)w1; }
                const auto r0 = __builtin_amdgcn_permlane16_swap(w[0][0], w[1][0], false, false), r1 = __builtin_amdgcn_permlane16_swap(w[0][1], w[1][1], false, false);
                *(u32x4*)(Y8 + (rowi * (unsigned)DM + (unsigned)(u.col0 + wc * 32 + ((q2 & 1) ? 128 + 8 * (q2 - 1) : 8 * q2)))) = (u32x4){r0[0], r1[0], r0[1], r1[1]};
                asm volatile("" ::: "memory");
            }
    }
};
struct MoeSched {
    pg8::TileOrder o; const volatile LAS int* tpre; const volatile LAS int* roff;
    const char* A; size_t a_row_bytes; const char* Wt; size_t w_exp_bytes; int brow; const int* list; bool gather;
    __device__ __forceinline__ void tables(const volatile LAS int* tp, const volatile LAS int* ro) { tpre = tp; roff = ro; }
    __device__ __forceinline__ bool next(int i, pg8::Unit& u) const { int pm, pn; if (!o.tile(i, pm, pn)) return false;
        int l = lane_id(); const int j = l < 32 ? l : 32; const int tv = tpre[j], rv = roff[j];
        const unsigned long long mk = __ballot(l >= 1 && l < NEXP && tv <= pm); const int e = __builtin_popcountll(mk);
        const int tp = __builtin_amdgcn_readlane(tv, e), r0 = __builtin_amdgcn_readlane(rv, e), r1 = __builtin_amdgcn_readlane(rv, e + 1);
        const int mt = pm - tp, cnt = r1 - r0; u.row0 = r0 + mt * 256; u.rows = (cnt - mt * 256) < 256 ? (cnt - mt * 256) : 256; u.col0 = pn * 256; u.pn = pn; u.e = e;
        u.a = gather ? A : A + (size_t)u.row0 * a_row_bytes; u.b = Wt + (size_t)e * w_exp_bytes + (size_t)pn * 256 * brow; u.list = list + (size_t)e * T + mt * 256; return true; }
};
__device__ __forceinline__ int moe_tables(const Frame& F, const int* cnt) {
    volatile LAS int* tp = (volatile LAS int*)(F.MISC + 64); volatile LAS int* ro = (volatile LAS int*)(F.MISC + 128);
    __syncthreads();
    if (F.wave == 0 && lane_id() == 0) { int t = 0, r = 0; for (int e = 0; e < NEXP; ++e) { const int c = __hip_atomic_load(cnt + e, __ATOMIC_RELAXED, __HIP_MEMORY_SCOPE_AGENT); tp[e] = t; ro[e] = r; t += (c + 255) >> 8; r += c; } tp[NEXP] = t; ro[NEXP] = r; }
    __syncthreads();
    return __builtin_amdgcn_readfirstlane(tp[NEXP]);
}
__device__ __forceinline__ void p7_route(const Frame& F, const MegaArgs& a, const size_t dummy) {
    unsigned char* ws = a.ws; const float* wrg = (const float*)(ws + WS_WRG); const bf16* h2 = (const bf16*)(ws + WS_XN); const float* gln = a.in[17]; const float* br = a.in[19];
    unsigned char* XF8 = ws + WS_XF8 + dummy; int* cnt = (int*)(ws + WS_CTL) + CW_CNT + (dummy ? 64 : 0);   const size_t d2 = dummy ? (WS_QM - WS_TOPI) : 0; int* topi = (int*)(ws + WS_TOPI + d2); float* gate = (float*)(ws + WS_GATE + d2); int* slot = (int*)(ws + WS_SLOT + d2); int* list = (int*)(ws + WS_LIST + d2); float* gsort = (float*)(ws + WS_GSORT + (dummy ? 8 * MiB : 0));
    LAS float* W = (LAS float*)F.lds; int tid = (F.wave << 6) | lane_id(); asm volatile("" : "+v"(tid)); const int lane = tid & 63;
    volatile LAS int* lcnt = (volatile LAS int*)(F.MISC + 16); volatile LAS int* lbase = (volatile LAS int*)(F.MISC + 192); LAS int* rec = (LAS int*)(F.MISC + 256);
    { const bf16* wh = (const bf16*)wrg; LAS unsigned char* Wb = F.lds;
      for (int idx = tid; idx < 8192; idx += NWAVES * 64) { const int pc = idx >> 12, R = (idx >> 5) & 127, c = idx & 31, kq_ = R >> 5, e = R & 31;
          *(LAS u32x4*)(Wb + pc * 65536 + R * 512 + ((c ^ (R & 15)) << 4)) = *(const u32x4*)(wh + (size_t)pc * DM * NEXP + e * DM + 32 * c + 8 * kq_); } }
    if (tid < NEXP) lcnt[tid] = 0;
    __syncthreads();
    const int TPB = T / F.G, t0 = F.vcu * TPB, TPW = TPB / NWAVES;
    const int li = lane & 15, kq = lane >> 4, tw0 = t0 + F.wave * TPW;
    float rs;
    f32x4 d0 = (f32x4){0.f, 0.f, 0.f, 0.f}, d1 = (f32x4){0.f, 0.f, 0.f, 0.f};
    { const bf16* xrow = h2 + (size_t)(tw0 + li) * DM + 8 * kq; const LAS unsigned char* w0 = F.lds + (kq * 32 + li) * 512;
      float ssq = 0.f;
#pragma unroll
      for (int c = 0; c < 4; ++c) { u32x4 xr[8];
#pragma unroll
          for (int u = 0; u < 8; ++u) xr[u] = *(const u32x4*)(xrow + 32 * (8 * c + u));
#pragma unroll
          for (int u = 0; u < 8; ++u) { const int sw = ((8 * c + u) ^ li) << 4; const bf16x8 av = __builtin_bit_cast(bf16x8, xr[u]);
              const bf16x8 bh0 = *(const LAS bf16x8*)(w0 + sw), bl0 = *(const LAS bf16x8*)(w0 + 65536 + sw), bh1 = *(const LAS bf16x8*)(w0 + 8192 + sw), bl1 = *(const LAS bf16x8*)(w0 + 65536 + 8192 + sw);
              d0 = __builtin_amdgcn_mfma_f32_16x16x32_bf16(av, bh0, d0, 0, 0, 0); d1 = __builtin_amdgcn_mfma_f32_16x16x32_bf16(av, bh1, d1, 0, 0, 0);
              d0 = __builtin_amdgcn_mfma_f32_16x16x32_bf16(av, bl0, d0, 0, 0, 0); d1 = __builtin_amdgcn_mfma_f32_16x16x32_bf16(av, bl1, d1, 0, 0, 0);
#pragma unroll
              for (int j = 0; j < 4; ++j) { const float xl = __uint_as_float(xr[u][j] << 16), xh = __uint_as_float(xr[u][j] & 0xffff0000u); ssq += xl * xl + xh * xh; } } }
      ssq += __shfl_xor(ssq, 16); ssq += __shfl_xor(ssq, 32); rs = rsqrtf(ssq * (1.f / DM) + EPS); }
    { const float b0 = br[li], b1 = br[li + 16];
#pragma unroll
      for (int r = 0; r < 4; ++r) { const float rt = __shfl(rs, 4 * kq + r); float c0 = d0[r] * rt + b0, c1 = d1[r] * rt + b1;
        float tv[4]; int ti[4];
#pragma unroll
        for (int k = 0; k < 4; ++k) { float bv = c0; int bi = li; if (c1 > c0) { bv = c1; bi = li + 16; }
#pragma unroll
            for (int o = 1; o < 16; o <<= 1) { const float ov = __shfl_xor(bv, o); const int oi = __shfl_xor(bi, o); if (ov > bv || (ov == bv && oi < bi)) { bv = ov; bi = oi; } }
            tv[k] = bv; ti[k] = bi; if (bi == li) c0 = -INFINITY; if (bi == li + 16) c1 = -INFINITY; }
        const float e1 = __expf(tv[1] - tv[0]), e2 = __expf(tv[2] - tv[0]), e3 = __expf(tv[3] - tv[0]); const float inv = 1.f / (1.f + e1 + e2 + e3);
        const float gs[4] = {inv, e1 * inv, e2 * inv, e3 * inv};
        const int tok = F.wave * TPW + 4 * kq + r;
#pragma unroll
        for (int k = 0; k < 4; ++k) if ((ti[k] & 15) == li) { const int ex = ti[k]; const int ls = __hip_atomic_fetch_add((LAS int*)(lcnt + ex), 1, __ATOMIC_RELAXED, __HIP_MEMORY_SCOPE_WORKGROUP); LAS int* rr = rec + (tok * 4 + k) * 3; rr[0] = ex; rr[1] = __float_as_int(gs[k]); rr[2] = ls; } } }
    { f32x4 gv[4];
#pragma unroll
      for (int j = 0; j < 4; ++j) gv[j] = *(const f32x4*)(gln + 16 * lane + 4 * j);
#pragma unroll
      for (int tb = 0; tb < 16; tb += 8) { u32x4 xw[8][2];
#pragma unroll
          for (int tt = 0; tt < 8; ++tt)
#pragma unroll
              for (int j = 0; j < 2; ++j) xw[tt][j] = *(const u32x4*)(h2 + (size_t)(tw0 + tb + tt) * DM + 16 * lane + 8 * j);
#pragma unroll
          for (int tt = 0; tt < 8; ++tt) { const float rt = __shfl(rs, tb + tt); u32x4 f;
#pragma unroll
              for (int j = 0; j < 4; ++j) { const unsigned a0 = xw[tt][j >> 1][(j & 1) * 2], a1 = xw[tt][j >> 1][(j & 1) * 2 + 1];
                  const f32x4 y = (f32x4){__uint_as_float(a0 << 16), __uint_as_float(a0 & 0xffff0000u), __uint_as_float(a1 << 16), __uint_as_float(a1 & 0xffff0000u)} * rt * gv[j];
                  int w = 0; w = __builtin_amdgcn_cvt_pk_fp8_f32(y[0], y[1], w, false); w = __builtin_amdgcn_cvt_pk_fp8_f32(y[2], y[3], w, true); f[j] = (unsigned)w; }
              *(u32x4*)(XF8 + (size_t)(tw0 + tb + tt) * DM + 16 * lane) = f; } } }
    __syncthreads();
    if (tid < NEXP) lbase[tid] = atomicAdd(cnt + tid, (int)lcnt[tid]);
    __syncthreads();
    for (int idx = tid; idx < TPB * 4; idx += NWAVES * 64) { const LAS int* r = rec + idx * 3; const int e = r[0], sl = lbase[e] + r[2]; const int gi = t0 * 4 + idx;
        topi[gi] = e; gate[gi] = __int_as_float(r[1]); slot[gi] = sl; list[(size_t)e * T + sl] = gi; gsort[(size_t)e * T + sl] = __int_as_float(r[1]); }
}
__device__ __forceinline__ void p10_combine(const Frame& F, const MegaArgs& a, float* dst) {
    unsigned char* ws = a.ws; const unsigned char* Y8 = ws + WS_Y; const bf16* h2 = (const bf16*)(ws + WS_XN); const int* topi = (const int*)(ws + WS_TOPI); const int* slot = (const int*)(ws + WS_SLOT); const float* g = a.in[24];
    const volatile LAS int* ro = (const volatile LAS int*)(F.MISC + 128); int lane = lane_id(); asm volatile("" : "+v"(lane));
    const int t0 = F.vcu * NWAVES + F.wave, ts = F.G * NWAVES;
    f32x4 gv[4];
#pragma unroll
    for (int j = 0; j < 4; ++j) gv[j] = *(const f32x4*)(g + 16 * lane + 4 * j);
    constexpr int NB = 3;
    u32x4 yn[NB][4], hn[NB][2]; int en[NB], sn[NB];
#define P10_IDX(bt) do { _Pragma("unroll") for (int q_ = 0; q_ < NB; ++q_) { const int tt_ = (bt) + q_ * ts; en[q_] = 0; sn[q_] = 0; if (tt_ < T && lane < 4) { en[q_] = topi[tt_ * 4 + lane]; sn[q_] = slot[tt_ * 4 + lane]; } } } while (0)
#define P10_LOAD(bt) do { _Pragma("unroll") for (int q_ = 0; q_ < NB; ++q_) { const int tt_ = (bt) + q_ * ts; if (tt_ < T) { \
        const int pl_ = (lane < 4 ? ro[en[q_]] : 0) + sn[q_]; \
        _Pragma("unroll") for (int k = 0; k < 4; ++k) { const size_t pos = (size_t)__builtin_amdgcn_readlane(pl_, k); yn[q_][k] = *(const u32x4*)(Y8 + pos * DM + 16 * lane); } \
        _Pragma("unroll") for (int j = 0; j < 2; ++j) hn[q_][j] = *(const u32x4*)(h2 + (size_t)tt_ * DM + 16 * lane + 8 * j); } } } while (0)
    P10_IDX(t0); P10_LOAD(t0); P10_IDX(t0 + NB * ts);
    for (int tb = t0; tb < T; tb += NB * ts) {
        u32x4 y[NB][4], hw[NB][2];
#pragma unroll
        for (int q = 0; q < NB; ++q) {
#pragma unroll
            for (int k = 0; k < 4; ++k) y[q][k] = yn[q][k];
#pragma unroll
            for (int j = 0; j < 2; ++j) hw[q][j] = hn[q][j]; }
        if (tb + NB * ts < T) { P10_LOAD(tb + NB * ts); P10_IDX(tb + 2 * NB * ts); }
#pragma unroll
        for (int q = 0; q < NB; ++q) { const int t = tb + q * ts; if (t < T) {
            f32x4 v[4];
#pragma unroll
            for (int j = 0; j < 4; ++j) { f32x4 ys = (f32x4){0.f, 0.f, 0.f, 0.f};
#pragma unroll
                for (int k = 0; k < 4; ++k) { const f32x2 lo = __builtin_amdgcn_cvt_pk_f32_fp8((int)y[q][k][j], false), hi = __builtin_amdgcn_cvt_pk_f32_fp8((int)y[q][k][j], true); ys[0] += lo.x; ys[1] += lo.y; ys[2] += hi.x; ys[3] += hi.y; }
                const unsigned w0 = hw[q][j >> 1][(j & 1) * 2], w1 = hw[q][j >> 1][(j & 1) * 2 + 1];
                v[j] = (f32x4){__uint_as_float(w0 << 16), __uint_as_float(w0 & 0xffff0000u), __uint_as_float(w1 << 16), __uint_as_float(w1 & 0xffff0000u)} + ys * (1.f / Y8_SCALE); }
            float sq = 0.f;
#pragma unroll
            for (int j = 0; j < 4; ++j) sq += sum4sq(v[j]);
            const float r = rsqrtf(wave_sum(sq) * (1.f / DM) + EPS);
#pragma unroll
            for (int j = 0; j < 4; ++j) *(f32x4*)(dst + (size_t)t * DM + 16 * lane + 4 * j) = v[j] * r * gv[j]; } }
    }
#undef P10_LOAD
#undef P10_IDX
}
__global__ void __launch_bounds__(NWAVES * 64, 2) mega_fwd(MegaArgs args) {
    extern __shared__ __attribute__((aligned(16))) unsigned char lds_raw[];
    Frame F;
    F.lds = (LAS unsigned char*)lds_raw; F.MISC = (volatile LAS unsigned*)(F.lds + MISC_OFF); F.tabs = (LAS unsigned*)(F.lds + TABS_OFF);
    F.wave = __builtin_amdgcn_readfirstlane((int)threadIdx.x >> 6);
    F.G = gridDim.x; { const int bx = blockIdx.x; F.vcu = (F.G % 8 == 0) ? (bx % 8) * (F.G / 8) + bx / 8 : bx; }
    unsigned char* ws = args.ws;
    unsigned* ctl = (unsigned*)(ws + WS_CTL);
    for (int u = (F.wave << 6) | lane_id(); u < (LDS_BYTES - MISC_OFF) / 4; u += NWAVES * 64) ((LAS unsigned*)(F.lds + MISC_OFF))[u] = 0u;
    __syncthreads();
    XcdBarrier bar; bar.bar = ctl + CW_BAR; bar.x = 0; bar.st = nullptr; bar.wave0 = false;
    if (args.coop) bar = xcd_barrier_post(ctl + CW_BAR, F.MISC + 8, F.wave);
    const int lo = args.ph_lo, hi = args.ph_hi;
#define IN(k) (lo <= (k) && (k) < hi)
#define SEAM(k) do { if (args.coop && IN(k) && IN((k) + 1)) { xcd_barrier(bar); if ((PROBE_REP) == 100) xcd_barrier(bar); } } while (0)
    bf16 *WinT = (bf16*)(ws + WS_WIN), *WqT = (bf16*)(ws + WS_WQ), *WkvT = (bf16*)(ws + WS_WKV), *WmkvT = (bf16*)(ws + WS_WMKV);
    bf16 *XN = (bf16*)(ws + WS_XN), *PROJ = (bf16*)(ws + WS_PROJ), *QM = (bf16*)(ws + WS_QM), *KVM = (bf16*)(ws + WS_KVM), *MEMN = (bf16*)(ws + WS_MEMN), *KVMEM = (bf16*)(ws + WS_KVMEM);
    float *rope = (float*)(ws + WS_ROPE), *ssqq = (float*)(ws + WS_SSQQ), *ssqkv = (float*)(ws + WS_SSQKV), *LF = (float*)(ws + WS_LF);

    if (IN(0)) { REPS(0) p0_prologue(F, args); }
    if (args.coop == 2) cg::this_grid().sync();
    SEAM(0);
    if (IN(1)) REPS(1) {
        pg8::DenseSched S; S.init(XN, DM, WinT, T, NPROJ, DM, F.G, (int)blockIdx.x);
        EpiProj E{PROJ, ssqq, ssqkv, rope, LF, args.in[8]};
        pg8::gemm_phase<EpiProj, pg8::DenseSched, false>(F.lds, F.tabs, DM, DM, S, E, F.wave);
    }
    SEAM(1);
    if (IN(2)) REPS(2) {
        const int GA = (F.G * 3) / 4, bx = (int)blockIdx.x;
        if (bx >= GA) { const int sid = bx - GA, ns = F.G - GA;
          if (F.wave == 0) for (int it = sid; it < 64; it += ns) { int ln = lane_id(); asm volatile("" : "+v"(ln)); p2_scan_item(LF, (float*)(ws + WS_CUM), (bf16*)(ws + WS_KAUG), it, ln); }
          for (int item = sid * NWAVES + F.wave; item < BATCH * 64; item += ns * NWAVES) {
          { int ln = lane_id(); asm volatile("" : "+v"(ln)); const int b = item >> 6, t = item & 63; const bf16* kr = PROJ + ((size_t)b * SEQ + t * 64 + ln) * NPROJ + C_FK; float* KN = (float*)(ws + WS_KN);
            for (int h = 0; h < 8; ++h) { float s2 = 0.f;
#pragma unroll
                for (int c = 0; c < 8; ++c) { const u32x4 w = *(const u32x4*)(kr + h * 64 + c * 8);
#pragma unroll
                    for (int j = 0; j < 4; ++j) { const float a_ = __uint_as_float(w[j] << 16), b_ = __uint_as_float(w[j] & 0xffff0000u); s2 += a_ * a_ + b_ * b_; } }
#pragma unroll
                for (int o_ = 1; o_ < 64; o_ <<= 1) s2 = fmaxf(s2, __shfl_xor(s2, o_));
                if (ln == 0) KN[(size_t)(b * 8 + h) * 64 + t] = sqrtf(s2); } } } }
        __syncthreads();
        if (F.G >= 8 && (F.G % 32) == 0) {
            if (bx < GA) {
                { pg8::DenseSched S; S.init(PROJ + C_QLAT, NPROJ, WqT, T, 768, 256, GA, bx); EpiScale<4, true> E{QM, 768, ssqq, 1.f / 256.f, rope}; pg8::gemm_phase<EpiScale<4, true>, pg8::DenseSched, false>(F.lds, F.tabs, 256, NPROJ, S, E, F.wave); }
                { pg8::DenseSched S; S.init(PROJ + C_KVLAT, NPROJ, WkvT, T, 1024, 128, GA, bx); EpiScale<4, false> E{KVM, 1024, ssqkv, 1.f / 128.f, nullptr}; pg8::gemm_phase<EpiScale<4, false>, pg8::DenseSched, false>(F.lds, F.tabs, 128, NPROJ, S, E, F.wave); }
            } else {
                pg8::DenseSched S; S.init(MEMN, DM, WmkvT, TM, 2048, DM, F.G - GA, bx - GA); EpiMemKV E{KVMEM, ws + WS_KM8}; pg8::gemm_phase<EpiMemKV, pg8::DenseSched, false>(F.lds, F.tabs, DM, DM, S, E, F.wave);
            }
        }
    }
    SEAM(2);
    if (IN(3)) REPS(3) {
        bf16* O = (bf16*)(ws + WS_O); float* SSO = (float*)(ws + WS_SSO); const bf16* KAUG = (const bf16*)(ws + WS_KAUG);
        int upos = 0; unsigned chdone = 0u;
        for (int P = F.vcu; P < 512; P += F.G) {
            const int bh = P >> 3, pair = P & 7, b = bh >> 3, h = bh & 7;
            for (int j = 0; j < 2; ++j) {
                { const int q_ = upos & 3;
                  for (int i_ = 0; i_ < 2; ++i_) { const int ch = F.vcu + F.G * i_; if (ch < WCHUNKS && (((F.vcu & 3) + 2 * i_) & 3) == q_ && upos < 4) { p0_chunk(F, args, ch); chdone |= 1u << i_; } }
                  ++upos; }
                const int qb = j ? 15 - pair : pair; const size_t r0 = (size_t)b * SEQ, rq = r0 + (size_t)qb * 256;
                att::Src s; s.nt = 4 * (qb + 1); s.q0 = qb * 256; s.ldo = DM; s.kn = nullptr; s.cum = nullptr;
                s.q = QM + rq * 768 + h * 96; s.ldq = 768; s.k1 = KVM + r0 * 1024 + h * 128; s.ldk1 = 1024; s.k2 = PROJ + r0 * NPROJ + C_KPE; s.ldk2 = NPROJ; s.v = KVM + r0 * 1024 + h * 128 + 64; s.ldv = 1024;
                s.o = O + rq * DM + h * 64; s.sso = SSO + rq * 16 + h;
                att::unit<6, 8, 12, 2, true, false, false, true>(s, F.lds, F.wave); }
        }
        for (int i_ = 0; F.vcu + F.G * i_ < WCHUNKS; ++i_) if (i_ >= 2 || !((chdone >> i_) & 1u)) p0_chunk(F, args, F.vcu + F.G * i_);
        if (args.coop) {
            unsigned* fq = ctl + CW_FOXQ; volatile LAS unsigned* tk = F.MISC + 48; const bool lead = F.wave == 0 && lane_id() == 0;
            if (lead) tk[0] = __hip_atomic_fetch_add(fq, 1u, __ATOMIC_RELAXED, __HIP_MEMORY_SCOPE_AGENT);
            __syncthreads();
            unsigned cur = __builtin_amdgcn_readfirstlane(tk[0]);
            while (cur < 1024u) {
                unsigned nx = 0; if (lead) nx = __hip_atomic_fetch_add(fq, 1u, __ATOMIC_RELAXED, __HIP_MEMORY_SCOPE_AGENT);
                const int r = (int)(cur >> 7), qb = 15 - (int)((cur >> 3) & 15), b = (int)(cur & 7);
                const float* bfg = args.in[8]; int h = 0;
                for (int c = 0; c < 8; ++c) { int rk = 0; for (int j = 0; j < 8; ++j) rk += (bfg[j] > bfg[c] || (bfg[j] == bfg[c] && j < c)) ? 1 : 0; if (rk == r) h = c; }
                const size_t r0 = (size_t)b * SEQ, rq = r0 + (size_t)qb * 256;
                att::Src s; s.nt = 4 * (qb + 1); s.q0 = qb * 256; s.ldo = DM;
                s.q = PROJ + rq * NPROJ + C_FQ + h * 64; s.ldq = NPROJ; s.k1 = PROJ + r0 * NPROJ + C_FK + h * 64; s.ldk1 = NPROJ; s.k2 = KAUG + (size_t)(b * 8 + h) * SEQ * 8; s.ldk2 = 8; s.v = PROJ + r0 * NPROJ + C_FV + h * 64; s.ldv = NPROJ;
                s.o = O + rq * DM + 512 + h * 64; s.sso = SSO + rq * 16 + 8 + h; s.kn = (const float*)(ws + WS_KN) + (size_t)(b * 8 + h) * 64; s.cum = (const float*)(ws + WS_CUM) + (size_t)(b * 8 + h) * SEQ;
                att::unit<5, 8, 9, 2, true, true, true, true, true>(s, F.lds, F.wave);
                if (lead) tk[0] = nx;
                __syncthreads();
                cur = __builtin_amdgcn_readfirstlane(tk[0]);
            }
        }
    }
    SEAM(3);
    bf16 *WoT = (bf16*)(ws + WS_WO), *WxqT = (bf16*)(ws + WS_WXQ), *WxoT = (bf16*)(ws + WS_WXO), *XQ = (bf16*)(ws + WS_XQ), *XO = (bf16*)(ws + WS_XO);
    float* ssq1 = (float*)(ws + WS_SSQ1);
    if (IN(4)) REPS(4) {
        pg8::DenseSched S; S.init((const bf16*)(ws + WS_O), DM, WoT, T, DM, DM, F.G, (int)blockIdx.x);
        EpiWo E{(const float*)(ws + WS_SSO), (const float*)(ws + WS_RMSX), args.in[2], XN, ssq1, ws + WS_H1F8};
        pg8::gemm_phase<EpiWo, pg8::DenseSched, false>(F.lds, F.tabs, DM, DM, S, E, F.wave);
    }
    SEAM(4);
    if (IN(5)) REPS(5) {
        pg8::DenseSched S; S.init((const bf16*)(ws + WS_H1F8), DM / 2, WxqT, T, DM, DM / 2, F.G, (int)blockIdx.x);
        { EpiXQ8 E{ws + WS_XQ, ssq1, XQ8_SCALE / (H8_SCALE * WXQ8_SCALE)}; pg8::gemm_phase<EpiXQ8, pg8::DenseSched, false, true>(F.lds, F.tabs, DM, DM, S, E, F.wave); }
        asm volatile("s_waitcnt vmcnt(0)" ::: "memory"); __syncthreads();
        __builtin_amdgcn_fence(__ATOMIC_ACQUIRE, "agent"); asm volatile("s_waitcnt vmcnt(0)" ::: "memory"); __syncthreads();
        pg8::Unit u; pg8::DenseSched S2; S2.init(XN, DM, WxqT, T, DM, DM, F.G, (int)blockIdx.x);
        for (int i = 0; S2.next(i, u); ++i) {
            const int b = u.row0 / SEQ, h = u.pn;
            { att::Src s; s.kn = nullptr; s.cum = nullptr; s.nt = MEMLEN / 64; s.q0 = 0; s.q = (const bf16*)(ws + WS_XQ + (size_t)u.row0 * DM + h * 256); s.ldq = DM; s.k1 = (const bf16*)(ws + WS_KM8 + (size_t)b * MEMLEN * 1024 + h * 256); s.ldk1 = 1024; s.k2 = s.k1; s.ldk2 = 1024;
              s.v = KVMEM + (size_t)b * MEMLEN * 2048 + 1024 + h * 256; s.ldv = 2048; s.o = (bf16*)(ws + WS_XOF8 + (size_t)u.row0 * DM + h * 256); s.ldo = DM; s.sso = nullptr;
              att::xunit(s, F.lds, F.wave); }
        }
    }
    SEAM(5);
    if (IN(6)) {
        pg8::DenseSched S; S.init((const bf16*)(ws + WS_XOF8), DM / 2, WxoT, T, DM, DM / 2, F.G, (int)blockIdx.x);
        EpiAddOut E{XN, 1.f / (XO8_SCALE * WXO8_SCALE)};
        pg8::gemm_phase<EpiAddOut, pg8::DenseSched, false, true>(F.lds, F.tabs, DM, DM, S, E, F.wave);
    }
    SEAM(6);
    int* cnt = (int*)(ws + WS_CTL) + CW_CNT; const int* list = (const int*)(ws + WS_LIST);
    if (IN(7)) { if ((PROBE_REP) == 7) p7_route(F, args, (size_t)(WS_KVM - WS_XF8)); p7_route(F, args, 0); }
    SEAM(7);
    if (IN(8)) REPS(8) {
        const int nMt = moe_tables(F, cnt);
        MoeSched S; S.o.init(nMt, 2048 / 256, F.G, (int)blockIdx.x); S.tables((const volatile LAS int*)(F.MISC + 64), (const volatile LAS int*)(F.MISC + 128));
        S.A = (const char*)(ws + WS_XF8); S.a_row_bytes = 0; S.Wt = (const char*)(ws + WS_WGU); S.w_exp_bytes = (size_t)2048 * DM; S.brow = DM; S.list = list; S.gather = true;
        EpiGateUp E{args.in[21], ws + WS_ACT};
        pg8::gemm_phase<EpiGateUp, MoeSched, true, true>(F.lds, F.tabs, DM, DM, S, E, F.wave);
    }
    SEAM(8);
    if (IN(9)) REPS(9) {
        const int nMt = __builtin_amdgcn_readfirstlane(((const volatile LAS int*)(F.MISC + 64))[NEXP]);
        MoeSched S; S.o.init(nMt, DM / 256, F.G, (int)blockIdx.x); S.tables((const volatile LAS int*)(F.MISC + 64), (const volatile LAS int*)(F.MISC + 128));
        S.A = (const char*)(ws + WS_ACT); S.a_row_bytes = (size_t)DEXP; S.Wt = (const char*)(ws + WS_WD); S.w_exp_bytes = (size_t)DM * DEXP; S.brow = DEXP; S.list = list; S.gather = false;
        EpiDown E{args.in[23], (const float*)(ws + WS_GSORT), list, ws + WS_Y};
        pg8::gemm_phase<EpiDown, MoeSched, false, true>(F.lds, F.tabs, DEXP, DEXP, S, E, F.wave);
    }
    SEAM(9);
    if (IN(10)) { if ((PROBE_REP) == 10) p10_combine(F, args, (float*)(ws + WS_XQ)); p10_combine(F, args, args.out); }
#undef IN
#undef SEAM
}
extern "C" void kernel_launch(void* const* d_in, const int* in_sizes, int n_in, void* d_out, int out_size, void* d_ws, size_t ws_size, hipStream_t stream) {
    if (n_in != 25 || ws_size < WS_END || out_size != T * DM) { fprintf(stderr, "kernel_launch: unexpected shapes n_in %d ws %zu out %d\n", n_in, ws_size, out_size); return; }
    static int grid = 0;
    if (grid == 0) {
        int dev = 0, cus = 0, per_cu = 0;
        if (hipGetDevice(&dev) != hipSuccess || hipDeviceGetAttribute(&cus, hipDeviceAttributeMultiprocessorCount, dev) != hipSuccess) { fprintf(stderr, "kernel_launch: device query failed\n"); grid = -1; return; }
        if (hipFuncSetAttribute((const void*)mega_fwd, hipFuncAttributeMaxDynamicSharedMemorySize, LDS_BYTES) != hipSuccess) { fprintf(stderr, "kernel_launch: hipFuncSetAttribute failed\n"); grid = -1; return; }
        if (hipOccupancyMaxActiveBlocksPerMultiprocessor(&per_cu, (const void*)mega_fwd, NWAVES * 64, LDS_BYTES) != hipSuccess || per_cu < 1) { fprintf(stderr, "kernel_launch: occupancy query says %d blocks per CU\n", per_cu); (void)hipGetLastError(); grid = -1; return; }
        grid = cus;
    }
    if (grid < 0) return;
    (void)hipMemsetAsync((char*)d_ws + WS_CTL, 0, 1 * MiB, stream);
    MegaArgs a{}; for (int i = 0; i < 25; ++i) a.in[i] = (const float*)d_in[i]; a.out = (float*)d_out; a.ws = (unsigned char*)d_ws; a.ph_lo = 0; a.ph_hi = N_PHASES; a.coop = 1;
    void* params[] = {&a};
    const hipError_t e = hipLaunchCooperativeKernel((const void*)mega_fwd, dim3(grid), dim3(NWAVES * 64), params, LDS_BYTES, stream);
    if (e != hipSuccess) fprintf(stderr, "cooperative launch failed: %s (grid %d)\n", hipGetErrorString(e), grid);
}
```
